# Optimizing an MI355X kernel written in HIP

```python
import math
import jax, jax.numpy as jnp
from jax import lax
import numpy as np

D_MODEL = 1024
BATCH = 4
SEQ = 4096
DEPTH = 2

CHUNK = 64
EXPAND = 2
D_MIX = EXPAND * D_MODEL
N_GROUPS = 4
G = D_MIX // N_GROUPS
HEAD_DIM = 64
N_HEADS = G // HEAD_DIM
CONV_W = 4
LORA_W = 64
LORA_A = 64
RWKV_SHIFT = 3 * G + LORA_W + LORA_A
LRU_C = 8.0
W_DECAY_SCALE = 0.606531
ROPE_THETA = 10000.0
NORM_EPS = 1e-6
GN_EPS = 1e-5
D_IN = (2 * G + 3 * G + 2 * N_HEADS) + (RWKV_SHIFT + G) + (2 * G) + (4 * G)

kernel_name = "hybrid_parallel_mlstm_rwkv7_rglru_retention"


def rms_norm(x, g):
    xf = x.astype(jnp.float32)
    y = xf * lax.rsqrt(jnp.mean(xf * xf, -1, keepdims=True) + NORM_EPS)
    return (y * g.astype(jnp.float32)).astype(x.dtype)


def heads(t):
    return t.reshape(*t.shape[:-1], N_HEADS, HEAD_DIM)


def head_layer_norm(x, scale):
    xf = x.astype(jnp.float32)
    mu = jnp.mean(xf, -1, keepdims=True)
    var = jnp.mean(jnp.square(xf - mu), -1, keepdims=True)
    y = ((xf - mu) * lax.rsqrt(var + GN_EPS)).reshape(*x.shape[:-2], -1)
    return y * scale.astype(jnp.float32)


def causal_dwconv(x, w, b):
    c = x.shape[-1]
    y = lax.conv_general_dilated(
        x, w[:, None, :].astype(x.dtype), window_strides=(1,), padding=[(CONV_W - 1, 0)],
        dimension_numbers=("NWC", "WIO", "NWC"), feature_group_count=c)
    return y + b.astype(x.dtype)


def token_shift(x):
    return jnp.pad(x, ((0, 0), (1, 0), (0, 0)))[:, :-1]


def rope(x, cos, sin):
    half = HEAD_DIM // 2
    x1, x2 = x[..., :half], x[..., half:]
    return jnp.concatenate([x1 * cos - x2 * sin, x2 * cos + x1 * sin], -1)


def to_chunks(t):
    b, s, h, d = t.shape
    return t.reshape(b, s // CHUNK, CHUNK, h, d).transpose(1, 0, 3, 2, 4)


def from_chunks(t):
    nc, b, h, l, d = t.shape
    return t.transpose(1, 0, 3, 2, 4).reshape(b, nc * l, h, d)


def gate_chunks(t):
    b, s, h = t.shape
    return t.reshape(b, s // CHUNK, CHUNK, h).transpose(1, 0, 3, 2)


def mlstm_chunkwise(q, k, v, i_pre, f_pre):
    b, s, h, dh = q.shape
    f32 = jnp.float32
    qc = to_chunks(q.astype(f32))
    kc = to_chunks(k.astype(f32)) * (dh ** -0.5)
    vc = to_chunks(v.astype(f32))
    ic = gate_chunks(i_pre.astype(f32))
    lfc = gate_chunks(jax.nn.log_sigmoid(f_pre.astype(f32)))
    causal = jnp.tril(jnp.ones((CHUNK, CHUNK), bool))

    def step(carry, inp):
        c_st, n_st, m_st = carry
        qb, kb, vb, ib, lfb = inp
        cum = jnp.cumsum(lfb, -1)
        log_d = jnp.where(causal, cum[..., :, None] - cum[..., None, :] + ib[..., None, :], -jnp.inf)
        inter = cum + m_st[..., None]
        m_t = jnp.maximum(inter, jnp.max(log_d, -1))
        scores = jnp.einsum("bhld,bhsd->bhls", qb, kb) * jnp.exp(log_d - m_t[..., None])
        s_inter = jnp.exp(inter - m_t)
        num = jnp.einsum("bhls,bhsd->bhld", scores, vb) + s_inter[..., None] * jnp.einsum("bhld,bhed->bhle", qb, c_st)
        den = jnp.sum(scores, -1) + s_inter * jnp.einsum("bhld,bhd->bhl", qb, n_st)
        h_out = num / jnp.maximum(jnp.abs(den), jnp.exp(-m_t))[..., None]
        tot = cum[..., -1]
        log_w = tot[..., None] - cum + ib
        m_new = jnp.maximum(tot + m_st, jnp.max(log_w, -1))
        wj = jnp.exp(log_w - m_new[..., None])
        sc = jnp.exp(tot + m_st - m_new)
        c_new = sc[..., None, None] * c_st + jnp.einsum("bhl,bhle,bhld->bhed", wj, vb, kb)
        n_new = sc[..., None] * n_st + jnp.einsum("bhl,bhld->bhd", wj, kb)
        return (c_new, n_new, m_new), h_out

    init = (jnp.zeros((b, h, dh, dh), f32), jnp.zeros((b, h, dh), f32), jnp.zeros((b, h), f32))
    _, hc = lax.scan(step, init, (qc, kc, vc, ic, lfc))
    return from_chunks(hc)


def rwkv7_scan(r, w, k_t, v, kappa_hat, a):
    b, s, h, dh = r.shape

    def step(st, inp):
        r_t, w_t, k_tt, v_t, kh_t, a_t = inp
        sk = jnp.einsum("bhvk,bhk->bhv", st, kh_t)
        st = st * w_t[:, :, None, :] - sk[..., None] * (a_t * kh_t)[:, :, None, :] + v_t[..., None] * k_tt[:, :, None, :]
        return st, jnp.einsum("bhvk,bhk->bhv", st, r_t)

    xs = tuple(jnp.moveaxis(t, 1, 0) for t in (r, w, k_t, v, kappa_hat, a))
    _, y = lax.scan(step, jnp.zeros((b, h, dh, dh), jnp.float32), xs)
    return jnp.moveaxis(y, 0, 1)


def rglru(x, w_r, b_r, w_i, b_i, lam):
    xf = x.astype(jnp.float32)
    xh = heads(xf)
    r = jax.nn.sigmoid(jnp.einsum("bshi,hij->bshj", xh, w_r.astype(jnp.float32)).reshape(xf.shape) + b_r)
    i = jax.nn.sigmoid(jnp.einsum("bshi,hij->bshj", xh, w_i.astype(jnp.float32)).reshape(xf.shape) + b_i)
    log_a = -LRU_C * r * jax.nn.softplus(-lam.astype(jnp.float32))
    a = jnp.exp(log_a)
    u = jnp.sqrt(-jnp.expm1(2.0 * log_a)) * (i * xf)

    def combine(left, right):
        a1, b1 = left
        a2, b2 = right
        return a1 * a2, a2 * b1 + b2

    _, h = lax.associative_scan(combine, (a, u), axis=1)
    return h


def retention_chunkwise(q, k, v):
    b, s, h, dh = q.shape
    f32 = jnp.float32
    log_g = jnp.log1p(-jnp.exp2(-5.0 - jnp.arange(N_HEADS, dtype=f32)))
    idx = jnp.arange(CHUNK, dtype=f32)
    d_mat = jnp.exp(log_g[:, None, None] * jnp.abs(idx[:, None] - idx[None, :]))
    xi = jnp.exp(log_g[:, None] * (idx + 1.0))
    zeta = jnp.exp(log_g[:, None] * (CHUNK - 1.0 - idx))
    g_chunk = jnp.exp(log_g * CHUNK)

    def step(r_st, inp):
        qb, kb, vb = inp
        intra = jnp.einsum("bhld,bhsd->bhls", qb, kb) * d_mat
        o = jnp.einsum("bhls,bhse->bhle", intra, vb) + xi[..., None] * jnp.einsum("bhld,bhde->bhle", qb, r_st)
        r_st = g_chunk[:, None, None] * r_st + jnp.einsum("bhsd,bhse->bhde", kb * zeta[..., None], vb)
        return r_st, o

    xs = (to_chunks(q.astype(f32)), to_chunks(k.astype(f32)), to_chunks(v.astype(f32)))
    _, oc = lax.scan(step, jnp.zeros((b, h, dh, dh), f32), xs)
    return from_chunks(oc)


def split_at(t, sizes):
    idx = [int(i) for i in np.cumsum(sizes)[:-1]]
    return jnp.split(t, idx, axis=-1)


def setup_inputs(seed: int = 0) -> dict:
    key = jax.random.key(seed)
    ks = jax.random.split(key, 26)
    n = lambda k, shape: jax.random.normal(k, shape, jnp.float32)
    u_lam = jax.random.uniform(ks[24], (DEPTH, G), jnp.float32, 0.9, 0.999)
    s_lam = u_lam ** (1.0 / LRU_C)
    f_bias = jnp.linspace(3.0, 6.0, N_HEADS, dtype=jnp.float32)[None, :] + 0.1 * n(ks[8], (DEPTH, N_HEADS))
    return {
        "x": n(ks[0], (BATCH, SEQ, D_MODEL)),
        "norm_pre": 1.0 + 0.05 * n(ks[1], (DEPTH, D_MODEL)),
        "norm_post": 1.0 + 0.05 * n(ks[2], (DEPTH, D_MODEL)),
        "w_in": n(ks[3], (DEPTH, D_MODEL, D_IN)) * D_MODEL ** -0.5,
        "w_out": n(ks[4], (DEPTH, D_MIX, D_MODEL)) * D_MIX ** -0.5,
        "mlstm_conv_w": n(ks[5], (DEPTH, CONV_W, 2 * G)) * CONV_W ** -0.5,
        "mlstm_conv_b": 0.01 * n(ks[6], (DEPTH, 2 * G)),
        "mlstm_i_bias": 0.1 * n(ks[7], (DEPTH, N_HEADS)),
        "mlstm_f_bias": f_bias,
        "mlstm_norm_w": 1.0 + 0.05 * n(ks[9], (DEPTH, G)),
        "rwkv_mu": jax.random.uniform(ks[10], (DEPTH, RWKV_SHIFT), jnp.float32),
        "rwkv_w_up": 0.1 * n(ks[11], (DEPTH, LORA_W, G)),
        "rwkv_w0": jax.random.uniform(ks[12], (DEPTH, G), jnp.float32, -4.0, 2.0),
        "rwkv_a_up": 0.1 * n(ks[13], (DEPTH, LORA_A, G)),
        "rwkv_a0": 0.1 * n(ks[14], (DEPTH, G)),
        "rwkv_k_k": 0.85 + 0.05 * n(ks[15], (DEPTH, G)),
        "rwkv_k_a": 1.0 + 0.05 * n(ks[16], (DEPTH, G)),
        "rwkv_r_k": 0.1 * n(ks[17], (DEPTH, G)),
        "rwkv_gn_w": 1.0 + 0.05 * n(ks[18], (DEPTH, G)),
        "rwkv_gn_b": 0.01 * n(ks[19], (DEPTH, G)),
        "lru_conv_w": n(ks[20], (DEPTH, CONV_W, G)) * CONV_W ** -0.5,
        "lru_conv_b": 0.01 * n(ks[21], (DEPTH, G)),
        "lru_w_r": n(ks[22], (DEPTH, N_HEADS, HEAD_DIM, HEAD_DIM)) * HEAD_DIM ** -0.5,
        "lru_b_r": 0.01 * n(ks[23], (DEPTH, G)),
        "lru_w_i": n(ks[25], (DEPTH, N_HEADS, HEAD_DIM, HEAD_DIM)) * HEAD_DIM ** -0.5,
        "lru_b_i": 0.01 * n(jax.random.fold_in(ks[23], 1), (DEPTH, G)),
        "lru_lambda": jnp.log(s_lam) - jnp.log1p(-s_lam),
        "ret_norm_w": 1.0 + 0.05 * n(jax.random.fold_in(ks[24], 1), (DEPTH, G)),
    }


def reference(x, norm_pre, norm_post, w_in, w_out, mlstm_conv_w, mlstm_conv_b, mlstm_i_bias,
              mlstm_f_bias, mlstm_norm_w, rwkv_mu, rwkv_w_up, rwkv_w0, rwkv_a_up, rwkv_a0,
              rwkv_k_k, rwkv_k_a, rwkv_r_k, rwkv_gn_w, rwkv_gn_b, lru_conv_w, lru_conv_b,
              lru_w_r, lru_b_r, lru_w_i, lru_b_i, lru_lambda, ret_norm_w):
    f32 = jnp.float32
    seq = x.shape[1]
    half = HEAD_DIM // 2
    pos = jnp.arange(seq, dtype=f32)
    inv_freq = ROPE_THETA ** (-jnp.arange(half, dtype=f32) / half)
    ang = pos[:, None] * inv_freq[None, :]
    cos = jnp.cos(ang)[:, None, :]
    sin = jnp.sin(ang)[:, None, :]
    silu = lambda t: jax.nn.silu(t.astype(f32))

    for l in range(DEPTH):
        h = rms_norm(x, norm_pre[l])
        p = h @ w_in[l]
        (a_qk, a_v, a_o, a_z, a_i, a_f, b_sh, b_z, c_x, c_z, d_q, d_k, d_v, d_z) = split_at(
            p, [2 * G, G, G, G, N_HEADS, N_HEADS, RWKV_SHIFT, G, G, G, G, G, G, G])

        qk = jax.nn.silu(causal_dwconv(a_qk, mlstm_conv_w[l], mlstm_conv_b[l]))
        q_a, k_a = jnp.split(qk, 2, axis=-1)
        h_a = mlstm_chunkwise(heads(q_a), heads(k_a), heads(a_v),
                              a_i + mlstm_i_bias[l], a_f + mlstm_f_bias[l])
        h_a = h_a * jax.nn.sigmoid(heads(a_o).astype(f32))
        y_a = head_layer_norm(h_a, mlstm_norm_w[l]) * silu(a_z)

        b_sh = b_sh + rwkv_mu[l] * (token_shift(b_sh) - b_sh)
        r_b, k_b, v_b, w_lo, a_lo = split_at(b_sh.astype(f32), [G, G, G, LORA_W, LORA_A])
        decay_logit = rwkv_w0[l] + jnp.tanh(w_lo) @ rwkv_w_up[l].astype(f32)
        w_b = jnp.exp(-W_DECAY_SCALE * jax.nn.sigmoid(decay_logit))
        a_b = jax.nn.sigmoid(rwkv_a0[l] + a_lo @ rwkv_a_up[l].astype(f32))
        kappa = heads(k_b * rwkv_k_k[l])
        kappa_hat = kappa * lax.rsqrt(jnp.sum(kappa * kappa, -1, keepdims=True) + 1e-12)
        k_til = k_b * (1.0 + (a_b - 1.0) * rwkv_k_a[l])
        wkv = rwkv7_scan(heads(r_b), heads(w_b), heads(k_til), heads(v_b), kappa_hat, heads(a_b))
        bonus = jnp.sum(heads(r_b * rwkv_r_k[l] * k_til), -1, keepdims=True) * heads(v_b)
        y_b = (head_layer_norm(wkv, rwkv_gn_w[l]) + rwkv_gn_b[l] + bonus.reshape(bonus.shape[:-2] + (G,))) * silu(b_z)

        xc = causal_dwconv(c_x, lru_conv_w[l], lru_conv_b[l])
        y_c = rglru(xc, lru_w_r[l], lru_b_r[l], lru_w_i[l], lru_b_i[l], lru_lambda[l]) * silu(c_z)

        q_d = rope(heads(d_q).astype(f32), cos, sin)
        k_d = rope(heads(d_k).astype(f32), cos, sin) * (HEAD_DIM ** -0.5)
        o_d = retention_chunkwise(q_d, k_d, heads(d_v))
        y_d = head_layer_norm(o_d, ret_norm_w[l]) * silu(d_z)

        y = jnp.concatenate([y_a, y_b, y_c, y_d], axis=-1).astype(x.dtype) @ w_out[l]
        x = x + rms_norm(y, norm_post[l])
    return x
```

```cpp
#include <hip/hip_runtime.h>
#include <cstdint>
#include <cstdio>

typedef unsigned short bf16_t;
#define DI __device__ __forceinline__

constexpr int NB = 4, T = 4096, D = 1024, NL = 2, G = 512, NH = 8;
constexpr int TS = 2048, MS = NB * TS, NCS = TS / 64;
constexpr int DIN = 7824, PP = 7936, DMIX = 2048;
constexpr int A_Q = 0, A_K = 512, A_V = 1024, A_O = 1536, B_R = 2048, B_K = 2560, B_V = 3072, B_WLO = 3584, B_ALO = 3648, C_X = 3712,
              D_Q = 4224, D_K = 4736, D_V = 5248, ZA = 5760, ZB = 6272, ZC = 6784, ZD = 7296, A_I = 7808, A_F = 7816;
constexpr size_t MiB = 1u << 20;
constexpr size_t OFF_CTL = 0, OFF_ZROW = 512 * 1024, OFF_WIN = 1 * MiB, OFF_WOUT = 32 * MiB, OFF_ROPE = 40 * MiB, OFF_CARRY = 41 * MiB,
                 OFF_LS = 45 * MiB, OFF_BON = 45 * MiB + 512 * 1024, OFF_P = 46 * MiB, OFF_SA = 170 * MiB, OFF_H = 170 * MiB,
                 OFF_SD = 170 * MiB + 17301504, OFF_CK = 203 * MiB, OFF_Y = 203 * MiB;
constexpr size_t WIN_L = (size_t)PP * D * 2, WOUT_L = (size_t)D * DMIX * 2;
constexpr size_t CARRY_L = 2 * MiB, CA_OFF = 0, CD_OFF = 540672, CB_OFF = CD_OFF + 524288, CC_OFF = CB_OFF + 524288, HALO_OFF = CC_OFF + 8192;
constexpr int SAU = 4224;

struct Ctx {
    const float *x, *norm_pre, *norm_post, *w_in, *w_out, *mconv_w, *mconv_b, *mi_bias, *mf_bias, *mnorm_w, *rmu, *rw_up, *rw0, *ra_up, *ra0,
        *rk_k, *rk_a, *rr_k, *rgn_w, *rgn_b, *lconv_w, *lconv_b, *lw_r, *lb_r, *lw_i, *lb_i, *llam, *retnorm_w;
    float* out; unsigned char* ws; int layer, slab;
};

DI float bf2f(bf16_t v) { return __uint_as_float(((unsigned)v) << 16); }
DI bf16_t f2bf(float f) { unsigned u = __float_as_uint(f); u += 0x7fffu + ((u >> 16) & 1u); return (bf16_t)(u >> 16); }
DI float sigm(float x) { return 1.f / (1.f + expf(-x)); }
DI float siluf(float x) { return x / (1.f + expf(-x)); }
DI float softplusf(float x) { return fmaxf(x, 0.f) + log1pf(expf(-fabsf(x))); }
DI float wave_sum(float v) {
#pragma unroll
    for (int o = 1; o < 64; o <<= 1) v += __shfl_xor(v, o);
    return v;
}
DI int srccol(int n) {
    if (n < 2048) return n;
    if (n < 3712) return n + 528;
    if (n < 4224) return n + 1040;
    if (n < 5760) return n + 1552;
    if (n < 6272) return n - 3712;
    if (n < 6784) return n - 2032;
    if (n < 7296) return n - 1520;
    if (n < 7808) return n + 16;
    if (n < 7824) return n - 5248;
    return -1;
}
DI const bf16_t* prow(const unsigned char* ws, int layer, int slab, int b, int tl) {
    if (tl >= 0) return (const bf16_t*)(ws + OFF_P) + (size_t)(b * TS + tl) * PP;
    if (slab == 0) return (const bf16_t*)(ws + OFF_ZROW);
    return (const bf16_t*)(ws + OFF_CARRY + layer * CARRY_L + HALO_OFF) + (size_t)(b * 3 + 3 + tl) * PP;
}

DI void wt_item(const float* W, int K, int N, bf16_t* WT, bool permute, float* scr, int item, int lane) {
    const int nblk = (permute ? PP : N) / 32, kb = item / nblk, nb = item % nblk, k0 = 64 * kb, n0 = 32 * nb;
    const int nn = n0 + (lane & 31); const int sc = permute ? srccol(nn) : nn;
    for (int i = 0; i < 32; ++i) { const int kk = 2 * i + (lane >> 5); scr[kk * 33 + (lane & 31)] = sc >= 0 ? W[(size_t)(k0 + kk) * N + sc] : 0.f; }
    __builtin_amdgcn_s_waitcnt(0); __builtin_amdgcn_wave_barrier();
    const int c = lane & 7;
    for (int j = 0; j < 4; ++j) { const int n = (lane >> 3) + 8 * j; const float* s = scr + (8 * c) * 33 + n;
        uint4 o; o.x = f2bf(s[0]) | ((unsigned)f2bf(s[33]) << 16); o.y = f2bf(s[66]) | ((unsigned)f2bf(s[99]) << 16);
        o.z = f2bf(s[132]) | ((unsigned)f2bf(s[165]) << 16); o.w = f2bf(s[198]) | ((unsigned)f2bf(s[231]) << 16);
        *(uint4*)(WT + (size_t)(n0 + n) * K + k0 + 8 * c) = o; }
    __builtin_amdgcn_s_waitcnt(0); __builtin_amdgcn_wave_barrier();
}
__global__ void __launch_bounds__(512) k_p0(Ctx c) {
    extern __shared__ float lds[];
    const int tid = threadIdx.x, lane = tid & 63, wave = tid >> 6;
    float* scr = lds + wave * (64 * 33);
    const int gw = blockIdx.x * 8 + wave, NGW = gridDim.x * 8;
    constexpr int I_IN = (D / 64) * (PP / 32), I_OUT = (DMIX / 64) * (D / 32);
    for (int it = gw; it < NL * (I_IN + I_OUT); it += NGW) {
        const int l = it / (I_IN + I_OUT); int r = it % (I_IN + I_OUT);
        if (r < I_IN) wt_item(c.w_in + (size_t)l * D * DIN, D, DIN, (bf16_t*)(c.ws + OFF_WIN + l * WIN_L), true, scr, r, lane);
        else wt_item(c.w_out + (size_t)l * DMIX * D, DMIX, D, (bf16_t*)(c.ws + OFF_WOUT + l * WOUT_L), false, scr, r - I_IN, lane);
    }
    float* rope = (float*)(c.ws + OFF_ROPE);
    for (int i = blockIdx.x * 512 + tid; i < T * 32; i += gridDim.x * 512) {
        const int t = i >> 5, j = i & 31; const float inv = powf(10000.f, -(float)j / 32.f); const float ang = (float)t * inv;
        rope[2 * i] = cosf(ang); rope[2 * i + 1] = sinf(ang);
    }
}
DI void norm_row(const float* xrow, const float* g, bf16_t* hrow, int lane) {
    float4 v[4]; float ss = 0.f;
#pragma unroll
    for (int j = 0; j < 4; ++j) { v[j] = *(const float4*)(xrow + j * 256 + lane * 4); ss += v[j].x * v[j].x + v[j].y * v[j].y + v[j].z * v[j].z + v[j].w * v[j].w; }
    ss = wave_sum(ss); const float rs = rsqrtf(ss * (1.f / D) + 1e-6f);
#pragma unroll
    for (int j = 0; j < 4; ++j) { const float4 gg = *(const float4*)(g + j * 256 + lane * 4);
        uint2 o; o.x = f2bf(v[j].x * rs * gg.x) | ((unsigned)f2bf(v[j].y * rs * gg.y) << 16); o.y = f2bf(v[j].z * rs * gg.z) | ((unsigned)f2bf(v[j].w * rs * gg.w) << 16);
        *(uint2*)(hrow + j * 256 + lane * 4) = o; }
}
__global__ void __launch_bounds__(512) k_prenorm(Ctx c) {
    const int lane = threadIdx.x & 63, gw = blockIdx.x * 8 + (threadIdx.x >> 6), NGW = gridDim.x * 8;
    for (int r = gw; r < MS; r += NGW) { const int b = r / TS, tl = r % TS; const size_t grow = (size_t)b * T + c.slab * TS + tl;
        norm_row(c.x + grow * D, c.norm_pre, (bf16_t*)(c.ws + OFF_H) + (size_t)r * D, lane); }
}
template <bool OUT_BF16> __global__ void __launch_bounds__(512) k_gemm(const bf16_t* A, int lda, const bf16_t* Bt, int K, void* C, int ldc, int M, int N) {
    extern __shared__ float lds[];
    float* As = lds; float* Bs = lds + 32 * 132;
    const int tid = threadIdx.x, ty = tid >> 4, tx = tid & 15;
    const int ntn = N / 64, ntm = M / 128;
    for (int tile = blockIdx.x; tile < ntn * ntm; tile += gridDim.x) {
        const int m0 = (tile / ntn) * 128, n0 = (tile % ntn) * 64;
        float acc[4][4] = {};
        for (int k0 = 0; k0 < K; k0 += 32) {
            { const int row = tid >> 2, kq = (tid & 3) * 8; const uint4 v = *(const uint4*)(A + (size_t)(m0 + row) * lda + k0 + kq);
              const unsigned w[4] = {v.x, v.y, v.z, v.w};
#pragma unroll
              for (int i = 0; i < 4; ++i) { As[(kq + 2 * i) * 132 + row] = __uint_as_float(w[i] << 16); As[(kq + 2 * i + 1) * 132 + row] = __uint_as_float(w[i] & 0xffff0000u); } }
            if (tid < 256) { const int row = tid >> 2, kq = (tid & 3) * 8; const uint4 v = *(const uint4*)(Bt + (size_t)(n0 + row) * K + k0 + kq);
              const unsigned w[4] = {v.x, v.y, v.z, v.w};
#pragma unroll
              for (int i = 0; i < 4; ++i) { Bs[(kq + 2 * i) * 68 + row] = __uint_as_float(w[i] << 16); Bs[(kq + 2 * i + 1) * 68 + row] = __uint_as_float(w[i] & 0xffff0000u); } }
            __syncthreads();
#pragma unroll 8
            for (int k = 0; k < 32; ++k) { const float4 a = *(const float4*)(As + k * 132 + ty * 4); const float4 b = *(const float4*)(Bs + k * 68 + tx * 4);
                const float av[4] = {a.x, a.y, a.z, a.w}, bv[4] = {b.x, b.y, b.z, b.w};
#pragma unroll
                for (int i = 0; i < 4; ++i)
#pragma unroll
                    for (int j = 0; j < 4; ++j) acc[i][j] += av[i] * bv[j]; }
            __syncthreads();
        }
#pragma unroll
        for (int i = 0; i < 4; ++i) { const size_t off = (size_t)(m0 + ty * 4 + i) * ldc + n0 + tx * 4;
            if (OUT_BF16) { uint2 o; o.x = f2bf(acc[i][0]) | ((unsigned)f2bf(acc[i][1]) << 16); o.y = f2bf(acc[i][2]) | ((unsigned)f2bf(acc[i][3]) << 16); *(uint2*)((bf16_t*)C + off) = o; }
            else *(float4*)((float*)C + off) = make_float4(acc[i][0], acc[i][1], acc[i][2], acc[i][3]); }
    }
}
DI void load_conv_tile(const Ctx& c, int b, int tl0, int col0, const float* cw, int cwstride, const float* cb, bool act, float scale, float* dst, int tid) {
    for (int idx = tid; idx < 4096; idx += 512) { const int t = idx >> 6, j = idx & 63; float acc = cb[j];
#pragma unroll
        for (int w = 0; w < 4; ++w) acc += bf2f(prow(c.ws, c.layer, c.slab, b, tl0 + t - 3 + w)[col0 + j]) * cw[w * cwstride + j];
        if (act) acc = siluf(acc);
        dst[t * 65 + j] = acc * scale; }
}
DI void load_plain_tile(const Ctx& c, int b, int tl0, int col0, float* dst, int tid) {
    for (int idx = tid; idx < 4096; idx += 512) { const int t = idx >> 6, j = idx & 63; dst[t * 65 + j] = bf2f(prow(c.ws, c.layer, c.slab, b, tl0 + t)[col0 + j]); }
}
DI void load_rope_tile(const Ctx& c, int b, int tl0, int col0, float scale, float* dst, int tid) {
    const float* rope = (const float*)(c.ws + OFF_ROPE);
    for (int idx = tid; idx < 4096; idx += 512) { const int t = idx >> 6, j = idx & 63, jj = j & 31; const bf16_t* r = prow(c.ws, c.layer, c.slab, b, tl0 + t);
        const int pos = c.slab * TS + tl0 + t; const float cs = rope[(pos * 32 + jj) * 2], sn = rope[(pos * 32 + jj) * 2 + 1];
        const float x1 = bf2f(r[col0 + jj]), x2 = bf2f(r[col0 + 32 + jj]);
        dst[t * 65 + j] = (j < 32 ? x1 * cs - x2 * sn : x2 * cs + x1 * sn) * scale; }
}
DI void mlstm_gates(const Ctx& c, int b, int tl0, int h, float* ig, float* lf, float* cum, int tid) {
    if (tid < 64) { const bf16_t* r = prow(c.ws, c.layer, c.slab, b, tl0 + tid);
        ig[tid] = bf2f(r[A_I + h]) + c.mi_bias[c.layer * NH + h];
        lf[tid] = -softplusf(-(bf2f(r[A_F + h]) + c.mf_bias[c.layer * NH + h])); }
    __syncthreads();
    if (tid == 0) { float s = 0.f; for (int t = 0; t < 64; ++t) { s += lf[t]; cum[t] = s; } }
    __syncthreads();
}
DI void unit_ids(int item, int& b, int& cl, int& h) { b = item / (NCS * NH); cl = (item / NH) % NCS; h = item % NH; }
__global__ void __launch_bounds__(512) k_mA(Ctx c) {
    extern __shared__ float lds[];
    float *kk = lds, *vv = lds + 4160, *ig = lds + 8320, *lf = ig + 64, *cum = lf + 64, *wj = cum + 64, *sc = wj + 64;
    const int tid = threadIdx.x; const int l = c.layer;
    for (int item = blockIdx.x; item < NB * NCS * NH; item += gridDim.x) {
        int b, cl, h; unit_ids(item, b, cl, h); const int tl0 = cl * 64; const int u = (b * NH + h) * NCS + cl;
        load_conv_tile(c, b, tl0, A_K + h * 64, c.mconv_w + l * 4096 + 512 + h * 64, 1024, c.mconv_b + l * 1024 + 512 + h * 64, true, 0.125f, kk, tid);
        load_plain_tile(c, b, tl0, A_V + h * 64, vv, tid);
        mlstm_gates(c, b, tl0, h, ig, lf, cum, tid);
        if (tid == 0) { const float tot = cum[63]; float m = -INFINITY; for (int t = 0; t < 64; ++t) m = fmaxf(m, tot - cum[t] + ig[t]); sc[0] = m; sc[1] = tot; }
        __syncthreads();
        if (tid < 64) wj[tid] = expf(sc[1] - cum[tid] + ig[tid] - sc[0]);
        __syncthreads();
        float* S = (float*)(c.ws + OFF_SA) + (size_t)u * SAU;
        { const int e = tid >> 3, d0 = (tid & 7) * 8; float acc[8] = {};
          for (int t = 0; t < 64; ++t) { const float a = wj[t] * vv[t * 65 + e];
#pragma unroll
              for (int i = 0; i < 8; ++i) acc[i] += a * kk[t * 65 + d0 + i]; }
#pragma unroll
          for (int i = 0; i < 8; ++i) S[e * 64 + d0 + i] = acc[i]; }
        if (tid < 64) { float a = 0.f; for (int t = 0; t < 64; ++t) a += wj[t] * kk[t * 65 + tid]; S[4096 + tid] = a; }
        if (tid == 0) { S[4160] = sc[0]; S[4161] = sc[1]; }
        __syncthreads();
    }
}
__global__ void __launch_bounds__(512) k_mB(Ctx c) {
    const int tid = threadIdx.x;
    for (int item = blockIdx.x; item < NB * NH * 9; item += gridDim.x) {
        const int bh = item / 9, part = item % 9, el = part * 512 + tid; const bool on = el < 4160;
        float* CA = (float*)(c.ws + OFF_CARRY + c.layer * CARRY_L + CA_OFF) + (size_t)bh * SAU;
        float m = c.slab == 0 ? 0.f : CA[4160 + c.slab - 1]; float val = (c.slab == 0 || !on) ? 0.f : CA[el];
        for (int cl = 0; cl < NCS; ++cl) { float* S = (float*)(c.ws + OFF_SA) + (size_t)(bh * NCS + cl) * SAU;
            const float mloc = S[4160], tot = S[4161]; const float loc = on ? S[el] : 0.f;
            if (on) S[el] = val;
            if (el == 0) S[4162] = m;
            const float mn = fmaxf(tot + m, mloc); val = expf(tot + m - mn) * val + expf(mloc - mn) * loc; m = mn; }
        if (on) CA[el] = val;
        if (el == 0) CA[4160 + c.slab] = m;
    }
}
__global__ void __launch_bounds__(512) k_mC(Ctx c) {
    extern __shared__ float lds[];
    float *qq = lds, *kk = lds + 4160, *vv = lds + 8320, *Cs = lds + 12480, *Sm = lds + 16640, *ig = lds + 20800, *lf = ig + 64, *cum = lf + 64, *mx = cum + 64, *ns = mx + 64, *den = ns + 64;
    const int tid = threadIdx.x; const int l = c.layer;
    for (int item = blockIdx.x; item < NB * NCS * NH; item += gridDim.x) {
        int b, cl, h; unit_ids(item, b, cl, h); const int tl0 = cl * 64; const int u = (b * NH + h) * NCS + cl;
        const float* S = (const float*)(c.ws + OFF_SA) + (size_t)u * SAU;
        load_conv_tile(c, b, tl0, A_Q + h * 64, c.mconv_w + l * 4096 + h * 64, 1024, c.mconv_b + l * 1024 + h * 64, true, 1.f, qq, tid);
        load_conv_tile(c, b, tl0, A_K + h * 64, c.mconv_w + l * 4096 + 512 + h * 64, 1024, c.mconv_b + l * 1024 + 512 + h * 64, true, 0.125f, kk, tid);
        load_plain_tile(c, b, tl0, A_V + h * 64, vv, tid);
        for (int idx = tid; idx < 4096; idx += 512) Cs[(idx >> 6) * 65 + (idx & 63)] = S[idx];
        if (tid < 64) ns[tid] = S[4096 + tid];
        const float mst = S[4162];
        mlstm_gates(c, b, tl0, h, ig, lf, cum, tid);
        if (tid == 0) { float g = -INFINITY; for (int t = 0; t < 64; ++t) { g = fmaxf(g, ig[t] - cum[t]); mx[t] = fmaxf(mst, g); } }
        __syncthreads();
        const int t = tid >> 3, s0 = (tid & 7) * 8;
        { float acc[8] = {};
#pragma unroll 2
        for (int d = 0; d < 64; ++d) { const float qv = qq[t * 65 + d];
#pragma unroll
              for (int i = 0; i < 8; ++i) acc[i] += qv * kk[(s0 + i) * 65 + d]; }
#pragma unroll
          for (int i = 0; i < 8; ++i) { const int s = s0 + i; Sm[t * 65 + s] = s <= t ? acc[i] * expf(ig[s] - cum[s] - mx[t]) : 0.f; } }
        __syncthreads();
        const float sint = expf(mst - mx[t]);
        float num[8] = {}, qc[8] = {};
#pragma unroll 2
        for (int s = 0; s < 64; ++s) { const float pv = Sm[t * 65 + s];
#pragma unroll
            for (int i = 0; i < 8; ++i) num[i] += pv * vv[s * 65 + s0 + i]; }
#pragma unroll 2
        for (int d = 0; d < 64; ++d) { const float qv = qq[t * 65 + d];
#pragma unroll
            for (int i = 0; i < 8; ++i) qc[i] += qv * Cs[(s0 + i) * 65 + d]; }
        if (tid < 64) { float a = 0.f, q = 0.f;
#pragma unroll 4
            for (int s = 0; s < 64; ++s) a += Sm[tid * 65 + s];
#pragma unroll 4
            for (int d = 0; d < 64; ++d) q += qq[tid * 65 + d] * ns[d];
            den[tid] = a + expf(mst - mx[tid]) * q; }
        __syncthreads();
        const float dn = fmaxf(fabsf(den[t]), expf(-(cum[t] + mx[t])));
        bf16_t* prw = (bf16_t*)(c.ws + OFF_P) + (size_t)(b * TS + tl0 + t) * PP;
        float ho[8], sum = 0.f;
#pragma unroll
        for (int i = 0; i < 8; ++i) { const float hh = (num[i] + sint * qc[i]) / dn; ho[i] = hh * sigm(bf2f(prw[A_O + h * 64 + s0 + i])); sum += ho[i]; }
        sum += __shfl_xor(sum, 1); sum += __shfl_xor(sum, 2); sum += __shfl_xor(sum, 4);
        const float mu = sum * (1.f / 64.f); float vs = 0.f;
#pragma unroll
        for (int i = 0; i < 8; ++i) { ho[i] -= mu; vs += ho[i] * ho[i]; }
        vs += __shfl_xor(vs, 1); vs += __shfl_xor(vs, 2); vs += __shfl_xor(vs, 4);
        const float rstd = rsqrtf(vs * (1.f / 64.f) + 1e-5f);
#pragma unroll
        for (int i = 0; i < 8; ++i) { const int ch = h * 64 + s0 + i; const float z = bf2f(prw[ZA + ch]); prw[ZA + ch] = f2bf(ho[i] * rstd * c.mnorm_w[l * G + ch] * siluf(z)); }
        __syncthreads();
    }
}
DI float ret_logg(int h) { return log1pf(-exp2f(-5.f - (float)h)); }
__global__ void __launch_bounds__(512) k_dA(Ctx c) {
    extern __shared__ float lds[];
    float *kk = lds, *vv = lds + 4160;
    const int tid = threadIdx.x;
    for (int item = blockIdx.x; item < NB * NCS * NH; item += gridDim.x) {
        int b, cl, h; unit_ids(item, b, cl, h); const int tl0 = cl * 64; const int u = (b * NH + h) * NCS + cl; const float lg = ret_logg(h);
        load_rope_tile(c, b, tl0, D_K + h * 64, 0.125f, kk, tid);
        load_plain_tile(c, b, tl0, D_V + h * 64, vv, tid);
        __syncthreads();
        float* S = (float*)(c.ws + OFF_SD) + (size_t)u * 4096;
        const int d = tid >> 3, e0 = (tid & 7) * 8; float acc[8] = {};
        for (int s = 0; s < 64; ++s) { const float a = expf(lg * (float)(63 - s)) * kk[s * 65 + d];
#pragma unroll
            for (int i = 0; i < 8; ++i) acc[i] += a * vv[s * 65 + e0 + i]; }
#pragma unroll
        for (int i = 0; i < 8; ++i) S[d * 64 + e0 + i] = acc[i];
        __syncthreads();
    }
}
__global__ void __launch_bounds__(512) k_dB(Ctx c) {
    const int tid = threadIdx.x;
    for (int item = blockIdx.x; item < NB * NH * 8; item += gridDim.x) {
        const int bh = item / 8, el = (item % 8) * 512 + tid; const float gch = expf(ret_logg(bh % NH) * 64.f);
        float* CD = (float*)(c.ws + OFF_CARRY + c.layer * CARRY_L + CD_OFF) + (size_t)bh * 4096;
        float val = c.slab == 0 ? 0.f : CD[el];
        for (int cl = 0; cl < NCS; ++cl) { float* S = (float*)(c.ws + OFF_SD) + (size_t)(bh * NCS + cl) * 4096; const float loc = S[el]; S[el] = val; val = gch * val + loc; }
        CD[el] = val;
    }
}
__global__ void __launch_bounds__(512) k_dC(Ctx c) {
    extern __shared__ float lds[];
    float *qq = lds, *kk = lds + 4160, *vv = lds + 8320, *Rs = lds + 12480, *Sm = lds + 16640;
    const int tid = threadIdx.x; const int l = c.layer;
    for (int item = blockIdx.x; item < NB * NCS * NH; item += gridDim.x) {
        int b, cl, h; unit_ids(item, b, cl, h); const int tl0 = cl * 64; const int u = (b * NH + h) * NCS + cl; const float lg = ret_logg(h);
        const float* S = (const float*)(c.ws + OFF_SD) + (size_t)u * 4096;
        load_rope_tile(c, b, tl0, D_Q + h * 64, 1.f, qq, tid);
        load_rope_tile(c, b, tl0, D_K + h * 64, 0.125f, kk, tid);
        load_plain_tile(c, b, tl0, D_V + h * 64, vv, tid);
        for (int idx = tid; idx < 4096; idx += 512) Rs[(idx >> 6) * 65 + (idx & 63)] = S[idx];
        __syncthreads();
        const int t = tid >> 3, s0 = (tid & 7) * 8;
        { float acc[8] = {};
#pragma unroll 2
        for (int d = 0; d < 64; ++d) { const float qv = qq[t * 65 + d];
#pragma unroll
              for (int i = 0; i < 8; ++i) acc[i] += qv * kk[(s0 + i) * 65 + d]; }
#pragma unroll
          for (int i = 0; i < 8; ++i) { const int s = s0 + i; Sm[t * 65 + s] = acc[i] * expf(lg * fabsf((float)(t - s))); } }
        __syncthreads();
        float o[8] = {}, qr[8] = {};
#pragma unroll 2
        for (int s = 0; s < 64; ++s) { const float pv = Sm[t * 65 + s];
#pragma unroll
            for (int i = 0; i < 8; ++i) o[i] += pv * vv[s * 65 + s0 + i]; }
#pragma unroll 2
        for (int d = 0; d < 64; ++d) { const float qv = qq[t * 65 + d];
#pragma unroll
            for (int i = 0; i < 8; ++i) qr[i] += qv * Rs[d * 65 + s0 + i]; }
        const float xi = expf(lg * (float)(t + 1));
        float sum = 0.f;
#pragma unroll
        for (int i = 0; i < 8; ++i) { o[i] += xi * qr[i]; sum += o[i]; }
        sum += __shfl_xor(sum, 1); sum += __shfl_xor(sum, 2); sum += __shfl_xor(sum, 4);
        const float mu = sum * (1.f / 64.f); float vs = 0.f;
#pragma unroll
        for (int i = 0; i < 8; ++i) { o[i] -= mu; vs += o[i] * o[i]; }
        vs += __shfl_xor(vs, 1); vs += __shfl_xor(vs, 2); vs += __shfl_xor(vs, 4);
        const float rstd = rsqrtf(vs * (1.f / 64.f) + 1e-5f);
        bf16_t* prw = (bf16_t*)(c.ws + OFF_P) + (size_t)(b * TS + tl0 + t) * PP;
#pragma unroll
        for (int i = 0; i < 8; ++i) { const int ch = h * 64 + s0 + i; const float z = bf2f(prw[ZD + ch]); prw[ZD + ch] = f2bf(o[i] * rstd * c.retnorm_w[l * G + ch] * siluf(z)); }
        __syncthreads();
    }
}
DI void lru_au(const Ctx& c, int b, int tl0, int h, float* xc, float* Wr, float* Wi, float* Aa, float* Uu, int tid) {
    const int l = c.layer;
    load_conv_tile(c, b, tl0, C_X + h * 64, c.lconv_w + l * 2048 + h * 64, 512, c.lconv_b + l * 512 + h * 64, false, 1.f, xc, tid);
    for (int idx = tid; idx < 4096; idx += 512) { Wr[(idx >> 6) * 65 + (idx & 63)] = c.lw_r[(size_t)(l * NH + h) * 4096 + idx]; Wi[(idx >> 6) * 65 + (idx & 63)] = c.lw_i[(size_t)(l * NH + h) * 4096 + idx]; }
    __syncthreads();
    const int t = tid >> 3, j0 = (tid & 7) * 8; float ar[8] = {}, ai[8] = {};
    for (int i = 0; i < 64; ++i) { const float xv = xc[t * 65 + i];
#pragma unroll
        for (int j = 0; j < 8; ++j) { ar[j] += xv * Wr[i * 65 + j0 + j]; ai[j] += xv * Wi[i * 65 + j0 + j]; } }
#pragma unroll
    for (int j = 0; j < 8; ++j) { const int ch = h * 64 + j0 + j; const float r = sigm(ar[j] + c.lb_r[l * G + ch]), ii = sigm(ai[j] + c.lb_i[l * G + ch]);
        const float la = -8.f * r * softplusf(-c.llam[l * G + ch]);
        Aa[t * 65 + j0 + j] = expf(la); Uu[t * 65 + j0 + j] = sqrtf(-expm1f(2.f * la)) * (ii * xc[t * 65 + j0 + j]); }
    __syncthreads();
}
__global__ void __launch_bounds__(512) k_cA(Ctx c) {
    extern __shared__ float lds[];
    float *xc = lds, *Wr = lds + 4160, *Wi = lds + 8320, *Aa = lds + 12480, *Uu = lds + 16640;
    const int tid = threadIdx.x;
    for (int item = blockIdx.x; item < NB * NCS * NH; item += gridDim.x) {
        int b, cl, h; unit_ids(item, b, cl, h);
        lru_au(c, b, cl * 64, h, xc, Wr, Wi, Aa, Uu, tid);
        if (tid < 64) { float hl = 0.f, ap = 1.f; for (int t = 0; t < 64; ++t) { hl = Aa[t * 65 + tid] * hl + Uu[t * 65 + tid]; ap *= Aa[t * 65 + tid]; }
            float* LS = (float*)(c.ws + OFF_LS) + ((size_t)(b * NCS + cl) * G + h * 64 + tid) * 2; LS[0] = ap; LS[1] = hl; }
        __syncthreads();
    }
}
__global__ void __launch_bounds__(512) k_cB(Ctx c) {
    const int i = blockIdx.x * 512 + threadIdx.x; if (i >= NB * G) return;
    const int b = i / G, ch = i % G; float* CC = (float*)(c.ws + OFF_CARRY + c.layer * CARRY_L + CC_OFF);
    float hc = c.slab == 0 ? 0.f : CC[i];
    for (int cl = 0; cl < NCS; ++cl) { float* LS = (float*)(c.ws + OFF_LS) + ((size_t)(b * NCS + cl) * G + ch) * 2; const float ap = LS[0], hl = LS[1]; LS[0] = hc; hc = ap * hc + hl; }
    CC[i] = hc;
}
__global__ void __launch_bounds__(512) k_cC(Ctx c) {
    extern __shared__ float lds[];
    float *xc = lds, *Wr = lds + 4160, *Wi = lds + 8320, *Aa = lds + 12480, *Uu = lds + 16640;
    const int tid = threadIdx.x;
    for (int item = blockIdx.x; item < NB * NCS * NH; item += gridDim.x) {
        int b, cl, h; unit_ids(item, b, cl, h); const int tl0 = cl * 64;
        lru_au(c, b, tl0, h, xc, Wr, Wi, Aa, Uu, tid);
        if (tid < 64) { float hv = ((const float*)(c.ws + OFF_LS))[((size_t)(b * NCS + cl) * G + h * 64 + tid) * 2];
            for (int t = 0; t < 64; ++t) { hv = Aa[t * 65 + tid] * hv + Uu[t * 65 + tid]; Uu[t * 65 + tid] = hv; } }
        __syncthreads();
        for (int idx = tid; idx < 4096; idx += 512) { const int t = idx >> 6, j = idx & 63; bf16_t* prw = (bf16_t*)(c.ws + OFF_P) + (size_t)(b * TS + tl0 + t) * PP;
            const float z = bf2f(prw[ZC + h * 64 + j]); prw[ZC + h * 64 + j] = f2bf(Uu[t * 65 + j] * siluf(z)); }
        __syncthreads();
    }
}
__global__ void __launch_bounds__(512) k_bprep(Ctx c) {
    extern __shared__ float lds[];
    float *wl = lds, *al = lds + 4160, *Wu = lds + 8320, *Au = lds + 12480;
    const int tid = threadIdx.x; const int l = c.layer;
    const float* mu = c.rmu + l * 1664;
    for (int item = blockIdx.x; item < NB * NCS * NH; item += gridDim.x) {
        int b, cl, h; unit_ids(item, b, cl, h); const int tl0 = cl * 64;
        for (int idx = tid; idx < 4096; idx += 512) { const int t = idx >> 6, i = idx & 63;
            const bf16_t* r0 = prow(c.ws, l, c.slab, b, tl0 + t); const bf16_t* r1 = prow(c.ws, l, c.slab, b, tl0 + t - 1);
            float x = bf2f(r0[B_WLO + i]), xp = bf2f(r1[B_WLO + i]); wl[t * 65 + i] = tanhf(x + mu[1536 + i] * (xp - x));
            x = bf2f(r0[B_ALO + i]); xp = bf2f(r1[B_ALO + i]); al[t * 65 + i] = x + mu[1600 + i] * (xp - x);
            Wu[t * 65 + i] = c.rw_up[(size_t)l * 64 * G + t * G + h * 64 + i]; Au[t * 65 + i] = c.ra_up[(size_t)l * 64 * G + t * G + h * 64 + i]; }
        __syncthreads();
        const int t = tid >> 3, j0 = (tid & 7) * 8; float dl[8] = {}, da[8] = {};
        for (int i = 0; i < 64; ++i) { const float wv = wl[t * 65 + i], av = al[t * 65 + i];
#pragma unroll
            for (int j = 0; j < 8; ++j) { dl[j] += wv * Wu[i * 65 + j0 + j]; da[j] += av * Au[i * 65 + j0 + j]; } }
        const bf16_t* r0 = prow(c.ws, l, c.slab, b, tl0 + t); const bf16_t* r1 = prow(c.ws, l, c.slab, b, tl0 + t - 1);
        float omw[8], kh[8], akh[8], kt[8], rr[8]; float ss = 0.f, bon = 0.f;
#pragma unroll
        for (int j = 0; j < 8; ++j) { const int ch = h * 64 + j0 + j;
            const float sg = sigm(c.rw0[l * G + ch] + dl[j]); omw[j] = -expm1f(-0.606531f * sg);
            const float a = sigm(c.ra0[l * G + ch] + da[j]);
            float x = bf2f(r0[B_R + ch]), xp = bf2f(r1[B_R + ch]); rr[j] = x + mu[ch] * (xp - x);
            x = bf2f(r0[B_K + ch]); xp = bf2f(r1[B_K + ch]); const float k = x + mu[512 + ch] * (xp - x);
            const float kap = k * c.rk_k[l * G + ch]; ss += kap * kap; kh[j] = kap; akh[j] = a;
            kt[j] = k * (1.f + (a - 1.f) * c.rk_a[l * G + ch]); bon += rr[j] * c.rr_k[l * G + ch] * kt[j]; }
        ss += __shfl_xor(ss, 1); ss += __shfl_xor(ss, 2); ss += __shfl_xor(ss, 4);
        bon += __shfl_xor(bon, 1); bon += __shfl_xor(bon, 2); bon += __shfl_xor(bon, 4);
        const float rs = rsqrtf(ss + 1e-12f);
#pragma unroll
        for (int j = 0; j < 8; ++j) { kh[j] *= rs; akh[j] *= kh[j]; }
        unsigned char* rec = c.ws + OFF_CK + ((size_t)((b * NH + h) * TS + tl0 + t) * 16 + (j0 >> 2)) * 48;
#pragma unroll
        for (int g2 = 0; g2 < 2; ++g2) { const int o = g2 * 4;
            *(float4*)(rec + g2 * 48) = make_float4(omw[o], omw[o + 1], omw[o + 2], omw[o + 3]);
            uint4 w1; w1.x = f2bf(kh[o]) | ((unsigned)f2bf(kh[o + 1]) << 16); w1.y = f2bf(kh[o + 2]) | ((unsigned)f2bf(kh[o + 3]) << 16);
            w1.z = f2bf(akh[o]) | ((unsigned)f2bf(akh[o + 1]) << 16); w1.w = f2bf(akh[o + 2]) | ((unsigned)f2bf(akh[o + 3]) << 16);
            uint4 w2; w2.x = f2bf(kt[o]) | ((unsigned)f2bf(kt[o + 1]) << 16); w2.y = f2bf(kt[o + 2]) | ((unsigned)f2bf(kt[o + 3]) << 16);
            w2.z = f2bf(rr[o]) | ((unsigned)f2bf(rr[o + 1]) << 16); w2.w = f2bf(rr[o + 2]) | ((unsigned)f2bf(rr[o + 3]) << 16);
            *(uint4*)(rec + g2 * 48 + 16) = w1; *(uint4*)(rec + g2 * 48 + 32) = w2; }
        if ((tid & 7) == 0) ((float*)(c.ws + OFF_BON))[(size_t)(b * TS + tl0 + t) * NH + h] = bon;
        __syncthreads();
    }
    if (c.slab == 0) { bf16_t* halo = (bf16_t*)(c.ws + OFF_CARRY + l * CARRY_L + HALO_OFF);
        for (int i = blockIdx.x * 512 + tid; i < NB * 3 * PP; i += gridDim.x * 512) { const int b = i / (3 * PP), r = (i / PP) % 3, col = i % PP;
            halo[i] = ((const bf16_t*)(c.ws + OFF_P))[(size_t)(b * TS + TS - 3 + r) * PP + col]; } }
}
#define DPP_ADD(v, ctrl) v += __builtin_bit_cast(float, __builtin_amdgcn_update_dpp(0, __builtin_bit_cast(int, v), ctrl, 0xF, 0xF, true))
DI float allred16(float v) { DPP_ADD(v, 0xB1); DPP_ADD(v, 0x4E); DPP_ADD(v, 0x141); DPP_ADD(v, 0x140); return v; }
__global__ void __launch_bounds__(256) k_bscan(Ctx c) {
    const int tid = threadIdx.x, lane = tid & 63, wv = blockIdx.x * 4 + (tid >> 6);
    const int l = c.layer, bh = wv >> 4, jg = wv & 15, b = bh >> 3, h = bh & 7, rr = lane >> 4, kg = lane & 15, row = jg * 4 + rr;
    float* CB = (float*)(c.ws + OFF_CARRY + l * CARRY_L + CB_OFF) + ((size_t)bh * 64 + row) * 64 + kg * 4;
    float S[4];
#pragma unroll
    for (int e = 0; e < 4; ++e) S[e] = c.slab == 0 ? 0.f : CB[e];
    const float muv = c.rmu[l * 1664 + 1024 + h * 64 + row];
    const int vcol = B_V + h * 64 + row;
    float vprev = bf2f(prow(c.ws, l, c.slab, b, -1)[vcol]);
    const unsigned char* rec = c.ws + OFF_CK + ((size_t)bh * TS * 16 + kg) * 48;
    bf16_t* pbase = (bf16_t*)(c.ws + OFF_P) + (size_t)(b * TS) * PP;
    for (int tl = 0; tl < TS; ++tl) {
        const float4 om = *(const float4*)(rec); const uint4 w1 = *(const uint4*)(rec + 16); const uint4 w2 = *(const uint4*)(rec + 32); rec += 16 * 48;
        const float vcur = bf2f(pbase[(size_t)tl * PP + vcol]); const float vm = vcur + muv * (vprev - vcur); vprev = vcur;
        const float kh[4] = {__uint_as_float(w1.x << 16), __uint_as_float(w1.x & 0xffff0000u), __uint_as_float(w1.y << 16), __uint_as_float(w1.y & 0xffff0000u)};
        const float ak[4] = {__uint_as_float(w1.z << 16), __uint_as_float(w1.z & 0xffff0000u), __uint_as_float(w1.w << 16), __uint_as_float(w1.w & 0xffff0000u)};
        const float kt[4] = {__uint_as_float(w2.x << 16), __uint_as_float(w2.x & 0xffff0000u), __uint_as_float(w2.y << 16), __uint_as_float(w2.y & 0xffff0000u)};
        const float rv[4] = {__uint_as_float(w2.z << 16), __uint_as_float(w2.z & 0xffff0000u), __uint_as_float(w2.w << 16), __uint_as_float(w2.w & 0xffff0000u)};
        const float ow[4] = {om.x, om.y, om.z, om.w};
        float sk = S[0] * kh[0] + S[1] * kh[1] + S[2] * kh[2] + S[3] * kh[3];
        sk = allred16(sk);
        float y = 0.f;
#pragma unroll
        for (int e = 0; e < 4; ++e) { S[e] = S[e] - S[e] * ow[e] - sk * ak[e] + vm * kt[e]; y += S[e] * rv[e]; }
        y = allred16(y);
        if (kg == 0) ((float*)(pbase + (size_t)tl * PP + B_R))[h * 64 + row] = y;
    }
#pragma unroll
    for (int e = 0; e < 4; ++e) CB[e] = S[e];
}
__global__ void __launch_bounds__(512) k_bpost(Ctx c) {
    const int lane = threadIdx.x & 63, gw = blockIdx.x * 8 + (threadIdx.x >> 6), NGW = gridDim.x * 8; const int l = c.layer;
    for (int it = gw; it < MS * NH; it += NGW) { const int r = it >> 3, h = it & 7, b = r / TS, tl = r % TS, ch = h * 64 + lane;
        bf16_t* prw = (bf16_t*)(c.ws + OFF_P) + (size_t)r * PP;
        const float w = ((const float*)(prw + B_R))[ch];
        const float mean = wave_sum(w) * (1.f / 64.f); const float d = w - mean; const float var = wave_sum(d * d) * (1.f / 64.f);
        const float nrm = d * rsqrtf(var + 1e-5f);
        const float x = bf2f(prw[B_V + ch]), xp = bf2f(prow(c.ws, l, c.slab, b, tl - 1)[B_V + ch]); const float vm = x + c.rmu[l * 1664 + 1024 + ch] * (xp - x);
        const float bon = ((const float*)(c.ws + OFF_BON))[(size_t)r * NH + h];
        const float z = bf2f(prw[ZB + ch]);
        prw[ZB + ch] = f2bf((nrm * c.rgn_w[l * G + ch] + c.rgn_b[l * G + ch] + bon * vm) * siluf(z)); }
}
__global__ void __launch_bounds__(512) k_post(Ctx c) {
    const int lane = threadIdx.x & 63, gw = blockIdx.x * 8 + (threadIdx.x >> 6), NGW = gridDim.x * 8; const int l = c.layer;
    for (int r = gw; r < MS; r += NGW) { const int b = r / TS, tl = r % TS; const size_t grow = (size_t)b * T + c.slab * TS + tl;
        const float* yrow = (const float*)(c.ws + OFF_Y) + (size_t)r * D; const float* xr = (l == 0 ? c.x : c.out) + grow * D; float* orow = c.out + grow * D;
        float4 v[4]; float ss = 0.f;
#pragma unroll
        for (int j = 0; j < 4; ++j) { v[j] = *(const float4*)(yrow + j * 256 + lane * 4); ss += v[j].x * v[j].x + v[j].y * v[j].y + v[j].z * v[j].z + v[j].w * v[j].w; }
        ss = wave_sum(ss); const float rs = rsqrtf(ss * (1.f / D) + 1e-6f); float s2 = 0.f;
#pragma unroll
        for (int j = 0; j < 4; ++j) { const float4 gg = *(const float4*)(c.norm_post + l * D + j * 256 + lane * 4); const float4 xx = *(const float4*)(xr + j * 256 + lane * 4);
            v[j].x = xx.x + v[j].x * rs * gg.x; v[j].y = xx.y + v[j].y * rs * gg.y; v[j].z = xx.z + v[j].z * rs * gg.z; v[j].w = xx.w + v[j].w * rs * gg.w;
            *(float4*)(orow + j * 256 + lane * 4) = v[j]; s2 += v[j].x * v[j].x + v[j].y * v[j].y + v[j].z * v[j].z + v[j].w * v[j].w; }
        if (l == 0) { s2 = wave_sum(s2); const float r2 = rsqrtf(s2 * (1.f / D) + 1e-6f); bf16_t* hrow = (bf16_t*)(c.ws + OFF_H) + (size_t)r * D;
#pragma unroll
            for (int j = 0; j < 4; ++j) { const float4 gg = *(const float4*)(c.norm_pre + D + j * 256 + lane * 4);
                uint2 o; o.x = f2bf(v[j].x * r2 * gg.x) | ((unsigned)f2bf(v[j].y * r2 * gg.y) << 16); o.y = f2bf(v[j].z * r2 * gg.z) | ((unsigned)f2bf(v[j].w * r2 * gg.w) << 16);
                *(uint2*)(hrow + j * 256 + lane * 4) = o; } }
    }
}

extern "C" void kernel_launch(void* const* d_in, const int* in_sizes, int n_in, void* d_out, int out_size, void* d_ws, size_t ws_size, hipStream_t stream) {
    static bool init = false;
    const int LDSB = 100 * 1024;
    if (!init) { init = true;
        hipFuncSetAttribute((const void*)k_mC, hipFuncAttributeMaxDynamicSharedMemorySize, LDSB); hipFuncSetAttribute((const void*)k_dC, hipFuncAttributeMaxDynamicSharedMemorySize, LDSB);
        hipFuncSetAttribute((const void*)k_cA, hipFuncAttributeMaxDynamicSharedMemorySize, LDSB); hipFuncSetAttribute((const void*)k_cC, hipFuncAttributeMaxDynamicSharedMemorySize, LDSB);
        hipFuncSetAttribute((const void*)k_p0, hipFuncAttributeMaxDynamicSharedMemorySize, LDSB); hipFuncSetAttribute((const void*)k_bprep, hipFuncAttributeMaxDynamicSharedMemorySize, LDSB);
    }
    Ctx c{};
    const float** f = (const float**)&c;
    for (int i = 0; i < 28; ++i) f[i] = (const float*)d_in[i];
    c.out = (float*)d_out; c.ws = (unsigned char*)d_ws;
    hipMemsetAsync(d_ws, 0, 1 * MiB, stream);
    k_p0<<<512, 512, LDSB, stream>>>(c);
    for (int slab = 0; slab < 2; ++slab)
        for (int l = 0; l < NL; ++l) {
            c.layer = l; c.slab = slab;
            if (l == 0) k_prenorm<<<512, 512, 0, stream>>>(c);
            k_gemm<true><<<1024, 512, 32768, stream>>>((const bf16_t*)((char*)d_ws + OFF_H), D, (const bf16_t*)((char*)d_ws + OFF_WIN + l * WIN_L), D, (char*)d_ws + OFF_P, PP, MS, PP);
            k_mA<<<1024, 512, 40000, stream>>>(c); k_dA<<<1024, 512, 40000, stream>>>(c); k_cA<<<1024, 512, LDSB, stream>>>(c); k_bprep<<<1024, 512, LDSB, stream>>>(c);
            k_mB<<<288, 512, 0, stream>>>(c); k_dB<<<256, 512, 0, stream>>>(c); k_cB<<<4, 512, 0, stream>>>(c);
            k_bscan<<<128, 256, 0, stream>>>(c);
            k_mC<<<1024, 512, LDSB, stream>>>(c); k_dC<<<1024, 512, LDSB, stream>>>(c); k_cC<<<1024, 512, LDSB, stream>>>(c);
            k_bpost<<<1024, 512, 0, stream>>>(c);
            k_gemm<false><<<512, 512, 32768, stream>>>((const bf16_t*)((char*)d_ws + OFF_P) + ZA, PP, (const bf16_t*)((char*)d_ws + OFF_WOUT + l * WOUT_L), DMIX, (char*)d_ws + OFF_Y, D, MS, D);
            k_post<<<512, 512, 0, stream>>>(c);
        }
}
```

```cpp
#include <hip/hip_runtime.h>
#include <cstdint>
#include <cstdio>

typedef unsigned short bf16_t;
#define DI __device__ __forceinline__

constexpr int NB = 4, T = 4096, D = 1024, NL = 2, G = 512, NH = 8;
constexpr int TS = 2048, MS = NB * TS, NCS = TS / 64;
constexpr int DIN = 7824, PP = 7936, DMIX = 2048;
constexpr int A_Q = 0, A_K = 512, A_V = 1024, A_O = 1536, B_R = 2048, B_K = 2560, B_V = 3072, B_WLO = 3584, B_ALO = 3648, C_X = 3712,
              D_Q = 4224, D_K = 4736, D_V = 5248, ZA = 5760, ZB = 6272, ZC = 6784, ZD = 7296, A_I = 7808, A_F = 7816;
constexpr size_t MiB = 1u << 20;
constexpr size_t OFF_CTL = 0, OFF_ZROW = 512 * 1024, OFF_WIN = 1 * MiB, OFF_WOUT = 32 * MiB, OFF_ROPE = 40 * MiB, OFF_CARRY = 41 * MiB,
                 OFF_LS = 45 * MiB, OFF_BON = 45 * MiB + 512 * 1024, OFF_P = 46 * MiB, OFF_SA = 170 * MiB, OFF_H = 170 * MiB,
                 OFF_SD = 170 * MiB + 17301504, OFF_CK = 203 * MiB, OFF_Y = 203 * MiB;
constexpr size_t WIN_L = (size_t)PP * D * 2, WOUT_L = (size_t)D * DMIX * 2;
constexpr size_t CARRY_L = 2 * MiB, CA_OFF = 0, CD_OFF = 540672, CB_OFF = CD_OFF + 524288, CC_OFF = CB_OFF + 524288, HALO_OFF = CC_OFF + 8192;
constexpr int SAU = 4224;

struct Ctx {
    const float *x, *norm_pre, *norm_post, *w_in, *w_out, *mconv_w, *mconv_b, *mi_bias, *mf_bias, *mnorm_w, *rmu, *rw_up, *rw0, *ra_up, *ra0,
        *rk_k, *rk_a, *rr_k, *rgn_w, *rgn_b, *lconv_w, *lconv_b, *lw_r, *lb_r, *lw_i, *lb_i, *llam, *retnorm_w;
    float* out; unsigned char* ws;
};

DI int otid() { int t = threadIdx.x; asm volatile("" : "+v"(t)); return t; }
DI float bf2f(bf16_t v) { return __uint_as_float(((unsigned)v) << 16); }
DI bf16_t f2bf(float f) { unsigned u = __float_as_uint(f); u += 0x7fffu + ((u >> 16) & 1u); return (bf16_t)(u >> 16); }
DI float sigm(float x) { return 1.f / (1.f + expf(-x)); }
DI float siluf(float x) { return x / (1.f + expf(-x)); }
DI float softplusf(float x) { return fmaxf(x, 0.f) + log1pf(expf(-fabsf(x))); }
DI float wave_sum(float v) {
#pragma unroll
    for (int o = 1; o < 64; o <<= 1) v += __shfl_xor(v, o);
    return v;
}
DI int srccol(int n) {
    if (n < 2048) return n;
    if (n < 3712) return n + 528;
    if (n < 4224) return n + 1040;
    if (n < 5760) return n + 1552;
    if (n < 6272) return n - 3712;
    if (n < 6784) return n - 2032;
    if (n < 7296) return n - 1520;
    if (n < 7808) return n + 16;
    if (n < 7824) return n - 5248;
    return -1;
}
DI const bf16_t* prow(const unsigned char* ws, int layer, int slab, int b, int tl) {
    if (tl >= 0) return (const bf16_t*)(ws + OFF_P) + (size_t)(b * TS + tl) * PP;
    if (slab == 0) return (const bf16_t*)(ws + OFF_ZROW);
    return (const bf16_t*)(ws + OFF_CARRY + layer * CARRY_L + HALO_OFF) + (size_t)(b * 3 + 3 + tl) * PP;
}

DI void wt_item(const float* W, int K, int N, bf16_t* WT, bool permute, float* scr, int item, int lane) {
    const int nblk = (permute ? PP : N) / 32, kb = item / nblk, nb = item % nblk, k0 = 64 * kb, n0 = 32 * nb;
    const int nn = n0 + (lane & 31); const int sc = permute ? srccol(nn) : nn;
    for (int i = 0; i < 32; ++i) { const int kk = 2 * i + (lane >> 5); scr[kk * 33 + (lane & 31)] = sc >= 0 ? W[(size_t)(k0 + kk) * N + sc] : 0.f; }
    __builtin_amdgcn_s_waitcnt(0); __builtin_amdgcn_wave_barrier();
    const int c = lane & 7;
    for (int j = 0; j < 4; ++j) { const int n = (lane >> 3) + 8 * j; const float* s = scr + (8 * c) * 33 + n;
        uint4 o; o.x = f2bf(s[0]) | ((unsigned)f2bf(s[33]) << 16); o.y = f2bf(s[66]) | ((unsigned)f2bf(s[99]) << 16);
        o.z = f2bf(s[132]) | ((unsigned)f2bf(s[165]) << 16); o.w = f2bf(s[198]) | ((unsigned)f2bf(s[231]) << 16);
        *(uint4*)(WT + (size_t)(n0 + n) * K + k0 + 8 * c) = o; }
    __builtin_amdgcn_s_waitcnt(0); __builtin_amdgcn_wave_barrier();
}
DI void s_p0(const Ctx& c, int l, int slab, float* lds, int bid, int nblk) {
    const int tid = otid(), lane = tid & 63, wave = tid >> 6;
    float* scr = lds + wave * (64 * 33);
    const int gw = bid * 8 + wave, NGW = nblk * 8;
    constexpr int I_IN = (D / 64) * (PP / 32), I_OUT = (DMIX / 64) * (D / 32);
    for (int it = gw; it < NL * (I_IN + I_OUT); it += NGW) {
        const int l = it / (I_IN + I_OUT); int r = it % (I_IN + I_OUT);
        if (r < I_IN) wt_item(c.w_in + (size_t)l * D * DIN, D, DIN, (bf16_t*)(c.ws + OFF_WIN + l * WIN_L), true, scr, r, lane);
        else wt_item(c.w_out + (size_t)l * DMIX * D, DMIX, D, (bf16_t*)(c.ws + OFF_WOUT + l * WOUT_L), false, scr, r - I_IN, lane);
    }
    float* rope = (float*)(c.ws + OFF_ROPE);
    for (int i = bid * 512 + tid; i < T * 32; i += nblk * 512) {
        const int t = i >> 5, j = i & 31; const float inv = powf(10000.f, -(float)j / 32.f); const float ang = (float)t * inv;
        rope[2 * i] = cosf(ang); rope[2 * i + 1] = sinf(ang);
    }
}
DI void norm_row(const float* xrow, const float* g, bf16_t* hrow, int lane) {
    float4 v[4]; float ss = 0.f;
#pragma unroll
    for (int j = 0; j < 4; ++j) { v[j] = *(const float4*)(xrow + j * 256 + lane * 4); ss += v[j].x * v[j].x + v[j].y * v[j].y + v[j].z * v[j].z + v[j].w * v[j].w; }
    ss = wave_sum(ss); const float rs = rsqrtf(ss * (1.f / D) + 1e-6f);
#pragma unroll
    for (int j = 0; j < 4; ++j) { const float4 gg = *(const float4*)(g + j * 256 + lane * 4);
        uint2 o; o.x = f2bf(v[j].x * rs * gg.x) | ((unsigned)f2bf(v[j].y * rs * gg.y) << 16); o.y = f2bf(v[j].z * rs * gg.z) | ((unsigned)f2bf(v[j].w * rs * gg.w) << 16);
        *(uint2*)(hrow + j * 256 + lane * 4) = o; }
}
DI void s_prenorm(const Ctx& c, int l, int slab, float* lds, int bid, int nblk) {
    const int lane = otid() & 63, gw = bid * 8 + (otid() >> 6), NGW = nblk * 8;
    for (int r = gw; r < MS; r += NGW) { const int b = r / TS, tl = r % TS; const size_t grow = (size_t)b * T + slab * TS + tl;
        norm_row(c.x + grow * D, c.norm_pre, (bf16_t*)(c.ws + OFF_H) + (size_t)r * D, lane); }
}
template <bool OUT_BF16> DI void s_gemm(const bf16_t* A, int lda, const bf16_t* Bt, int K, void* C, int ldc, int M, int N, float* lds, int bid, int nblk) {
    float* As = lds; float* Bs = lds + 32 * 132;
    const int tid = otid(), ty = tid >> 4, tx = tid & 15;
    const int ntn = N / 64, ntm = M / 128;
    for (int tile = bid; tile < ntn * ntm; tile += nblk) {
        const int m0 = (tile / ntn) * 128, n0 = (tile % ntn) * 64;
        float acc[4][4] = {};
        for (int k0 = 0; k0 < K; k0 += 32) {
            { const int row = tid >> 2, kq = (tid & 3) * 8; const uint4 v = *(const uint4*)(A + (size_t)(m0 + row) * lda + k0 + kq);
              const unsigned w[4] = {v.x, v.y, v.z, v.w};
#pragma unroll
              for (int i = 0; i < 4; ++i) { As[(kq + 2 * i) * 132 + row] = __uint_as_float(w[i] << 16); As[(kq + 2 * i + 1) * 132 + row] = __uint_as_float(w[i] & 0xffff0000u); } }
            if (tid < 256) { const int row = tid >> 2, kq = (tid & 3) * 8; const uint4 v = *(const uint4*)(Bt + (size_t)(n0 + row) * K + k0 + kq);
              const unsigned w[4] = {v.x, v.y, v.z, v.w};
#pragma unroll
              for (int i = 0; i < 4; ++i) { Bs[(kq + 2 * i) * 68 + row] = __uint_as_float(w[i] << 16); Bs[(kq + 2 * i + 1) * 68 + row] = __uint_as_float(w[i] & 0xffff0000u); } }
            __syncthreads();
#pragma unroll 8
            for (int k = 0; k < 32; ++k) { const float4 a = *(const float4*)(As + k * 132 + ty * 4); const float4 b = *(const float4*)(Bs + k * 68 + tx * 4);
                const float av[4] = {a.x, a.y, a.z, a.w}, bv[4] = {b.x, b.y, b.z, b.w};
#pragma unroll
                for (int i = 0; i < 4; ++i)
#pragma unroll
                    for (int j = 0; j < 4; ++j) acc[i][j] += av[i] * bv[j]; }
            __syncthreads();
        }
#pragma unroll
        for (int i = 0; i < 4; ++i) { const size_t off = (size_t)(m0 + ty * 4 + i) * ldc + n0 + tx * 4;
            if (OUT_BF16) { uint2 o; o.x = f2bf(acc[i][0]) | ((unsigned)f2bf(acc[i][1]) << 16); o.y = f2bf(acc[i][2]) | ((unsigned)f2bf(acc[i][3]) << 16); *(uint2*)((bf16_t*)C + off) = o; }
            else *(float4*)((float*)C + off) = make_float4(acc[i][0], acc[i][1], acc[i][2], acc[i][3]); }
    }
}
DI void load_conv_tile(const Ctx& c, int l, int slab, int b, int tl0, int col0, const float* cw, int cwstride, const float* cb, bool act, float scale, float* dst, int tid) {
    for (int idx = tid; idx < 4096; idx += 512) { const int t = idx >> 6, j = idx & 63; float acc = cb[j];
#pragma unroll
        for (int w = 0; w < 4; ++w) acc += bf2f(prow(c.ws, l, slab, b, tl0 + t - 3 + w)[col0 + j]) * cw[w * cwstride + j];
        if (act) acc = siluf(acc);
        dst[t * 65 + j] = acc * scale; }
}
DI void load_plain_tile(const Ctx& c, int l, int slab, int b, int tl0, int col0, float* dst, int tid) {
    for (int idx = tid; idx < 4096; idx += 512) { const int t = idx >> 6, j = idx & 63; dst[t * 65 + j] = bf2f(prow(c.ws, l, slab, b, tl0 + t)[col0 + j]); }
}
DI void load_rope_tile(const Ctx& c, int l, int slab, int b, int tl0, int col0, float scale, float* dst, int tid) {
    const float* rope = (const float*)(c.ws + OFF_ROPE);
    for (int idx = tid; idx < 4096; idx += 512) { const int t = idx >> 6, j = idx & 63, jj = j & 31; const bf16_t* r = prow(c.ws, l, slab, b, tl0 + t);
        const int pos = slab * TS + tl0 + t; const float cs = rope[(pos * 32 + jj) * 2], sn = rope[(pos * 32 + jj) * 2 + 1];
        const float x1 = bf2f(r[col0 + jj]), x2 = bf2f(r[col0 + 32 + jj]);
        dst[t * 65 + j] = (j < 32 ? x1 * cs - x2 * sn : x2 * cs + x1 * sn) * scale; }
}
DI void mlstm_gates(const Ctx& c, int l, int slab, int b, int tl0, int h, float* ig, float* lf, float* cum, int tid) {
    if (tid < 64) { const bf16_t* r = prow(c.ws, l, slab, b, tl0 + tid);
        ig[tid] = bf2f(r[A_I + h]) + c.mi_bias[l * NH + h];
        lf[tid] = -softplusf(-(bf2f(r[A_F + h]) + c.mf_bias[l * NH + h])); }
    __syncthreads();
    if (tid == 0) { float s = 0.f; for (int t = 0; t < 64; ++t) { s += lf[t]; cum[t] = s; } }
    __syncthreads();
}
DI void unit_ids(int item, int& b, int& cl, int& h) { b = item / (NCS * NH); cl = (item / NH) % NCS; h = item % NH; }
DI void s_mA(const Ctx& c, int l, int slab, float* lds, int bid, int nblk) {
    float *kk = lds, *vv = lds + 4160, *ig = lds + 8320, *lf = ig + 64, *cum = lf + 64, *wj = cum + 64, *sc = wj + 64;
    const int tid = otid();
    for (int item = bid; item < NB * NCS * NH; item += nblk) {
        int b, cl, h; unit_ids(item, b, cl, h); const int tl0 = cl * 64; const int u = (b * NH + h) * NCS + cl;
        load_conv_tile(c, l, slab, b, tl0, A_K + h * 64, c.mconv_w + l * 4096 + 512 + h * 64, 1024, c.mconv_b + l * 1024 + 512 + h * 64, true, 0.125f, kk, tid);
        load_plain_tile(c, l, slab, b, tl0, A_V + h * 64, vv, tid);
        mlstm_gates(c, l, slab, b, tl0, h, ig, lf, cum, tid);
        if (tid == 0) { const float tot = cum[63]; float m = -INFINITY; for (int t = 0; t < 64; ++t) m = fmaxf(m, tot - cum[t] + ig[t]); sc[0] = m; sc[1] = tot; }
        __syncthreads();
        if (tid < 64) wj[tid] = expf(sc[1] - cum[tid] + ig[tid] - sc[0]);
        __syncthreads();
        float* S = (float*)(c.ws + OFF_SA) + (size_t)u * SAU;
        { const int e = tid >> 3, d0 = (tid & 7) * 8; float acc[8] = {};
          for (int t = 0; t < 64; ++t) { const float a = wj[t] * vv[t * 65 + e];
#pragma unroll
              for (int i = 0; i < 8; ++i) acc[i] += a * kk[t * 65 + d0 + i]; }
#pragma unroll
          for (int i = 0; i < 8; ++i) S[e * 64 + d0 + i] = acc[i]; }
        if (tid < 64) { float a = 0.f; for (int t = 0; t < 64; ++t) a += wj[t] * kk[t * 65 + tid]; S[4096 + tid] = a; }
        if (tid == 0) { S[4160] = sc[0]; S[4161] = sc[1]; }
        __syncthreads();
    }
}
DI void s_mB(const Ctx& c, int l, int slab, float* lds, int bid, int nblk) {
    const int tid = otid();
    for (int item = bid; item < NB * NH * 9; item += nblk) {
        const int bh = item / 9, part = item % 9, el = part * 512 + tid; const bool on = el < 4160;
        float* CA = (float*)(c.ws + OFF_CARRY + l * CARRY_L + CA_OFF) + (size_t)bh * SAU;
        float m = slab == 0 ? 0.f : CA[4160 + slab - 1]; float val = (slab == 0 || !on) ? 0.f : CA[el];
        for (int cl = 0; cl < NCS; ++cl) { float* S = (float*)(c.ws + OFF_SA) + (size_t)(bh * NCS + cl) * SAU;
            const float mloc = S[4160], tot = S[4161]; const float loc = on ? S[el] : 0.f;
            if (on) S[el] = val;
            if (el == 0) S[4162] = m;
            const float mn = fmaxf(tot + m, mloc); val = expf(tot + m - mn) * val + expf(mloc - mn) * loc; m = mn; }
        if (on) CA[el] = val;
        if (el == 0) CA[4160 + slab] = m;
    }
}
DI void s_mC(const Ctx& c, int l, int slab, float* lds, int bid, int nblk) {
    float *qq = lds, *kk = lds + 4160, *vv = lds + 8320, *Cs = lds + 12480, *Sm = lds + 16640, *ig = lds + 20800, *lf = ig + 64, *cum = lf + 64, *mx = cum + 64, *ns = mx + 64, *den = ns + 64;
    const int tid = otid();
    for (int item = bid; item < NB * NCS * NH; item += nblk) {
        int b, cl, h; unit_ids(item, b, cl, h); const int tl0 = cl * 64; const int u = (b * NH + h) * NCS + cl;
        const float* S = (const float*)(c.ws + OFF_SA) + (size_t)u * SAU;
        load_conv_tile(c, l, slab, b, tl0, A_Q + h * 64, c.mconv_w + l * 4096 + h * 64, 1024, c.mconv_b + l * 1024 + h * 64, true, 1.f, qq, tid);
        load_conv_tile(c, l, slab, b, tl0, A_K + h * 64, c.mconv_w + l * 4096 + 512 + h * 64, 1024, c.mconv_b + l * 1024 + 512 + h * 64, true, 0.125f, kk, tid);
        load_plain_tile(c, l, slab, b, tl0, A_V + h * 64, vv, tid);
        for (int idx = tid; idx < 4096; idx += 512) Cs[(idx >> 6) * 65 + (idx & 63)] = S[idx];
        if (tid < 64) ns[tid] = S[4096 + tid];
        const float mst = S[4162];
        mlstm_gates(c, l, slab, b, tl0, h, ig, lf, cum, tid);
        if (tid == 0) { float g = -INFINITY; for (int t = 0; t < 64; ++t) { g = fmaxf(g, ig[t] - cum[t]); mx[t] = fmaxf(mst, g); } }
        __syncthreads();
        const int t = tid >> 3, s0 = (tid & 7) * 8;
        { float acc[8] = {};
#pragma unroll 2
        for (int d = 0; d < 64; ++d) { const float qv = qq[t * 65 + d];
#pragma unroll
              for (int i = 0; i < 8; ++i) acc[i] += qv * kk[(s0 + i) * 65 + d]; }
#pragma unroll
          for (int i = 0; i < 8; ++i) { const int s = s0 + i; Sm[t * 65 + s] = s <= t ? acc[i] * expf(ig[s] - cum[s] - mx[t]) : 0.f; } }
        __syncthreads();
        const float sint = expf(mst - mx[t]);
        float num[8] = {}, qc[8] = {};
#pragma unroll 2
        for (int s = 0; s < 64; ++s) { const float pv = Sm[t * 65 + s];
#pragma unroll
            for (int i = 0; i < 8; ++i) num[i] += pv * vv[s * 65 + s0 + i]; }
#pragma unroll 2
        for (int d = 0; d < 64; ++d) { const float qv = qq[t * 65 + d];
#pragma unroll
            for (int i = 0; i < 8; ++i) qc[i] += qv * Cs[(s0 + i) * 65 + d]; }
        if (tid < 64) { float a = 0.f, q = 0.f;
#pragma unroll 4
            for (int s = 0; s < 64; ++s) a += Sm[tid * 65 + s];
#pragma unroll 4
            for (int d = 0; d < 64; ++d) q += qq[tid * 65 + d] * ns[d];
            den[tid] = a + expf(mst - mx[tid]) * q; }
        __syncthreads();
        const float dn = fmaxf(fabsf(den[t]), expf(-(cum[t] + mx[t])));
        bf16_t* prw = (bf16_t*)(c.ws + OFF_P) + (size_t)(b * TS + tl0 + t) * PP;
        float ho[8], sum = 0.f;
#pragma unroll
        for (int i = 0; i < 8; ++i) { const float hh = (num[i] + sint * qc[i]) / dn; ho[i] = hh * sigm(bf2f(prw[A_O + h * 64 + s0 + i])); sum += ho[i]; }
        sum += __shfl_xor(sum, 1); sum += __shfl_xor(sum, 2); sum += __shfl_xor(sum, 4);
        const float mu = sum * (1.f / 64.f); float vs = 0.f;
#pragma unroll
        for (int i = 0; i < 8; ++i) { ho[i] -= mu; vs += ho[i] * ho[i]; }
        vs += __shfl_xor(vs, 1); vs += __shfl_xor(vs, 2); vs += __shfl_xor(vs, 4);
        const float rstd = rsqrtf(vs * (1.f / 64.f) + 1e-5f);
#pragma unroll
        for (int i = 0; i < 8; ++i) { const int ch = h * 64 + s0 + i; const float z = bf2f(prw[ZA + ch]); prw[ZA + ch] = f2bf(ho[i] * rstd * c.mnorm_w[l * G + ch] * siluf(z)); }
        __syncthreads();
    }
}
DI float ret_logg(int h) { return log1pf(-exp2f(-5.f - (float)h)); }
DI void s_dA(const Ctx& c, int l, int slab, float* lds, int bid, int nblk) {
    float *kk = lds, *vv = lds + 4160;
    const int tid = otid();
    for (int item = bid; item < NB * NCS * NH; item += nblk) {
        int b, cl, h; unit_ids(item, b, cl, h); const int tl0 = cl * 64; const int u = (b * NH + h) * NCS + cl; const float lg = ret_logg(h);
        load_rope_tile(c, l, slab, b, tl0, D_K + h * 64, 0.125f, kk, tid);
        load_plain_tile(c, l, slab, b, tl0, D_V + h * 64, vv, tid);
        __syncthreads();
        float* S = (float*)(c.ws + OFF_SD) + (size_t)u * 4096;
        const int d = tid >> 3, e0 = (tid & 7) * 8; float acc[8] = {};
        for (int s = 0; s < 64; ++s) { const float a = expf(lg * (float)(63 - s)) * kk[s * 65 + d];
#pragma unroll
            for (int i = 0; i < 8; ++i) acc[i] += a * vv[s * 65 + e0 + i]; }
#pragma unroll
        for (int i = 0; i < 8; ++i) S[d * 64 + e0 + i] = acc[i];
        __syncthreads();
    }
}
DI void s_dB(const Ctx& c, int l, int slab, float* lds, int bid, int nblk) {
    const int tid = otid();
    for (int item = bid; item < NB * NH * 8; item += nblk) {
        const int bh = item / 8, el = (item % 8) * 512 + tid; const float gch = expf(ret_logg(bh % NH) * 64.f);
        float* CD = (float*)(c.ws + OFF_CARRY + l * CARRY_L + CD_OFF) + (size_t)bh * 4096;
        float val = slab == 0 ? 0.f : CD[el];
        for (int cl = 0; cl < NCS; ++cl) { float* S = (float*)(c.ws + OFF_SD) + (size_t)(bh * NCS + cl) * 4096; const float loc = S[el]; S[el] = val; val = gch * val + loc; }
        CD[el] = val;
    }
}
DI void s_dC(const Ctx& c, int l, int slab, float* lds, int bid, int nblk) {
    float *qq = lds, *kk = lds + 4160, *vv = lds + 8320, *Rs = lds + 12480, *Sm = lds + 16640;
    const int tid = otid();
    for (int item = bid; item < NB * NCS * NH; item += nblk) {
        int b, cl, h; unit_ids(item, b, cl, h); const int tl0 = cl * 64; const int u = (b * NH + h) * NCS + cl; const float lg = ret_logg(h);
        const float* S = (const float*)(c.ws + OFF_SD) + (size_t)u * 4096;
        load_rope_tile(c, l, slab, b, tl0, D_Q + h * 64, 1.f, qq, tid);
        load_rope_tile(c, l, slab, b, tl0, D_K + h * 64, 0.125f, kk, tid);
        load_plain_tile(c, l, slab, b, tl0, D_V + h * 64, vv, tid);
        for (int idx = tid; idx < 4096; idx += 512) Rs[(idx >> 6) * 65 + (idx & 63)] = S[idx];
        __syncthreads();
        const int t = tid >> 3, s0 = (tid & 7) * 8;
        { float acc[8] = {};
#pragma unroll 2
        for (int d = 0; d < 64; ++d) { const float qv = qq[t * 65 + d];
#pragma unroll
              for (int i = 0; i < 8; ++i) acc[i] += qv * kk[(s0 + i) * 65 + d]; }
#pragma unroll
          for (int i = 0; i < 8; ++i) { const int s = s0 + i; Sm[t * 65 + s] = acc[i] * expf(lg * fabsf((float)(t - s))); } }
        __syncthreads();
        float o[8] = {}, qr[8] = {};
#pragma unroll 2
        for (int s = 0; s < 64; ++s) { const float pv = Sm[t * 65 + s];
#pragma unroll
            for (int i = 0; i < 8; ++i) o[i] += pv * vv[s * 65 + s0 + i]; }
#pragma unroll 2
        for (int d = 0; d < 64; ++d) { const float qv = qq[t * 65 + d];
#pragma unroll
            for (int i = 0; i < 8; ++i) qr[i] += qv * Rs[d * 65 + s0 + i]; }
        const float xi = expf(lg * (float)(t + 1));
        float sum = 0.f;
#pragma unroll
        for (int i = 0; i < 8; ++i) { o[i] += xi * qr[i]; sum += o[i]; }
        sum += __shfl_xor(sum, 1); sum += __shfl_xor(sum, 2); sum += __shfl_xor(sum, 4);
        const float mu = sum * (1.f / 64.f); float vs = 0.f;
#pragma unroll
        for (int i = 0; i < 8; ++i) { o[i] -= mu; vs += o[i] * o[i]; }
        vs += __shfl_xor(vs, 1); vs += __shfl_xor(vs, 2); vs += __shfl_xor(vs, 4);
        const float rstd = rsqrtf(vs * (1.f / 64.f) + 1e-5f);
        bf16_t* prw = (bf16_t*)(c.ws + OFF_P) + (size_t)(b * TS + tl0 + t) * PP;
#pragma unroll
        for (int i = 0; i < 8; ++i) { const int ch = h * 64 + s0 + i; const float z = bf2f(prw[ZD + ch]); prw[ZD + ch] = f2bf(o[i] * rstd * c.retnorm_w[l * G + ch] * siluf(z)); }
        __syncthreads();
    }
}
DI void lru_au(const Ctx& c, int l, int slab, int b, int tl0, int h, float* xc, float* Wr, float* Wi, float* Aa, float* Uu, int tid) {
    load_conv_tile(c, l, slab, b, tl0, C_X + h * 64, c.lconv_w + l * 2048 + h * 64, 512, c.lconv_b + l * 512 + h * 64, false, 1.f, xc, tid);
    for (int idx = tid; idx < 4096; idx += 512) { Wr[(idx >> 6) * 65 + (idx & 63)] = c.lw_r[(size_t)(l * NH + h) * 4096 + idx]; Wi[(idx >> 6) * 65 + (idx & 63)] = c.lw_i[(size_t)(l * NH + h) * 4096 + idx]; }
    __syncthreads();
    const int t = tid >> 3, j0 = (tid & 7) * 8; float ar[8] = {}, ai[8] = {};
    for (int i = 0; i < 64; ++i) { const float xv = xc[t * 65 + i];
#pragma unroll
        for (int j = 0; j < 8; ++j) { ar[j] += xv * Wr[i * 65 + j0 + j]; ai[j] += xv * Wi[i * 65 + j0 + j]; } }
#pragma unroll
    for (int j = 0; j < 8; ++j) { const int ch = h * 64 + j0 + j; const float r = sigm(ar[j] + c.lb_r[l * G + ch]), ii = sigm(ai[j] + c.lb_i[l * G + ch]);
        const float la = -8.f * r * softplusf(-c.llam[l * G + ch]);
        Aa[t * 65 + j0 + j] = expf(la); Uu[t * 65 + j0 + j] = sqrtf(-expm1f(2.f * la)) * (ii * xc[t * 65 + j0 + j]); }
    __syncthreads();
}
DI void s_cA(const Ctx& c, int l, int slab, float* lds, int bid, int nblk) {
    float *xc = lds, *Wr = lds + 4160, *Wi = lds + 8320, *Aa = lds + 12480, *Uu = lds + 16640;
    const int tid = otid();
    for (int item = bid; item < NB * NCS * NH; item += nblk) {
        int b, cl, h; unit_ids(item, b, cl, h);
        lru_au(c, l, slab, b, cl * 64, h, xc, Wr, Wi, Aa, Uu, tid);
        if (tid < 64) { float hl = 0.f, ap = 1.f; for (int t = 0; t < 64; ++t) { hl = Aa[t * 65 + tid] * hl + Uu[t * 65 + tid]; ap *= Aa[t * 65 + tid]; }
            float* LS = (float*)(c.ws + OFF_LS) + ((size_t)(b * NCS + cl) * G + h * 64 + tid) * 2; LS[0] = ap; LS[1] = hl; }
        __syncthreads();
    }
}
DI void s_cB(const Ctx& c, int l, int slab, float* lds, int bid, int nblk) {
    for (int i = bid * 512 + otid(); i < NB * G; i += nblk * 512) {
    const int b = i / G, ch = i % G; float* CC = (float*)(c.ws + OFF_CARRY + l * CARRY_L + CC_OFF);
    float hc = slab == 0 ? 0.f : CC[i];
    for (int cl = 0; cl < NCS; ++cl) { float* LS = (float*)(c.ws + OFF_LS) + ((size_t)(b * NCS + cl) * G + ch) * 2; const float ap = LS[0], hl = LS[1]; LS[0] = hc; hc = ap * hc + hl; }
    CC[i] = hc; }
}
DI void s_cC(const Ctx& c, int l, int slab, float* lds, int bid, int nblk) {
    float *xc = lds, *Wr = lds + 4160, *Wi = lds + 8320, *Aa = lds + 12480, *Uu = lds + 16640;
    const int tid = otid();
    for (int item = bid; item < NB * NCS * NH; item += nblk) {
        int b, cl, h; unit_ids(item, b, cl, h); const int tl0 = cl * 64;
        lru_au(c, l, slab, b, tl0, h, xc, Wr, Wi, Aa, Uu, tid);
        if (tid < 64) { float hv = ((const float*)(c.ws + OFF_LS))[((size_t)(b * NCS + cl) * G + h * 64 + tid) * 2];
            for (int t = 0; t < 64; ++t) { hv = Aa[t * 65 + tid] * hv + Uu[t * 65 + tid]; Uu[t * 65 + tid] = hv; } }
        __syncthreads();
        for (int idx = tid; idx < 4096; idx += 512) { const int t = idx >> 6, j = idx & 63; bf16_t* prw = (bf16_t*)(c.ws + OFF_P) + (size_t)(b * TS + tl0 + t) * PP;
            const float z = bf2f(prw[ZC + h * 64 + j]); prw[ZC + h * 64 + j] = f2bf(Uu[t * 65 + j] * siluf(z)); }
        __syncthreads();
    }
}
DI void s_bprep(const Ctx& c, int l, int slab, float* lds, int bid, int nblk) {
    float *wl = lds, *al = lds + 4160, *Wu = lds + 8320, *Au = lds + 12480;
    const int tid = otid();
    const float* mu = c.rmu + l * 1664;
    for (int item = bid; item < NB * NCS * NH; item += nblk) {
        int b, cl, h; unit_ids(item, b, cl, h); const int tl0 = cl * 64;
        for (int idx = tid; idx < 4096; idx += 512) { const int t = idx >> 6, i = idx & 63;
            const bf16_t* r0 = prow(c.ws, l, slab, b, tl0 + t); const bf16_t* r1 = prow(c.ws, l, slab, b, tl0 + t - 1);
            float x = bf2f(r0[B_WLO + i]), xp = bf2f(r1[B_WLO + i]); wl[t * 65 + i] = tanhf(x + mu[1536 + i] * (xp - x));
            x = bf2f(r0[B_ALO + i]); xp = bf2f(r1[B_ALO + i]); al[t * 65 + i] = x + mu[1600 + i] * (xp - x);
            Wu[t * 65 + i] = c.rw_up[(size_t)l * 64 * G + t * G + h * 64 + i]; Au[t * 65 + i] = c.ra_up[(size_t)l * 64 * G + t * G + h * 64 + i]; }
        __syncthreads();
        const int t = tid >> 3, j0 = (tid & 7) * 8; float dl[8] = {}, da[8] = {};
        for (int i = 0; i < 64; ++i) { const float wv = wl[t * 65 + i], av = al[t * 65 + i];
#pragma unroll
            for (int j = 0; j < 8; ++j) { dl[j] += wv * Wu[i * 65 + j0 + j]; da[j] += av * Au[i * 65 + j0 + j]; } }
        const bf16_t* r0 = prow(c.ws, l, slab, b, tl0 + t); const bf16_t* r1 = prow(c.ws, l, slab, b, tl0 + t - 1);
        float omw[8], kh[8], akh[8], kt[8], rr[8]; float ss = 0.f, bon = 0.f;
#pragma unroll
        for (int j = 0; j < 8; ++j) { const int ch = h * 64 + j0 + j;
            const float sg = sigm(c.rw0[l * G + ch] + dl[j]); omw[j] = -expm1f(-0.606531f * sg);
            const float a = sigm(c.ra0[l * G + ch] + da[j]);
            float x = bf2f(r0[B_R + ch]), xp = bf2f(r1[B_R + ch]); rr[j] = x + mu[ch] * (xp - x);
            x = bf2f(r0[B_K + ch]); xp = bf2f(r1[B_K + ch]); const float k = x + mu[512 + ch] * (xp - x);
            const float kap = k * c.rk_k[l * G + ch]; ss += kap * kap; kh[j] = kap; akh[j] = a;
            kt[j] = k * (1.f + (a - 1.f) * c.rk_a[l * G + ch]); bon += rr[j] * c.rr_k[l * G + ch] * kt[j]; }
        ss += __shfl_xor(ss, 1); ss += __shfl_xor(ss, 2); ss += __shfl_xor(ss, 4);
        bon += __shfl_xor(bon, 1); bon += __shfl_xor(bon, 2); bon += __shfl_xor(bon, 4);
        const float rs = rsqrtf(ss + 1e-12f);
#pragma unroll
        for (int j = 0; j < 8; ++j) { kh[j] *= rs; akh[j] *= kh[j]; }
        unsigned char* rec = c.ws + OFF_CK + ((size_t)((b * NH + h) * TS + tl0 + t) * 16 + (j0 >> 2)) * 48;
#pragma unroll
        for (int g2 = 0; g2 < 2; ++g2) { const int o = g2 * 4;
            *(float4*)(rec + g2 * 48) = make_float4(omw[o], omw[o + 1], omw[o + 2], omw[o + 3]);
            uint4 w1; w1.x = f2bf(kh[o]) | ((unsigned)f2bf(kh[o + 1]) << 16); w1.y = f2bf(kh[o + 2]) | ((unsigned)f2bf(kh[o + 3]) << 16);
            w1.z = f2bf(akh[o]) | ((unsigned)f2bf(akh[o + 1]) << 16); w1.w = f2bf(akh[o + 2]) | ((unsigned)f2bf(akh[o + 3]) << 16);
            uint4 w2; w2.x = f2bf(kt[o]) | ((unsigned)f2bf(kt[o + 1]) << 16); w2.y = f2bf(kt[o + 2]) | ((unsigned)f2bf(kt[o + 3]) << 16);
            w2.z = f2bf(rr[o]) | ((unsigned)f2bf(rr[o + 1]) << 16); w2.w = f2bf(rr[o + 2]) | ((unsigned)f2bf(rr[o + 3]) << 16);
            *(uint4*)(rec + g2 * 48 + 16) = w1; *(uint4*)(rec + g2 * 48 + 32) = w2; }
        if ((tid & 7) == 0) ((float*)(c.ws + OFF_BON))[(size_t)(b * TS + tl0 + t) * NH + h] = bon;
        __syncthreads();
    }
    if (slab == 0) { bf16_t* halo = (bf16_t*)(c.ws + OFF_CARRY + l * CARRY_L + HALO_OFF);
        for (int i = bid * 512 + tid; i < NB * 3 * PP; i += nblk * 512) { const int b = i / (3 * PP), r = (i / PP) % 3, col = i % PP;
            halo[i] = ((const bf16_t*)(c.ws + OFF_P))[(size_t)(b * TS + TS - 3 + r) * PP + col]; } }
}
#define DPP_ADD(v, ctrl) v += __builtin_bit_cast(float, __builtin_amdgcn_update_dpp(0, __builtin_bit_cast(int, v), ctrl, 0xF, 0xF, true))
DI float allred16(float v) { DPP_ADD(v, 0xB1); DPP_ADD(v, 0x4E); DPP_ADD(v, 0x141); DPP_ADD(v, 0x140); return v; }
DI void s_bscan(const Ctx& c, int l, int slab, float* lds, int bid, int nblk) {
    const int tid = otid(), lane = tid & 63, wv = bid * 4 + (tid >> 6);
    const int bh = wv >> 4, jg = wv & 15, b = bh >> 3, h = bh & 7, rr = lane >> 4, kg = lane & 15, row = jg * 4 + rr;
    float* CB = (float*)(c.ws + OFF_CARRY + l * CARRY_L + CB_OFF) + ((size_t)bh * 64 + row) * 64 + kg * 4;
    float S[4];
#pragma unroll
    for (int e = 0; e < 4; ++e) S[e] = slab == 0 ? 0.f : CB[e];
    const float muv = c.rmu[l * 1664 + 1024 + h * 64 + row];
    const int vcol = B_V + h * 64 + row;
    float vprev = bf2f(prow(c.ws, l, slab, b, -1)[vcol]);
    const unsigned char* rec = c.ws + OFF_CK + ((size_t)bh * TS * 16 + kg) * 48;
    bf16_t* pbase = (bf16_t*)(c.ws + OFF_P) + (size_t)(b * TS) * PP;
    for (int tl = 0; tl < TS; ++tl) {
        const float4 om = *(const float4*)(rec); const uint4 w1 = *(const uint4*)(rec + 16); const uint4 w2 = *(const uint4*)(rec + 32); rec += 16 * 48;
        const float vcur = bf2f(pbase[(size_t)tl * PP + vcol]); const float vm = vcur + muv * (vprev - vcur); vprev = vcur;
        const float kh[4] = {__uint_as_float(w1.x << 16), __uint_as_float(w1.x & 0xffff0000u), __uint_as_float(w1.y << 16), __uint_as_float(w1.y & 0xffff0000u)};
        const float ak[4] = {__uint_as_float(w1.z << 16), __uint_as_float(w1.z & 0xffff0000u), __uint_as_float(w1.w << 16), __uint_as_float(w1.w & 0xffff0000u)};
        const float kt[4] = {__uint_as_float(w2.x << 16), __uint_as_float(w2.x & 0xffff0000u), __uint_as_float(w2.y << 16), __uint_as_float(w2.y & 0xffff0000u)};
        const float rv[4] = {__uint_as_float(w2.z << 16), __uint_as_float(w2.z & 0xffff0000u), __uint_as_float(w2.w << 16), __uint_as_float(w2.w & 0xffff0000u)};
        const float ow[4] = {om.x, om.y, om.z, om.w};
        float sk = S[0] * kh[0] + S[1] * kh[1] + S[2] * kh[2] + S[3] * kh[3];
        sk = allred16(sk);
        float y = 0.f;
#pragma unroll
        for (int e = 0; e < 4; ++e) { S[e] = S[e] - S[e] * ow[e] - sk * ak[e] + vm * kt[e]; y += S[e] * rv[e]; }
        y = allred16(y);
        if (kg == 0) ((float*)(pbase + (size_t)tl * PP + B_R))[h * 64 + row] = y;
    }
#pragma unroll
    for (int e = 0; e < 4; ++e) CB[e] = S[e];
}
DI void s_bpost(const Ctx& c, int l, int slab, float* lds, int bid, int nblk) {
    const int lane = otid() & 63, gw = bid * 8 + (otid() >> 6), NGW = nblk * 8;
    for (int it = gw; it < MS * NH; it += NGW) { const int r = it >> 3, h = it & 7, b = r / TS, tl = r % TS, ch = h * 64 + lane;
        bf16_t* prw = (bf16_t*)(c.ws + OFF_P) + (size_t)r * PP;
        const float w = ((const float*)(prw + B_R))[ch];
        const float mean = wave_sum(w) * (1.f / 64.f); const float d = w - mean; const float var = wave_sum(d * d) * (1.f / 64.f);
        const float nrm = d * rsqrtf(var + 1e-5f);
        const float x = bf2f(prw[B_V + ch]), xp = bf2f(prow(c.ws, l, slab, b, tl - 1)[B_V + ch]); const float vm = x + c.rmu[l * 1664 + 1024 + ch] * (xp - x);
        const float bon = ((const float*)(c.ws + OFF_BON))[(size_t)r * NH + h];
        const float z = bf2f(prw[ZB + ch]);
        prw[ZB + ch] = f2bf((nrm * c.rgn_w[l * G + ch] + c.rgn_b[l * G + ch] + bon * vm) * siluf(z)); }
}
DI void s_post(const Ctx& c, int l, int slab, float* lds, int bid, int nblk) {
    const int lane = otid() & 63, gw = bid * 8 + (otid() >> 6), NGW = nblk * 8;
    for (int r = gw; r < MS; r += NGW) { const int b = r / TS, tl = r % TS; const size_t grow = (size_t)b * T + slab * TS + tl;
        const float* yrow = (const float*)(c.ws + OFF_Y) + (size_t)r * D; const float* xr = (l == 0 ? c.x : c.out) + grow * D; float* orow = c.out + grow * D;
        float4 v[4]; float ss = 0.f;
#pragma unroll
        for (int j = 0; j < 4; ++j) { v[j] = *(const float4*)(yrow + j * 256 + lane * 4); ss += v[j].x * v[j].x + v[j].y * v[j].y + v[j].z * v[j].z + v[j].w * v[j].w; }
        ss = wave_sum(ss); const float rs = rsqrtf(ss * (1.f / D) + 1e-6f); float s2 = 0.f;
#pragma unroll
        for (int j = 0; j < 4; ++j) { const float4 gg = *(const float4*)(c.norm_post + l * D + j * 256 + lane * 4); const float4 xx = *(const float4*)(xr + j * 256 + lane * 4);
            v[j].x = xx.x + v[j].x * rs * gg.x; v[j].y = xx.y + v[j].y * rs * gg.y; v[j].z = xx.z + v[j].z * rs * gg.z; v[j].w = xx.w + v[j].w * rs * gg.w;
            *(float4*)(orow + j * 256 + lane * 4) = v[j]; s2 += v[j].x * v[j].x + v[j].y * v[j].y + v[j].z * v[j].z + v[j].w * v[j].w; }
        if (l == 0) { s2 = wave_sum(s2); const float r2 = rsqrtf(s2 * (1.f / D) + 1e-6f); bf16_t* hrow = (bf16_t*)(c.ws + OFF_H) + (size_t)r * D;
#pragma unroll
            for (int j = 0; j < 4; ++j) { const float4 gg = *(const float4*)(c.norm_pre + D + j * 256 + lane * 4);
                uint2 o; o.x = f2bf(v[j].x * r2 * gg.x) | ((unsigned)f2bf(v[j].y * r2 * gg.y) << 16); o.y = f2bf(v[j].z * r2 * gg.z) | ((unsigned)f2bf(v[j].w * r2 * gg.w) << 16);
                *(uint2*)(hrow + j * 256 + lane * 4) = o; } }
    }
}

#define LAS __attribute__((address_space(3)))
#define XB_TMO      128
#define XB_XCNT(j)  (256  + 64 * (j))
#define XB_XSUB(j)  (1280 + 64 * (j))
#define XB_XGEN(j)  (2304 + 64 * (j))
#define XB_TOP      3328
#define XB_TOPGEN   3392
#define XCD_BAR_WORDS 3456
#define XB_SPIN_CAP (1u << 18)
DI unsigned xb_ld(unsigned* p)              { return __hip_atomic_load(p, __ATOMIC_RELAXED, __HIP_MEMORY_SCOPE_AGENT); }
DI unsigned xb_add(unsigned* p, unsigned v) { return __hip_atomic_fetch_add(p, v, __ATOMIC_RELAXED, __HIP_MEMORY_SCOPE_AGENT); }
DI unsigned xb_xcc_id() { return (unsigned)__builtin_amdgcn_s_getreg((3 << 11) | 20) & 0xFu; }
#define XB_SPIN(cond, bar) do { unsigned _sp = 0; while (cond) { __builtin_amdgcn_s_sleep(1); \
    if ((++_sp & 255u) == 0u) { if (xb_ld(&(bar)[XB_TMO])) break; if (_sp > XB_SPIN_CAP) { atomicAdd(&(bar)[XB_TMO], 1u); break; } } } } while (0)
struct XcdBarrier { unsigned* bar; unsigned x; volatile LAS unsigned* st; };
DI XcdBarrier xcd_barrier_post(unsigned* bar, volatile LAS unsigned* st) {
    XcdBarrier b; b.bar = bar; b.x = xb_xcc_id(); b.st = st;
    if (threadIdx.x == 0) (void)xb_add(&bar[XB_XCNT(b.x)], 1u);
    return b;
}
DI void xcd_barrier_complete(unsigned* bar, unsigned x, unsigned& nloc, unsigned& nx) {
    const unsigned Gd = gridDim.x * gridDim.y * gridDim.z;
    unsigned sum, cnt, mine, sp = 0u;
    for (;;) {
        sum = 0u; cnt = 0u; mine = 0u;
#pragma unroll
        for (unsigned j = 0; j < 16; ++j) { const unsigned cc = xb_ld(&bar[XB_XCNT(j)]); sum += cc; cnt += (cc > 0u) ? 1u : 0u; mine = (j == x) ? cc : mine; }
        if (sum == Gd) break;
        __builtin_amdgcn_s_sleep(1);
        if ((++sp & 255u) == 0u) { if (xb_ld(&bar[XB_TMO])) break; if (sp > XB_SPIN_CAP) { atomicAdd(&bar[XB_TMO], 1u); break; } }
    }
    nloc = mine > 0u ? mine : 1u; nx = cnt > 0u ? cnt : 1u;
}
DI void xcd_barrier(const XcdBarrier& b) {
    asm volatile("s_waitcnt vmcnt(0)" ::: "memory");
    __syncthreads();
    if (threadIdx.x == 0) {
        unsigned* bar = b.bar;
        __builtin_amdgcn_s_waitcnt(0);
        unsigned nloc = b.st[0], nx = b.st[1];
        if (nloc == 0u) { xcd_barrier_complete(bar, b.x, nloc, nx); b.st[0] = nloc; b.st[1] = nx; }
        const unsigned old = xb_add(&bar[XB_XSUB(b.x)], 1u);
        const unsigned gen = old / nloc;
        if (old + 1u == (gen + 1u) * nloc) {
            __builtin_amdgcn_fence(__ATOMIC_RELEASE, "agent");
            asm volatile("s_waitcnt vmcnt(0)" ::: "memory");
            const unsigned og = xb_add(&bar[XB_TOP], 1u);
            const unsigned tg = og / nx;
            if (og + 1u == (tg + 1u) * nx) xb_add(&bar[XB_TOPGEN], 1u);
            else XB_SPIN(xb_ld(&bar[XB_TOPGEN]) == tg, bar);
            __builtin_amdgcn_fence(__ATOMIC_ACQUIRE, "agent");
            xb_add(&bar[XB_XGEN(b.x)], 1u);
            asm volatile("s_waitcnt vmcnt(0)" ::: "memory");
        } else {
            XB_SPIN(xb_ld(&bar[XB_XGEN(b.x)]) == gen, bar);
            __builtin_amdgcn_fence(__ATOMIC_ACQUIRE, "agent");
            asm volatile("s_waitcnt vmcnt(0)" ::: "memory");
        }
    }
    __syncthreads();
}
constexpr int LDS_BYTES = 147456, MISC_OFF = 131072 + 320, CW_BAR = 4096;
__global__ void __launch_bounds__(512) mk_fwd(Ctx c) {
    extern __shared__ __attribute__((aligned(16))) unsigned char ldsraw[];
    float* lds = (float*)ldsraw;
    const int tid = threadIdx.x, bid = blockIdx.x, nblk = gridDim.x;
    volatile LAS unsigned* MISC = (volatile LAS unsigned*)((LAS unsigned char*)ldsraw + MISC_OFF);
    if (tid < 32) MISC[tid] = 0u;
    __syncthreads();
    XcdBarrier bar = xcd_barrier_post((unsigned*)(c.ws + OFF_CTL) + CW_BAR, MISC + 8);
    s_p0(c, 0, 0, lds, bid, nblk);
    s_prenorm(c, 0, 0, lds, bid, nblk);
    xcd_barrier(bar);
    for (int slab_ = 0; slab_ < 2; ++slab_)
        for (int l_ = 0; l_ < NL; ++l_) {
            int l = l_, slab = slab_; asm volatile("" : "+s"(l), "+s"(slab));
            s_gemm<true>((const bf16_t*)(c.ws + OFF_H), D, (const bf16_t*)(c.ws + OFF_WIN + l * WIN_L), D, c.ws + OFF_P, PP, MS, PP, lds, bid, nblk);
            xcd_barrier(bar);
            s_mA(c, l, slab, lds, bid, nblk); s_dA(c, l, slab, lds, bid, nblk); s_cA(c, l, slab, lds, bid, nblk); s_bprep(c, l, slab, lds, bid, nblk);
            xcd_barrier(bar);
            s_mB(c, l, slab, lds, bid, nblk); s_dB(c, l, slab, lds, bid, nblk); s_cB(c, l, slab, lds, bid, nblk);
            xcd_barrier(bar);
            if (nblk >= 256) {
                if (bid < 128) { if (tid < 256) s_bscan(c, l, slab, lds, bid, 128); }
                else { s_mC(c, l, slab, lds, bid - 128, nblk - 128); s_dC(c, l, slab, lds, bid - 128, nblk - 128); s_cC(c, l, slab, lds, bid - 128, nblk - 128); }
            }
            xcd_barrier(bar);
            s_bpost(c, l, slab, lds, bid, nblk);
            xcd_barrier(bar);
            s_gemm<false>((const bf16_t*)(c.ws + OFF_P) + ZA, PP, (const bf16_t*)(c.ws + OFF_WOUT + l * WOUT_L), DMIX, c.ws + OFF_Y, D, MS, D, lds, bid, nblk);
            xcd_barrier(bar);
            s_post(c, l, slab, lds, bid, nblk);
            if (l == 1 && slab == 0) s_prenorm(c, 0, 1, lds, bid, nblk);
            xcd_barrier(bar);
        }
}

extern "C" void kernel_launch(void* const* d_in, const int* in_sizes, int n_in, void* d_out, int out_size, void* d_ws, size_t ws_size, hipStream_t stream) {
    static int grid = 0;
    if (grid == 0) {
        int dev = 0, cus = 0, per_cu = 0;
        (void)hipGetDevice(&dev);
        (void)hipDeviceGetAttribute(&cus, hipDeviceAttributeMultiprocessorCount, dev);
        (void)hipFuncSetAttribute((const void*)mk_fwd, hipFuncAttributeMaxDynamicSharedMemorySize, LDS_BYTES);
        (void)hipOccupancyMaxActiveBlocksPerMultiprocessor(&per_cu, (const void*)mk_fwd, 512, LDS_BYTES);
        if (per_cu < 1) { fprintf(stderr, "kernel_launch: occupancy query says %d blocks/CU\n", per_cu); per_cu = 1; }
        grid = cus;
        if (grid != 256) fprintf(stderr, "kernel_launch: %d CUs (built for 256)\n", grid);
    }
    Ctx c{};
    const float** f = (const float**)&c;
    for (int i = 0; i < 28; ++i) f[i] = (const float*)d_in[i];
    c.out = (float*)d_out; c.ws = (unsigned char*)d_ws;
    (void)hipMemsetAsync(d_ws, 0, 1 * MiB, stream);
    void* args[] = {&c};
    hipError_t e = hipLaunchCooperativeKernel((const void*)mk_fwd, dim3(grid), dim3(512), args, LDS_BYTES, stream);
    if (e != hipSuccess) fprintf(stderr, "cooperative launch failed: %s (grid %d)\n", hipGetErrorString(e), grid);
}
```

```cpp
#include <hip/hip_runtime.h>
#include <cstdint>
#include <cstdio>

typedef unsigned short bf16_t;
#define DI __device__ __forceinline__
#define LAS __attribute__((address_space(3)))

constexpr int NB = 4, T = 4096, D = 1024, NL = 2, G = 512, NH = 8;
constexpr int TS = 2048, MS = NB * TS, NCS = TS / 64;
constexpr int DIN = 7824, PP = 7936, DMIX = 2048;
constexpr int A_Q = 0, A_K = 512, A_V = 1024, A_O = 1536, B_R = 2048, B_K = 2560, B_V = 3072, B_WLO = 3584, B_ALO = 3648, C_X = 3712,
              D_Q = 4224, D_K = 4736, D_V = 5248, ZA = 5760, ZB = 6272, ZC = 6784, ZD = 7296, A_I = 7808, A_F = 7816;
constexpr size_t MiB = 1u << 20;
constexpr size_t OFF_CTL = 0, OFF_ZROW = 512 * 1024, OFF_WIN = 1 * MiB, OFF_WOUT = 32 * MiB, OFF_ROPE = 40 * MiB, OFF_CARRY = 41 * MiB,
                 OFF_LS = 45 * MiB, OFF_BON = 45 * MiB + 512 * 1024, OFF_P = 46 * MiB, OFF_SA = 170 * MiB, OFF_H = 170 * MiB,
                 OFF_SD = 170 * MiB + 17301504, OFF_CK = 203 * MiB, OFF_Y = 203 * MiB;
constexpr size_t WIN_L = (size_t)PP * D * 2, WOUT_L = (size_t)D * DMIX * 2;
constexpr size_t CARRY_L = 2 * MiB, CA_OFF = 0, CD_OFF = 540672, CB_OFF = CD_OFF + 524288, CC_OFF = CB_OFF + 524288, HALO_OFF = CC_OFF + 8192;
constexpr int SAU = 4224;

struct Ctx {
    const float *x, *norm_pre, *norm_post, *w_in, *w_out, *mconv_w, *mconv_b, *mi_bias, *mf_bias, *mnorm_w, *rmu, *rw_up, *rw0, *ra_up, *ra0,
        *rk_k, *rk_a, *rr_k, *rgn_w, *rgn_b, *lconv_w, *lconv_b, *lw_r, *lb_r, *lw_i, *lb_i, *llam, *retnorm_w;
    float* out; unsigned char* ws;
};
typedef const __attribute__((address_space(4))) Ctx* CtxP;


DI int otid() { int t = threadIdx.x; asm volatile("" : "+v"(t)); return t; }
DI float bf2f(bf16_t v) { return __uint_as_float(((unsigned)v) << 16); }
DI bf16_t f2bf(float f) { unsigned u = __float_as_uint(f); u += 0x7fffu + ((u >> 16) & 1u); return (bf16_t)(u >> 16); }
DI float sigm(float x) { return __builtin_amdgcn_rcpf(1.f + __expf(-x)); }
DI float siluf(float x) { return x * __builtin_amdgcn_rcpf(1.f + __expf(-x)); }
DI float softplusf(float x) { return fmaxf(x, 0.f) + log1pf(expf(-fabsf(x))); }
DI float wave_sum(float v) {
#pragma unroll
    for (int o = 1; o < 64; o <<= 1) v += __shfl_xor(v, o);
    return v;
}
DI int srccol(int n) {
    if (n < 2048) return n;
    if (n < 3712) return n + 528;
    if (n < 4224) return n + 1040;
    if (n < 5760) return n + 1552;
    if (n < 6272) return n - 3712;
    if (n < 6784) return n - 2032;
    if (n < 7296) return n - 1520;
    if (n < 7808) return n + 16;
    if (n < 7824) return n - 5248;
    return -1;
}
DI const bf16_t* prow(const unsigned char* ws, int layer, int slab, int b, int tl) {
    if (tl >= 0) return (const bf16_t*)(ws + OFF_P) + (size_t)(b * TS + tl) * PP;
    if (slab == 0) return (const bf16_t*)(ws + OFF_ZROW);
    return (const bf16_t*)(ws + OFF_CARRY + layer * CARRY_L + HALO_OFF) + (size_t)(b * 3 + 3 + tl) * PP;
}

DI void wt_item(const float* W, int K, int N, bf16_t* WT, bool permute, float* scr, int item, int lane) {
    const int nblk = (permute ? PP : N) / 32, kb = item / nblk, nb = item % nblk, k0 = 64 * kb, n0 = 32 * nb;
    const int nn = n0 + (lane & 31); const int sc = permute ? srccol(nn) : nn;
    for (int i = 0; i < 32; ++i) { const int kk = 2 * i + (lane >> 5); scr[kk * 33 + (lane & 31)] = sc >= 0 ? W[(size_t)(k0 + kk) * N + sc] : 0.f; }
    __builtin_amdgcn_s_waitcnt(0); __builtin_amdgcn_wave_barrier();
    const int c = lane & 7;
    for (int j = 0; j < 4; ++j) { const int n = (lane >> 3) + 8 * j; const float* s = scr + (8 * c) * 33 + n;
        uint4 o; o.x = f2bf(s[0]) | ((unsigned)f2bf(s[33]) << 16); o.y = f2bf(s[66]) | ((unsigned)f2bf(s[99]) << 16);
        o.z = f2bf(s[132]) | ((unsigned)f2bf(s[165]) << 16); o.w = f2bf(s[198]) | ((unsigned)f2bf(s[231]) << 16);
        *(uint4*)(WT + (size_t)(n0 + n) * K + k0 + 8 * c) = o; }
    __builtin_amdgcn_s_waitcnt(0); __builtin_amdgcn_wave_barrier();
}
DI void s_p0(CtxP c, int l, int slab, float* lds, int bid, int nblk) {
    const int tid = otid(), lane = tid & 63, wave = tid >> 6;
    float* scr = lds + wave * (64 * 33);
    const int gw = bid * 8 + wave, NGW = nblk * 8;
    constexpr int I_IN = (D / 64) * (PP / 32), I_OUT = (DMIX / 64) * (D / 32);
    for (int it = gw; it < NL * (I_IN + I_OUT); it += NGW) {
        const int l = it / (I_IN + I_OUT); int r = it % (I_IN + I_OUT);
        if (r < I_IN) wt_item(c->w_in + (size_t)l * D * DIN, D, DIN, (bf16_t*)(c->ws + OFF_WIN + l * WIN_L), true, scr, r, lane);
        else wt_item(c->w_out + (size_t)l * DMIX * D, DMIX, D, (bf16_t*)(c->ws + OFF_WOUT + l * WOUT_L), false, scr, r - I_IN, lane);
    }
    float* rope = (float*)(c->ws + OFF_ROPE);
    for (int i = bid * 512 + tid; i < T * 32; i += nblk * 512) {
        const int t = i >> 5, j = i & 31; const float inv = powf(10000.f, -(float)j / 32.f); const float ang = (float)t * inv;
        rope[2 * i] = cosf(ang); rope[2 * i + 1] = sinf(ang);
    }
}
DI void norm_row(const float* xrow, const float* g, bf16_t* hrow, int lane) {
    float4 v[4]; float ss = 0.f;
#pragma unroll
    for (int j = 0; j < 4; ++j) { v[j] = *(const float4*)(xrow + j * 256 + lane * 4); ss += v[j].x * v[j].x + v[j].y * v[j].y + v[j].z * v[j].z + v[j].w * v[j].w; }
    ss = wave_sum(ss); const float rs = rsqrtf(ss * (1.f / D) + 1e-6f);
#pragma unroll
    for (int j = 0; j < 4; ++j) { const float4 gg = *(const float4*)(g + j * 256 + lane * 4);
        uint2 o; o.x = f2bf(v[j].x * rs * gg.x) | ((unsigned)f2bf(v[j].y * rs * gg.y) << 16); o.y = f2bf(v[j].z * rs * gg.z) | ((unsigned)f2bf(v[j].w * rs * gg.w) << 16);
        *(uint2*)(hrow + j * 256 + lane * 4) = o; }
}
DI void s_prenorm(CtxP c, int l, int slab, float* lds, int bid, int nblk) {
    const int lane = otid() & 63, gw = bid * 8 + (otid() >> 6), NGW = nblk * 8;
    for (int r = gw; r < MS; r += NGW) { const int b = r / TS, tl = r % TS; const size_t grow = (size_t)b * T + slab * TS + tl;
        norm_row(c->x + grow * D, c->norm_pre, (bf16_t*)(c->ws + OFF_H) + (size_t)r * D, lane); }
}
template <bool OUT_BF16> DI void s_gemm(const bf16_t* A, int lda, const bf16_t* Bt, int K, void* C, int ldc, int M, int N, float* lds, int bid, int nblk) {
    float* As = lds; float* Bs = lds + 32 * 132;
    const int tid = otid(), ty = tid >> 4, tx = tid & 15;
    const int ntn = N / 64, ntm = M / 128;
    for (int tile = bid; tile < ntn * ntm; tile += nblk) {
        const int m0 = (tile / ntn) * 128, n0 = (tile % ntn) * 64;
        float acc[4][4] = {};
        for (int k0 = 0; k0 < K; k0 += 32) {
            { const int row = tid >> 2, kq = (tid & 3) * 8; const uint4 v = *(const uint4*)(A + (size_t)(m0 + row) * lda + k0 + kq);
              const unsigned w[4] = {v.x, v.y, v.z, v.w};
#pragma unroll
              for (int i = 0; i < 4; ++i) { As[(kq + 2 * i) * 132 + row] = __uint_as_float(w[i] << 16); As[(kq + 2 * i + 1) * 132 + row] = __uint_as_float(w[i] & 0xffff0000u); } }
            if (tid < 256) { const int row = tid >> 2, kq = (tid & 3) * 8; const uint4 v = *(const uint4*)(Bt + (size_t)(n0 + row) * K + k0 + kq);
              const unsigned w[4] = {v.x, v.y, v.z, v.w};
#pragma unroll
              for (int i = 0; i < 4; ++i) { Bs[(kq + 2 * i) * 68 + row] = __uint_as_float(w[i] << 16); Bs[(kq + 2 * i + 1) * 68 + row] = __uint_as_float(w[i] & 0xffff0000u); } }
            __syncthreads();
#pragma unroll 8
            for (int k = 0; k < 32; ++k) { const float4 a = *(const float4*)(As + k * 132 + ty * 4); const float4 b = *(const float4*)(Bs + k * 68 + tx * 4);
                const float av[4] = {a.x, a.y, a.z, a.w}, bv[4] = {b.x, b.y, b.z, b.w};
#pragma unroll
                for (int i = 0; i < 4; ++i)
#pragma unroll
                    for (int j = 0; j < 4; ++j) acc[i][j] += av[i] * bv[j]; }
            __syncthreads();
        }
#pragma unroll
        for (int i = 0; i < 4; ++i) { const size_t off = (size_t)(m0 + ty * 4 + i) * ldc + n0 + tx * 4;
            if (OUT_BF16) { uint2 o; o.x = f2bf(acc[i][0]) | ((unsigned)f2bf(acc[i][1]) << 16); o.y = f2bf(acc[i][2]) | ((unsigned)f2bf(acc[i][3]) << 16); *(uint2*)((bf16_t*)C + off) = o; }
            else *(float4*)((float*)C + off) = make_float4(acc[i][0], acc[i][1], acc[i][2], acc[i][3]); }
    }
}
DI void load_conv_tile(CtxP c, int l, int slab, int b, int tl0, int col0, const float* cw, int cwstride, const float* cb, bool act, float scale, float* dst, int tid) {
    for (int idx = tid; idx < 4096; idx += 512) { const int t = idx >> 6, j = idx & 63; float acc = cb[j];
#pragma unroll
        for (int w = 0; w < 4; ++w) acc += bf2f(prow(c->ws, l, slab, b, tl0 + t - 3 + w)[col0 + j]) * cw[w * cwstride + j];
        if (act) acc = siluf(acc);
        dst[t * 65 + j] = acc * scale; }
}
DI void load_plain_tile(CtxP c, int l, int slab, int b, int tl0, int col0, float* dst, int tid) {
    for (int idx = tid; idx < 4096; idx += 512) { const int t = idx >> 6, j = idx & 63; dst[t * 65 + j] = bf2f(prow(c->ws, l, slab, b, tl0 + t)[col0 + j]); }
}
DI void load_rope_tile(CtxP c, int l, int slab, int b, int tl0, int col0, float scale, float* dst, int tid) {
    const float* rope = (const float*)(c->ws + OFF_ROPE);
    for (int idx = tid; idx < 4096; idx += 512) { const int t = idx >> 6, j = idx & 63, jj = j & 31; const bf16_t* r = prow(c->ws, l, slab, b, tl0 + t);
        const int pos = slab * TS + tl0 + t; const float cs = rope[(pos * 32 + jj) * 2], sn = rope[(pos * 32 + jj) * 2 + 1];
        const float x1 = bf2f(r[col0 + jj]), x2 = bf2f(r[col0 + 32 + jj]);
        dst[t * 65 + j] = (j < 32 ? x1 * cs - x2 * sn : x2 * cs + x1 * sn) * scale; }
}
DI void mlstm_gates(CtxP c, int l, int slab, int b, int tl0, int h, float* ig, float* lf, float* cum, int tid) {
    if (tid < 64) { const bf16_t* r = prow(c->ws, l, slab, b, tl0 + tid);
        ig[tid] = bf2f(r[A_I + h]) + c->mi_bias[l * NH + h];
        lf[tid] = -softplusf(-(bf2f(r[A_F + h]) + c->mf_bias[l * NH + h])); }
    __syncthreads();
    if (tid == 0) { float s = 0.f; for (int t = 0; t < 64; ++t) { s += lf[t]; cum[t] = s; } }
    __syncthreads();
}
DI void unit_ids(int item, int& b, int& cl, int& h) { b = item / (NCS * NH); cl = (item / NH) % NCS; h = item % NH; }
DI void s_mA(CtxP c, int l, int slab, float* lds, int bid, int nblk) {
    float *kk = lds, *vv = lds + 4160, *ig = lds + 8320, *lf = ig + 64, *cum = lf + 64, *wj = cum + 64, *sc = wj + 64;
    const int tid = otid();
    for (int item = bid; item < NB * NCS * NH; item += nblk) {
        int b, cl, h; unit_ids(item, b, cl, h); const int tl0 = cl * 64; const int u = (b * NH + h) * NCS + cl;
        load_conv_tile(c, l, slab, b, tl0, A_K + h * 64, c->mconv_w + l * 4096 + 512 + h * 64, 1024, c->mconv_b + l * 1024 + 512 + h * 64, true, 0.125f, kk, tid);
        load_plain_tile(c, l, slab, b, tl0, A_V + h * 64, vv, tid);
        mlstm_gates(c, l, slab, b, tl0, h, ig, lf, cum, tid);
        if (tid == 0) { const float tot = cum[63]; float m = -INFINITY; for (int t = 0; t < 64; ++t) m = fmaxf(m, tot - cum[t] + ig[t]); sc[0] = m; sc[1] = tot; }
        __syncthreads();
        if (tid < 64) wj[tid] = expf(sc[1] - cum[tid] + ig[tid] - sc[0]);
        __syncthreads();
        float* S = (float*)(c->ws + OFF_SA) + (size_t)u * SAU;
        { const int e = tid >> 3, d0 = (tid & 7) * 8; float acc[8] = {};
          for (int t = 0; t < 64; ++t) { const float a = wj[t] * vv[t * 65 + e];
#pragma unroll
              for (int i = 0; i < 8; ++i) acc[i] += a * kk[t * 65 + d0 + i]; }
#pragma unroll
          for (int i = 0; i < 8; ++i) S[e * 64 + d0 + i] = acc[i]; }
        if (tid < 64) { float a = 0.f; for (int t = 0; t < 64; ++t) a += wj[t] * kk[t * 65 + tid]; S[4096 + tid] = a; }
        if (tid == 0) { S[4160] = sc[0]; S[4161] = sc[1]; }
        __syncthreads();
    }
}
DI void s_mB(CtxP c, int l, int slab, float* lds, int bid, int nblk) {
    const int tid = otid();
    for (int item = bid; item < NB * NH * 9; item += nblk) {
        const int bh = item / 9, part = item % 9, el = part * 512 + tid; const bool on = el < 4160;
        float* CA = (float*)(c->ws + OFF_CARRY + l * CARRY_L + CA_OFF) + (size_t)bh * SAU;
        float m = slab == 0 ? 0.f : CA[4160 + slab - 1]; float val = (slab == 0 || !on) ? 0.f : CA[el];
        for (int cl = 0; cl < NCS; ++cl) { float* S = (float*)(c->ws + OFF_SA) + (size_t)(bh * NCS + cl) * SAU;
            const float mloc = S[4160], tot = S[4161]; const float loc = on ? S[el] : 0.f;
            if (on) S[el] = val;
            if (el == 0) S[4162] = m;
            const float mn = fmaxf(tot + m, mloc); val = expf(tot + m - mn) * val + expf(mloc - mn) * loc; m = mn; }
        if (on) CA[el] = val;
        if (el == 0) CA[4160 + slab] = m;
    }
}
DI void s_mC(CtxP c, int l, int slab, float* lds, int bid, int nblk) {
    float *qq = lds, *kk = lds + 4160, *vv = lds + 8320, *Cs = lds + 12480, *Sm = lds + 16640, *ig = lds + 20800, *lf = ig + 64, *cum = lf + 64, *mx = cum + 64, *ns = mx + 64, *den = ns + 64;
    const int tid = otid();
    for (int item = bid; item < NB * NCS * NH; item += nblk) {
        int b, cl, h; unit_ids(item, b, cl, h); const int tl0 = cl * 64; const int u = (b * NH + h) * NCS + cl;
        const float* S = (const float*)(c->ws + OFF_SA) + (size_t)u * SAU;
        load_conv_tile(c, l, slab, b, tl0, A_Q + h * 64, c->mconv_w + l * 4096 + h * 64, 1024, c->mconv_b + l * 1024 + h * 64, true, 1.f, qq, tid);
        load_conv_tile(c, l, slab, b, tl0, A_K + h * 64, c->mconv_w + l * 4096 + 512 + h * 64, 1024, c->mconv_b + l * 1024 + 512 + h * 64, true, 0.125f, kk, tid);
        load_plain_tile(c, l, slab, b, tl0, A_V + h * 64, vv, tid);
        for (int idx = tid; idx < 4096; idx += 512) Cs[(idx >> 6) * 65 + (idx & 63)] = S[idx];
        if (tid < 64) ns[tid] = S[4096 + tid];
        const float mst = S[4162];
        mlstm_gates(c, l, slab, b, tl0, h, ig, lf, cum, tid);
        if (tid == 0) { float g = -INFINITY; for (int t = 0; t < 64; ++t) { g = fmaxf(g, ig[t] - cum[t]); mx[t] = fmaxf(mst, g); } }
        __syncthreads();
        const int t = tid >> 3, s0 = (tid & 7) * 8;
        { float acc[8] = {};
#pragma unroll 2
        for (int d = 0; d < 64; ++d) { const float qv = qq[t * 65 + d];
#pragma unroll
              for (int i = 0; i < 8; ++i) acc[i] += qv * kk[(s0 + i) * 65 + d]; }
#pragma unroll
          for (int i = 0; i < 8; ++i) { const int s = s0 + i; Sm[t * 65 + s] = s <= t ? acc[i] * expf(ig[s] - cum[s] - mx[t]) : 0.f; } }
        __syncthreads();
        const float sint = expf(mst - mx[t]);
        float num[8] = {}, qc[8] = {};
#pragma unroll 2
        for (int s = 0; s < 64; ++s) { const float pv = Sm[t * 65 + s];
#pragma unroll
            for (int i = 0; i < 8; ++i) num[i] += pv * vv[s * 65 + s0 + i]; }
#pragma unroll 2
        for (int d = 0; d < 64; ++d) { const float qv = qq[t * 65 + d];
#pragma unroll
            for (int i = 0; i < 8; ++i) qc[i] += qv * Cs[(s0 + i) * 65 + d]; }
        if (tid < 64) { float a = 0.f, q = 0.f;
#pragma unroll 4
            for (int s = 0; s < 64; ++s) a += Sm[tid * 65 + s];
#pragma unroll 4
            for (int d = 0; d < 64; ++d) q += qq[tid * 65 + d] * ns[d];
            den[tid] = a + expf(mst - mx[tid]) * q; }
        __syncthreads();
        const float dn = fmaxf(fabsf(den[t]), expf(-(cum[t] + mx[t])));
        bf16_t* prw = (bf16_t*)(c->ws + OFF_P) + (size_t)(b * TS + tl0 + t) * PP;
        float ho[8], sum = 0.f;
#pragma unroll
        for (int i = 0; i < 8; ++i) { const float hh = (num[i] + sint * qc[i]) / dn; ho[i] = hh * sigm(bf2f(prw[A_O + h * 64 + s0 + i])); sum += ho[i]; }
        sum += __shfl_xor(sum, 1); sum += __shfl_xor(sum, 2); sum += __shfl_xor(sum, 4);
        const float mu = sum * (1.f / 64.f); float vs = 0.f;
#pragma unroll
        for (int i = 0; i < 8; ++i) { ho[i] -= mu; vs += ho[i] * ho[i]; }
        vs += __shfl_xor(vs, 1); vs += __shfl_xor(vs, 2); vs += __shfl_xor(vs, 4);
        const float rstd = rsqrtf(vs * (1.f / 64.f) + 1e-5f);
#pragma unroll
        for (int i = 0; i < 8; ++i) { const int ch = h * 64 + s0 + i; const float z = bf2f(prw[ZA + ch]); prw[ZA + ch] = f2bf(ho[i] * rstd * c->mnorm_w[l * G + ch] * siluf(z)); }
        __syncthreads();
    }
}
DI float ret_logg(int h) { return log1pf(-exp2f(-5.f - (float)h)); }
DI void s_dA(CtxP c, int l, int slab, float* lds, int bid, int nblk) {
    float *kk = lds, *vv = lds + 4160;
    const int tid = otid();
    for (int item = bid; item < NB * NCS * NH; item += nblk) {
        int b, cl, h; unit_ids(item, b, cl, h); const int tl0 = cl * 64; const int u = (b * NH + h) * NCS + cl; const float lg = ret_logg(h);
        load_rope_tile(c, l, slab, b, tl0, D_K + h * 64, 0.125f, kk, tid);
        load_plain_tile(c, l, slab, b, tl0, D_V + h * 64, vv, tid);
        __syncthreads();
        float* S = (float*)(c->ws + OFF_SD) + (size_t)u * 4096;
        const int d = tid >> 3, e0 = (tid & 7) * 8; float acc[8] = {};
        for (int s = 0; s < 64; ++s) { const float a = expf(lg * (float)(63 - s)) * kk[s * 65 + d];
#pragma unroll
            for (int i = 0; i < 8; ++i) acc[i] += a * vv[s * 65 + e0 + i]; }
#pragma unroll
        for (int i = 0; i < 8; ++i) S[d * 64 + e0 + i] = acc[i];
        __syncthreads();
    }
}
DI void s_dB(CtxP c, int l, int slab, float* lds, int bid, int nblk) {
    const int tid = otid();
    for (int item = bid; item < NB * NH * 8; item += nblk) {
        const int bh = item / 8, el = (item % 8) * 512 + tid; const float gch = expf(ret_logg(bh % NH) * 64.f);
        float* CD = (float*)(c->ws + OFF_CARRY + l * CARRY_L + CD_OFF) + (size_t)bh * 4096;
        float val = slab == 0 ? 0.f : CD[el];
        for (int cl = 0; cl < NCS; ++cl) { float* S = (float*)(c->ws + OFF_SD) + (size_t)(bh * NCS + cl) * 4096; const float loc = S[el]; S[el] = val; val = gch * val + loc; }
        CD[el] = val;
    }
}
DI void s_dC(CtxP c, int l, int slab, float* lds, int bid, int nblk) {
    float *qq = lds, *kk = lds + 4160, *vv = lds + 8320, *Rs = lds + 12480, *Sm = lds + 16640;
    const int tid = otid();
    for (int item = bid; item < NB * NCS * NH; item += nblk) {
        int b, cl, h; unit_ids(item, b, cl, h); const int tl0 = cl * 64; const int u = (b * NH + h) * NCS + cl; const float lg = ret_logg(h);
        const float* S = (const float*)(c->ws + OFF_SD) + (size_t)u * 4096;
        load_rope_tile(c, l, slab, b, tl0, D_Q + h * 64, 1.f, qq, tid);
        load_rope_tile(c, l, slab, b, tl0, D_K + h * 64, 0.125f, kk, tid);
        load_plain_tile(c, l, slab, b, tl0, D_V + h * 64, vv, tid);
        for (int idx = tid; idx < 4096; idx += 512) Rs[(idx >> 6) * 65 + (idx & 63)] = S[idx];
        __syncthreads();
        const int t = tid >> 3, s0 = (tid & 7) * 8;
        { float acc[8] = {};
#pragma unroll 2
        for (int d = 0; d < 64; ++d) { const float qv = qq[t * 65 + d];
#pragma unroll
              for (int i = 0; i < 8; ++i) acc[i] += qv * kk[(s0 + i) * 65 + d]; }
#pragma unroll
          for (int i = 0; i < 8; ++i) { const int s = s0 + i; Sm[t * 65 + s] = acc[i] * expf(lg * fabsf((float)(t - s))); } }
        __syncthreads();
        float o[8] = {}, qr[8] = {};
#pragma unroll 2
        for (int s = 0; s < 64; ++s) { const float pv = Sm[t * 65 + s];
#pragma unroll
            for (int i = 0; i < 8; ++i) o[i] += pv * vv[s * 65 + s0 + i]; }
#pragma unroll 2
        for (int d = 0; d < 64; ++d) { const float qv = qq[t * 65 + d];
#pragma unroll
            for (int i = 0; i < 8; ++i) qr[i] += qv * Rs[d * 65 + s0 + i]; }
        const float xi = expf(lg * (float)(t + 1));
        float sum = 0.f;
#pragma unroll
        for (int i = 0; i < 8; ++i) { o[i] += xi * qr[i]; sum += o[i]; }
        sum += __shfl_xor(sum, 1); sum += __shfl_xor(sum, 2); sum += __shfl_xor(sum, 4);
        const float mu = sum * (1.f / 64.f); float vs = 0.f;
#pragma unroll
        for (int i = 0; i < 8; ++i) { o[i] -= mu; vs += o[i] * o[i]; }
        vs += __shfl_xor(vs, 1); vs += __shfl_xor(vs, 2); vs += __shfl_xor(vs, 4);
        const float rstd = rsqrtf(vs * (1.f / 64.f) + 1e-5f);
        bf16_t* prw = (bf16_t*)(c->ws + OFF_P) + (size_t)(b * TS + tl0 + t) * PP;
#pragma unroll
        for (int i = 0; i < 8; ++i) { const int ch = h * 64 + s0 + i; const float z = bf2f(prw[ZD + ch]); prw[ZD + ch] = f2bf(o[i] * rstd * c->retnorm_w[l * G + ch] * siluf(z)); }
        __syncthreads();
    }
}
typedef short bf16x8 __attribute__((ext_vector_type(8)));
typedef float f32x16 __attribute__((ext_vector_type(16)));
typedef float f32x2_t __attribute__((ext_vector_type(2)));
typedef __bf16 bf16x2_t __attribute__((ext_vector_type(2)));
DI unsigned pk2(float lo, float hi) { f32x2_t v = {lo, hi}; bf16x2_t b = __builtin_convertvector(v, bf16x2_t); return __builtin_bit_cast(unsigned, b); }
DI bf16x8 pack8(const float* v) { uint4 u; u.x = pk2(v[0], v[1]); u.y = pk2(v[2], v[3]); u.z = pk2(v[4], v[5]); u.w = pk2(v[6], v[7]); return __builtin_bit_cast(bf16x8, u); }
DI void unpack8(uint4 u, float* v) { v[0] = __uint_as_float(u.x << 16); v[1] = __uint_as_float(u.x & 0xffff0000u); v[2] = __uint_as_float(u.y << 16); v[3] = __uint_as_float(u.y & 0xffff0000u);
    v[4] = __uint_as_float(u.z << 16); v[5] = __uint_as_float(u.z & 0xffff0000u); v[6] = __uint_as_float(u.w << 16); v[7] = __uint_as_float(u.w & 0xffff0000u); }
#define MFMA32(a, b, c) __builtin_amdgcn_mfma_f32_32x32x16_bf16((a), (b), (c), 0, 0, 0)
#define WSYNC() do { __builtin_amdgcn_fence(__ATOMIC_RELEASE, "wavefront"); __builtin_amdgcn_wave_barrier(); __builtin_amdgcn_fence(__ATOMIC_ACQUIRE, "wavefront"); } while (0)
DI float wave_psum(float v, int lane) {
#pragma unroll
    for (int o = 1; o < 64; o <<= 1) { const float t = __shfl_up(v, o); if (lane >= o) v += t; }
    return v;
}
DI float wave_pmax(float v, int lane) {
#pragma unroll
    for (int o = 1; o < 64; o <<= 1) { const float t = __shfl_up(v, o); if (lane >= o) v = fmaxf(v, t); }
    return v;
}
DI float wave_max(float v) {
#pragma unroll
    for (int o = 1; o < 64; o <<= 1) v = fmaxf(v, __shfl_xor(v, o));
    return v;
}
constexpr int TP = 144;
constexpr int WLDS = 10240;
DI void stage_tile(CtxP c, int l, int slab, int b, int tl_first, int nrows, int col, unsigned char* tile, int lane) {
    for (int i = lane; i < nrows * 8; i += 64) { const int r = i >> 3, ch = i & 7;
        *(uint4*)(tile + r * TP + ch * 16) = *(const uint4*)(prow(c->ws, l, slab, b, tl_first + r) + col + ch * 8); }
    WSYNC();
}
DI void proc_conv_tile(unsigned char* tile, const float* cw, int cws, const float* cb, float scale, int lane) {
    const int ch = lane & 7; float w[4][8], bb[8];
#pragma unroll
    for (int t = 0; t < 4; ++t) { const float4 a = *(const float4*)(cw + t * cws + ch * 8), d = *(const float4*)(cw + t * cws + ch * 8 + 4);
        w[t][0] = a.x; w[t][1] = a.y; w[t][2] = a.z; w[t][3] = a.w; w[t][4] = d.x; w[t][5] = d.y; w[t][6] = d.z; w[t][7] = d.w; }
    { const float4 a = *(const float4*)(cb + ch * 8), d = *(const float4*)(cb + ch * 8 + 4); bb[0] = a.x; bb[1] = a.y; bb[2] = a.z; bb[3] = a.w; bb[4] = d.x; bb[5] = d.y; bb[6] = d.z; bb[7] = d.w; }
    bf16x8 res[8];
#pragma unroll
    for (int k = 0; k < 8; ++k) { const int row = (lane >> 3) + 8 * k; float acc[8];
#pragma unroll
        for (int i = 0; i < 8; ++i) acc[i] = bb[i];
#pragma unroll
        for (int t = 0; t < 4; ++t) { float x[8]; unpack8(*(const uint4*)(tile + (row + t) * TP + ch * 16), x);
#pragma unroll
            for (int i = 0; i < 8; ++i) acc[i] += x[i] * w[t][i]; }
#pragma unroll
        for (int i = 0; i < 8; ++i) acc[i] = siluf(acc[i]) * scale;
        res[k] = pack8(acc); asm volatile("" ::: "memory"); }
    WSYNC();
#pragma unroll
    for (int k = 0; k < 8; ++k) *(bf16x8*)(tile + ((lane >> 3) + 8 * k) * TP + ch * 16) = res[k];
    WSYNC();
}
DI void proc_rope_tile(unsigned char* tile, const float* ropet, int pos0, float scale, int lane) {
    const int p = lane & 3;
#pragma unroll
    for (int k = 0; k < 4; ++k) { const int row = (lane >> 2) + 16 * k; float x1[8], x2[8], o1[8], o2[8];
        unpack8(*(const uint4*)(tile + row * TP + p * 16), x1); unpack8(*(const uint4*)(tile + row * TP + (p + 4) * 16), x2);
        const float* cs = ropet + ((size_t)(pos0 + row) * 32 + p * 8) * 2;
#pragma unroll
        for (int q = 0; q < 4; ++q) { const float4 v = *(const float4*)(cs + 4 * q);
            o1[2 * q] = (x1[2 * q] * v.x - x2[2 * q] * v.y) * scale; o2[2 * q] = (x2[2 * q] * v.x + x1[2 * q] * v.y) * scale;
            o1[2 * q + 1] = (x1[2 * q + 1] * v.z - x2[2 * q + 1] * v.w) * scale; o2[2 * q + 1] = (x2[2 * q + 1] * v.z + x1[2 * q + 1] * v.w) * scale; }
        *(bf16x8*)(tile + row * TP + p * 16) = pack8(o1); *(bf16x8*)(tile + row * TP + (p + 4) * 16) = pack8(o2); asm volatile("" ::: "memory"); }
    WSYNC();
}
DI bf16x8 frag_nat(const unsigned char* tile, int row, int ch) { return *(const bf16x8*)(tile + row * TP + ch * 16); }
DI float tile_at(const unsigned char* tile, int row, int col) { return bf2f(*(const bf16_t*)(tile + row * TP + col * 2)); }

template <bool RET> DI void w_chunkA(CtxP c, int l, int slab, int u, unsigned char* wl, int lane) {
    const int bh = u / NCS, cl = u % NCS, b = bh >> 3, h = bh & 7, tl0 = cl * 64, hs = lane >> 5, li = lane & 31;
    unsigned char* tile = wl; float* tab = (float*)(wl + 9728);
    float* S = RET ? (float*)(c->ws + OFF_SD) + (size_t)u * 4096 : (float*)(c->ws + OFF_SA) + (size_t)u * SAU;
    float mloc = 0.f, tot = 0.f;
    if (RET) { tab[lane] = expf(ret_logg(h) * (float)(63 - lane)); }
    else { const bf16_t* gr = (const bf16_t*)(c->ws + OFF_P) + (size_t)(b * TS + tl0 + lane) * PP;
        const float ig = bf2f(gr[A_I + h]) + c->mi_bias[l * NH + h]; const float lf = -softplusf(-(bf2f(gr[A_F + h]) + c->mf_bias[l * NH + h]));
        const float cum = wave_psum(lf, lane); tot = __shfl(cum, 63); const float lw = tot - cum + ig; mloc = wave_max(lw); tab[lane] = expf(lw - mloc); }
    if (RET) { stage_tile(c, l, slab, b, tl0, 64, D_K + h * 64, tile, lane); proc_rope_tile(tile, (const float*)(c->ws + OFF_ROPE), slab * TS + tl0, 0.125f, lane); }
    else { stage_tile(c, l, slab, b, tl0 - 3, 67, A_K + h * 64, tile, lane); proc_conv_tile(tile, c->mconv_w + l * 4096 + 512 + h * 64, 1024, c->mconv_b + l * 1024 + 512 + h * 64, 0.125f, lane); }
    bf16x8 kf[2][4]; float nl[2] = {0.f, 0.f};
#pragma unroll
    for (int db = 0; db < 2; ++db)
#pragma unroll
        for (int ks = 0; ks < 4; ++ks) { float v[8];
#pragma unroll
            for (int j = 0; j < 8; ++j) { const int t = 16 * ks + 8 * hs + j; v[j] = tile_at(tile, t, 32 * db + li); nl[db] += tab[t] * v[j]; }
            kf[db][ks] = pack8(v); }
    WSYNC();
    stage_tile(c, l, slab, b, tl0, 64, (RET ? D_V : A_V) + h * 64, tile, lane);
    f32x16 acc[2][2];
#pragma unroll
    for (int eb = 0; eb < 2; ++eb)
#pragma unroll
        for (int db = 0; db < 2; ++db)
#pragma unroll
            for (int r = 0; r < 16; ++r) acc[eb][db][r] = 0.f;
#pragma unroll
    for (int eb = 0; eb < 2; ++eb)
#pragma unroll
        for (int ks = 0; ks < 4; ++ks) { float v[8];
#pragma unroll
            for (int j = 0; j < 8; ++j) { const int t = 16 * ks + 8 * hs + j; v[j] = tile_at(tile, t, 32 * eb + li) * tab[t]; }
            const bf16x8 vf = pack8(v);
#pragma unroll
            for (int db = 0; db < 2; ++db) acc[eb][db] = MFMA32(vf, kf[db][ks], acc[eb][db]); }
#pragma unroll
    for (int eb = 0; eb < 2; ++eb)
#pragma unroll
        for (int db = 0; db < 2; ++db)
#pragma unroll
            for (int r = 0; r < 16; ++r) S[(32 * eb + (r & 3) + 8 * (r >> 2) + 4 * hs) * 64 + 32 * db + li] = acc[eb][db][r];
    if (!RET) {
#pragma unroll
        for (int db = 0; db < 2; ++db) { nl[db] += __shfl_xor(nl[db], 32); if (hs == 0) S[4096 + 32 * db + li] = nl[db]; }
        if (lane == 0) { S[4160] = mloc; S[4161] = tot; } }
    WSYNC();
}
template <bool RET> DI void w_chunkC(CtxP c, int l, int slab, int u, unsigned char* wl, int lane) {
    const int bh = u / NCS, cl = u % NCS, b = bh >> 3, h = bh & 7, tl0 = cl * 64, hs = lane >> 5, li = lane & 31;
    unsigned char* tile = wl; float* tab = (float*)(wl + 9728);
    const float* S = RET ? (const float*)(c->ws + OFF_SD) + (size_t)u * 4096 : (const float*)(c->ws + OFF_SA) + (size_t)u * SAU;
    const float lg = RET ? ret_logg(h) : 0.f;
    float mx_t[2] = {0.f, 0.f}, sc_t[2], dnf_t[2] = {0.f, 0.f};
    if (RET) { sc_t[0] = expf(lg * (float)(li + 1)); sc_t[1] = expf(lg * (float)(li + 33)); }
    else { const bf16_t* gr = (const bf16_t*)(c->ws + OFF_P) + (size_t)(b * TS + tl0 + lane) * PP;
        const float ig = bf2f(gr[A_I + h]) + c->mi_bias[l * NH + h]; const float lf = -softplusf(-(bf2f(gr[A_F + h]) + c->mf_bias[l * NH + h]));
        const float cum = wave_psum(lf, lane); const float a = ig - cum; const float g = wave_pmax(a, lane);
        const float mst = S[4162]; const float mx = fmaxf(mst, g); const float sint = expf(mst - mx); const float dnf = expf(-(cum + mx));
        tab[lane] = a;
        mx_t[0] = __shfl(mx, li); mx_t[1] = __shfl(mx, 32 + li); sc_t[0] = __shfl(sint, li); sc_t[1] = __shfl(sint, 32 + li); dnf_t[0] = __shfl(dnf, li); dnf_t[1] = __shfl(dnf, 32 + li); }
    bf16x8 kf[2][4], qf[2][4], cf[2][4];
#pragma unroll
    for (int eb = 0; eb < 2; ++eb)
#pragma unroll
        for (int ks = 0; ks < 4; ++ks) { const float* cp = S + (32 * eb + li) * 64 + 16 * ks + 8 * hs; const float4 c0 = *(const float4*)cp, c1 = *(const float4*)(cp + 4);
            const float cv[8] = {c0.x, c0.y, c0.z, c0.w, c1.x, c1.y, c1.z, c1.w}; cf[eb][ks] = pack8(cv); }
    do { asm volatile("" ::: "memory"); __builtin_amdgcn_sched_barrier(0); } while (0);
    if (RET) { stage_tile(c, l, slab, b, tl0, 64, D_K + h * 64, tile, lane); proc_rope_tile(tile, (const float*)(c->ws + OFF_ROPE), slab * TS + tl0, 0.125f, lane); }
    else { stage_tile(c, l, slab, b, tl0 - 3, 67, A_K + h * 64, tile, lane); proc_conv_tile(tile, c->mconv_w + l * 4096 + 512 + h * 64, 1024, c->mconv_b + l * 1024 + 512 + h * 64, 0.125f, lane); }
#pragma unroll
    for (int mb = 0; mb < 2; ++mb)
#pragma unroll
        for (int ks = 0; ks < 4; ++ks) kf[mb][ks] = frag_nat(tile, 32 * mb + li, 2 * ks + hs);
    WSYNC(); __builtin_amdgcn_sched_barrier(0);
    if (RET) { stage_tile(c, l, slab, b, tl0, 64, D_Q + h * 64, tile, lane); proc_rope_tile(tile, (const float*)(c->ws + OFF_ROPE), slab * TS + tl0, 1.f, lane); }
    else { stage_tile(c, l, slab, b, tl0 - 3, 67, A_Q + h * 64, tile, lane); proc_conv_tile(tile, c->mconv_w + l * 4096 + h * 64, 1024, c->mconv_b + l * 1024 + h * 64, 1.f, lane); }
#pragma unroll
    for (int nb = 0; nb < 2; ++nb)
#pragma unroll
        for (int ks = 0; ks < 4; ++ks) qf[nb][ks] = frag_nat(tile, 32 * nb + li, 2 * ks + hs);
    WSYNC(); __builtin_amdgcn_sched_barrier(0);
    stage_tile(c, l, slab, b, tl0, 64, (RET ? D_V : A_V) + h * 64, tile, lane);
    const int zc = (RET ? ZD : ZA) + h * 64; const float* nw = (RET ? c->retnorm_w : c->mnorm_w) + l * G + h * 64;
#pragma unroll
    for (int nb = 0; nb < 2; ++nb) {
        bf16x8 xf[2][2]; float csum = 0.f;
#pragma unroll
        for (int mb = 0; mb < 2; ++mb) {
            if (!RET && mb == 1 && nb == 0) continue;
            f32x16 sa;
#pragma unroll
            for (int r = 0; r < 16; ++r) sa[r] = 0.f;
#pragma unroll
            for (int ks = 0; ks < 4; ++ks) sa = MFMA32(kf[mb][ks], qf[nb][ks], sa);
            float xv[16];
#pragma unroll
            for (int rg = 0; rg < 4; ++rg) { float av[4] = {0.f, 0.f, 0.f, 0.f};
                if (!RET) { const float4 t4 = *(const float4*)(tab + 32 * mb + 8 * rg + 4 * hs); av[0] = t4.x; av[1] = t4.y; av[2] = t4.z; av[3] = t4.w; }
#pragma unroll
                for (int i = 0; i < 4; ++i) { const int r = 4 * rg + i, s = 32 * mb + 8 * rg + 4 * hs + i, t = 32 * nb + li;
                    float w;
                    if (RET) w = __expf(lg * fabsf((float)(t - s))); else w = s <= t ? __expf(av[i] - mx_t[nb]) : 0.f;
                    xv[r] = sa[r] * w; csum += xv[r]; } }
            xf[mb][0] = pack8(xv); xf[mb][1] = pack8(xv + 8); __builtin_amdgcn_sched_barrier(0); }
        f32x16 o[2];
#pragma unroll
        for (int eb = 0; eb < 2; ++eb) {
#pragma unroll
            for (int r = 0; r < 16; ++r) o[eb][r] = 0.f;
#pragma unroll
            for (int ks = 0; ks < 4; ++ks) o[eb] = MFMA32(cf[eb][ks], qf[nb][ks], o[eb]);
#pragma unroll
            for (int r = 0; r < 16; ++r) o[eb][r] *= sc_t[nb]; }
        __builtin_amdgcn_sched_barrier(0);
        float dn = 1.f;
        if (!RET) { float qn = 0.f;
#pragma unroll
            for (int ks = 0; ks < 4; ++ks) { const float4 n0 = *(const float4*)(S + 4096 + 16 * ks + 8 * hs), n1 = *(const float4*)(S + 4096 + 16 * ks + 8 * hs + 4);
                const float nv[8] = {n0.x, n0.y, n0.z, n0.w, n1.x, n1.y, n1.z, n1.w}; float qv[8]; unpack8(__builtin_bit_cast(uint4, qf[nb][ks]), qv);
#pragma unroll
                for (int j = 0; j < 8; ++j) qn += qv[j] * nv[j]; }
            qn += __shfl_xor(qn, 32); csum += __shfl_xor(csum, 32); dn = fmaxf(fabsf(csum + sc_t[nb] * qn), dnf_t[nb]); }
#pragma unroll
        for (int eb = 0; eb < 2; ++eb)
#pragma unroll
            for (int sb = 0; sb < 2; ++sb) {
                if (!RET && sb == 1 && nb == 0) continue;
#pragma unroll
                for (int st = 0; st < 2; ++st) { bf16x8 vf;
#pragma unroll
                    for (int j = 0; j < 8; ++j) vf[j] = (short)*(const bf16_t*)(tile + (32 * sb + 16 * st + 8 * (j >> 2) + 4 * hs + (j & 3)) * TP + (32 * eb + li) * 2);
                    o[eb] = MFMA32(vf, xf[sb][st], o[eb]); }
                do { asm volatile("" ::: "memory"); __builtin_amdgcn_sched_barrier(0); } while (0); }
        do { asm volatile("" ::: "memory"); __builtin_amdgcn_sched_barrier(0); } while (0);
        bf16_t* prw = (bf16_t*)(c->ws + OFF_P) + (size_t)(b * TS + tl0 + 32 * nb + li) * PP; const float inv = 1.f / dn; float sum = 0.f;
#pragma unroll
        for (int eb = 0; eb < 2; ++eb)
#pragma unroll
            for (int rg = 0; rg < 4; ++rg) { const int e0 = 32 * eb + 8 * rg + 4 * hs; float og[4] = {1.f, 1.f, 1.f, 1.f};
                if (!RET) { const uint2 ov = *(const uint2*)(prw + A_O + h * 64 + e0); og[0] = sigm(__uint_as_float(ov.x << 16)); og[1] = sigm(__uint_as_float(ov.x & 0xffff0000u)); og[2] = sigm(__uint_as_float(ov.y << 16)); og[3] = sigm(__uint_as_float(ov.y & 0xffff0000u)); }
#pragma unroll
                for (int i = 0; i < 4; ++i) { const float v = o[eb][4 * rg + i] * inv * og[i]; o[eb][4 * rg + i] = v; sum += v; } }
        sum += __shfl_xor(sum, 32); const float mu = sum * (1.f / 64.f); float vs = 0.f;
#pragma unroll
        for (int eb = 0; eb < 2; ++eb)
#pragma unroll
            for (int r = 0; r < 16; ++r) { const float d = o[eb][r] - mu; vs += d * d; }
        vs += __shfl_xor(vs, 32); const float rstd = rsqrtf(vs * (1.f / 64.f) + 1e-5f);
#pragma unroll
        for (int eb = 0; eb < 2; ++eb)
#pragma unroll
            for (int rg = 0; rg < 4; ++rg) { const int e0 = 32 * eb + 8 * rg + 4 * hs; const uint2 zv = *(const uint2*)(prw + zc + e0); const float4 w4 = *(const float4*)(nw + e0);
                const float z[4] = {__uint_as_float(zv.x << 16), __uint_as_float(zv.x & 0xffff0000u), __uint_as_float(zv.y << 16), __uint_as_float(zv.y & 0xffff0000u)}; const float wv[4] = {w4.x, w4.y, w4.z, w4.w}; float y[4];
#pragma unroll
                for (int i = 0; i < 4; ++i) y[i] = (o[eb][4 * rg + i] - mu) * rstd * wv[i] * siluf(z[i]);
                uint2 ov; ov.x = pk2(y[0], y[1]); ov.y = pk2(y[2], y[3]); *(uint2*)(prw + zc + e0) = ov; }
        do { asm volatile("" ::: "memory"); __builtin_amdgcn_sched_barrier(0); } while (0);
    }
    WSYNC(); __builtin_amdgcn_sched_barrier(0);
}
template <bool RET> DI void s_chunkA(CtxP c, int l, int slab, float* lds, int bid, int nblk) {
    const int tid = otid(), lane = tid & 63, wave = tid >> 6; unsigned char* wl = (unsigned char*)lds + wave * WLDS;
    for (int u = bid * 8 + wave; u < NB * NH * NCS; u += nblk * 8) { int ln = lane; asm volatile("" : "+v"(ln)); w_chunkA<RET>(c, l, slab, u, wl, ln); }
}
template <bool RET> DI void s_chunkC(CtxP c, int l, int slab, float* lds, int bid, int nblk) {
    const int tid = otid(), lane = tid & 63, wave = tid >> 6; unsigned char* wl = (unsigned char*)lds + wave * WLDS;
    for (int u = bid * 8 + wave; u < NB * NH * NCS; u += nblk * 8) { int ln = lane; asm volatile("" : "+v"(ln)); w_chunkC<RET>(c, l, slab, u, wl, ln); }
}
DI void lru_au(CtxP c, int l, int slab, int b, int tl0, int h, float* xc, float* Wr, float* Wi, float* Aa, float* Uu, int tid) {
    load_conv_tile(c, l, slab, b, tl0, C_X + h * 64, c->lconv_w + l * 2048 + h * 64, 512, c->lconv_b + l * 512 + h * 64, false, 1.f, xc, tid);
    for (int idx = tid; idx < 4096; idx += 512) { Wr[(idx >> 6) * 65 + (idx & 63)] = c->lw_r[(size_t)(l * NH + h) * 4096 + idx]; Wi[(idx >> 6) * 65 + (idx & 63)] = c->lw_i[(size_t)(l * NH + h) * 4096 + idx]; }
    __syncthreads();
    const int t = tid >> 3, j0 = (tid & 7) * 8; float ar[8] = {}, ai[8] = {};
    for (int i = 0; i < 64; ++i) { const float xv = xc[t * 65 + i];
#pragma unroll
        for (int j = 0; j < 8; ++j) { ar[j] += xv * Wr[i * 65 + j0 + j]; ai[j] += xv * Wi[i * 65 + j0 + j]; } }
#pragma unroll
    for (int j = 0; j < 8; ++j) { const int ch = h * 64 + j0 + j; const float r = sigm(ar[j] + c->lb_r[l * G + ch]), ii = sigm(ai[j] + c->lb_i[l * G + ch]);
        const float la = -8.f * r * softplusf(-c->llam[l * G + ch]);
        Aa[t * 65 + j0 + j] = expf(la); Uu[t * 65 + j0 + j] = sqrtf(-expm1f(2.f * la)) * (ii * xc[t * 65 + j0 + j]); }
    __syncthreads();
}
DI void s_cA(CtxP c, int l, int slab, float* lds, int bid, int nblk) {
    float *xc = lds, *Wr = lds + 4160, *Wi = lds + 8320, *Aa = lds + 12480, *Uu = lds + 16640;
    const int tid = otid();
    for (int item = bid; item < NB * NCS * NH; item += nblk) {
        int b, cl, h; unit_ids(item, b, cl, h);
        lru_au(c, l, slab, b, cl * 64, h, xc, Wr, Wi, Aa, Uu, tid);
        if (tid < 64) { float hl = 0.f, ap = 1.f; for (int t = 0; t < 64; ++t) { hl = Aa[t * 65 + tid] * hl + Uu[t * 65 + tid]; ap *= Aa[t * 65 + tid]; }
            float* LS = (float*)(c->ws + OFF_LS) + ((size_t)(b * NCS + cl) * G + h * 64 + tid) * 2; LS[0] = ap; LS[1] = hl; }
        __syncthreads();
    }
}
DI void s_cB(CtxP c, int l, int slab, float* lds, int bid, int nblk) {
    for (int i = bid * 512 + otid(); i < NB * G; i += nblk * 512) {
    const int b = i / G, ch = i % G; float* CC = (float*)(c->ws + OFF_CARRY + l * CARRY_L + CC_OFF);
    float hc = slab == 0 ? 0.f : CC[i];
    for (int cl = 0; cl < NCS; ++cl) { float* LS = (float*)(c->ws + OFF_LS) + ((size_t)(b * NCS + cl) * G + ch) * 2; const float ap = LS[0], hl = LS[1]; LS[0] = hc; hc = ap * hc + hl; }
    CC[i] = hc; }
}
DI void s_cC(CtxP c, int l, int slab, float* lds, int bid, int nblk) {
    float *xc = lds, *Wr = lds + 4160, *Wi = lds + 8320, *Aa = lds + 12480, *Uu = lds + 16640;
    const int tid = otid();
    for (int item = bid; item < NB * NCS * NH; item += nblk) {
        int b, cl, h; unit_ids(item, b, cl, h); const int tl0 = cl * 64;
        lru_au(c, l, slab, b, tl0, h, xc, Wr, Wi, Aa, Uu, tid);
        if (tid < 64) { float hv = ((const float*)(c->ws + OFF_LS))[((size_t)(b * NCS + cl) * G + h * 64 + tid) * 2];
            for (int t = 0; t < 64; ++t) { hv = Aa[t * 65 + tid] * hv + Uu[t * 65 + tid]; Uu[t * 65 + tid] = hv; } }
        __syncthreads();
        for (int idx = tid; idx < 4096; idx += 512) { const int t = idx >> 6, j = idx & 63; bf16_t* prw = (bf16_t*)(c->ws + OFF_P) + (size_t)(b * TS + tl0 + t) * PP;
            const float z = bf2f(prw[ZC + h * 64 + j]); prw[ZC + h * 64 + j] = f2bf(Uu[t * 65 + j] * siluf(z)); }
        __syncthreads();
    }
}
DI void s_bprep(CtxP c, int l, int slab, float* lds, int bid, int nblk) {
    float *wl = lds, *al = lds + 4160, *Wu = lds + 8320, *Au = lds + 12480;
    const int tid = otid();
    const float* mu = c->rmu + l * 1664;
    for (int item = bid; item < NB * NCS * NH; item += nblk) {
        int b, cl, h; unit_ids(item, b, cl, h); const int tl0 = cl * 64;
        for (int idx = tid; idx < 4096; idx += 512) { const int t = idx >> 6, i = idx & 63;
            const bf16_t* r0 = prow(c->ws, l, slab, b, tl0 + t); const bf16_t* r1 = prow(c->ws, l, slab, b, tl0 + t - 1);
            float x = bf2f(r0[B_WLO + i]), xp = bf2f(r1[B_WLO + i]); wl[t * 65 + i] = tanhf(x + mu[1536 + i] * (xp - x));
            x = bf2f(r0[B_ALO + i]); xp = bf2f(r1[B_ALO + i]); al[t * 65 + i] = x + mu[1600 + i] * (xp - x);
            Wu[t * 65 + i] = c->rw_up[(size_t)l * 64 * G + t * G + h * 64 + i]; Au[t * 65 + i] = c->ra_up[(size_t)l * 64 * G + t * G + h * 64 + i]; }
        __syncthreads();
        const int t = tid >> 3, j0 = (tid & 7) * 8; float dl[8] = {}, da[8] = {};
        for (int i = 0; i < 64; ++i) { const float wv = wl[t * 65 + i], av = al[t * 65 + i];
#pragma unroll
            for (int j = 0; j < 8; ++j) { dl[j] += wv * Wu[i * 65 + j0 + j]; da[j] += av * Au[i * 65 + j0 + j]; } }
        const bf16_t* r0 = prow(c->ws, l, slab, b, tl0 + t); const bf16_t* r1 = prow(c->ws, l, slab, b, tl0 + t - 1);
        float omw[8], kh[8], akh[8], kt[8], rr[8]; float ss = 0.f, bon = 0.f;
#pragma unroll
        for (int j = 0; j < 8; ++j) { const int ch = h * 64 + j0 + j;
            const float sg = sigm(c->rw0[l * G + ch] + dl[j]); omw[j] = -expm1f(-0.606531f * sg);
            const float a = sigm(c->ra0[l * G + ch] + da[j]);
            float x = bf2f(r0[B_R + ch]), xp = bf2f(r1[B_R + ch]); rr[j] = x + mu[ch] * (xp - x);
            x = bf2f(r0[B_K + ch]); xp = bf2f(r1[B_K + ch]); const float k = x + mu[512 + ch] * (xp - x);
            const float kap = k * c->rk_k[l * G + ch]; ss += kap * kap; kh[j] = kap; akh[j] = a;
            kt[j] = k * (1.f + (a - 1.f) * c->rk_a[l * G + ch]); bon += rr[j] * c->rr_k[l * G + ch] * kt[j]; }
        ss += __shfl_xor(ss, 1); ss += __shfl_xor(ss, 2); ss += __shfl_xor(ss, 4);
        bon += __shfl_xor(bon, 1); bon += __shfl_xor(bon, 2); bon += __shfl_xor(bon, 4);
        const float rs = rsqrtf(ss + 1e-12f);
#pragma unroll
        for (int j = 0; j < 8; ++j) { kh[j] *= rs; akh[j] *= kh[j]; }
        unsigned char* rec = c->ws + OFF_CK + ((size_t)((b * NH + h) * TS + tl0 + t) * 16 + (j0 >> 2)) * 48;
#pragma unroll
        for (int g2 = 0; g2 < 2; ++g2) { const int o = g2 * 4;
            *(float4*)(rec + g2 * 48) = make_float4(omw[o], omw[o + 1], omw[o + 2], omw[o + 3]);
            uint4 w1; w1.x = f2bf(kh[o]) | ((unsigned)f2bf(kh[o + 1]) << 16); w1.y = f2bf(kh[o + 2]) | ((unsigned)f2bf(kh[o + 3]) << 16);
            w1.z = f2bf(akh[o]) | ((unsigned)f2bf(akh[o + 1]) << 16); w1.w = f2bf(akh[o + 2]) | ((unsigned)f2bf(akh[o + 3]) << 16);
            uint4 w2; w2.x = f2bf(kt[o]) | ((unsigned)f2bf(kt[o + 1]) << 16); w2.y = f2bf(kt[o + 2]) | ((unsigned)f2bf(kt[o + 3]) << 16);
            w2.z = f2bf(rr[o]) | ((unsigned)f2bf(rr[o + 1]) << 16); w2.w = f2bf(rr[o + 2]) | ((unsigned)f2bf(rr[o + 3]) << 16);
            *(uint4*)(rec + g2 * 48 + 16) = w1; *(uint4*)(rec + g2 * 48 + 32) = w2; }
        if ((tid & 7) == 0) ((float*)(c->ws + OFF_BON))[(size_t)(b * TS + tl0 + t) * NH + h] = bon;
        __syncthreads();
    }
    if (slab == 0) { bf16_t* halo = (bf16_t*)(c->ws + OFF_CARRY + l * CARRY_L + HALO_OFF);
        for (int i = bid * 512 + tid; i < NB * 3 * PP; i += nblk * 512) { const int b = i / (3 * PP), r = (i / PP) % 3, col = i % PP;
            halo[i] = ((const bf16_t*)(c->ws + OFF_P))[(size_t)(b * TS + TS - 3 + r) * PP + col]; } }
}
#define DPP_ADD(v, ctrl) v += __builtin_bit_cast(float, __builtin_amdgcn_update_dpp(0, __builtin_bit_cast(int, v), ctrl, 0xF, 0xF, true))
DI float allred16(float v) { DPP_ADD(v, 0xB1); DPP_ADD(v, 0x4E); DPP_ADD(v, 0x141); DPP_ADD(v, 0x140); return v; }
constexpr int SC_CH = 64, SC_BUF = SC_CH * 768, SC_VM = SC_CH * 16 * 4;
DI void s_bscan(CtxP c, int l, int slab, float* lds, int bid) {
    const int tid = otid(), lane = tid & 63, wave = tid >> 6;
    const int bh = bid >> 2, rg16 = bid & 3, b = bh >> 3, h = bh & 7;
    unsigned char* ring = (unsigned char*)lds; float* vmr = (float*)(ring + 2 * SC_BUF);
    const unsigned char* ck = c->ws + OFF_CK + (size_t)bh * TS * 768;
    const int rr = lane >> 4, kg = lane & 15, row = rg16 * 16 + (wave & 3) * 4 + rr;
    float* CB = (float*)(c->ws + OFF_CARRY + l * CARRY_L + CB_OFF) + ((size_t)bh * 64 + row) * 64 + kg * 4;
    float S[4] = {0.f, 0.f, 0.f, 0.f};
    if (wave < 4 && slab != 0) {
#pragma unroll
        for (int e = 0; e < 4; ++e) S[e] = CB[e]; }
    const int p = tid - 256, pst = p >> 2, prq = p & 3; const int vcol = B_V + h * 64 + rg16 * 16 + prq * 4;
    float4 muv = make_float4(0.f, 0.f, 0.f, 0.f);
    if (wave >= 4) muv = *(const float4*)(c->rmu + l * 1664 + 1024 + h * 64 + rg16 * 16 + prq * 4);
    auto produce = [&](int ch) {
        unsigned char* dst = ring + (ch & 1) * SC_BUF; const uint4* src = (const uint4*)(ck + (size_t)ch * SC_BUF);
        uint4 t[12];
#pragma unroll
        for (int k = 0; k < 12; ++k) t[k] = src[p + 256 * k];
        const int tl = ch * SC_CH + pst;
        const uint2 vc = *(const uint2*)(prow(c->ws, l, slab, b, tl) + vcol), vp = *(const uint2*)(prow(c->ws, l, slab, b, tl - 1) + vcol);
#pragma unroll
        for (int k = 0; k < 12; ++k) ((uint4*)dst)[p + 256 * k] = t[k];
        const float v0 = __uint_as_float(vc.x << 16), v1 = __uint_as_float(vc.x & 0xffff0000u), v2 = __uint_as_float(vc.y << 16), v3 = __uint_as_float(vc.y & 0xffff0000u);
        const float q0 = __uint_as_float(vp.x << 16), q1 = __uint_as_float(vp.x & 0xffff0000u), q2 = __uint_as_float(vp.y << 16), q3 = __uint_as_float(vp.y & 0xffff0000u);
        *(float4*)(vmr + (ch & 1) * (SC_CH * 16) + pst * 16 + prq * 4) = make_float4(v0 + muv.x * (q0 - v0), v1 + muv.y * (q1 - v1), v2 + muv.z * (q2 - v2), v3 + muv.w * (q3 - v3));
    };
    if (wave >= 4) produce(0);
    __syncthreads();
    bf16_t* pbase = (bf16_t*)(c->ws + OFF_P) + (size_t)(b * TS) * PP;
    for (int ch = 0; ch < TS / SC_CH; ++ch) {
        if (wave >= 4) { if (ch + 1 < TS / SC_CH) produce(ch + 1); }
        else {
            const unsigned char* rec = ring + (ch & 1) * SC_BUF + kg * 48; const float* vmp = vmr + (ch & 1) * (SC_CH * 16) + (wave & 3) * 4 + rr;
            float4 om = *(const float4*)(rec); uint4 w1 = *(const uint4*)(rec + 16), w2 = *(const uint4*)(rec + 32); float vm = vmp[0];
#pragma unroll 4
            for (int s = 0; s < SC_CH; ++s) {
                const int sn = s + 1 < SC_CH ? s + 1 : s;
                const float4 om_n = *(const float4*)(rec + sn * 768); const uint4 w1_n = *(const uint4*)(rec + sn * 768 + 16), w2_n = *(const uint4*)(rec + sn * 768 + 32); const float vm_n = vmp[sn * 16];
                const float kh[4] = {__uint_as_float(w1.x << 16), __uint_as_float(w1.x & 0xffff0000u), __uint_as_float(w1.y << 16), __uint_as_float(w1.y & 0xffff0000u)};
                const float ak[4] = {__uint_as_float(w1.z << 16), __uint_as_float(w1.z & 0xffff0000u), __uint_as_float(w1.w << 16), __uint_as_float(w1.w & 0xffff0000u)};
                const float kt[4] = {__uint_as_float(w2.x << 16), __uint_as_float(w2.x & 0xffff0000u), __uint_as_float(w2.y << 16), __uint_as_float(w2.y & 0xffff0000u)};
                const float rv[4] = {__uint_as_float(w2.z << 16), __uint_as_float(w2.z & 0xffff0000u), __uint_as_float(w2.w << 16), __uint_as_float(w2.w & 0xffff0000u)};
                const float ow[4] = {om.x, om.y, om.z, om.w};
                float sk = S[0] * kh[0] + S[1] * kh[1] + S[2] * kh[2] + S[3] * kh[3];
                sk = allred16(sk);
                float y = 0.f;
#pragma unroll
                for (int e = 0; e < 4; ++e) { S[e] = S[e] - S[e] * ow[e] - sk * ak[e] + vm * kt[e]; y += S[e] * rv[e]; }
                y = allred16(y);
                if (kg == 0) ((float*)(pbase + (size_t)(ch * SC_CH + s) * PP + B_R))[h * 64 + row] = y;
                om = om_n; w1 = w1_n; w2 = w2_n; vm = vm_n;
            }
        }
        __syncthreads();
    }
    if (wave < 4) {
#pragma unroll
        for (int e = 0; e < 4; ++e) CB[e] = S[e]; }
}
DI void s_bpost(CtxP c, int l, int slab, float* lds, int bid, int nblk) {
    const int lane = otid() & 63, gw = bid * 8 + (otid() >> 6), NGW = nblk * 8;
    for (int it = gw; it < MS * NH; it += NGW) { const int r = it >> 3, h = it & 7, b = r / TS, tl = r % TS, ch = h * 64 + lane;
        bf16_t* prw = (bf16_t*)(c->ws + OFF_P) + (size_t)r * PP;
        const float w = ((const float*)(prw + B_R))[ch];
        const float mean = wave_sum(w) * (1.f / 64.f); const float d = w - mean; const float var = wave_sum(d * d) * (1.f / 64.f);
        const float nrm = d * rsqrtf(var + 1e-5f);
        const float x = bf2f(prw[B_V + ch]), xp = bf2f(prow(c->ws, l, slab, b, tl - 1)[B_V + ch]); const float vm = x + c->rmu[l * 1664 + 1024 + ch] * (xp - x);
        const float bon = ((const float*)(c->ws + OFF_BON))[(size_t)r * NH + h];
        const float z = bf2f(prw[ZB + ch]);
        prw[ZB + ch] = f2bf((nrm * c->rgn_w[l * G + ch] + c->rgn_b[l * G + ch] + bon * vm) * siluf(z)); }
}
DI void s_post(CtxP c, int l, int slab, float* lds, int bid, int nblk) {
    const int lane = otid() & 63, gw = bid * 8 + (otid() >> 6), NGW = nblk * 8;
    for (int r = gw; r < MS; r += NGW) { const int b = r / TS, tl = r % TS; const size_t grow = (size_t)b * T + slab * TS + tl;
        const float* yrow = (const float*)(c->ws + OFF_Y) + (size_t)r * D; const float* xr = (l == 0 ? c->x : c->out) + grow * D; float* orow = c->out + grow * D;
        float4 v[4]; float ss = 0.f;
#pragma unroll
        for (int j = 0; j < 4; ++j) { v[j] = *(const float4*)(yrow + j * 256 + lane * 4); ss += v[j].x * v[j].x + v[j].y * v[j].y + v[j].z * v[j].z + v[j].w * v[j].w; }
        ss = wave_sum(ss); const float rs = rsqrtf(ss * (1.f / D) + 1e-6f); float s2 = 0.f;
#pragma unroll
        for (int j = 0; j < 4; ++j) { const float4 gg = *(const float4*)(c->norm_post + l * D + j * 256 + lane * 4); const float4 xx = *(const float4*)(xr + j * 256 + lane * 4);
            v[j].x = xx.x + v[j].x * rs * gg.x; v[j].y = xx.y + v[j].y * rs * gg.y; v[j].z = xx.z + v[j].z * rs * gg.z; v[j].w = xx.w + v[j].w * rs * gg.w;
            *(float4*)(orow + j * 256 + lane * 4) = v[j]; s2 += v[j].x * v[j].x + v[j].y * v[j].y + v[j].z * v[j].z + v[j].w * v[j].w; }
        if (l == 0) { s2 = wave_sum(s2); const float r2 = rsqrtf(s2 * (1.f / D) + 1e-6f); bf16_t* hrow = (bf16_t*)(c->ws + OFF_H) + (size_t)r * D;
#pragma unroll
            for (int j = 0; j < 4; ++j) { const float4 gg = *(const float4*)(c->norm_pre + D + j * 256 + lane * 4);
                uint2 o; o.x = f2bf(v[j].x * r2 * gg.x) | ((unsigned)f2bf(v[j].y * r2 * gg.y) << 16); o.y = f2bf(v[j].z * r2 * gg.z) | ((unsigned)f2bf(v[j].w * r2 * gg.w) << 16);
                *(uint2*)(hrow + j * 256 + lane * 4) = o; } }
    }
}

namespace pg8 {
#define PG8_LAS __attribute__((address_space(3)))
typedef unsigned short bf16_t;
typedef short bf16x8 __attribute__((ext_vector_type(8)));
typedef float f32x4 __attribute__((ext_vector_type(4)));
typedef unsigned u32x4 __attribute__((ext_vector_type(4)));
constexpr int BM = 256, BK = 64, HALF = 128, HTB = HALF * BK * 2  , STAGE_BYTES = 8 * HTB, NXCD = 8, WGM = 8;

__host__ __device__ __forceinline__ int lds_byte(int r, int c) { const int st = (r >> 4) * 2 + (c >> 5), rr = r & 15, cc = c & 31, ob = rr * 64 + cc * 2; return st * 1024 + (ob ^ (((ob >> 9) & 1) << 5)); }
__host__ __device__ __forceinline__ void stage_rc(int b, int& R, int& C) { const int st = b / 1024, sb = b % 1024, swz = sb ^ (((sb >> 9) & 1) << 5); R = (st >> 1) * 16 + swz / 64; C = (st & 1) * 32 + (swz % 64) / 2; }
__host__ __device__ __forceinline__ int perm32(int rho) { const int n = rho >> 4, i = rho & 15; return 8 * (i >> 2) + 4 * n + (i & 3); }

struct Unit { int pm, pn; };
struct Gemm { const bf16_t* A; const bf16_t* Bt; int M, N, K, lda; };

struct StaticOrder {
    int nM, nN, nwg, G, c;
    __host__ __device__ void init(int M, int N, int G_, int c_) { nM = M / BM; nN = N / BM; nwg = nM * nN; G = G_; c = c_; }
    __host__ __device__ bool next(int i, Unit& u) const {
        const long L = (long)i * G + c; if (L >= nwg) return false;
        int wgid = (int)L; { const int q = nwg / NXCD, r = nwg % NXCD, xcd = wgid % NXCD, off = wgid / NXCD; wgid = (xcd < r ? xcd * (q + 1) : r * (q + 1) + (xcd - r) * q) + off; }
        const int nig = WGM * nN, gid = wgid / nig, fm = gid * WGM, gsz = (nM - fm) < WGM ? (nM - fm) : WGM;
        u.pm = fm + ((wgid % nig) % gsz); u.pn = (wgid % nig) / gsz; return true;
    }
    __device__ __forceinline__ void a_ready(const Unit&) const {}
    __device__ __forceinline__ void done(const Unit&) const {}
};

__device__ __forceinline__ unsigned cvt_pk_bf16(float lo, float hi) { unsigned r; asm volatile("v_cvt_pk_bf16_f32 %0, %1, %2" : "=v"(r) : "v"(lo), "v"(hi)); return r; }
typedef float f32x2 __attribute__((ext_vector_type(2)));
__device__ __forceinline__ f32x2 gelu_pk(f32x2 v) {
    const f32x2 av = __builtin_elementwise_abs(v), d = av * 0.2316418882f + 1.0f;
    f32x2 t; t.x = __builtin_amdgcn_rcpf(d.x); t.y = __builtin_amdgcn_rcpf(d.y);
    f32x2 q = t * 0.5307027145f + (-0.7265760135f); q = q * t + 0.7107068705f; q = q * t + (-0.142248368f); q = q * t + 0.127414796f; q = q * t;
    const f32x2 s = (v * v) * (-0.72134752044f);
    f32x2 e; e.x = __builtin_amdgcn_exp2f(s.x); e.y = __builtin_amdgcn_exp2f(s.y);
    const f32x2 m = v * (q * e), r = v - m;
    f32x2 o; o.x = v.x < 0.f ? m.x : r.x; o.y = v.y < 0.f ? m.y : r.y; return o;
}

template <int ACT  > struct EpiBf16 {
    static constexpr bool PERM = true, AFTER_DRAIN = false; static_assert(ACT == 0 || ACT == 1, "EpiBf16: ACT is 0 (none) or 1 (gelu_pk)");
    bf16_t* O; int ldc; const float* bias; int split_cols; size_t split_stride; float scale0;
    __device__ __forceinline__ void operator()(const f32x4 (&acc)[2][2][4][2], const Unit& u, int wr, int wc, int fr, int fq) const {
        const int row0 = u.pm * BM + wr * 64 + fr; int colt = u.pn * BM; bf16_t* base = O;
        float sc = 1.f; if (split_cols) { const int t = colt / split_cols; base += (size_t)t * split_stride; colt -= t * split_cols; if (t == 0) sc = scale0; }
        const int col0 = colt + wc * 32 + 8 * fq, bcol0 = u.pn * BM + wc * 32 + 8 * fq;
        f32x4 bv[2][2];
#pragma unroll
        for (int bj = 0; bj < 2; ++bj)
#pragma unroll
            for (int n = 0; n < 2; ++n) bv[bj][n] = bias ? *(const f32x4*)(bias + bcol0 + bj * HALF + 4 * n) : (f32x4){0.f, 0.f, 0.f, 0.f};
#pragma unroll
        for (int ai = 0; ai < 2; ++ai)
#pragma unroll
            for (int m = 0; m < 4; ++m) { bf16_t* rowp = base + (size_t)(row0 + ai * HALF + m * 16) * ldc + col0;
#pragma unroll
                for (int bj = 0; bj < 2; ++bj) { f32x4 v0 = acc[ai][bj][m][0] + bv[bj][0], v1 = acc[ai][bj][m][1] + bv[bj][1];
                    if (ACT == 1) { f32x2 a = gelu_pk((f32x2){v0[0], v0[1]}), b = gelu_pk((f32x2){v0[2], v0[3]}), c = gelu_pk((f32x2){v1[0], v1[1]}), d = gelu_pk((f32x2){v1[2], v1[3]});
                        v0 = (f32x4){a.x, a.y, b.x, b.y}; v1 = (f32x4){c.x, c.y, d.x, d.y}; }
                    v0 = v0 * sc; v1 = v1 * sc; u32x4 w; w.x = cvt_pk_bf16(v0[0], v0[1]); w.y = cvt_pk_bf16(v0[2], v0[3]); w.z = cvt_pk_bf16(v1[0], v1[1]); w.w = cvt_pk_bf16(v1[2], v1[3]);
                    *(u32x4*)(rowp + bj * HALF) = w; } }
    }
};


struct EpiF32 {
    static constexpr bool PERM = false, AFTER_DRAIN = false;
    float* O; int ldc;
    __device__ __forceinline__ void operator()(const f32x4 (&acc)[2][2][4][2], const Unit& u, int wr, int wc, int fr, int fq) const {
        const int row0 = u.pm * BM + wr * 64 + fr, col0 = u.pn * BM + wc * 32 + 4 * fq;
#pragma unroll
        for (int ai = 0; ai < 2; ++ai)
#pragma unroll
            for (int m = 0; m < 4; ++m) { float* rowp = O + (size_t)(row0 + ai * HALF + m * 16) * ldc + col0;
#pragma unroll
                for (int bj = 0; bj < 2; ++bj)
#pragma unroll
                    for (int n = 0; n < 2; ++n) *(f32x4*)(rowp + bj * HALF + n * 16) = acc[ai][bj][m][n]; }
    }
};
template <class Epi, class Sched, bool ALIGN_EPI, bool SP2, int KK, int LDA>
__device__ __forceinline__ void gemm_phase(PG8_LAS unsigned char* lds, const Gemm g, const Sched& S, const Epi& E) {
    const int tid = otid(), wid = __builtin_amdgcn_readfirstlane(tid >> 6), lane = tid & 63, wr = wid >> 2, wc = wid & 3, fr = lane & 15, fq = lane >> 4;
    constexpr int K = KK, nt = K / BK;
    unsigned voffA[2], voffB[2];
#pragma unroll
    for (int i = 0; i < 2; ++i) { int R, C; stage_rc(tid * 16 + i * 8192, R, C); const int Rb = Epi::PERM ? ((R & ~31) + perm32(R & 31)) : R;
        voffA[i] = (unsigned)(R * LDA + C) * 2u; voffB[i] = (unsigned)(Rb * K + C) * 2u; }
    constexpr size_t kstep = (size_t)(BK * 2);
    constexpr size_t hstepA = (size_t)HALF * LDA * 2, hstepB = (size_t)HALF * K * 2;
    constexpr size_t tstepA = 2 * hstepA, tstepB = 2 * hstepB;
    const unsigned ldsw = (unsigned)wid * 1024u;
    const int aoff = lds_byte(wr * 64 + fr, fq * 8), boff = lds_byte(wc * 32 + fr, fq * 8);
#define PG8_SA(b, h) (((b) * 2 + (h)) * HTB)
#define PG8_SB(b, h) ((4 + (b) * 2 + (h)) * HTB)
#define PG8_STAGE(bufoff, gbase, voff) do { _Pragma("unroll") for (int _i = 0; _i < 2; ++_i) \
        __builtin_amdgcn_global_load_lds((const unsigned*)((const char*)(gbase) + (voff)[_i]), (PG8_LAS unsigned*)(lds + (bufoff) + ldsw + _i * 8192), 16, 0, 0); } while (0)
#define PG8_LDA(dst, b, h) do { _Pragma("unroll") for (int m = 0; m < 4; ++m) _Pragma("unroll") for (int k = 0; k < 2; ++k) dst[m][k] = *(const PG8_LAS bf16x8*)(lds + PG8_SA(b, h) + aoff + m * 2048 + k * 1024); } while (0)
#define PG8_LDB(dst, b, h) do { _Pragma("unroll") for (int n = 0; n < 2; ++n) _Pragma("unroll") for (int k = 0; k < 2; ++k) dst[n][k] = *(const PG8_LAS bf16x8*)(lds + PG8_SB(b, h) + boff + n * 2048 + k * 1024); } while (0)
#define PG8_MMA(ai, bj, At, Bt) do { __builtin_amdgcn_s_setprio(1); _Pragma("unroll") for (int m = 0; m < 4; ++m) _Pragma("unroll") for (int n = 0; n < 2; ++n) _Pragma("unroll") for (int k = 0; k < 2; ++k) \
        acc[ai][bj][m][n] = __builtin_amdgcn_mfma_f32_16x16x32_bf16(Bt[n][k], At[m][k], acc[ai][bj][m][n], 0, 0, 0); __builtin_amdgcn_s_setprio(0); } while (0)
#define PG8_WAIT_V(n) asm volatile("s_waitcnt vmcnt(" #n ")" ::: "memory")
#define PG8_WAIT_L(n) asm volatile("s_waitcnt lgkmcnt(" #n ")" ::: "memory")
#define PG8_BAR __builtin_amdgcn_s_barrier()
#define PG8_SCHED __builtin_amdgcn_sched_barrier(0)
    Unit cur, nxt; int ui = 0;
    if (!S.next(0, cur)) return;
    f32x4 acc[2][2][4][2];
#pragma unroll
    for (int a = 0; a < 2; ++a)
#pragma unroll
        for (int b = 0; b < 2; ++b)
#pragma unroll
            for (int m = 0; m < 4; ++m)
#pragma unroll
                for (int n = 0; n < 2; ++n) acc[a][b][m][n] = (f32x4){0.f, 0.f, 0.f, 0.f};
    bf16x8 At[4][2], B0[2][2], B1[2][2];
    const char* cA = (const char*)g.A + (size_t)cur.pm * tstepA; const char* cB = (const char*)g.Bt + (size_t)cur.pn * tstepB;
    S.a_ready(cur);
    if constexpr (SP2) {
        PG8_STAGE(PG8_SB(0, 0), cB, voffB); PG8_STAGE(PG8_SB(0, 1), cB + hstepB, voffB); PG8_STAGE(PG8_SA(0, 0), cA, voffA); PG8_STAGE(PG8_SA(0, 1), cA + hstepA, voffA);
        if (wr == 1) PG8_BAR;
        PG8_WAIT_V(2); PG8_BAR;
        PG8_STAGE(PG8_SB(1, 0), cB + kstep, voffB); PG8_STAGE(PG8_SA(1, 0), cA + kstep, voffA); PG8_STAGE(PG8_SB(1, 1), cB + hstepB + kstep, voffB);
        PG8_WAIT_V(6); PG8_BAR;
    } else {
        PG8_STAGE(PG8_SB(0, 0), cB, voffB); PG8_STAGE(PG8_SA(0, 0), cA, voffA); PG8_STAGE(PG8_SB(0, 1), cB + hstepB, voffB); PG8_STAGE(PG8_SA(0, 1), cA + hstepA, voffA);
        if (wr == 1) PG8_BAR;
        PG8_WAIT_V(4); PG8_BAR;
        PG8_STAGE(PG8_SB(1, 0), cB + kstep, voffB); PG8_STAGE(PG8_SA(1, 0), cA + kstep, voffA); PG8_STAGE(PG8_SB(1, 1), cB + hstepB + kstep, voffB);
        PG8_WAIT_V(6); PG8_BAR;
    }
    for (;;) {
        const bool has_next = S.next(ui + 1, nxt);
        const char* nA = has_next ? (const char*)g.A + (size_t)nxt.pm * tstepA : cA; const char* nB = has_next ? (const char*)g.Bt + (size_t)nxt.pn * tstepB : cB;
        for (int t = 0; t < nt; t += 2) {
            const bool last = (t == nt - 2);
            const char* a1 = cA + (size_t)(t + 1) * kstep;
            const char* a2 = last ? nA : cA + (size_t)(t + 2) * kstep; const char* b2 = last ? nB : cB + (size_t)(t + 2) * kstep;
            const char* a3 = a2 + kstep; const char* b3 = b2 + kstep;
            if (last && has_next) S.a_ready(nxt);
            if constexpr (SP2) {
            PG8_LDB(B0, 0, 0); PG8_LDB(B1, 0, 1); PG8_SCHED; PG8_LDA(At, 0, 0); PG8_STAGE(PG8_SA(1, 1), a1 + hstepA, voffA);
            PG8_WAIT_V(8); PG8_WAIT_L(0); PG8_BAR; PG8_MMA(0, 0, At, B0); PG8_MMA(0, 1, At, B1); PG8_BAR; PG8_SCHED;
            PG8_LDA(At, 0, 1); PG8_STAGE(PG8_SB(0, 0), b2, voffB); PG8_STAGE(PG8_SB(0, 1), b2 + hstepB, voffB); PG8_STAGE(PG8_SA(0, 0), a2, voffA);
            PG8_WAIT_V(8); PG8_WAIT_L(0); PG8_BAR; PG8_MMA(1, 0, At, B0); PG8_MMA(1, 1, At, B1); PG8_BAR; PG8_SCHED;
            PG8_LDB(B0, 1, 0); PG8_LDB(B1, 1, 1); PG8_SCHED; PG8_LDA(At, 1, 0); PG8_STAGE(PG8_SA(0, 1), a2 + hstepA, voffA);
            PG8_WAIT_V(8); PG8_WAIT_L(0); PG8_BAR; PG8_MMA(0, 0, At, B0); PG8_MMA(0, 1, At, B1); PG8_BAR; PG8_SCHED;
            PG8_LDA(At, 1, 1); PG8_STAGE(PG8_SB(1, 0), b3, voffB); PG8_STAGE(PG8_SB(1, 1), b3 + hstepB, voffB); PG8_STAGE(PG8_SA(1, 0), a3, voffA);
            PG8_WAIT_V(8); PG8_WAIT_L(0); PG8_BAR; PG8_MMA(1, 0, At, B0); PG8_MMA(1, 1, At, B1); PG8_BAR; PG8_SCHED;
            } else {
            PG8_LDB(B0, 0, 0); PG8_SCHED; PG8_LDA(At, 0, 0); PG8_STAGE(PG8_SA(1, 1), a1 + hstepA, voffA);
            PG8_WAIT_L(8); PG8_BAR; PG8_WAIT_L(0); PG8_MMA(0, 0, At, B0); PG8_BAR; PG8_SCHED;
            PG8_LDB(B1, 0, 1); PG8_STAGE(PG8_SB(0, 0), b2, voffB);
            PG8_BAR; PG8_WAIT_L(0); PG8_MMA(0, 1, At, B1); PG8_BAR;
            PG8_LDA(At, 0, 1); PG8_STAGE(PG8_SA(0, 0), a2, voffA);
            PG8_BAR; PG8_WAIT_L(0); PG8_MMA(1, 0, At, B0); PG8_BAR; PG8_SCHED;
            PG8_STAGE(PG8_SB(0, 1), b2 + hstepB, voffB);
            PG8_WAIT_V(6); PG8_BAR; PG8_MMA(1, 1, At, B1); PG8_BAR;
            PG8_LDB(B0, 1, 0); PG8_SCHED; PG8_LDA(At, 1, 0); PG8_STAGE(PG8_SA(0, 1), a2 + hstepA, voffA);
            PG8_WAIT_L(8); PG8_BAR; PG8_WAIT_L(0); PG8_MMA(0, 0, At, B0); PG8_BAR; PG8_SCHED;
            PG8_LDB(B1, 1, 1); PG8_STAGE(PG8_SB(1, 0), b3, voffB);
            PG8_BAR; PG8_WAIT_L(0); PG8_MMA(0, 1, At, B1); PG8_BAR;
            PG8_LDA(At, 1, 1); PG8_STAGE(PG8_SA(1, 0), a3, voffA);
            PG8_BAR; PG8_WAIT_L(0); PG8_MMA(1, 0, At, B0); PG8_BAR; PG8_SCHED;
            PG8_STAGE(PG8_SB(1, 1), b3 + hstepB, voffB);
            PG8_WAIT_V(6); PG8_BAR; PG8_MMA(1, 1, At, B1); PG8_BAR;
            }
        }
        if constexpr (ALIGN_EPI) { if (wr == 0) PG8_BAR; }
        if constexpr (!Epi::AFTER_DRAIN) { E(acc, cur, wr, wc, fr, fq); S.done(cur); }
        if (!has_next) break;
#pragma unroll
        for (int a = 0; a < 2; ++a)
#pragma unroll
            for (int b = 0; b < 2; ++b)
#pragma unroll
                for (int m = 0; m < 4; ++m)
#pragma unroll
                    for (int n = 0; n < 2; ++n) acc[a][b][m][n] = (f32x4){0.f, 0.f, 0.f, 0.f};
        cur = nxt; cA = nA; cB = nB; ++ui;
        if constexpr (ALIGN_EPI) { if (wr == 1) PG8_BAR; }
    }
    PG8_WAIT_V(0);
    if constexpr (!ALIGN_EPI) { if (wr == 0) PG8_BAR; }
    PG8_BAR;
    if constexpr (Epi::AFTER_DRAIN) { E.fused(acc, cur, wr, wc, fr, fq, lds, wid, lane); S.done(cur); }
#undef PG8_SA
#undef PG8_SB
#undef PG8_STAGE
#undef PG8_LDA
#undef PG8_LDB
#undef PG8_MMA
#undef PG8_WAIT_V
#undef PG8_WAIT_L
#undef PG8_BAR
#undef PG8_SCHED
}
}

#define XB_TMO      128
#define XB_XCNT(j)  (256  + 64 * (j))
#define XB_XSUB(j)  (1280 + 64 * (j))
#define XB_XGEN(j)  (2304 + 64 * (j))
#define XB_TOP      3328
#define XB_TOPGEN   3392
#define XCD_BAR_WORDS 3456
#define XB_SPIN_CAP (1u << 18)
DI unsigned xb_ld(unsigned* p)              { return __hip_atomic_load(p, __ATOMIC_RELAXED, __HIP_MEMORY_SCOPE_AGENT); }
DI unsigned xb_add(unsigned* p, unsigned v) { return __hip_atomic_fetch_add(p, v, __ATOMIC_RELAXED, __HIP_MEMORY_SCOPE_AGENT); }
DI unsigned xb_xcc_id() { return (unsigned)__builtin_amdgcn_s_getreg((3 << 11) | 20) & 0xFu; }
#define XB_SPIN(cond, bar) do { unsigned _sp = 0; while (cond) { __builtin_amdgcn_s_sleep(1); \
    if ((++_sp & 255u) == 0u) { if (xb_ld(&(bar)[XB_TMO])) break; if (_sp > XB_SPIN_CAP) { atomicAdd(&(bar)[XB_TMO], 1u); break; } } } } while (0)
struct XcdBarrier { unsigned* bar; unsigned x; volatile LAS unsigned* st; };
DI XcdBarrier xcd_barrier_post(unsigned* bar, volatile LAS unsigned* st) {
    XcdBarrier b; b.bar = bar; b.x = (unsigned)__builtin_amdgcn_readfirstlane((int)xb_xcc_id()); b.st = st;
    if (threadIdx.x == 0) (void)xb_add(&bar[XB_XCNT(b.x)], 1u);
    return b;
}
DI void xcd_barrier_complete(unsigned* bar, unsigned x, unsigned& nloc, unsigned& nx) {
    const unsigned Gd = gridDim.x * gridDim.y * gridDim.z;
    unsigned sum, cnt, mine, sp = 0u;
    for (;;) {
        sum = 0u; cnt = 0u; mine = 0u;
#pragma unroll
        for (unsigned j = 0; j < 16; ++j) { const unsigned cc = xb_ld(&bar[XB_XCNT(j)]); sum += cc; cnt += (cc > 0u) ? 1u : 0u; mine = (j == x) ? cc : mine; }
        if (sum == Gd) break;
        __builtin_amdgcn_s_sleep(1);
        if ((++sp & 255u) == 0u) { if (xb_ld(&bar[XB_TMO])) break; if (sp > XB_SPIN_CAP) { atomicAdd(&bar[XB_TMO], 1u); break; } }
    }
    nloc = mine > 0u ? mine : 1u; nx = cnt > 0u ? cnt : 1u;
}
DI void xcd_barrier(const XcdBarrier& b) {
    asm volatile("s_waitcnt vmcnt(0)" ::: "memory");
    __syncthreads();
    if (threadIdx.x == 0) {
        unsigned* bar = b.bar; unsigned bx = b.x; asm volatile("" : "+s"(bar), "+s"(bx));
        __builtin_amdgcn_s_waitcnt(0);
        unsigned nloc = b.st[0], nx = b.st[1];
        if (nloc == 0u) { xcd_barrier_complete(bar, bx, nloc, nx); b.st[0] = nloc; b.st[1] = nx; }
        const unsigned old = xb_add(&bar[XB_XSUB(bx)], 1u);
        const unsigned gen = old / nloc;
        if (old + 1u == (gen + 1u) * nloc) {
            __builtin_amdgcn_fence(__ATOMIC_RELEASE, "agent");
            asm volatile("s_waitcnt vmcnt(0)" ::: "memory");
            const unsigned og = xb_add(&bar[XB_TOP], 1u);
            const unsigned tg = og / nx;
            if (og + 1u == (tg + 1u) * nx) xb_add(&bar[XB_TOPGEN], 1u);
            else XB_SPIN(xb_ld(&bar[XB_TOPGEN]) == tg, bar);
            __builtin_amdgcn_fence(__ATOMIC_ACQUIRE, "agent");
            xb_add(&bar[XB_XGEN(bx)], 1u);
            asm volatile("s_waitcnt vmcnt(0)" ::: "memory");
        } else {
            XB_SPIN(xb_ld(&bar[XB_XGEN(bx)]) == gen, bar);
            __builtin_amdgcn_fence(__ATOMIC_ACQUIRE, "agent");
            asm volatile("s_waitcnt vmcnt(0)" ::: "memory");
        }
    }
    __syncthreads();
}
constexpr int LDS_BYTES = 147456, MISC_OFF = 131072 + 320, CW_BAR = 4096;
__global__ void __launch_bounds__(512) mk_fwd(Ctx c_byval) {
    CtxP c = (CtxP)__builtin_amdgcn_kernarg_segment_ptr();
    extern __shared__ __attribute__((aligned(16))) unsigned char ldsraw[];
    float* lds = (float*)ldsraw;
    const int tid = threadIdx.x, bid = blockIdx.x, nblk = gridDim.x;
    volatile LAS unsigned* MISC = (volatile LAS unsigned*)((LAS unsigned char*)ldsraw + MISC_OFF);
    if (tid < 32) MISC[tid] = 0u;
    __syncthreads();
    XcdBarrier bar = xcd_barrier_post((unsigned*)(c->ws + OFF_CTL) + CW_BAR, MISC + 8);
    s_p0(c, 0, 0, lds, bid, nblk);
    s_prenorm(c, 0, 0, lds, bid, nblk);
    xcd_barrier(bar);
    for (int slab_ = 0; slab_ < 2; ++slab_)
        for (int l_ = 0; l_ < NL; ++l_) {
            int l = l_, slab = slab_; asm volatile("" : "+s"(l), "+s"(slab));
            { pg8::Gemm g{(const bf16_t*)(c->ws + OFF_H), (const bf16_t*)(c->ws + OFF_WIN + l * WIN_L), MS, PP, D, D}; pg8::StaticOrder S; S.init(MS, PP, nblk, bid);
              pg8::EpiBf16<0> E{(bf16_t*)(c->ws + OFF_P), PP, nullptr, 0, 0, 1.f};
              pg8::gemm_phase<pg8::EpiBf16<0>, pg8::StaticOrder, true, true, D, D>((LAS unsigned char*)ldsraw, g, S, E); }
            xcd_barrier(bar);
            s_chunkA<false>(c, l, slab, lds, bid, nblk); s_chunkA<true>(c, l, slab, lds, bid, nblk); __syncthreads(); s_cA(c, l, slab, lds, bid, nblk); s_bprep(c, l, slab, lds, bid, nblk);
            xcd_barrier(bar);
            s_mB(c, l, slab, lds, bid, nblk); s_dB(c, l, slab, lds, bid, nblk); s_cB(c, l, slab, lds, bid, nblk);
            xcd_barrier(bar);
            if (nblk >= 256) {
                if (bid < 128) s_bscan(c, l, slab, lds, bid);
                else { s_chunkC<false>(c, l, slab, lds, bid - 128, nblk - 128); s_chunkC<true>(c, l, slab, lds, bid - 128, nblk - 128); __syncthreads(); s_cC(c, l, slab, lds, bid - 128, nblk - 128); }
            }
            xcd_barrier(bar);
            s_bpost(c, l, slab, lds, bid, nblk);
            xcd_barrier(bar);
            { pg8::Gemm g{(const bf16_t*)(c->ws + OFF_P) + ZA, (const bf16_t*)(c->ws + OFF_WOUT + l * WOUT_L), MS, D, DMIX, PP}; pg8::StaticOrder S; S.init(MS, D, nblk, bid);
              pg8::EpiF32 E{(float*)(c->ws + OFF_Y), D};
              pg8::gemm_phase<pg8::EpiF32, pg8::StaticOrder, true, true, DMIX, PP>((LAS unsigned char*)ldsraw, g, S, E); }
            xcd_barrier(bar);
            s_post(c, l, slab, lds, bid, nblk);
            if (l == 1 && slab == 0) s_prenorm(c, 0, 1, lds, bid, nblk);
            xcd_barrier(bar);
        }
}

extern "C" void kernel_launch(void* const* d_in, const int* in_sizes, int n_in, void* d_out, int out_size, void* d_ws, size_t ws_size, hipStream_t stream) {
    static int grid = 0;
    if (grid == 0) {
        int dev = 0, cus = 0, per_cu = 0;
        (void)hipGetDevice(&dev);
        (void)hipDeviceGetAttribute(&cus, hipDeviceAttributeMultiprocessorCount, dev);
        (void)hipFuncSetAttribute((const void*)mk_fwd, hipFuncAttributeMaxDynamicSharedMemorySize, LDS_BYTES);
        (void)hipOccupancyMaxActiveBlocksPerMultiprocessor(&per_cu, (const void*)mk_fwd, 512, LDS_BYTES);
        if (per_cu < 1) { fprintf(stderr, "kernel_launch: occupancy query says %d blocks/CU\n", per_cu); per_cu = 1; }
        grid = cus;
        if (grid != 256) fprintf(stderr, "kernel_launch: %d CUs (built for 256)\n", grid);
    }
    Ctx c{};
    const float** f = (const float**)&c;
    for (int i = 0; i < 28; ++i) f[i] = (const float*)d_in[i];
    c.out = (float*)d_out; c.ws = (unsigned char*)d_ws;
    (void)hipMemsetAsync(d_ws, 0, 1 * MiB, stream);
    void* args[] = {&c};
    hipError_t e = hipLaunchCooperativeKernel((const void*)mk_fwd, dim3(grid), dim3(512), args, LDS_BYTES, stream);
    if (e != hipSuccess) fprintf(stderr, "cooperative launch failed: %s (grid %d)\n", hipGetErrorString(e), grid);
}
```

```cpp
#include <hip/hip_runtime.h>
#include <cstdint>
#include <cstdio>

typedef unsigned short bf16_t;
#define DI __device__ __forceinline__
#define LAS __attribute__((address_space(3)))

constexpr int NB = 4, T = 4096, D = 1024, NL = 2, G = 512, NH = 8;
constexpr int TS = 2048, MS = NB * TS, NCS = TS / 64;
constexpr int DIN = 7824, PP = 7936, DMIX = 2048;
constexpr int A_Q = 0, A_K = 512, A_V = 1024, A_O = 1536, B_R = 2048, B_K = 2560, B_V = 3072, B_WLO = 3584, B_ALO = 3648, C_X = 3712,
              D_Q = 4224, D_K = 4736, D_V = 5248, ZA = 5760, ZB = 6272, ZC = 6784, ZD = 7296, A_I = 7808, A_F = 7816;
constexpr size_t MiB = 1u << 20;
constexpr size_t OFF_CTL = 0, OFF_ZROW = 512 * 1024, OFF_WIN = 1 * MiB, OFF_WOUT = 32 * MiB, OFF_ROPE = 40 * MiB, OFF_CARRY = 41 * MiB,
                 OFF_LS = 45 * MiB, OFF_BON = 45 * MiB + 512 * 1024, OFF_P = 46 * MiB, OFF_SA = 170 * MiB, OFF_H = 170 * MiB,
                 OFF_SD = 170 * MiB + 17301504, OFF_CK = 203 * MiB, OFF_Y = 203 * MiB,
                 OFF_WRT = 251 * MiB, OFF_WIT = OFF_WRT + 262144, OFF_WUT = OFF_WIT + 262144, OFF_AUT = OFF_WUT + 262144;
constexpr size_t WIN_L = (size_t)PP * D * 2, WOUT_L = (size_t)D * DMIX * 2;
constexpr size_t CARRY_L = 2 * MiB, CA_OFF = 0, CD_OFF = 540672, CB_OFF = CD_OFF + 524288, CC_OFF = CB_OFF + 524288, HALO_OFF = CC_OFF + 8192;
constexpr int SAU = 4224;

struct Ctx {
    const float *x, *norm_pre, *norm_post, *w_in, *w_out, *mconv_w, *mconv_b, *mi_bias, *mf_bias, *mnorm_w, *rmu, *rw_up, *rw0, *ra_up, *ra0,
        *rk_k, *rk_a, *rr_k, *rgn_w, *rgn_b, *lconv_w, *lconv_b, *lw_r, *lb_r, *lw_i, *lb_i, *llam, *retnorm_w;
    float* out; unsigned char* ws;
};
typedef const __attribute__((address_space(4))) Ctx* CtxP;


constexpr int WVTAB_OFF = 155648 + 512;
DI int hw_slot() { return __builtin_amdgcn_s_getreg((5 << 11) | 4) & 63; }
DI int otid() { int lane; asm volatile("v_mbcnt_lo_u32_b32 %0, -1, 0\n\tv_mbcnt_hi_u32_b32 %0, -1, %0" : "=v"(lane));
    const int wv = __builtin_amdgcn_readfirstlane(((volatile LAS int*)(unsigned long)WVTAB_OFF)[hw_slot()]);
    int t = (wv << 6) | lane; asm volatile("" : "+v"(t)); return t; }
DI float bf2f(bf16_t v) { return __uint_as_float(((unsigned)v) << 16); }
DI bf16_t f2bf(float f) { unsigned u = __float_as_uint(f); u += 0x7fffu + ((u >> 16) & 1u); return (bf16_t)(u >> 16); }
DI float sigm(float x) { return __builtin_amdgcn_rcpf(1.f + __expf(-x)); }
DI float siluf(float x) { return x * __builtin_amdgcn_rcpf(1.f + __expf(-x)); }
DI float softplusf(float x) { return fmaxf(x, 0.f) + log1pf(expf(-fabsf(x))); }
DI float wave_sum(float v) {
#pragma unroll
    for (int o = 1; o < 64; o <<= 1) v += __shfl_xor(v, o);
    return v;
}
DI int srccol(int n) {
    if (n < 2048) return n;
    if (n < 3712) return n + 528;
    if (n < 4224) return n + 1040;
    if (n < 5760) return n + 1552;
    if (n < 6272) return n - 3712;
    if (n < 6784) return n - 2032;
    if (n < 7296) return n - 1520;
    if (n < 7808) return n + 16;
    if (n < 7824) return n - 5248;
    return -1;
}
DI const bf16_t* prow(const unsigned char* ws, int layer, int slab, int b, int tl) {
    if (tl >= 0) return (const bf16_t*)(ws + OFF_P) + (size_t)(b * TS + tl) * PP;
    if (slab == 0) return (const bf16_t*)(ws + OFF_ZROW);
    return (const bf16_t*)(ws + OFF_CARRY + layer * CARRY_L + HALO_OFF) + (size_t)(b * 3 + 3 + tl) * PP;
}

DI void wt_item(const float* W, int K, int N, bf16_t* WT, bool permute, float* scr, int item, int lane) {
    const int nblk = (permute ? PP : N) / 32, kb = item / nblk, nb = item % nblk, k0 = 64 * kb, n0 = 32 * nb;
    const int nn = n0 + (lane & 31); const int sc = permute ? srccol(nn) : nn;
    for (int i = 0; i < 32; ++i) { const int kk = 2 * i + (lane >> 5); scr[kk * 33 + (lane & 31)] = sc >= 0 ? W[(size_t)(k0 + kk) * N + sc] : 0.f; }
    __builtin_amdgcn_s_waitcnt(0); __builtin_amdgcn_wave_barrier();
    const int c = lane & 7;
    for (int j = 0; j < 4; ++j) { const int n = (lane >> 3) + 8 * j; const float* s = scr + (8 * c) * 33 + n;
        uint4 o; o.x = f2bf(s[0]) | ((unsigned)f2bf(s[33]) << 16); o.y = f2bf(s[66]) | ((unsigned)f2bf(s[99]) << 16);
        o.z = f2bf(s[132]) | ((unsigned)f2bf(s[165]) << 16); o.w = f2bf(s[198]) | ((unsigned)f2bf(s[231]) << 16);
        *(uint4*)(WT + (size_t)(n0 + n) * K + k0 + 8 * c) = o; }
    __builtin_amdgcn_s_waitcnt(0); __builtin_amdgcn_wave_barrier();
}
DI void s_p0(CtxP c, int l, int slab, float* lds, int bid, int nblk) {
    const int tid = otid(), lane = tid & 63, wave = tid >> 6;
    float* scr = lds + wave * (64 * 33);
    const int gw = bid * 8 + wave, NGW = nblk * 8;
    constexpr int I_IN = (D / 64) * (PP / 32), I_OUT = (DMIX / 64) * (D / 32);
    for (int it = gw; it < NL * (I_IN + I_OUT); it += NGW) {
        const int l = it / (I_IN + I_OUT); int r = it % (I_IN + I_OUT);
        if (r < I_IN) wt_item(c->w_in + (size_t)l * D * DIN, D, DIN, (bf16_t*)(c->ws + OFF_WIN + l * WIN_L), true, scr, r, lane);
        else wt_item(c->w_out + (size_t)l * DMIX * D, DMIX, D, (bf16_t*)(c->ws + OFF_WOUT + l * WOUT_L), false, scr, r - I_IN, lane);
    }
    { bf16_t* wrt = (bf16_t*)(c->ws + OFF_WRT); bf16_t* wit = (bf16_t*)(c->ws + OFF_WIT); bf16_t* wut = (bf16_t*)(c->ws + OFF_WUT); bf16_t* aut = (bf16_t*)(c->ws + OFF_AUT);
      for (int i = bid * 512 + tid; i < NL * NH * 4096; i += nblk * 512) { const int lh = i >> 12, j = (i >> 6) & 63, ii = i & 63;
          wrt[i] = f2bf(c->lw_r[(size_t)lh * 4096 + ii * 64 + j]); wit[i] = f2bf(c->lw_i[(size_t)lh * 4096 + ii * 64 + j]); }
      for (int i = bid * 512 + tid; i < NL * G * 64; i += nblk * 512) { const int l2 = i / (G * 64), j = (i >> 6) % G, ii = i & 63;
          wut[i] = f2bf(c->rw_up[(size_t)l2 * 64 * G + ii * G + j]); aut[i] = f2bf(c->ra_up[(size_t)l2 * 64 * G + ii * G + j]); } }
    float* rope = (float*)(c->ws + OFF_ROPE);
    for (int i = bid * 512 + tid; i < T * 32; i += nblk * 512) {
        const int t = i >> 5, j = i & 31; const float inv = powf(10000.f, -(float)j / 32.f); const float ang = (float)t * inv;
        rope[2 * i] = cosf(ang); rope[2 * i + 1] = sinf(ang);
    }
}
DI void norm_row(const float* xrow, const float* g, bf16_t* hrow, int lane) {
    float4 v[4]; float ss = 0.f;
#pragma unroll
    for (int j = 0; j < 4; ++j) { v[j] = *(const float4*)(xrow + j * 256 + lane * 4); ss += v[j].x * v[j].x + v[j].y * v[j].y + v[j].z * v[j].z + v[j].w * v[j].w; }
    ss = wave_sum(ss); const float rs = rsqrtf(ss * (1.f / D) + 1e-6f);
#pragma unroll
    for (int j = 0; j < 4; ++j) { const float4 gg = *(const float4*)(g + j * 256 + lane * 4);
        uint2 o; o.x = f2bf(v[j].x * rs * gg.x) | ((unsigned)f2bf(v[j].y * rs * gg.y) << 16); o.y = f2bf(v[j].z * rs * gg.z) | ((unsigned)f2bf(v[j].w * rs * gg.w) << 16);
        *(uint2*)(hrow + j * 256 + lane * 4) = o; }
}
DI void s_prenorm(CtxP c, int l, int slab, float* lds, int bid, int nblk) {
    const int lane = otid() & 63, gw = bid * 8 + (otid() >> 6), NGW = nblk * 8;
    for (int r = gw; r < MS; r += NGW) { const int b = r / TS, tl = r % TS; const size_t grow = (size_t)b * T + slab * TS + tl;
        norm_row(c->x + grow * D, c->norm_pre, (bf16_t*)(c->ws + OFF_H) + (size_t)r * D, lane); }
}
template <bool OUT_BF16> DI void s_gemm(const bf16_t* A, int lda, const bf16_t* Bt, int K, void* C, int ldc, int M, int N, float* lds, int bid, int nblk) {
    float* As = lds; float* Bs = lds + 32 * 132;
    const int tid = otid(), ty = tid >> 4, tx = tid & 15;
    const int ntn = N / 64, ntm = M / 128;
    for (int tile = bid; tile < ntn * ntm; tile += nblk) {
        const int m0 = (tile / ntn) * 128, n0 = (tile % ntn) * 64;
        float acc[4][4] = {};
        for (int k0 = 0; k0 < K; k0 += 32) {
            { const int row = tid >> 2, kq = (tid & 3) * 8; const uint4 v = *(const uint4*)(A + (size_t)(m0 + row) * lda + k0 + kq);
              const unsigned w[4] = {v.x, v.y, v.z, v.w};
#pragma unroll
              for (int i = 0; i < 4; ++i) { As[(kq + 2 * i) * 132 + row] = __uint_as_float(w[i] << 16); As[(kq + 2 * i + 1) * 132 + row] = __uint_as_float(w[i] & 0xffff0000u); } }
            if (tid < 256) { const int row = tid >> 2, kq = (tid & 3) * 8; const uint4 v = *(const uint4*)(Bt + (size_t)(n0 + row) * K + k0 + kq);
              const unsigned w[4] = {v.x, v.y, v.z, v.w};
#pragma unroll
              for (int i = 0; i < 4; ++i) { Bs[(kq + 2 * i) * 68 + row] = __uint_as_float(w[i] << 16); Bs[(kq + 2 * i + 1) * 68 + row] = __uint_as_float(w[i] & 0xffff0000u); } }
            __syncthreads();
#pragma unroll 8
            for (int k = 0; k < 32; ++k) { const float4 a = *(const float4*)(As + k * 132 + ty * 4); const float4 b = *(const float4*)(Bs + k * 68 + tx * 4);
                const float av[4] = {a.x, a.y, a.z, a.w}, bv[4] = {b.x, b.y, b.z, b.w};
#pragma unroll
                for (int i = 0; i < 4; ++i)
#pragma unroll
                    for (int j = 0; j < 4; ++j) acc[i][j] += av[i] * bv[j]; }
            __syncthreads();
        }
#pragma unroll
        for (int i = 0; i < 4; ++i) { const size_t off = (size_t)(m0 + ty * 4 + i) * ldc + n0 + tx * 4;
            if (OUT_BF16) { uint2 o; o.x = f2bf(acc[i][0]) | ((unsigned)f2bf(acc[i][1]) << 16); o.y = f2bf(acc[i][2]) | ((unsigned)f2bf(acc[i][3]) << 16); *(uint2*)((bf16_t*)C + off) = o; }
            else *(float4*)((float*)C + off) = make_float4(acc[i][0], acc[i][1], acc[i][2], acc[i][3]); }
    }
}
DI void load_conv_tile(CtxP c, int l, int slab, int b, int tl0, int col0, const float* cw, int cwstride, const float* cb, bool act, float scale, float* dst, int tid) {
    for (int idx = tid; idx < 4096; idx += 512) { const int t = idx >> 6, j = idx & 63; float acc = cb[j];
#pragma unroll
        for (int w = 0; w < 4; ++w) acc += bf2f(prow(c->ws, l, slab, b, tl0 + t - 3 + w)[col0 + j]) * cw[w * cwstride + j];
        if (act) acc = siluf(acc);
        dst[t * 65 + j] = acc * scale; }
}
DI void load_plain_tile(CtxP c, int l, int slab, int b, int tl0, int col0, float* dst, int tid) {
    for (int idx = tid; idx < 4096; idx += 512) { const int t = idx >> 6, j = idx & 63; dst[t * 65 + j] = bf2f(prow(c->ws, l, slab, b, tl0 + t)[col0 + j]); }
}
DI void load_rope_tile(CtxP c, int l, int slab, int b, int tl0, int col0, float scale, float* dst, int tid) {
    const float* rope = (const float*)(c->ws + OFF_ROPE);
    for (int idx = tid; idx < 4096; idx += 512) { const int t = idx >> 6, j = idx & 63, jj = j & 31; const bf16_t* r = prow(c->ws, l, slab, b, tl0 + t);
        const int pos = slab * TS + tl0 + t; const float cs = rope[(pos * 32 + jj) * 2], sn = rope[(pos * 32 + jj) * 2 + 1];
        const float x1 = bf2f(r[col0 + jj]), x2 = bf2f(r[col0 + 32 + jj]);
        dst[t * 65 + j] = (j < 32 ? x1 * cs - x2 * sn : x2 * cs + x1 * sn) * scale; }
}
DI void mlstm_gates(CtxP c, int l, int slab, int b, int tl0, int h, float* ig, float* lf, float* cum, int tid) {
    if (tid < 64) { const bf16_t* r = prow(c->ws, l, slab, b, tl0 + tid);
        ig[tid] = bf2f(r[A_I + h]) + c->mi_bias[l * NH + h];
        lf[tid] = -softplusf(-(bf2f(r[A_F + h]) + c->mf_bias[l * NH + h])); }
    __syncthreads();
    if (tid == 0) { float s = 0.f; for (int t = 0; t < 64; ++t) { s += lf[t]; cum[t] = s; } }
    __syncthreads();
}
DI void unit_ids(int item, int& b, int& cl, int& h) { b = item / (NCS * NH); cl = (item / NH) % NCS; h = item % NH; }
DI void s_mA(CtxP c, int l, int slab, float* lds, int bid, int nblk) {
    float *kk = lds, *vv = lds + 4160, *ig = lds + 8320, *lf = ig + 64, *cum = lf + 64, *wj = cum + 64, *sc = wj + 64;
    const int tid = otid();
    for (int item = bid; item < NB * NCS * NH; item += nblk) {
        int b, cl, h; unit_ids(item, b, cl, h); const int tl0 = cl * 64; const int u = (b * NH + h) * NCS + cl;
        load_conv_tile(c, l, slab, b, tl0, A_K + h * 64, c->mconv_w + l * 4096 + 512 + h * 64, 1024, c->mconv_b + l * 1024 + 512 + h * 64, true, 0.125f, kk, tid);
        load_plain_tile(c, l, slab, b, tl0, A_V + h * 64, vv, tid);
        mlstm_gates(c, l, slab, b, tl0, h, ig, lf, cum, tid);
        if (tid == 0) { const float tot = cum[63]; float m = -INFINITY; for (int t = 0; t < 64; ++t) m = fmaxf(m, tot - cum[t] + ig[t]); sc[0] = m; sc[1] = tot; }
        __syncthreads();
        if (tid < 64) wj[tid] = expf(sc[1] - cum[tid] + ig[tid] - sc[0]);
        __syncthreads();
        float* S = (float*)(c->ws + OFF_SA) + (size_t)u * SAU;
        { const int e = tid >> 3, d0 = (tid & 7) * 8; float acc[8] = {};
          for (int t = 0; t < 64; ++t) { const float a = wj[t] * vv[t * 65 + e];
#pragma unroll
              for (int i = 0; i < 8; ++i) acc[i] += a * kk[t * 65 + d0 + i]; }
#pragma unroll
          for (int i = 0; i < 8; ++i) S[e * 64 + d0 + i] = acc[i]; }
        if (tid < 64) { float a = 0.f; for (int t = 0; t < 64; ++t) a += wj[t] * kk[t * 65 + tid]; S[4096 + tid] = a; }
        if (tid == 0) { S[4160] = sc[0]; S[4161] = sc[1]; }
        __syncthreads();
    }
}
DI void s_mB(CtxP c, int l, int slab, float* lds, int bid, int nblk) {
    const int tid = otid();
    for (int item = bid; item < NB * NH * 9; item += nblk) {
        const int bh = item / 9, part = item % 9, el = part * 512 + tid; const bool on = el < 4160;
        float* CA = (float*)(c->ws + OFF_CARRY + l * CARRY_L + CA_OFF) + (size_t)bh * SAU;
        float m = slab == 0 ? 0.f : CA[4160 + slab - 1]; float val = (slab == 0 || !on) ? 0.f : CA[el];
        for (int cl = 0; cl < NCS; ++cl) { float* S = (float*)(c->ws + OFF_SA) + (size_t)(bh * NCS + cl) * SAU;
            const float mloc = S[4160], tot = S[4161]; const float loc = on ? S[el] : 0.f;
            if (on) S[el] = val;
            if (el == 0) S[4162] = m;
            const float mn = fmaxf(tot + m, mloc); val = expf(tot + m - mn) * val + expf(mloc - mn) * loc; m = mn; }
        if (on) CA[el] = val;
        if (el == 0) CA[4160 + slab] = m;
    }
}
DI void s_mC(CtxP c, int l, int slab, float* lds, int bid, int nblk) {
    float *qq = lds, *kk = lds + 4160, *vv = lds + 8320, *Cs = lds + 12480, *Sm = lds + 16640, *ig = lds + 20800, *lf = ig + 64, *cum = lf + 64, *mx = cum + 64, *ns = mx + 64, *den = ns + 64;
    const int tid = otid();
    for (int item = bid; item < NB * NCS * NH; item += nblk) {
        int b, cl, h; unit_ids(item, b, cl, h); const int tl0 = cl * 64; const int u = (b * NH + h) * NCS + cl;
        const float* S = (const float*)(c->ws + OFF_SA) + (size_t)u * SAU;
        load_conv_tile(c, l, slab, b, tl0, A_Q + h * 64, c->mconv_w + l * 4096 + h * 64, 1024, c->mconv_b + l * 1024 + h * 64, true, 1.f, qq, tid);
        load_conv_tile(c, l, slab, b, tl0, A_K + h * 64, c->mconv_w + l * 4096 + 512 + h * 64, 1024, c->mconv_b + l * 1024 + 512 + h * 64, true, 0.125f, kk, tid);
        load_plain_tile(c, l, slab, b, tl0, A_V + h * 64, vv, tid);
        for (int idx = tid; idx < 4096; idx += 512) Cs[(idx >> 6) * 65 + (idx & 63)] = S[idx];
        if (tid < 64) ns[tid] = S[4096 + tid];
        const float mst = S[4162];
        mlstm_gates(c, l, slab, b, tl0, h, ig, lf, cum, tid);
        if (tid == 0) { float g = -INFINITY; for (int t = 0; t < 64; ++t) { g = fmaxf(g, ig[t] - cum[t]); mx[t] = fmaxf(mst, g); } }
        __syncthreads();
        const int t = tid >> 3, s0 = (tid & 7) * 8;
        { float acc[8] = {};
#pragma unroll 2
        for (int d = 0; d < 64; ++d) { const float qv = qq[t * 65 + d];
#pragma unroll
              for (int i = 0; i < 8; ++i) acc[i] += qv * kk[(s0 + i) * 65 + d]; }
#pragma unroll
          for (int i = 0; i < 8; ++i) { const int s = s0 + i; Sm[t * 65 + s] = s <= t ? acc[i] * expf(ig[s] - cum[s] - mx[t]) : 0.f; } }
        __syncthreads();
        const float sint = expf(mst - mx[t]);
        float num[8] = {}, qc[8] = {};
#pragma unroll 2
        for (int s = 0; s < 64; ++s) { const float pv = Sm[t * 65 + s];
#pragma unroll
            for (int i = 0; i < 8; ++i) num[i] += pv * vv[s * 65 + s0 + i]; }
#pragma unroll 2
        for (int d = 0; d < 64; ++d) { const float qv = qq[t * 65 + d];
#pragma unroll
            for (int i = 0; i < 8; ++i) qc[i] += qv * Cs[(s0 + i) * 65 + d]; }
        if (tid < 64) { float a = 0.f, q = 0.f;
#pragma unroll 4
            for (int s = 0; s < 64; ++s) a += Sm[tid * 65 + s];
#pragma unroll 4
            for (int d = 0; d < 64; ++d) q += qq[tid * 65 + d] * ns[d];
            den[tid] = a + expf(mst - mx[tid]) * q; }
        __syncthreads();
        const float dn = fmaxf(fabsf(den[t]), expf(-(cum[t] + mx[t])));
        bf16_t* prw = (bf16_t*)(c->ws + OFF_P) + (size_t)(b * TS + tl0 + t) * PP;
        float ho[8], sum = 0.f;
#pragma unroll
        for (int i = 0; i < 8; ++i) { const float hh = (num[i] + sint * qc[i]) / dn; ho[i] = hh * sigm(bf2f(prw[A_O + h * 64 + s0 + i])); sum += ho[i]; }
        sum += __shfl_xor(sum, 1); sum += __shfl_xor(sum, 2); sum += __shfl_xor(sum, 4);
        const float mu = sum * (1.f / 64.f); float vs = 0.f;
#pragma unroll
        for (int i = 0; i < 8; ++i) { ho[i] -= mu; vs += ho[i] * ho[i]; }
        vs += __shfl_xor(vs, 1); vs += __shfl_xor(vs, 2); vs += __shfl_xor(vs, 4);
        const float rstd = rsqrtf(vs * (1.f / 64.f) + 1e-5f);
#pragma unroll
        for (int i = 0; i < 8; ++i) { const int ch = h * 64 + s0 + i; const float z = bf2f(prw[ZA + ch]); prw[ZA + ch] = f2bf(ho[i] * rstd * c->mnorm_w[l * G + ch] * siluf(z)); }
        __syncthreads();
    }
}
DI float ret_logg(int h) { return log1pf(-exp2f(-5.f - (float)h)); }
DI void s_dA(CtxP c, int l, int slab, float* lds, int bid, int nblk) {
    float *kk = lds, *vv = lds + 4160;
    const int tid = otid();
    for (int item = bid; item < NB * NCS * NH; item += nblk) {
        int b, cl, h; unit_ids(item, b, cl, h); const int tl0 = cl * 64; const int u = (b * NH + h) * NCS + cl; const float lg = ret_logg(h);
        load_rope_tile(c, l, slab, b, tl0, D_K + h * 64, 0.125f, kk, tid);
        load_plain_tile(c, l, slab, b, tl0, D_V + h * 64, vv, tid);
        __syncthreads();
        float* S = (float*)(c->ws + OFF_SD) + (size_t)u * 4096;
        const int d = tid >> 3, e0 = (tid & 7) * 8; float acc[8] = {};
        for (int s = 0; s < 64; ++s) { const float a = expf(lg * (float)(63 - s)) * kk[s * 65 + d];
#pragma unroll
            for (int i = 0; i < 8; ++i) acc[i] += a * vv[s * 65 + e0 + i]; }
#pragma unroll
        for (int i = 0; i < 8; ++i) S[d * 64 + e0 + i] = acc[i];
        __syncthreads();
    }
}
DI void s_dB(CtxP c, int l, int slab, float* lds, int bid, int nblk) {
    const int tid = otid();
    for (int item = bid; item < NB * NH * 8; item += nblk) {
        const int bh = item / 8, el = (item % 8) * 512 + tid; const float gch = expf(ret_logg(bh % NH) * 64.f);
        float* CD = (float*)(c->ws + OFF_CARRY + l * CARRY_L + CD_OFF) + (size_t)bh * 4096;
        float val = slab == 0 ? 0.f : CD[el];
        for (int cl = 0; cl < NCS; ++cl) { float* S = (float*)(c->ws + OFF_SD) + (size_t)(bh * NCS + cl) * 4096; const float loc = S[el]; S[el] = val; val = gch * val + loc; }
        CD[el] = val;
    }
}
DI void s_dC(CtxP c, int l, int slab, float* lds, int bid, int nblk) {
    float *qq = lds, *kk = lds + 4160, *vv = lds + 8320, *Rs = lds + 12480, *Sm = lds + 16640;
    const int tid = otid();
    for (int item = bid; item < NB * NCS * NH; item += nblk) {
        int b, cl, h; unit_ids(item, b, cl, h); const int tl0 = cl * 64; const int u = (b * NH + h) * NCS + cl; const float lg = ret_logg(h);
        const float* S = (const float*)(c->ws + OFF_SD) + (size_t)u * 4096;
        load_rope_tile(c, l, slab, b, tl0, D_Q + h * 64, 1.f, qq, tid);
        load_rope_tile(c, l, slab, b, tl0, D_K + h * 64, 0.125f, kk, tid);
        load_plain_tile(c, l, slab, b, tl0, D_V + h * 64, vv, tid);
        for (int idx = tid; idx < 4096; idx += 512) Rs[(idx >> 6) * 65 + (idx & 63)] = S[idx];
        __syncthreads();
        const int t = tid >> 3, s0 = (tid & 7) * 8;
        { float acc[8] = {};
#pragma unroll 2
        for (int d = 0; d < 64; ++d) { const float qv = qq[t * 65 + d];
#pragma unroll
              for (int i = 0; i < 8; ++i) acc[i] += qv * kk[(s0 + i) * 65 + d]; }
#pragma unroll
          for (int i = 0; i < 8; ++i) { const int s = s0 + i; Sm[t * 65 + s] = acc[i] * expf(lg * fabsf((float)(t - s))); } }
        __syncthreads();
        float o[8] = {}, qr[8] = {};
#pragma unroll 2
        for (int s = 0; s < 64; ++s) { const float pv = Sm[t * 65 + s];
#pragma unroll
            for (int i = 0; i < 8; ++i) o[i] += pv * vv[s * 65 + s0 + i]; }
#pragma unroll 2
        for (int d = 0; d < 64; ++d) { const float qv = qq[t * 65 + d];
#pragma unroll
            for (int i = 0; i < 8; ++i) qr[i] += qv * Rs[d * 65 + s0 + i]; }
        const float xi = expf(lg * (float)(t + 1));
        float sum = 0.f;
#pragma unroll
        for (int i = 0; i < 8; ++i) { o[i] += xi * qr[i]; sum += o[i]; }
        sum += __shfl_xor(sum, 1); sum += __shfl_xor(sum, 2); sum += __shfl_xor(sum, 4);
        const float mu = sum * (1.f / 64.f); float vs = 0.f;
#pragma unroll
        for (int i = 0; i < 8; ++i) { o[i] -= mu; vs += o[i] * o[i]; }
        vs += __shfl_xor(vs, 1); vs += __shfl_xor(vs, 2); vs += __shfl_xor(vs, 4);
        const float rstd = rsqrtf(vs * (1.f / 64.f) + 1e-5f);
        bf16_t* prw = (bf16_t*)(c->ws + OFF_P) + (size_t)(b * TS + tl0 + t) * PP;
#pragma unroll
        for (int i = 0; i < 8; ++i) { const int ch = h * 64 + s0 + i; const float z = bf2f(prw[ZD + ch]); prw[ZD + ch] = f2bf(o[i] * rstd * c->retnorm_w[l * G + ch] * siluf(z)); }
        __syncthreads();
    }
}
typedef short bf16x8 __attribute__((ext_vector_type(8)));
typedef float f32x16 __attribute__((ext_vector_type(16)));
typedef float f32x2_t __attribute__((ext_vector_type(2)));
typedef __bf16 bf16x2_t __attribute__((ext_vector_type(2)));
DI unsigned pk2(float lo, float hi) { f32x2_t v = {lo, hi}; bf16x2_t b = __builtin_convertvector(v, bf16x2_t); return __builtin_bit_cast(unsigned, b); }
DI bf16x8 pack8(const float* v) { uint4 u; u.x = pk2(v[0], v[1]); u.y = pk2(v[2], v[3]); u.z = pk2(v[4], v[5]); u.w = pk2(v[6], v[7]); return __builtin_bit_cast(bf16x8, u); }
DI void unpack8(uint4 u, float* v) { v[0] = __uint_as_float(u.x << 16); v[1] = __uint_as_float(u.x & 0xffff0000u); v[2] = __uint_as_float(u.y << 16); v[3] = __uint_as_float(u.y & 0xffff0000u);
    v[4] = __uint_as_float(u.z << 16); v[5] = __uint_as_float(u.z & 0xffff0000u); v[6] = __uint_as_float(u.w << 16); v[7] = __uint_as_float(u.w & 0xffff0000u); }
#define MFMA32(a, b, c) __builtin_amdgcn_mfma_f32_32x32x16_bf16((a), (b), (c), 0, 0, 0)
#define WSYNC() do { __builtin_amdgcn_fence(__ATOMIC_RELEASE, "wavefront"); __builtin_amdgcn_wave_barrier(); __builtin_amdgcn_fence(__ATOMIC_ACQUIRE, "wavefront"); } while (0)
DI float wave_psum(float v, int lane) {
#pragma unroll
    for (int o = 1; o < 64; o <<= 1) { const float t = __shfl_up(v, o); if (lane >= o) v += t; }
    return v;
}
DI float wave_pmax(float v, int lane) {
#pragma unroll
    for (int o = 1; o < 64; o <<= 1) { const float t = __shfl_up(v, o); if (lane >= o) v = fmaxf(v, t); }
    return v;
}
DI float wave_max(float v) {
#pragma unroll
    for (int o = 1; o < 64; o <<= 1) v = fmaxf(v, __shfl_xor(v, o));
    return v;
}
constexpr int TP = 144;
constexpr int WLDS = 19456;
DI void stage_tile(CtxP c, int l, int slab, int b, int tl_first, int nrows, int col, unsigned char* tile, int lane) {
    for (int i = lane; i < nrows * 8; i += 64) { const int r = i >> 3, ch = i & 7;
        *(uint4*)(tile + r * TP + ch * 16) = *(const uint4*)(prow(c->ws, l, slab, b, tl_first + r) + col + ch * 8); }
    WSYNC();
}
DI void proc_conv_tile(unsigned char* tile, const float* cw, int cws, const float* cb, float scale, int lane) {
    const int ch = lane & 7; float w[4][8], bb[8];
#pragma unroll
    for (int t = 0; t < 4; ++t) { const float4 a = *(const float4*)(cw + t * cws + ch * 8), d = *(const float4*)(cw + t * cws + ch * 8 + 4);
        w[t][0] = a.x; w[t][1] = a.y; w[t][2] = a.z; w[t][3] = a.w; w[t][4] = d.x; w[t][5] = d.y; w[t][6] = d.z; w[t][7] = d.w; }
    { const float4 a = *(const float4*)(cb + ch * 8), d = *(const float4*)(cb + ch * 8 + 4); bb[0] = a.x; bb[1] = a.y; bb[2] = a.z; bb[3] = a.w; bb[4] = d.x; bb[5] = d.y; bb[6] = d.z; bb[7] = d.w; }
    bf16x8 res[8];
#pragma unroll
    for (int k = 0; k < 8; ++k) { const int row = (lane >> 3) + 8 * k; float acc[8];
#pragma unroll
        for (int i = 0; i < 8; ++i) acc[i] = bb[i];
#pragma unroll
        for (int t = 0; t < 4; ++t) { float x[8]; unpack8(*(const uint4*)(tile + (row + t) * TP + ch * 16), x);
#pragma unroll
            for (int i = 0; i < 8; ++i) acc[i] += x[i] * w[t][i]; }
#pragma unroll
        for (int i = 0; i < 8; ++i) acc[i] = siluf(acc[i]) * scale;
        res[k] = pack8(acc); asm volatile("" ::: "memory"); }
    WSYNC();
#pragma unroll
    for (int k = 0; k < 8; ++k) *(bf16x8*)(tile + ((lane >> 3) + 8 * k) * TP + ch * 16) = res[k];
    WSYNC();
}
DI void proc_rope_tile(unsigned char* tile, const float* ropet, int pos0, float scale, int lane) {
    const int p = lane & 3;
#pragma unroll
    for (int k = 0; k < 4; ++k) { const int row = (lane >> 2) + 16 * k; float x1[8], x2[8], o1[8], o2[8];
        unpack8(*(const uint4*)(tile + row * TP + p * 16), x1); unpack8(*(const uint4*)(tile + row * TP + (p + 4) * 16), x2);
        const float* cs = ropet + ((size_t)(pos0 + row) * 32 + p * 8) * 2;
#pragma unroll
        for (int q = 0; q < 4; ++q) { const float4 v = *(const float4*)(cs + 4 * q);
            o1[2 * q] = (x1[2 * q] * v.x - x2[2 * q] * v.y) * scale; o2[2 * q] = (x2[2 * q] * v.x + x1[2 * q] * v.y) * scale;
            o1[2 * q + 1] = (x1[2 * q + 1] * v.z - x2[2 * q + 1] * v.w) * scale; o2[2 * q + 1] = (x2[2 * q + 1] * v.z + x1[2 * q + 1] * v.w) * scale; }
        *(bf16x8*)(tile + row * TP + p * 16) = pack8(o1); *(bf16x8*)(tile + row * TP + (p + 4) * 16) = pack8(o2); asm volatile("" ::: "memory"); }
    WSYNC();
}
DI bf16x8 frag_nat(const unsigned char* tile, int row, int ch) { return *(const bf16x8*)(tile + row * TP + ch * 16); }
DI float tile_at(const unsigned char* tile, int row, int col) { return bf2f(*(const bf16_t*)(tile + row * TP + col * 2)); }

template <bool RET> DI void w_chunkA(CtxP c, int l, int slab, int u, unsigned char* wl, int lane) {
    const int bh = u / NCS, cl = u % NCS, b = bh >> 3, h = bh & 7, tl0 = cl * 64, hs = lane >> 5, li = lane & 31;
    unsigned char* tile = wl; float* tab = (float*)(wl + 9728);
    float* S = RET ? (float*)(c->ws + OFF_SD) + (size_t)u * 4096 : (float*)(c->ws + OFF_SA) + (size_t)u * SAU;
    float mloc = 0.f, tot = 0.f;
    if (RET) { tab[lane] = expf(ret_logg(h) * (float)(63 - lane)); }
    else { const bf16_t* gr = (const bf16_t*)(c->ws + OFF_P) + (size_t)(b * TS + tl0 + lane) * PP;
        const float ig = bf2f(gr[A_I + h]) + c->mi_bias[l * NH + h]; const float lf = -softplusf(-(bf2f(gr[A_F + h]) + c->mf_bias[l * NH + h]));
        const float cum = wave_psum(lf, lane); tot = __shfl(cum, 63); const float lw = tot - cum + ig; mloc = wave_max(lw); tab[lane] = expf(lw - mloc); }
    if (RET) { stage_tile(c, l, slab, b, tl0, 64, D_K + h * 64, tile, lane); proc_rope_tile(tile, (const float*)(c->ws + OFF_ROPE), slab * TS + tl0, 0.125f, lane); }
    else { stage_tile(c, l, slab, b, tl0 - 3, 67, A_K + h * 64, tile, lane); proc_conv_tile(tile, c->mconv_w + l * 4096 + 512 + h * 64, 1024, c->mconv_b + l * 1024 + 512 + h * 64, 0.125f, lane); }
    bf16x8 kf[2][4]; float nl[2] = {0.f, 0.f};
#pragma unroll
    for (int db = 0; db < 2; ++db)
#pragma unroll
        for (int ks = 0; ks < 4; ++ks) { float v[8];
#pragma unroll
            for (int j = 0; j < 8; ++j) { const int t = 16 * ks + 8 * hs + j; v[j] = tile_at(tile, t, 32 * db + li); nl[db] += tab[t] * v[j]; }
            kf[db][ks] = pack8(v); }
    WSYNC();
    stage_tile(c, l, slab, b, tl0, 64, (RET ? D_V : A_V) + h * 64, tile, lane);
    f32x16 acc[2][2];
#pragma unroll
    for (int eb = 0; eb < 2; ++eb)
#pragma unroll
        for (int db = 0; db < 2; ++db)
#pragma unroll
            for (int r = 0; r < 16; ++r) acc[eb][db][r] = 0.f;
#pragma unroll
    for (int eb = 0; eb < 2; ++eb)
#pragma unroll
        for (int ks = 0; ks < 4; ++ks) { float v[8];
#pragma unroll
            for (int j = 0; j < 8; ++j) { const int t = 16 * ks + 8 * hs + j; v[j] = tile_at(tile, t, 32 * eb + li) * tab[t]; }
            const bf16x8 vf = pack8(v);
#pragma unroll
            for (int db = 0; db < 2; ++db) acc[eb][db] = MFMA32(vf, kf[db][ks], acc[eb][db]); }
#pragma unroll
    for (int eb = 0; eb < 2; ++eb)
#pragma unroll
        for (int db = 0; db < 2; ++db)
#pragma unroll
            for (int r = 0; r < 16; ++r) S[(32 * eb + (r & 3) + 8 * (r >> 2) + 4 * hs) * 64 + 32 * db + li] = acc[eb][db][r];
    if (!RET) {
#pragma unroll
        for (int db = 0; db < 2; ++db) { nl[db] += __shfl_xor(nl[db], 32); if (hs == 0) S[4096 + 32 * db + li] = nl[db]; }
        if (lane == 0) { S[4160] = mloc; S[4161] = tot; } }
    WSYNC();
}
template <bool RET> DI void w_chunkC(CtxP c, int l, int slab, int u, unsigned char* wl, int lane) {
    const int bh = u / NCS, cl = u % NCS, b = bh >> 3, h = bh & 7, tl0 = cl * 64, hs = lane >> 5, li = lane & 31;
    unsigned char* tile = wl; float* tab = (float*)(wl + 9728);
    const float* S = RET ? (const float*)(c->ws + OFF_SD) + (size_t)u * 4096 : (const float*)(c->ws + OFF_SA) + (size_t)u * SAU;
    const float lg = RET ? ret_logg(h) : 0.f;
    float mx_t[2] = {0.f, 0.f}, sc_t[2], dnf_t[2] = {0.f, 0.f};
    if (RET) { sc_t[0] = expf(lg * (float)(li + 1)); sc_t[1] = expf(lg * (float)(li + 33)); }
    else { const bf16_t* gr = (const bf16_t*)(c->ws + OFF_P) + (size_t)(b * TS + tl0 + lane) * PP;
        const float ig = bf2f(gr[A_I + h]) + c->mi_bias[l * NH + h]; const float lf = -softplusf(-(bf2f(gr[A_F + h]) + c->mf_bias[l * NH + h]));
        const float cum = wave_psum(lf, lane); const float a = ig - cum; const float g = wave_pmax(a, lane);
        const float mst = S[4162]; const float mx = fmaxf(mst, g); const float sint = expf(mst - mx); const float dnf = expf(-(cum + mx));
        tab[lane] = a;
        mx_t[0] = __shfl(mx, li); mx_t[1] = __shfl(mx, 32 + li); sc_t[0] = __shfl(sint, li); sc_t[1] = __shfl(sint, 32 + li); dnf_t[0] = __shfl(dnf, li); dnf_t[1] = __shfl(dnf, 32 + li); }
    bf16x8 kf[2][4], qf[2][4], cf[2][4];
#pragma unroll
    for (int eb = 0; eb < 2; ++eb)
#pragma unroll
        for (int ks = 0; ks < 4; ++ks) { const float* cp = S + (32 * eb + li) * 64 + 16 * ks + 8 * hs; const float4 c0 = *(const float4*)cp, c1 = *(const float4*)(cp + 4);
            const float cv[8] = {c0.x, c0.y, c0.z, c0.w, c1.x, c1.y, c1.z, c1.w}; cf[eb][ks] = pack8(cv); }
    do { asm volatile("" ::: "memory"); __builtin_amdgcn_sched_barrier(0); } while (0);
    if (RET) { stage_tile(c, l, slab, b, tl0, 64, D_K + h * 64, tile, lane); proc_rope_tile(tile, (const float*)(c->ws + OFF_ROPE), slab * TS + tl0, 0.125f, lane); }
    else { stage_tile(c, l, slab, b, tl0 - 3, 67, A_K + h * 64, tile, lane); proc_conv_tile(tile, c->mconv_w + l * 4096 + 512 + h * 64, 1024, c->mconv_b + l * 1024 + 512 + h * 64, 0.125f, lane); }
#pragma unroll
    for (int mb = 0; mb < 2; ++mb)
#pragma unroll
        for (int ks = 0; ks < 4; ++ks) kf[mb][ks] = frag_nat(tile, 32 * mb + li, 2 * ks + hs);
    WSYNC(); __builtin_amdgcn_sched_barrier(0);
    if (RET) { stage_tile(c, l, slab, b, tl0, 64, D_Q + h * 64, tile, lane); proc_rope_tile(tile, (const float*)(c->ws + OFF_ROPE), slab * TS + tl0, 1.f, lane); }
    else { stage_tile(c, l, slab, b, tl0 - 3, 67, A_Q + h * 64, tile, lane); proc_conv_tile(tile, c->mconv_w + l * 4096 + h * 64, 1024, c->mconv_b + l * 1024 + h * 64, 1.f, lane); }
#pragma unroll
    for (int nb = 0; nb < 2; ++nb)
#pragma unroll
        for (int ks = 0; ks < 4; ++ks) qf[nb][ks] = frag_nat(tile, 32 * nb + li, 2 * ks + hs);
    WSYNC(); __builtin_amdgcn_sched_barrier(0);
    stage_tile(c, l, slab, b, tl0, 64, (RET ? D_V : A_V) + h * 64, tile, lane);
    const int zc = (RET ? ZD : ZA) + h * 64; const float* nw = (RET ? c->retnorm_w : c->mnorm_w) + l * G + h * 64;
#pragma unroll
    for (int nb = 0; nb < 2; ++nb) {
        bf16x8 xf[2][2]; float csum = 0.f;
#pragma unroll
        for (int mb = 0; mb < 2; ++mb) {
            if (!RET && mb == 1 && nb == 0) continue;
            f32x16 sa;
#pragma unroll
            for (int r = 0; r < 16; ++r) sa[r] = 0.f;
#pragma unroll
            for (int ks = 0; ks < 4; ++ks) sa = MFMA32(kf[mb][ks], qf[nb][ks], sa);
            float xv[16];
#pragma unroll
            for (int rg = 0; rg < 4; ++rg) { float av[4] = {0.f, 0.f, 0.f, 0.f};
                if (!RET) { const float4 t4 = *(const float4*)(tab + 32 * mb + 8 * rg + 4 * hs); av[0] = t4.x; av[1] = t4.y; av[2] = t4.z; av[3] = t4.w; }
#pragma unroll
                for (int i = 0; i < 4; ++i) { const int r = 4 * rg + i, s = 32 * mb + 8 * rg + 4 * hs + i, t = 32 * nb + li;
                    float w;
                    if (RET) w = __expf(lg * fabsf((float)(t - s))); else w = s <= t ? __expf(av[i] - mx_t[nb]) : 0.f;
                    xv[r] = sa[r] * w; csum += xv[r]; } }
            xf[mb][0] = pack8(xv); xf[mb][1] = pack8(xv + 8); __builtin_amdgcn_sched_barrier(0); }
        f32x16 o[2];
#pragma unroll
        for (int eb = 0; eb < 2; ++eb) {
#pragma unroll
            for (int r = 0; r < 16; ++r) o[eb][r] = 0.f;
#pragma unroll
            for (int ks = 0; ks < 4; ++ks) o[eb] = MFMA32(cf[eb][ks], qf[nb][ks], o[eb]);
#pragma unroll
            for (int r = 0; r < 16; ++r) o[eb][r] *= sc_t[nb]; }
        __builtin_amdgcn_sched_barrier(0);
        float dn = 1.f;
        if (!RET) { float qn = 0.f;
#pragma unroll
            for (int ks = 0; ks < 4; ++ks) { const float4 n0 = *(const float4*)(S + 4096 + 16 * ks + 8 * hs), n1 = *(const float4*)(S + 4096 + 16 * ks + 8 * hs + 4);
                const float nv[8] = {n0.x, n0.y, n0.z, n0.w, n1.x, n1.y, n1.z, n1.w}; float qv[8]; unpack8(__builtin_bit_cast(uint4, qf[nb][ks]), qv);
#pragma unroll
                for (int j = 0; j < 8; ++j) qn += qv[j] * nv[j]; }
            qn += __shfl_xor(qn, 32); csum += __shfl_xor(csum, 32); dn = fmaxf(fabsf(csum + sc_t[nb] * qn), dnf_t[nb]); }
#pragma unroll
        for (int eb = 0; eb < 2; ++eb)
#pragma unroll
            for (int sb = 0; sb < 2; ++sb) {
                if (!RET && sb == 1 && nb == 0) continue;
#pragma unroll
                for (int st = 0; st < 2; ++st) { bf16x8 vf;
#pragma unroll
                    for (int j = 0; j < 8; ++j) vf[j] = (short)*(const bf16_t*)(tile + (32 * sb + 16 * st + 8 * (j >> 2) + 4 * hs + (j & 3)) * TP + (32 * eb + li) * 2);
                    o[eb] = MFMA32(vf, xf[sb][st], o[eb]); }
                do { asm volatile("" ::: "memory"); __builtin_amdgcn_sched_barrier(0); } while (0); }
        do { asm volatile("" ::: "memory"); __builtin_amdgcn_sched_barrier(0); } while (0);
        bf16_t* prw = (bf16_t*)(c->ws + OFF_P) + (size_t)(b * TS + tl0 + 32 * nb + li) * PP; const float inv = 1.f / dn; float sum = 0.f;
#pragma unroll
        for (int eb = 0; eb < 2; ++eb)
#pragma unroll
            for (int rg = 0; rg < 4; ++rg) { const int e0 = 32 * eb + 8 * rg + 4 * hs; float og[4] = {1.f, 1.f, 1.f, 1.f};
                if (!RET) { const uint2 ov = *(const uint2*)(prw + A_O + h * 64 + e0); og[0] = sigm(__uint_as_float(ov.x << 16)); og[1] = sigm(__uint_as_float(ov.x & 0xffff0000u)); og[2] = sigm(__uint_as_float(ov.y << 16)); og[3] = sigm(__uint_as_float(ov.y & 0xffff0000u)); }
#pragma unroll
                for (int i = 0; i < 4; ++i) { const float v = o[eb][4 * rg + i] * inv * og[i]; o[eb][4 * rg + i] = v; sum += v; } }
        sum += __shfl_xor(sum, 32); const float mu = sum * (1.f / 64.f); float vs = 0.f;
#pragma unroll
        for (int eb = 0; eb < 2; ++eb)
#pragma unroll
            for (int r = 0; r < 16; ++r) { const float d = o[eb][r] - mu; vs += d * d; }
        vs += __shfl_xor(vs, 32); const float rstd = rsqrtf(vs * (1.f / 64.f) + 1e-5f);
#pragma unroll
        for (int eb = 0; eb < 2; ++eb)
#pragma unroll
            for (int rg = 0; rg < 4; ++rg) { const int e0 = 32 * eb + 8 * rg + 4 * hs; const uint2 zv = *(const uint2*)(prw + zc + e0); const float4 w4 = *(const float4*)(nw + e0);
                const float z[4] = {__uint_as_float(zv.x << 16), __uint_as_float(zv.x & 0xffff0000u), __uint_as_float(zv.y << 16), __uint_as_float(zv.y & 0xffff0000u)}; const float wv[4] = {w4.x, w4.y, w4.z, w4.w}; float y[4];
#pragma unroll
                for (int i = 0; i < 4; ++i) y[i] = (o[eb][4 * rg + i] - mu) * rstd * wv[i] * siluf(z[i]);
                uint2 ov; ov.x = pk2(y[0], y[1]); ov.y = pk2(y[2], y[3]); *(uint2*)(prw + zc + e0) = ov; }
        do { asm volatile("" ::: "memory"); __builtin_amdgcn_sched_barrier(0); } while (0);
    }
    WSYNC(); __builtin_amdgcn_sched_barrier(0);
}
template <bool RET> DI void s_chunkA(CtxP c, int l, int slab, float* lds, int bid, int nblk) {
    const int tid = otid(), lane = tid & 63, wave = tid >> 6; unsigned char* wl = (unsigned char*)lds + wave * WLDS;
    for (int u = bid * 8 + wave; u < NB * NH * NCS; u += nblk * 8) { int ln = lane; asm volatile("" : "+v"(ln)); w_chunkA<RET>(c, l, slab, u, wl, ln); }
}
template <bool RET> DI void s_chunkC(CtxP c, int l, int slab, float* lds, int bid, int nblk) {
    const int tid = otid(), lane = tid & 63, wave = tid >> 6; unsigned char* wl = (unsigned char*)lds + wave * WLDS;
    for (int u = bid * 8 + wave; u < NB * NH * NCS; u += nblk * 8) { int ln = lane; asm volatile("" : "+v"(ln)); w_chunkC<RET>(c, l, slab, u, wl, ln); }
}
DI void lru_au(CtxP c, int l, int slab, int b, int tl0, int h, float* xc, float* Wr, float* Wi, float* Aa, float* Uu, int tid) {
    load_conv_tile(c, l, slab, b, tl0, C_X + h * 64, c->lconv_w + l * 2048 + h * 64, 512, c->lconv_b + l * 512 + h * 64, false, 1.f, xc, tid);
    for (int idx = tid; idx < 4096; idx += 512) { Wr[(idx >> 6) * 65 + (idx & 63)] = c->lw_r[(size_t)(l * NH + h) * 4096 + idx]; Wi[(idx >> 6) * 65 + (idx & 63)] = c->lw_i[(size_t)(l * NH + h) * 4096 + idx]; }
    __syncthreads();
    const int t = tid >> 3, j0 = (tid & 7) * 8; float ar[8] = {}, ai[8] = {};
    for (int i = 0; i < 64; ++i) { const float xv = xc[t * 65 + i];
#pragma unroll
        for (int j = 0; j < 8; ++j) { ar[j] += xv * Wr[i * 65 + j0 + j]; ai[j] += xv * Wi[i * 65 + j0 + j]; } }
#pragma unroll
    for (int j = 0; j < 8; ++j) { const int ch = h * 64 + j0 + j; const float r = sigm(ar[j] + c->lb_r[l * G + ch]), ii = sigm(ai[j] + c->lb_i[l * G + ch]);
        const float la = -8.f * r * softplusf(-c->llam[l * G + ch]);
        Aa[t * 65 + j0 + j] = expf(la); Uu[t * 65 + j0 + j] = sqrtf(-expm1f(2.f * la)) * (ii * xc[t * 65 + j0 + j]); }
    __syncthreads();
}
DI void s_cA(CtxP c, int l, int slab, float* lds, int bid, int nblk) {
    float *xc = lds, *Wr = lds + 4160, *Wi = lds + 8320, *Aa = lds + 12480, *Uu = lds + 16640;
    const int tid = otid();
    for (int item = bid; item < NB * NCS * NH; item += nblk) {
        int b, cl, h; unit_ids(item, b, cl, h);
        lru_au(c, l, slab, b, cl * 64, h, xc, Wr, Wi, Aa, Uu, tid);
        if (tid < 64) { float hl = 0.f, ap = 1.f; for (int t = 0; t < 64; ++t) { hl = Aa[t * 65 + tid] * hl + Uu[t * 65 + tid]; ap *= Aa[t * 65 + tid]; }
            float* LS = (float*)(c->ws + OFF_LS) + ((size_t)(b * NCS + cl) * G + h * 64 + tid) * 2; LS[0] = ap; LS[1] = hl; }
        __syncthreads();
    }
}
DI void s_cB(CtxP c, int l, int slab, float* lds, int bid, int nblk) {
    for (int i = bid * 512 + otid(); i < NB * G; i += nblk * 512) {
    const int b = i / G, ch = i % G; float* CC = (float*)(c->ws + OFF_CARRY + l * CARRY_L + CC_OFF);
    float hc = slab == 0 ? 0.f : CC[i];
    for (int cl = 0; cl < NCS; ++cl) { float* LS = (float*)(c->ws + OFF_LS) + ((size_t)(b * NCS + cl) * G + ch) * 2; const float ap = LS[0], hl = LS[1]; LS[0] = hc; hc = ap * hc + hl; }
    CC[i] = hc; }
}
DI void s_cC(CtxP c, int l, int slab, float* lds, int bid, int nblk) {
    float *xc = lds, *Wr = lds + 4160, *Wi = lds + 8320, *Aa = lds + 12480, *Uu = lds + 16640;
    const int tid = otid();
    for (int item = bid; item < NB * NCS * NH; item += nblk) {
        int b, cl, h; unit_ids(item, b, cl, h); const int tl0 = cl * 64;
        lru_au(c, l, slab, b, tl0, h, xc, Wr, Wi, Aa, Uu, tid);
        if (tid < 64) { float hv = ((const float*)(c->ws + OFF_LS))[((size_t)(b * NCS + cl) * G + h * 64 + tid) * 2];
            for (int t = 0; t < 64; ++t) { hv = Aa[t * 65 + tid] * hv + Uu[t * 65 + tid]; Uu[t * 65 + tid] = hv; } }
        __syncthreads();
        for (int idx = tid; idx < 4096; idx += 512) { const int t = idx >> 6, j = idx & 63; bf16_t* prw = (bf16_t*)(c->ws + OFF_P) + (size_t)(b * TS + tl0 + t) * PP;
            const float z = bf2f(prw[ZC + h * 64 + j]); prw[ZC + h * 64 + j] = f2bf(Uu[t * 65 + j] * siluf(z)); }
        __syncthreads();
    }
}
DI void proc_conv_tile_lin(unsigned char* tile, const float* cw, int cws, const float* cb, int lane) {
    const int ch = lane & 7; float w[4][8], bb[8];
#pragma unroll
    for (int t = 0; t < 4; ++t) { const float4 a = *(const float4*)(cw + t * cws + ch * 8), d = *(const float4*)(cw + t * cws + ch * 8 + 4);
        w[t][0] = a.x; w[t][1] = a.y; w[t][2] = a.z; w[t][3] = a.w; w[t][4] = d.x; w[t][5] = d.y; w[t][6] = d.z; w[t][7] = d.w; }
    { const float4 a = *(const float4*)(cb + ch * 8), d = *(const float4*)(cb + ch * 8 + 4); bb[0] = a.x; bb[1] = a.y; bb[2] = a.z; bb[3] = a.w; bb[4] = d.x; bb[5] = d.y; bb[6] = d.z; bb[7] = d.w; }
    bf16x8 res[8];
#pragma unroll
    for (int k = 0; k < 8; ++k) { const int row = (lane >> 3) + 8 * k; float acc[8];
#pragma unroll
        for (int i = 0; i < 8; ++i) acc[i] = bb[i];
#pragma unroll
        for (int t = 0; t < 4; ++t) { float x[8]; unpack8(*(const uint4*)(tile + (row + t) * TP + ch * 16), x);
#pragma unroll
            for (int i = 0; i < 8; ++i) acc[i] += x[i] * w[t][i]; }
        res[k] = pack8(acc); asm volatile("" ::: "memory"); }
    WSYNC();
#pragma unroll
    for (int k = 0; k < 8; ++k) *(bf16x8*)(tile + ((lane >> 3) + 8 * k) * TP + ch * 16) = res[k];
    WSYNC();
}
DI void lru_gates(CtxP c, int l, int h, int jb, const unsigned char* tile, const bf16x8 (&xf)[2][4], float (&a)[2][16], float (&u)[2][16], int li, int hs) {
    const int j = 32 * jb + li, ch = h * 64 + j;
    const bf16_t* wr = (const bf16_t*)(c->ws + OFF_WRT) + ((size_t)(l * NH + h) * 64 + j) * 64; const bf16_t* wi = (const bf16_t*)(c->ws + OFF_WIT) + ((size_t)(l * NH + h) * 64 + j) * 64;
    bf16x8 wrf[4], wif[4];
#pragma unroll
    for (int ks = 0; ks < 4; ++ks) { wrf[ks] = *(const bf16x8*)(wr + 16 * ks + 8 * hs); wif[ks] = *(const bf16x8*)(wi + 16 * ks + 8 * hs); }
    const float br = c->lb_r[l * G + ch], bi = c->lb_i[l * G + ch], sp8 = -8.f * softplusf(-c->llam[l * G + ch]);
#pragma unroll
    for (int tb = 0; tb < 2; ++tb) { f32x16 ar, ai;
#pragma unroll
        for (int r = 0; r < 16; ++r) { ar[r] = 0.f; ai[r] = 0.f; }
#pragma unroll
        for (int ks = 0; ks < 4; ++ks) { ar = MFMA32(xf[tb][ks], wrf[ks], ar); ai = MFMA32(xf[tb][ks], wif[ks], ai); }
#pragma unroll
        for (int r = 0; r < 16; ++r) { const int t = 32 * tb + (r & 3) + 8 * (r >> 2) + 4 * hs; const float x = tile_at(tile, t, j);
            const float la = sp8 * sigm(ar[r] + br); a[tb][r] = __expf(la); u[tb][r] = sqrtf(-expm1f(2.f * la)) * (sigm(ai[r] + bi) * x); } }
}
template <bool STEP_C> DI void w_lru(CtxP c, int l, int slab, int u_, unsigned char* wl, int lane) {
    const int bh = u_ / NCS, cl = u_ % NCS, b = bh >> 3, h = bh & 7, tl0 = cl * 64, hs = lane >> 5, li = lane & 31;
    unsigned char* tile = wl;
    stage_tile(c, l, slab, b, tl0 - 3, 67, C_X + h * 64, tile, lane);
    proc_conv_tile_lin(tile, c->lconv_w + l * 2048 + h * 64, 512, c->lconv_b + l * 512 + h * 64, lane);
    bf16x8 xf[2][4];
#pragma unroll
    for (int tb = 0; tb < 2; ++tb)
#pragma unroll
        for (int ks = 0; ks < 4; ++ks) xf[tb][ks] = frag_nat(tile, 32 * tb + li, 2 * ks + hs);
#pragma unroll
    for (int jb = 0; jb < 2; ++jb) {
        float a[2][16], u[2][16];
        lru_gates(c, l, h, jb, tile, xf, a, u, li, hs);
        const int ch = h * 64 + 32 * jb + li; float* LS = (float*)(c->ws + OFF_LS) + ((size_t)(b * NCS + cl) * G + ch) * 2;
        float cst = STEP_C ? LS[0] : 0.f, pr = 1.f;
#pragma unroll
        for (int tb = 0; tb < 2; ++tb)
#pragma unroll
            for (int q = 0; q < 4; ++q) {
                float ga = 1.f, gu = 0.f;
#pragma unroll
                for (int i = 0; i < 4; ++i) { gu = a[tb][4 * q + i] * gu + u[tb][4 * q + i]; ga *= a[tb][4 * q + i]; }
                const float pa = __shfl_xor(ga, 32), pu = __shfl_xor(gu, 32);
                const float a0 = hs ? pa : ga, u0 = hs ? pu : gu, a1 = hs ? ga : pa, u1 = hs ? gu : pu;
                if (STEP_C) { float hv = hs ? a0 * cst + u0 : cst;
#pragma unroll
                    for (int i = 0; i < 4; ++i) { hv = a[tb][4 * q + i] * hv + u[tb][4 * q + i]; u[tb][4 * q + i] = hv; } }
                cst = a1 * (a0 * cst + u0) + u1; pr *= a0 * a1; }
        if (!STEP_C) { if (hs == 0) { LS[0] = pr; LS[1] = cst; } }
        else {
#pragma unroll
            for (int tb = 0; tb < 2; ++tb)
#pragma unroll
                for (int r = 0; r < 16; ++r) { const int t = 32 * tb + (r & 3) + 8 * (r >> 2) + 4 * hs; bf16_t* pz = (bf16_t*)(c->ws + OFF_P) + (size_t)(b * TS + tl0 + t) * PP + ZC + ch;
                    *pz = f2bf(u[tb][r] * siluf(bf2f(*pz))); } }
        asm volatile("" ::: "memory"); __builtin_amdgcn_sched_barrier(0);
    }
    WSYNC();
}
template <bool STEP_C> DI void s_lru(CtxP c, int l, int slab, float* lds, int bid, int nblk) {
    const int tid = otid(), lane = tid & 63, wave = tid >> 6; unsigned char* wl = (unsigned char*)lds + wave * WLDS;
    for (int u = bid * 8 + wave; u < NB * NH * NCS; u += nblk * 8) { int ln = lane; asm volatile("" : "+v"(ln)); w_lru<STEP_C>(c, l, slab, u, wl, ln); }
}
DI void s_bprep(CtxP c, int l, int slab, float* lds, int bid, int nblk) {
    float *wl = lds, *al = lds + 4160, *Wu = lds + 8320, *Au = lds + 12480;
    const int tid = otid();
    const float* mu = c->rmu + l * 1664;
    for (int item = bid; item < NB * NCS * NH; item += nblk) {
        int b, cl, h; unit_ids(item, b, cl, h); const int tl0 = cl * 64;
        for (int idx = tid; idx < 4096; idx += 512) { const int t = idx >> 6, i = idx & 63;
            const bf16_t* r0 = prow(c->ws, l, slab, b, tl0 + t); const bf16_t* r1 = prow(c->ws, l, slab, b, tl0 + t - 1);
            float x = bf2f(r0[B_WLO + i]), xp = bf2f(r1[B_WLO + i]); wl[t * 65 + i] = tanhf(x + mu[1536 + i] * (xp - x));
            x = bf2f(r0[B_ALO + i]); xp = bf2f(r1[B_ALO + i]); al[t * 65 + i] = x + mu[1600 + i] * (xp - x);
            Wu[t * 65 + i] = c->rw_up[(size_t)l * 64 * G + t * G + h * 64 + i]; Au[t * 65 + i] = c->ra_up[(size_t)l * 64 * G + t * G + h * 64 + i]; }
        __syncthreads();
        const int t = tid >> 3, j0 = (tid & 7) * 8; float dl[8] = {}, da[8] = {};
        for (int i = 0; i < 64; ++i) { const float wv = wl[t * 65 + i], av = al[t * 65 + i];
#pragma unroll
            for (int j = 0; j < 8; ++j) { dl[j] += wv * Wu[i * 65 + j0 + j]; da[j] += av * Au[i * 65 + j0 + j]; } }
        const bf16_t* r0 = prow(c->ws, l, slab, b, tl0 + t); const bf16_t* r1 = prow(c->ws, l, slab, b, tl0 + t - 1);
        float omw[8], kh[8], akh[8], kt[8], rr[8]; float ss = 0.f, bon = 0.f;
#pragma unroll
        for (int j = 0; j < 8; ++j) { const int ch = h * 64 + j0 + j;
            const float sg = sigm(c->rw0[l * G + ch] + dl[j]); omw[j] = -expm1f(-0.606531f * sg);
            const float a = sigm(c->ra0[l * G + ch] + da[j]);
            float x = bf2f(r0[B_R + ch]), xp = bf2f(r1[B_R + ch]); rr[j] = x + mu[ch] * (xp - x);
            x = bf2f(r0[B_K + ch]); xp = bf2f(r1[B_K + ch]); const float k = x + mu[512 + ch] * (xp - x);
            const float kap = k * c->rk_k[l * G + ch]; ss += kap * kap; kh[j] = kap; akh[j] = a;
            kt[j] = k * (1.f + (a - 1.f) * c->rk_a[l * G + ch]); bon += rr[j] * c->rr_k[l * G + ch] * kt[j]; }
        ss += __shfl_xor(ss, 1); ss += __shfl_xor(ss, 2); ss += __shfl_xor(ss, 4);
        bon += __shfl_xor(bon, 1); bon += __shfl_xor(bon, 2); bon += __shfl_xor(bon, 4);
        const float rs = rsqrtf(ss + 1e-12f);
#pragma unroll
        for (int j = 0; j < 8; ++j) { kh[j] *= rs; akh[j] *= kh[j]; }
        unsigned char* rec = c->ws + OFF_CK + (size_t)((b * NH + h) * TS + tl0 + t) * 768;
        *(float4*)(rec + j0 * 4) = make_float4(1.f - omw[0], 1.f - omw[1], 1.f - omw[2], 1.f - omw[3]); *(float4*)(rec + j0 * 4 + 16) = make_float4(1.f - omw[4], 1.f - omw[5], 1.f - omw[6], 1.f - omw[7]);
        { uint4 w; w.x = f2bf(kh[0]) | ((unsigned)f2bf(kh[1]) << 16); w.y = f2bf(kh[2]) | ((unsigned)f2bf(kh[3]) << 16); w.z = f2bf(kh[4]) | ((unsigned)f2bf(kh[5]) << 16); w.w = f2bf(kh[6]) | ((unsigned)f2bf(kh[7]) << 16); *(uint4*)(rec + 256 + j0 * 2) = w; }
        { uint4 w; w.x = f2bf(akh[0]) | ((unsigned)f2bf(akh[1]) << 16); w.y = f2bf(akh[2]) | ((unsigned)f2bf(akh[3]) << 16); w.z = f2bf(akh[4]) | ((unsigned)f2bf(akh[5]) << 16); w.w = f2bf(akh[6]) | ((unsigned)f2bf(akh[7]) << 16); *(uint4*)(rec + 384 + j0 * 2) = w; }
        { uint4 w; w.x = f2bf(kt[0]) | ((unsigned)f2bf(kt[1]) << 16); w.y = f2bf(kt[2]) | ((unsigned)f2bf(kt[3]) << 16); w.z = f2bf(kt[4]) | ((unsigned)f2bf(kt[5]) << 16); w.w = f2bf(kt[6]) | ((unsigned)f2bf(kt[7]) << 16); *(uint4*)(rec + 512 + j0 * 2) = w; }
        { uint4 w; w.x = f2bf(rr[0]) | ((unsigned)f2bf(rr[1]) << 16); w.y = f2bf(rr[2]) | ((unsigned)f2bf(rr[3]) << 16); w.z = f2bf(rr[4]) | ((unsigned)f2bf(rr[5]) << 16); w.w = f2bf(rr[6]) | ((unsigned)f2bf(rr[7]) << 16); *(uint4*)(rec + 640 + j0 * 2) = w; }
        if ((tid & 7) == 0) ((float*)(c->ws + OFF_BON))[(size_t)(b * TS + tl0 + t) * NH + h] = bon;
        __syncthreads();
    }
    if (slab == 0) { bf16_t* halo = (bf16_t*)(c->ws + OFF_CARRY + l * CARRY_L + HALO_OFF);
        for (int i = bid * 512 + tid; i < NB * 3 * PP; i += nblk * 512) { const int b = i / (3 * PP), r = (i / PP) % 3, col = i % PP;
            halo[i] = ((const bf16_t*)(c->ws + OFF_P))[(size_t)(b * TS + TS - 3 + r) * PP + col]; } }
}
#define DPP_ADD(v, ctrl) v += __builtin_bit_cast(float, __builtin_amdgcn_update_dpp(0, __builtin_bit_cast(int, v), ctrl, 0xF, 0xF, true))
DI float allred16(float v) { DPP_ADD(v, 0xB1); DPP_ADD(v, 0x4E); DPP_ADD(v, 0x141); DPP_ADD(v, 0x140); return v; }
DI float allred32(float v) { v = allred16(v); v += __shfl_xor(v, 16); return v; }
template <bool TANH> DI void proc_shift_tile(unsigned char* tile, const float* mu, int lane) {
    const int ch = lane & 7; float m[8];
    { const float4 a = *(const float4*)(mu + ch * 8), d = *(const float4*)(mu + ch * 8 + 4); m[0] = a.x; m[1] = a.y; m[2] = a.z; m[3] = a.w; m[4] = d.x; m[5] = d.y; m[6] = d.z; m[7] = d.w; }
    bf16x8 res[8];
#pragma unroll
    for (int k = 0; k < 8; ++k) { const int row = (lane >> 3) + 8 * k; float xp[8], x[8];
        unpack8(*(const uint4*)(tile + row * TP + ch * 16), xp); unpack8(*(const uint4*)(tile + (row + 1) * TP + ch * 16), x);
#pragma unroll
        for (int i = 0; i < 8; ++i) { const float v = x[i] + m[i] * (xp[i] - x[i]); x[i] = TANH ? tanhf(v) : v; }
        res[k] = pack8(x); asm volatile("" ::: "memory"); }
    WSYNC();
#pragma unroll
    for (int k = 0; k < 8; ++k) *(bf16x8*)(tile + ((lane >> 3) + 8 * k) * TP + ch * 16) = res[k];
    WSYNC();
}
DI void w_bprep(CtxP c, int l, int slab, int u_, unsigned char* wl, int lane) {
    const int bh = u_ / NCS, cl = u_ % NCS, b = bh >> 3, h = bh & 7, tl0 = cl * 64, hs = lane >> 5, li = lane & 31;
    unsigned char* T0 = wl; unsigned char* T1 = wl + 10096;
    const float* mu = c->rmu + l * 1664;
    bf16x8 wlf[2][4], alf[2][4];
    stage_tile(c, l, slab, b, tl0 - 1, 65, B_WLO, T0, lane); proc_shift_tile<true>(T0, mu + 1536, lane);
#pragma unroll
    for (int tb = 0; tb < 2; ++tb)
#pragma unroll
        for (int ks = 0; ks < 4; ++ks) wlf[tb][ks] = frag_nat(T0, 32 * tb + li, 2 * ks + hs);
    WSYNC();
    stage_tile(c, l, slab, b, tl0 - 1, 65, B_ALO, T0, lane); proc_shift_tile<false>(T0, mu + 1600, lane);
#pragma unroll
    for (int tb = 0; tb < 2; ++tb)
#pragma unroll
        for (int ks = 0; ks < 4; ++ks) alf[tb][ks] = frag_nat(T0, 32 * tb + li, 2 * ks + hs);
    WSYNC();
    stage_tile(c, l, slab, b, tl0 - 1, 65, B_R + h * 64, T0, lane); stage_tile(c, l, slab, b, tl0 - 1, 65, B_K + h * 64, T1, lane);
    __builtin_amdgcn_sched_barrier(0);
#pragma unroll
    for (int tb = 0; tb < 2; ++tb) {
        float rs[16], bonp[16];
        { float kk[2], mk[2];
#pragma unroll
          for (int jb = 0; jb < 2; ++jb) { kk[jb] = c->rk_k[l * G + h * 64 + 32 * jb + li]; mk[jb] = mu[512 + h * 64 + 32 * jb + li]; }
#pragma unroll
          for (int r = 0; r < 16; ++r) { const int t = 32 * tb + (r & 3) + 8 * (r >> 2) + 4 * hs; float ss = 0.f;
#pragma unroll
              for (int jb = 0; jb < 2; ++jb) { const float x = tile_at(T1, t + 1, 32 * jb + li), xp = tile_at(T1, t, 32 * jb + li); const float kap = (x + mk[jb] * (xp - x)) * kk[jb]; ss += kap * kap; }
              rs[r] = rsqrtf(allred32(ss) + 1e-12f); bonp[r] = 0.f; } }
        __builtin_amdgcn_sched_barrier(0);
#pragma unroll
        for (int jb = 0; jb < 2; ++jb) {
            const int j = 32 * jb + li, ch = h * 64 + j;
            const bf16_t* wu = (const bf16_t*)(c->ws + OFF_WUT) + ((size_t)l * G + ch) * 64; const bf16_t* au = (const bf16_t*)(c->ws + OFF_AUT) + ((size_t)l * G + ch) * 64;
            bf16x8 wuf[4], auf[4];
#pragma unroll
            for (int ks = 0; ks < 4; ++ks) { wuf[ks] = *(const bf16x8*)(wu + 16 * ks + 8 * hs); auf[ks] = *(const bf16x8*)(au + 16 * ks + 8 * hs); }
            const float w0 = c->rw0[l * G + ch], a0 = c->ra0[l * G + ch], kkj = c->rk_k[l * G + ch], kaj = c->rk_a[l * G + ch], rkj = c->rr_k[l * G + ch], mr = mu[ch], mk = mu[512 + ch];
            f32x16 dl, da;
#pragma unroll
            for (int r = 0; r < 16; ++r) { dl[r] = 0.f; da[r] = 0.f; }
#pragma unroll
            for (int ks = 0; ks < 4; ++ks) { dl = MFMA32(wlf[tb][ks], wuf[ks], dl); da = MFMA32(alf[tb][ks], auf[ks], da); }
            __builtin_amdgcn_sched_barrier(0);
            unsigned char* ckb = c->ws + OFF_CK + (size_t)(bh * TS + tl0) * 768;
#pragma unroll
            for (int r = 0; r < 16; ++r) { const int t = 32 * tb + (r & 3) + 8 * (r >> 2) + 4 * hs;
                const float w = __expf(-0.606531f * sigm(w0 + dl[r])); const float a = sigm(a0 + da[r]);
                float x = tile_at(T0, t + 1, j), xp = tile_at(T0, t, j); const float rm = x + mr * (xp - x);
                x = tile_at(T1, t + 1, j); xp = tile_at(T1, t, j); const float km = x + mk * (xp - x);
                const float kh = km * kkj * rs[r], kt = km * (1.f + (a - 1.f) * kaj);
                bonp[r] += rm * rkj * kt;
                const unsigned o4 = (unsigned)t * 768u + (unsigned)j * 4u, o2 = (unsigned)t * 768u + 256u + (unsigned)j * 2u;
                *(float*)(ckb + o4) = w; *(bf16_t*)(ckb + o2) = f2bf(kh); *(bf16_t*)(ckb + o2 + 128u) = f2bf(a * kh); *(bf16_t*)(ckb + o2 + 256u) = f2bf(kt); *(bf16_t*)(ckb + o2 + 384u) = f2bf(rm);
                if ((r & 3) == 3) { asm volatile("" ::: "memory"); __builtin_amdgcn_sched_barrier(0); } }
        }
#pragma unroll
        for (int r = 0; r < 16; ++r) { const float bsum = allred32(bonp[r]); const int t = 32 * tb + (r & 3) + 8 * (r >> 2) + 4 * hs;
            if (li == 0) ((float*)(c->ws + OFF_BON))[(size_t)(b * TS + tl0 + t) * NH + h] = bsum; }
        asm volatile("" ::: "memory"); __builtin_amdgcn_sched_barrier(0);
    }
    WSYNC();
}
DI void s_bprep2(CtxP c, int l, int slab, float* lds, int bid, int nblk) {
    const int tid = otid(), lane = tid & 63, wave = tid >> 6; unsigned char* wl = (unsigned char*)lds + wave * WLDS;
    for (int u = bid * 8 + wave; u < NB * NH * NCS; u += nblk * 8) { int ln = lane; asm volatile("" : "+v"(ln)); w_bprep(c, l, slab, u, wl, ln); }
    if (slab == 0) { bf16_t* halo = (bf16_t*)(c->ws + OFF_CARRY + l * CARRY_L + HALO_OFF);
        for (int i = bid * 512 + tid; i < NB * 3 * PP; i += nblk * 512) { const int b = i / (3 * PP), r = (i / PP) % 3, col = i % PP;
            halo[i] = ((const bf16_t*)(c->ws + OFF_P))[(size_t)(b * TS + TS - 3 + r) * PP + col]; } }
}
typedef float f2v __attribute__((ext_vector_type(2)));
constexpr int SC_CH = 32, SC_REC = 1280, SC_BUF = SC_CH * SC_REC, SC_VMF = SC_CH * 16;
DI void s_bscan(CtxP c, int l, int slab, float* lds, int bid) {
    const int tid = otid(), lane = tid & 63, wave = tid >> 6;
    const int bh = bid >> 2, rg16 = bid & 3, b = bh >> 3, h = bh & 7;
    unsigned char* ring = (unsigned char*)lds; float* vmr = (float*)(ring + 2 * SC_BUF);
    const unsigned char* ck = c->ws + OFF_CK + (size_t)bh * TS * 768;
    const int rr = lane >> 4, kg = lane & 15, row = rg16 * 16 + (wave & 3) * 4 + rr;
    float* CB = (float*)(c->ws + OFF_CARRY + l * CARRY_L + CB_OFF) + ((size_t)bh * 64 + row) * 64 + kg * 4;
    f2v S01 = {0.f, 0.f}, S23 = {0.f, 0.f};
    if (wave < 4 && slab != 0) { S01.x = CB[0]; S01.y = CB[1]; S23.x = CB[2]; S23.y = CB[3]; }
    const int p = tid - 256, pst = p >> 3, prq = p & 3; const int vcol = B_V + h * 64 + rg16 * 16 + prq * 4;
    float4 muv = make_float4(0.f, 0.f, 0.f, 0.f);
    if (wave >= 4) muv = *(const float4*)(c->rmu + l * 1664 + 1024 + h * 64 + rg16 * 16 + prq * 4);
    auto produce = [&](int ch) {
        unsigned char* dst = ring + (ch & 1) * SC_BUF; const uint4* src = (const uint4*)(ck + (size_t)ch * (SC_CH * 768));
        uint4 t[6];
#pragma unroll
        for (int k = 0; k < 6; ++k) t[k] = src[p + 256 * k];
        uint2 vc = make_uint2(0u, 0u), vp = make_uint2(0u, 0u); const int tl = ch * SC_CH + pst;
        if ((p & 4) == 0) { vc = *(const uint2*)(prow(c->ws, l, slab, b, tl) + vcol); vp = *(const uint2*)(prow(c->ws, l, slab, b, tl - 1) + vcol); }
#pragma unroll
        for (int k = 0; k < 6; ++k) { const int idx = p + 256 * k, st = idx / 48, w = idx % 48; unsigned char* r = dst + st * SC_REC;
            if (w < 16) *(uint4*)(r + w * 16) = t[k];
            else { float f[8]; unpack8(t[k], f); float* d = (float*)(r + 256) + (w - 16) * 8; *(float4*)d = make_float4(f[0], f[1], f[2], f[3]); *(float4*)(d + 4) = make_float4(f[4], f[5], f[6], f[7]); } }
        if ((p & 4) == 0) {
            const float v0 = __uint_as_float(vc.x << 16), v1 = __uint_as_float(vc.x & 0xffff0000u), v2 = __uint_as_float(vc.y << 16), v3 = __uint_as_float(vc.y & 0xffff0000u);
            const float q0 = __uint_as_float(vp.x << 16), q1 = __uint_as_float(vp.x & 0xffff0000u), q2 = __uint_as_float(vp.y << 16), q3 = __uint_as_float(vp.y & 0xffff0000u);
            *(float4*)(vmr + (ch & 1) * SC_VMF + pst * 16 + prq * 4) = make_float4(v0 + muv.x * (q0 - v0), v1 + muv.y * (q1 - v1), v2 + muv.z * (q2 - v2), v3 + muv.w * (q3 - v3)); }
    };
    if (wave >= 4) produce(0);
    __syncthreads();
    bf16_t* pbase = (bf16_t*)(c->ws + OFF_P) + (size_t)(b * TS) * PP;
    float ykeep = 0.f;
    for (int ch = 0; ch < TS / SC_CH; ++ch) {
        if (wave >= 4) { if (ch + 1 < TS / SC_CH) produce(ch + 1); }
        else {
            const unsigned char* rec = ring + (ch & 1) * SC_BUF + kg * 16; const float* vmp = vmr + (ch & 1) * SC_VMF + (wave & 3) * 4 + rr;
            float4 wv = *(const float4*)(rec), kh = *(const float4*)(rec + 256), ak = *(const float4*)(rec + 512), kt = *(const float4*)(rec + 768), rv = *(const float4*)(rec + 1024); float vm = vmp[0];
#pragma unroll 4
            for (int s = 0; s < SC_CH; ++s) {
                const int sn = s + 1 < SC_CH ? s + 1 : s; const unsigned char* rn = rec + sn * SC_REC;
                const float4 wv_n = *(const float4*)(rn), kh_n = *(const float4*)(rn + 256), ak_n = *(const float4*)(rn + 512), kt_n = *(const float4*)(rn + 768), rv_n = *(const float4*)(rn + 1024); const float vm_n = vmp[sn * 16];
                f2v pp = S01 * (f2v){kh.x, kh.y}; pp = S23 * (f2v){kh.z, kh.w} + pp;
                float sk = allred16(pp.x + pp.y);
                const f2v vm2 = {vm, vm}, nsk = {-sk, -sk};
                f2v t01 = S01 * (f2v){wv.x, wv.y} + vm2 * (f2v){kt.x, kt.y}, t23 = S23 * (f2v){wv.z, wv.w} + vm2 * (f2v){kt.z, kt.w};
                S01 = nsk * (f2v){ak.x, ak.y} + t01; S23 = nsk * (f2v){ak.z, ak.w} + t23;
                f2v qq = S01 * (f2v){rv.x, rv.y}; qq = S23 * (f2v){rv.z, rv.w} + qq;
                const float y = allred16(qq.x + qq.y);
                ykeep = ((s & 15) == kg) ? y : ykeep;
                if ((s & 15) == 15) ((float*)(pbase + (size_t)(ch * SC_CH + (s & 16) + kg) * PP + B_R))[h * 64 + row] = ykeep;
                wv = wv_n; kh = kh_n; ak = ak_n; kt = kt_n; rv = rv_n; vm = vm_n;
            }
        }
        __syncthreads();
    }
    if (wave < 4) { CB[0] = S01.x; CB[1] = S01.y; CB[2] = S23.x; CB[3] = S23.y; }
}
DI void s_bpost(CtxP c, int l, int slab, float* lds, int bid, int nblk) {
    const int lane = otid() & 63, gw = bid * 8 + (otid() >> 6), NGW = nblk * 8;
    for (int it = gw; it < MS * NH; it += NGW) { const int r = it >> 3, h = it & 7, b = r / TS, tl = r % TS, ch = h * 64 + lane;
        bf16_t* prw = (bf16_t*)(c->ws + OFF_P) + (size_t)r * PP;
        const float w = ((const float*)(prw + B_R))[ch];
        const float mean = wave_sum(w) * (1.f / 64.f); const float d = w - mean; const float var = wave_sum(d * d) * (1.f / 64.f);
        const float nrm = d * rsqrtf(var + 1e-5f);
        const float x = bf2f(prw[B_V + ch]), xp = bf2f(prow(c->ws, l, slab, b, tl - 1)[B_V + ch]); const float vm = x + c->rmu[l * 1664 + 1024 + ch] * (xp - x);
        const float bon = ((const float*)(c->ws + OFF_BON))[(size_t)r * NH + h];
        const float z = bf2f(prw[ZB + ch]);
        prw[ZB + ch] = f2bf((nrm * c->rgn_w[l * G + ch] + c->rgn_b[l * G + ch] + bon * vm) * siluf(z)); }
}
DI void s_post(CtxP c, int l, int slab, float* lds, int bid, int nblk) {
    const int lane = otid() & 63, gw = bid * 8 + (otid() >> 6), NGW = nblk * 8;
    for (int r = gw; r < MS; r += NGW) { const int b = r / TS, tl = r % TS; const size_t grow = (size_t)b * T + slab * TS + tl;
        const float* yrow = (const float*)(c->ws + OFF_Y) + (size_t)r * D; const float* xr = (l == 0 ? c->x : c->out) + grow * D; float* orow = c->out + grow * D;
        float4 v[4]; float ss = 0.f;
#pragma unroll
        for (int j = 0; j < 4; ++j) { v[j] = *(const float4*)(yrow + j * 256 + lane * 4); ss += v[j].x * v[j].x + v[j].y * v[j].y + v[j].z * v[j].z + v[j].w * v[j].w; }
        ss = wave_sum(ss); const float rs = rsqrtf(ss * (1.f / D) + 1e-6f); float s2 = 0.f;
#pragma unroll
        for (int j = 0; j < 4; ++j) { const float4 gg = *(const float4*)(c->norm_post + l * D + j * 256 + lane * 4); const float4 xx = *(const float4*)(xr + j * 256 + lane * 4);
            v[j].x = xx.x + v[j].x * rs * gg.x; v[j].y = xx.y + v[j].y * rs * gg.y; v[j].z = xx.z + v[j].z * rs * gg.z; v[j].w = xx.w + v[j].w * rs * gg.w;
            *(float4*)(orow + j * 256 + lane * 4) = v[j]; s2 += v[j].x * v[j].x + v[j].y * v[j].y + v[j].z * v[j].z + v[j].w * v[j].w; }
        if (l == 0) { s2 = wave_sum(s2); const float r2 = rsqrtf(s2 * (1.f / D) + 1e-6f); bf16_t* hrow = (bf16_t*)(c->ws + OFF_H) + (size_t)r * D;
#pragma unroll
            for (int j = 0; j < 4; ++j) { const float4 gg = *(const float4*)(c->norm_pre + D + j * 256 + lane * 4);
                uint2 o; o.x = f2bf(v[j].x * r2 * gg.x) | ((unsigned)f2bf(v[j].y * r2 * gg.y) << 16); o.y = f2bf(v[j].z * r2 * gg.z) | ((unsigned)f2bf(v[j].w * r2 * gg.w) << 16);
                *(uint2*)(hrow + j * 256 + lane * 4) = o; } }
    }
}

namespace pg8 {
#define PG8_LAS __attribute__((address_space(3)))
typedef unsigned short bf16_t;
typedef short bf16x8 __attribute__((ext_vector_type(8)));
typedef float f32x4 __attribute__((ext_vector_type(4)));
typedef unsigned u32x4 __attribute__((ext_vector_type(4)));
constexpr int BM = 256, BK = 64, HALF = 128, HTB = HALF * BK * 2  , STAGE_BYTES = 8 * HTB, NXCD = 8, WGM = 8;

__host__ __device__ __forceinline__ int lds_byte(int r, int c) { const int st = (r >> 4) * 2 + (c >> 5), rr = r & 15, cc = c & 31, ob = rr * 64 + cc * 2; return st * 1024 + (ob ^ (((ob >> 9) & 1) << 5)); }
__host__ __device__ __forceinline__ void stage_rc(int b, int& R, int& C) { const int st = b / 1024, sb = b % 1024, swz = sb ^ (((sb >> 9) & 1) << 5); R = (st >> 1) * 16 + swz / 64; C = (st & 1) * 32 + (swz % 64) / 2; }
__host__ __device__ __forceinline__ int perm32(int rho) { const int n = rho >> 4, i = rho & 15; return 8 * (i >> 2) + 4 * n + (i & 3); }

struct Unit { int pm, pn; };
struct Gemm { const bf16_t* A; const bf16_t* Bt; int M, N, K, lda; };

struct StaticOrder {
    int nM, nN, nwg, G, c;
    __host__ __device__ void init(int M, int N, int G_, int c_) { nM = M / BM; nN = N / BM; nwg = nM * nN; G = G_; c = c_; }
    __host__ __device__ bool next(int i, Unit& u) const {
        const long L = (long)i * G + c; if (L >= nwg) return false;
        int wgid = (int)L; { const int q = nwg / NXCD, r = nwg % NXCD, xcd = wgid % NXCD, off = wgid / NXCD; wgid = (xcd < r ? xcd * (q + 1) : r * (q + 1) + (xcd - r) * q) + off; }
        const int nig = WGM * nN, gid = wgid / nig, fm = gid * WGM, gsz = (nM - fm) < WGM ? (nM - fm) : WGM;
        u.pm = fm + ((wgid % nig) % gsz); u.pn = (wgid % nig) / gsz; return true;
    }
    __device__ __forceinline__ void a_ready(const Unit&) const {}
    __device__ __forceinline__ void done(const Unit&) const {}
};

__device__ __forceinline__ unsigned cvt_pk_bf16(float lo, float hi) { unsigned r; asm volatile("v_cvt_pk_bf16_f32 %0, %1, %2" : "=v"(r) : "v"(lo), "v"(hi)); return r; }
typedef float f32x2 __attribute__((ext_vector_type(2)));
__device__ __forceinline__ f32x2 gelu_pk(f32x2 v) {
    const f32x2 av = __builtin_elementwise_abs(v), d = av * 0.2316418882f + 1.0f;
    f32x2 t; t.x = __builtin_amdgcn_rcpf(d.x); t.y = __builtin_amdgcn_rcpf(d.y);
    f32x2 q = t * 0.5307027145f + (-0.7265760135f); q = q * t + 0.7107068705f; q = q * t + (-0.142248368f); q = q * t + 0.127414796f; q = q * t;
    const f32x2 s = (v * v) * (-0.72134752044f);
    f32x2 e; e.x = __builtin_amdgcn_exp2f(s.x); e.y = __builtin_amdgcn_exp2f(s.y);
    const f32x2 m = v * (q * e), r = v - m;
    f32x2 o; o.x = v.x < 0.f ? m.x : r.x; o.y = v.y < 0.f ? m.y : r.y; return o;
}

template <int ACT  > struct EpiBf16 {
    static constexpr bool PERM = true, AFTER_DRAIN = false; static_assert(ACT == 0 || ACT == 1, "EpiBf16: ACT is 0 (none) or 1 (gelu_pk)");
    bf16_t* O; int ldc; const float* bias; int split_cols; size_t split_stride; float scale0;
    __device__ __forceinline__ void operator()(const f32x4 (&acc)[2][2][4][2], const Unit& u, int wr, int wc, int fr, int fq) const {
        const int row0 = u.pm * BM + wr * 64 + fr; int colt = u.pn * BM; bf16_t* base = O;
        float sc = 1.f; if (split_cols) { const int t = colt / split_cols; base += (size_t)t * split_stride; colt -= t * split_cols; if (t == 0) sc = scale0; }
        const int col0 = colt + wc * 32 + 8 * fq, bcol0 = u.pn * BM + wc * 32 + 8 * fq;
        f32x4 bv[2][2];
#pragma unroll
        for (int bj = 0; bj < 2; ++bj)
#pragma unroll
            for (int n = 0; n < 2; ++n) bv[bj][n] = bias ? *(const f32x4*)(bias + bcol0 + bj * HALF + 4 * n) : (f32x4){0.f, 0.f, 0.f, 0.f};
#pragma unroll
        for (int ai = 0; ai < 2; ++ai)
#pragma unroll
            for (int m = 0; m < 4; ++m) { bf16_t* rowp = base + (size_t)(row0 + ai * HALF + m * 16) * ldc + col0;
#pragma unroll
                for (int bj = 0; bj < 2; ++bj) { f32x4 v0 = acc[ai][bj][m][0] + bv[bj][0], v1 = acc[ai][bj][m][1] + bv[bj][1];
                    if (ACT == 1) { f32x2 a = gelu_pk((f32x2){v0[0], v0[1]}), b = gelu_pk((f32x2){v0[2], v0[3]}), c = gelu_pk((f32x2){v1[0], v1[1]}), d = gelu_pk((f32x2){v1[2], v1[3]});
                        v0 = (f32x4){a.x, a.y, b.x, b.y}; v1 = (f32x4){c.x, c.y, d.x, d.y}; }
                    v0 = v0 * sc; v1 = v1 * sc; u32x4 w; w.x = cvt_pk_bf16(v0[0], v0[1]); w.y = cvt_pk_bf16(v0[2], v0[3]); w.z = cvt_pk_bf16(v1[0], v1[1]); w.w = cvt_pk_bf16(v1[2], v1[3]);
                    *(u32x4*)(rowp + bj * HALF) = w; } }
    }
};


struct EpiF32 {
    static constexpr bool PERM = false, AFTER_DRAIN = false;
    float* O; int ldc;
    __device__ __forceinline__ void operator()(const f32x4 (&acc)[2][2][4][2], const Unit& u, int wr, int wc, int fr, int fq) const {
        const int row0 = u.pm * BM + wr * 64 + fr, col0 = u.pn * BM + wc * 32 + 4 * fq;
#pragma unroll
        for (int ai = 0; ai < 2; ++ai)
#pragma unroll
            for (int m = 0; m < 4; ++m) { float* rowp = O + (size_t)(row0 + ai * HALF + m * 16) * ldc + col0;
#pragma unroll
                for (int bj = 0; bj < 2; ++bj)
#pragma unroll
                    for (int n = 0; n < 2; ++n) *(f32x4*)(rowp + bj * HALF + n * 16) = acc[ai][bj][m][n]; }
    }
};
template <class Epi, class Sched, bool ALIGN_EPI, bool SP2, int KK, int LDA>
__device__ __forceinline__ void gemm_phase(PG8_LAS unsigned char* lds, const Gemm g, const Sched& S, const Epi& E) {
    const int tid = otid(), wid = __builtin_amdgcn_readfirstlane(tid >> 6), lane = tid & 63, wr = wid >> 2, wc = wid & 3, fr = lane & 15, fq = lane >> 4;
    constexpr int K = KK, nt = K / BK;
    unsigned voffA[2], voffB[2];
#pragma unroll
    for (int i = 0; i < 2; ++i) { int R, C; stage_rc(tid * 16 + i * 8192, R, C); const int Rb = Epi::PERM ? ((R & ~31) + perm32(R & 31)) : R;
        voffA[i] = (unsigned)(R * LDA + C) * 2u; voffB[i] = (unsigned)(Rb * K + C) * 2u; }
    constexpr size_t kstep = (size_t)(BK * 2);
    constexpr size_t hstepA = (size_t)HALF * LDA * 2, hstepB = (size_t)HALF * K * 2;
    constexpr size_t tstepA = 2 * hstepA, tstepB = 2 * hstepB;
    const unsigned ldsw = (unsigned)wid * 1024u;
    const int aoff = lds_byte(wr * 64 + fr, fq * 8), boff = lds_byte(wc * 32 + fr, fq * 8);
#define PG8_SA(b, h) (((b) * 2 + (h)) * HTB)
#define PG8_SB(b, h) ((4 + (b) * 2 + (h)) * HTB)
#define PG8_STAGE(bufoff, gbase, voff) do { _Pragma("unroll") for (int _i = 0; _i < 2; ++_i) \
        __builtin_amdgcn_global_load_lds((const unsigned*)((const char*)(gbase) + (voff)[_i]), (PG8_LAS unsigned*)(lds + (bufoff) + ldsw + _i * 8192), 16, 0, 0); } while (0)
#define PG8_LDA(dst, b, h) do { _Pragma("unroll") for (int m = 0; m < 4; ++m) _Pragma("unroll") for (int k = 0; k < 2; ++k) dst[m][k] = *(const PG8_LAS bf16x8*)(lds + PG8_SA(b, h) + aoff + m * 2048 + k * 1024); } while (0)
#define PG8_LDB(dst, b, h) do { _Pragma("unroll") for (int n = 0; n < 2; ++n) _Pragma("unroll") for (int k = 0; k < 2; ++k) dst[n][k] = *(const PG8_LAS bf16x8*)(lds + PG8_SB(b, h) + boff + n * 2048 + k * 1024); } while (0)
#define PG8_MMA(ai, bj, At, Bt) do { __builtin_amdgcn_s_setprio(1); _Pragma("unroll") for (int m = 0; m < 4; ++m) _Pragma("unroll") for (int n = 0; n < 2; ++n) _Pragma("unroll") for (int k = 0; k < 2; ++k) \
        acc[ai][bj][m][n] = __builtin_amdgcn_mfma_f32_16x16x32_bf16(Bt[n][k], At[m][k], acc[ai][bj][m][n], 0, 0, 0); __builtin_amdgcn_s_setprio(0); } while (0)
#define PG8_WAIT_V(n) asm volatile("s_waitcnt vmcnt(" #n ")" ::: "memory")
#define PG8_WAIT_L(n) asm volatile("s_waitcnt lgkmcnt(" #n ")" ::: "memory")
#define PG8_BAR __builtin_amdgcn_s_barrier()
#define PG8_SCHED __builtin_amdgcn_sched_barrier(0)
    Unit cur, nxt; int ui = 0;
    if (!S.next(0, cur)) return;
    f32x4 acc[2][2][4][2];
#pragma unroll
    for (int a = 0; a < 2; ++a)
#pragma unroll
        for (int b = 0; b < 2; ++b)
#pragma unroll
            for (int m = 0; m < 4; ++m)
#pragma unroll
                for (int n = 0; n < 2; ++n) acc[a][b][m][n] = (f32x4){0.f, 0.f, 0.f, 0.f};
    bf16x8 At[4][2], B0[2][2], B1[2][2];
    const char* cA = (const char*)g.A + (size_t)cur.pm * tstepA; const char* cB = (const char*)g.Bt + (size_t)cur.pn * tstepB;
    S.a_ready(cur);
    if constexpr (SP2) {
        PG8_STAGE(PG8_SB(0, 0), cB, voffB); PG8_STAGE(PG8_SB(0, 1), cB + hstepB, voffB); PG8_STAGE(PG8_SA(0, 0), cA, voffA); PG8_STAGE(PG8_SA(0, 1), cA + hstepA, voffA);
        if (wr == 1) PG8_BAR;
        PG8_WAIT_V(2); PG8_BAR;
        PG8_STAGE(PG8_SB(1, 0), cB + kstep, voffB); PG8_STAGE(PG8_SA(1, 0), cA + kstep, voffA); PG8_STAGE(PG8_SB(1, 1), cB + hstepB + kstep, voffB);
        PG8_WAIT_V(6); PG8_BAR;
    } else {
        PG8_STAGE(PG8_SB(0, 0), cB, voffB); PG8_STAGE(PG8_SA(0, 0), cA, voffA); PG8_STAGE(PG8_SB(0, 1), cB + hstepB, voffB); PG8_STAGE(PG8_SA(0, 1), cA + hstepA, voffA);
        if (wr == 1) PG8_BAR;
        PG8_WAIT_V(4); PG8_BAR;
        PG8_STAGE(PG8_SB(1, 0), cB + kstep, voffB); PG8_STAGE(PG8_SA(1, 0), cA + kstep, voffA); PG8_STAGE(PG8_SB(1, 1), cB + hstepB + kstep, voffB);
        PG8_WAIT_V(6); PG8_BAR;
    }
    for (;;) {
        const bool has_next = S.next(ui + 1, nxt);
        const char* nA = has_next ? (const char*)g.A + (size_t)nxt.pm * tstepA : cA; const char* nB = has_next ? (const char*)g.Bt + (size_t)nxt.pn * tstepB : cB;
        for (int t = 0; t < nt; t += 2) {
            const bool last = (t == nt - 2);
            const char* a1 = cA + (size_t)(t + 1) * kstep;
            const char* a2 = last ? nA : cA + (size_t)(t + 2) * kstep; const char* b2 = last ? nB : cB + (size_t)(t + 2) * kstep;
            const char* a3 = a2 + kstep; const char* b3 = b2 + kstep;
            if (last && has_next) S.a_ready(nxt);
            if constexpr (SP2) {
            PG8_LDB(B0, 0, 0); PG8_LDB(B1, 0, 1); PG8_SCHED; PG8_LDA(At, 0, 0); PG8_STAGE(PG8_SA(1, 1), a1 + hstepA, voffA);
            PG8_WAIT_V(8); PG8_WAIT_L(0); PG8_BAR; PG8_MMA(0, 0, At, B0); PG8_MMA(0, 1, At, B1); PG8_BAR; PG8_SCHED;
            PG8_LDA(At, 0, 1); PG8_STAGE(PG8_SB(0, 0), b2, voffB); PG8_STAGE(PG8_SB(0, 1), b2 + hstepB, voffB); PG8_STAGE(PG8_SA(0, 0), a2, voffA);
            PG8_WAIT_V(8); PG8_WAIT_L(0); PG8_BAR; PG8_MMA(1, 0, At, B0); PG8_MMA(1, 1, At, B1); PG8_BAR; PG8_SCHED;
            PG8_LDB(B0, 1, 0); PG8_LDB(B1, 1, 1); PG8_SCHED; PG8_LDA(At, 1, 0); PG8_STAGE(PG8_SA(0, 1), a2 + hstepA, voffA);
            PG8_WAIT_V(8); PG8_WAIT_L(0); PG8_BAR; PG8_MMA(0, 0, At, B0); PG8_MMA(0, 1, At, B1); PG8_BAR; PG8_SCHED;
            PG8_LDA(At, 1, 1); PG8_STAGE(PG8_SB(1, 0), b3, voffB); PG8_STAGE(PG8_SB(1, 1), b3 + hstepB, voffB); PG8_STAGE(PG8_SA(1, 0), a3, voffA);
            PG8_WAIT_V(8); PG8_WAIT_L(0); PG8_BAR; PG8_MMA(1, 0, At, B0); PG8_MMA(1, 1, At, B1); PG8_BAR; PG8_SCHED;
            } else {
            PG8_LDB(B0, 0, 0); PG8_SCHED; PG8_LDA(At, 0, 0); PG8_STAGE(PG8_SA(1, 1), a1 + hstepA, voffA);
            PG8_WAIT_L(8); PG8_BAR; PG8_WAIT_L(0); PG8_MMA(0, 0, At, B0); PG8_BAR; PG8_SCHED;
            PG8_LDB(B1, 0, 1); PG8_STAGE(PG8_SB(0, 0), b2, voffB);
            PG8_BAR; PG8_WAIT_L(0); PG8_MMA(0, 1, At, B1); PG8_BAR;
            PG8_LDA(At, 0, 1); PG8_STAGE(PG8_SA(0, 0), a2, voffA);
            PG8_BAR; PG8_WAIT_L(0); PG8_MMA(1, 0, At, B0); PG8_BAR; PG8_SCHED;
            PG8_STAGE(PG8_SB(0, 1), b2 + hstepB, voffB);
            PG8_WAIT_V(6); PG8_BAR; PG8_MMA(1, 1, At, B1); PG8_BAR;
            PG8_LDB(B0, 1, 0); PG8_SCHED; PG8_LDA(At, 1, 0); PG8_STAGE(PG8_SA(0, 1), a2 + hstepA, voffA);
            PG8_WAIT_L(8); PG8_BAR; PG8_WAIT_L(0); PG8_MMA(0, 0, At, B0); PG8_BAR; PG8_SCHED;
            PG8_LDB(B1, 1, 1); PG8_STAGE(PG8_SB(1, 0), b3, voffB);
            PG8_BAR; PG8_WAIT_L(0); PG8_MMA(0, 1, At, B1); PG8_BAR;
            PG8_LDA(At, 1, 1); PG8_STAGE(PG8_SA(1, 0), a3, voffA);
            PG8_BAR; PG8_WAIT_L(0); PG8_MMA(1, 0, At, B0); PG8_BAR; PG8_SCHED;
            PG8_STAGE(PG8_SB(1, 1), b3 + hstepB, voffB);
            PG8_WAIT_V(6); PG8_BAR; PG8_MMA(1, 1, At, B1); PG8_BAR;
            }
        }
        if constexpr (ALIGN_EPI) { if (wr == 0) PG8_BAR; }
        if constexpr (!Epi::AFTER_DRAIN) { E(acc, cur, wr, wc, fr, fq); S.done(cur); }
        if (!has_next) break;
#pragma unroll
        for (int a = 0; a < 2; ++a)
#pragma unroll
            for (int b = 0; b < 2; ++b)
#pragma unroll
                for (int m = 0; m < 4; ++m)
#pragma unroll
                    for (int n = 0; n < 2; ++n) acc[a][b][m][n] = (f32x4){0.f, 0.f, 0.f, 0.f};
        cur = nxt; cA = nA; cB = nB; ++ui;
        if constexpr (ALIGN_EPI) { if (wr == 1) PG8_BAR; }
    }
    PG8_WAIT_V(0);
    if constexpr (!ALIGN_EPI) { if (wr == 0) PG8_BAR; }
    PG8_BAR;
    if constexpr (Epi::AFTER_DRAIN) { E.fused(acc, cur, wr, wc, fr, fq, lds, wid, lane); S.done(cur); }
#undef PG8_SA
#undef PG8_SB
#undef PG8_STAGE
#undef PG8_LDA
#undef PG8_LDB
#undef PG8_MMA
#undef PG8_WAIT_V
#undef PG8_WAIT_L
#undef PG8_BAR
#undef PG8_SCHED
}
}

#define XB_TMO      128
#define XB_XCNT(j)  (256  + 64 * (j))
#define XB_XSUB(j)  (1280 + 64 * (j))
#define XB_XGEN(j)  (2304 + 64 * (j))
#define XB_TOP      3328
#define XB_TOPGEN   3392
#define XCD_BAR_WORDS 3456
#define XB_SPIN_CAP (1u << 18)
DI unsigned xb_ld(unsigned* p)              { return __hip_atomic_load(p, __ATOMIC_RELAXED, __HIP_MEMORY_SCOPE_AGENT); }
DI unsigned xb_add(unsigned* p, unsigned v) { return __hip_atomic_fetch_add(p, v, __ATOMIC_RELAXED, __HIP_MEMORY_SCOPE_AGENT); }
DI unsigned xb_xcc_id() { return (unsigned)__builtin_amdgcn_s_getreg((3 << 11) | 20) & 0xFu; }
#define XB_SPIN(cond, bar) do { unsigned _sp = 0; while (cond) { __builtin_amdgcn_s_sleep(1); \
    if ((++_sp & 255u) == 0u) { if (xb_ld(&(bar)[XB_TMO])) break; if (_sp > XB_SPIN_CAP) { atomicAdd(&(bar)[XB_TMO], 1u); break; } } } } while (0)
struct XcdBarrier { unsigned* bar; unsigned x; volatile LAS unsigned* st; };
DI XcdBarrier xcd_barrier_post(unsigned* bar, volatile LAS unsigned* st) {
    XcdBarrier b; b.bar = bar; b.x = (unsigned)__builtin_amdgcn_readfirstlane((int)xb_xcc_id()); b.st = st;
    if (threadIdx.x == 0) (void)xb_add(&bar[XB_XCNT(b.x)], 1u);
    return b;
}
DI void xcd_barrier_complete(unsigned* bar, unsigned x, unsigned& nloc, unsigned& nx) {
    const unsigned Gd = gridDim.x * gridDim.y * gridDim.z;
    unsigned sum, cnt, mine, sp = 0u;
    for (;;) {
        sum = 0u; cnt = 0u; mine = 0u;
#pragma unroll
        for (unsigned j = 0; j < 16; ++j) { const unsigned cc = xb_ld(&bar[XB_XCNT(j)]); sum += cc; cnt += (cc > 0u) ? 1u : 0u; mine = (j == x) ? cc : mine; }
        if (sum == Gd) break;
        __builtin_amdgcn_s_sleep(1);
        if ((++sp & 255u) == 0u) { if (xb_ld(&bar[XB_TMO])) break; if (sp > XB_SPIN_CAP) { atomicAdd(&bar[XB_TMO], 1u); break; } }
    }
    nloc = mine > 0u ? mine : 1u; nx = cnt > 0u ? cnt : 1u;
}
DI void xcd_barrier(const XcdBarrier& b) {
    asm volatile("s_waitcnt vmcnt(0)" ::: "memory");
    __syncthreads();
    if (threadIdx.x == 0) {
        unsigned* bar = b.bar; unsigned bx = b.x; asm volatile("" : "+s"(bar), "+s"(bx));
        __builtin_amdgcn_s_waitcnt(0);
        unsigned nloc = b.st[0], nx = b.st[1];
        if (nloc == 0u) { xcd_barrier_complete(bar, bx, nloc, nx); b.st[0] = nloc; b.st[1] = nx; }
        const unsigned old = xb_add(&bar[XB_XSUB(bx)], 1u);
        const unsigned gen = old / nloc;
        if (old + 1u == (gen + 1u) * nloc) {
            __builtin_amdgcn_fence(__ATOMIC_RELEASE, "agent");
            asm volatile("s_waitcnt vmcnt(0)" ::: "memory");
            const unsigned og = xb_add(&bar[XB_TOP], 1u);
            const unsigned tg = og / nx;
            if (og + 1u == (tg + 1u) * nx) xb_add(&bar[XB_TOPGEN], 1u);
            else XB_SPIN(xb_ld(&bar[XB_TOPGEN]) == tg, bar);
            __builtin_amdgcn_fence(__ATOMIC_ACQUIRE, "agent");
            xb_add(&bar[XB_XGEN(bx)], 1u);
            asm volatile("s_waitcnt vmcnt(0)" ::: "memory");
        } else {
            XB_SPIN(xb_ld(&bar[XB_XGEN(bx)]) == gen, bar);
            __builtin_amdgcn_fence(__ATOMIC_ACQUIRE, "agent");
            asm volatile("s_waitcnt vmcnt(0)" ::: "memory");
        }
    }
    __syncthreads();
}
constexpr int LDS_BYTES = 163840, MISC_OFF = 155648 + 320, CW_BAR = 4096;
__global__ void __launch_bounds__(512) mk_fwd(Ctx c_byval) {
    CtxP c = (CtxP)__builtin_amdgcn_kernarg_segment_ptr();
    extern __shared__ __attribute__((aligned(16))) unsigned char ldsraw[];
    float* lds = (float*)ldsraw;
    const int tid = threadIdx.x, bid = blockIdx.x, nblk = gridDim.x;
    volatile LAS unsigned* MISC = (volatile LAS unsigned*)((LAS unsigned char*)ldsraw + MISC_OFF);
    if (tid < 32) MISC[tid] = 0u;
    if ((tid & 63) == 0) ((volatile LAS int*)(unsigned long)WVTAB_OFF)[hw_slot()] = tid >> 6;
    __syncthreads();
    XcdBarrier bar = xcd_barrier_post((unsigned*)(c->ws + OFF_CTL) + CW_BAR, MISC + 8);
    s_p0(c, 0, 0, lds, bid, nblk);
    s_prenorm(c, 0, 0, lds, bid, nblk);
    xcd_barrier(bar);
    for (int slab_ = 0; slab_ < 2; ++slab_)
        for (int l_ = 0; l_ < NL; ++l_) {
            int l = l_, slab = slab_; asm volatile("" : "+s"(l), "+s"(slab));
            { pg8::Gemm g{(const bf16_t*)(c->ws + OFF_H), (const bf16_t*)(c->ws + OFF_WIN + l * WIN_L), MS, PP, D, D}; pg8::StaticOrder S; S.init(MS, PP, nblk, bid);
              pg8::EpiBf16<0> E{(bf16_t*)(c->ws + OFF_P), PP, nullptr, 0, 0, 1.f};
              pg8::gemm_phase<pg8::EpiBf16<0>, pg8::StaticOrder, true, true, D, D>((LAS unsigned char*)ldsraw, g, S, E); }
            xcd_barrier(bar);
            s_chunkA<false>(c, l, slab, lds, bid, nblk); s_chunkA<true>(c, l, slab, lds, bid, nblk); __syncthreads(); s_lru<false>(c, l, slab, lds, bid, nblk); __syncthreads(); s_bprep2(c, l, slab, lds, bid, nblk);
            xcd_barrier(bar);
            s_mB(c, l, slab, lds, bid, nblk); s_dB(c, l, slab, lds, bid, nblk); s_cB(c, l, slab, lds, bid, nblk);
            xcd_barrier(bar);
            if (nblk >= 256) {
                if (bid < 128) s_bscan(c, l, slab, lds, bid);
                else { s_chunkC<false>(c, l, slab, lds, bid - 128, nblk - 128); s_chunkC<true>(c, l, slab, lds, bid - 128, nblk - 128); __syncthreads(); s_lru<true>(c, l, slab, lds, bid - 128, nblk - 128); }
            }
            xcd_barrier(bar);
            s_bpost(c, l, slab, lds, bid, nblk);
            xcd_barrier(bar);
            { pg8::Gemm g{(const bf16_t*)(c->ws + OFF_P) + ZA, (const bf16_t*)(c->ws + OFF_WOUT + l * WOUT_L), MS, D, DMIX, PP}; pg8::StaticOrder S; S.init(MS, D, nblk, bid);
              pg8::EpiF32 E{(float*)(c->ws + OFF_Y), D};
              pg8::gemm_phase<pg8::EpiF32, pg8::StaticOrder, true, true, DMIX, PP>((LAS unsigned char*)ldsraw, g, S, E); }
            xcd_barrier(bar);
            s_post(c, l, slab, lds, bid, nblk);
            if (l == 1 && slab == 0) s_prenorm(c, 0, 1, lds, bid, nblk);
            xcd_barrier(bar);
        }
}

extern "C" void kernel_launch(void* const* d_in, const int* in_sizes, int n_in, void* d_out, int out_size, void* d_ws, size_t ws_size, hipStream_t stream) {
    static int grid = 0;
    if (grid == 0) {
        int dev = 0, cus = 0, per_cu = 0;
        (void)hipGetDevice(&dev);
        (void)hipDeviceGetAttribute(&cus, hipDeviceAttributeMultiprocessorCount, dev);
        (void)hipFuncSetAttribute((const void*)mk_fwd, hipFuncAttributeMaxDynamicSharedMemorySize, LDS_BYTES);
        (void)hipOccupancyMaxActiveBlocksPerMultiprocessor(&per_cu, (const void*)mk_fwd, 512, LDS_BYTES);
        if (per_cu < 1) { fprintf(stderr, "kernel_launch: occupancy query says %d blocks/CU\n", per_cu); per_cu = 1; }
        grid = cus;
        if (grid != 256) fprintf(stderr, "kernel_launch: %d CUs (built for 256)\n", grid);
    }
    Ctx c{};
    const float** f = (const float**)&c;
    for (int i = 0; i < 28; ++i) f[i] = (const float*)d_in[i];
    c.out = (float*)d_out; c.ws = (unsigned char*)d_ws;
    (void)hipMemsetAsync(d_ws, 0, 1 * MiB, stream);
    void* args[] = {&c};
    hipError_t e = hipLaunchCooperativeKernel((const void*)mk_fwd, dim3(grid), dim3(512), args, LDS_BYTES, stream);
    if (e != hipSuccess) fprintf(stderr, "cooperative launch failed: %s (grid %d)\n", hipGetErrorString(e), grid);
}
```

```cpp
#include <hip/hip_runtime.h>
#include <cstdint>
#include <cstdio>

typedef unsigned short bf16_t;
#define DI __device__ __forceinline__
#define LAS __attribute__((address_space(3)))

constexpr int NB = 4, T = 4096, D = 1024, NL = 2, G = 512, NH = 8;
constexpr int TS = 2048, MS = NB * TS, NCS = TS / 64, TSP = TS + 3;
constexpr int DIN = 7824, PP = 7936, DMIX = 2048;
constexpr int A_Q = 0, A_K = 512, A_V = 1024, A_O = 1536, B_R = 2048, B_K = 2560, B_V = 3072, B_WLO = 3584, B_ALO = 3648, C_X = 3712,
              D_Q = 4224, D_K = 4736, D_V = 5248, ZA = 5760, ZB = 6272, ZC = 6784, ZD = 7296, A_I = 7808, A_F = 7816;
constexpr size_t MiB = 1u << 20;
constexpr size_t OFF_CTL = 0, OFF_ZROW = 512 * 1024, OFF_WIN = 1 * MiB, OFF_WOUT = 32 * MiB, OFF_ROPE = 40 * MiB, OFF_CARRY = 41 * MiB,
                 OFF_LS = 45 * MiB, OFF_BON = 45 * MiB + 512 * 1024, OFF_P = 45 * MiB + 768 * 1024, OFF_SA = 170 * MiB, OFF_H = 170 * MiB,
                 OFF_SD = 170 * MiB + 17301504, OFF_CK = 203 * MiB, OFF_Y = 203 * MiB,
                 OFF_WRT = 251 * MiB, OFF_WIT = OFF_WRT + 262144, OFF_WUT = OFF_WIT + 262144, OFF_AUT = OFF_WUT + 262144;
constexpr size_t WIN_L = (size_t)PP * D * 2, WOUT_L = (size_t)D * DMIX * 2;
constexpr size_t CARRY_L = 2 * MiB, CA_OFF = 0, CD_OFF = 540672, CB_OFF = CD_OFF + 524288, CC_OFF = CB_OFF + 524288, HALO_OFF = CC_OFF + 8192;
constexpr int SAU = 4224;

struct Ctx {
    const float *x, *norm_pre, *norm_post, *w_in, *w_out, *mconv_w, *mconv_b, *mi_bias, *mf_bias, *mnorm_w, *rmu, *rw_up, *rw0, *ra_up, *ra0,
        *rk_k, *rk_a, *rr_k, *rgn_w, *rgn_b, *lconv_w, *lconv_b, *lw_r, *lb_r, *lw_i, *lb_i, *llam, *retnorm_w;
    float* out; unsigned char* ws;
};
typedef const __attribute__((address_space(4))) Ctx* CtxP;


constexpr int WVTAB_OFF = 155648 + 512;
DI int hw_slot() { return __builtin_amdgcn_s_getreg((5 << 11) | 4) & 63; }
DI int otid() { int lane; asm volatile("v_mbcnt_lo_u32_b32 %0, -1, 0\n\tv_mbcnt_hi_u32_b32 %0, -1, %0" : "=v"(lane));
    const int wv = __builtin_amdgcn_readfirstlane(((volatile LAS int*)(unsigned long)WVTAB_OFF)[hw_slot()]);
    int t = (wv << 6) | lane; asm volatile("" : "+v"(t)); return t; }
DI size_t prow_off(int b, int tl) { return (size_t)(b * TSP + 3 + tl) * PP; }
DI float bf2f(bf16_t v) { return __uint_as_float(((unsigned)v) << 16); }
DI bf16_t f2bf(float f) { unsigned u = __float_as_uint(f); u += 0x7fffu + ((u >> 16) & 1u); return (bf16_t)(u >> 16); }
DI float sigm(float x) { return __builtin_amdgcn_rcpf(1.f + __expf(-x)); }
DI float siluf(float x) { return x * __builtin_amdgcn_rcpf(1.f + __expf(-x)); }
DI float softplusf(float x) { return fmaxf(x, 0.f) + log1pf(expf(-fabsf(x))); }
DI float wave_sum(float v) {
#pragma unroll
    for (int o = 1; o < 64; o <<= 1) v += __shfl_xor(v, o);
    return v;
}
DI int srccol(int n) {
    if (n < 2048) return n;
    if (n < 3712) return n + 528;
    if (n < 4224) return n + 1040;
    if (n < 5760) return n + 1552;
    if (n < 6272) return n - 3712;
    if (n < 6784) return n - 2032;
    if (n < 7296) return n - 1520;
    if (n < 7808) return n + 16;
    if (n < 7824) return n - 5248;
    return -1;
}
DI void wt_item(const float* W, int K, int N, bf16_t* WT, bool permute, float* scr, int item, int lane) {
    const int nblk = (permute ? PP : N) / 32, kb = item / nblk, nb = item % nblk, k0 = 64 * kb, n0 = 32 * nb;
    const int nn = n0 + (lane & 31); const int sc = permute ? srccol(nn) : nn;
    for (int i = 0; i < 32; ++i) { const int kk = 2 * i + (lane >> 5); scr[kk * 33 + (lane & 31)] = sc >= 0 ? W[(size_t)(k0 + kk) * N + sc] : 0.f; }
    __builtin_amdgcn_s_waitcnt(0); __builtin_amdgcn_wave_barrier();
    const int c = lane & 7;
    for (int j = 0; j < 4; ++j) { const int n = (lane >> 3) + 8 * j; const float* s = scr + (8 * c) * 33 + n;
        uint4 o; o.x = f2bf(s[0]) | ((unsigned)f2bf(s[33]) << 16); o.y = f2bf(s[66]) | ((unsigned)f2bf(s[99]) << 16);
        o.z = f2bf(s[132]) | ((unsigned)f2bf(s[165]) << 16); o.w = f2bf(s[198]) | ((unsigned)f2bf(s[231]) << 16);
        *(uint4*)(WT + (size_t)(n0 + n) * K + k0 + 8 * c) = o; }
    __builtin_amdgcn_s_waitcnt(0); __builtin_amdgcn_wave_barrier();
}
DI void s_p0(CtxP c, int l, int slab, float* lds, int bid, int nblk) {
    const int tid = otid(), lane = tid & 63, wave = tid >> 6;
    float* scr = lds + wave * (64 * 33);
    const int gw = bid * 8 + wave, NGW = nblk * 8;
    constexpr int I_IN = (D / 64) * (PP / 32), I_OUT = (DMIX / 64) * (D / 32);
    for (int it = gw; it < NL * (I_IN + I_OUT); it += NGW) {
        const int l = it / (I_IN + I_OUT); int r = it % (I_IN + I_OUT);
        if (r < I_IN) wt_item(c->w_in + (size_t)l * D * DIN, D, DIN, (bf16_t*)(c->ws + OFF_WIN + l * WIN_L), true, scr, r, lane);
        else wt_item(c->w_out + (size_t)l * DMIX * D, DMIX, D, (bf16_t*)(c->ws + OFF_WOUT + l * WOUT_L), false, scr, r - I_IN, lane);
    }
    { bf16_t* wrt = (bf16_t*)(c->ws + OFF_WRT); bf16_t* wit = (bf16_t*)(c->ws + OFF_WIT); bf16_t* wut = (bf16_t*)(c->ws + OFF_WUT); bf16_t* aut = (bf16_t*)(c->ws + OFF_AUT);
      for (int i = bid * 512 + tid; i < NL * NH * 4096; i += nblk * 512) { const int lh = i >> 12, j = (i >> 6) & 63, ii = i & 63;
          wrt[i] = f2bf(c->lw_r[(size_t)lh * 4096 + ii * 64 + j]); wit[i] = f2bf(c->lw_i[(size_t)lh * 4096 + ii * 64 + j]); }
      for (int i = bid * 512 + tid; i < NL * G * 64; i += nblk * 512) { const int l2 = i / (G * 64), j = (i >> 6) % G, ii = i & 63;
          wut[i] = f2bf(c->rw_up[(size_t)l2 * 64 * G + ii * G + j]); aut[i] = f2bf(c->ra_up[(size_t)l2 * 64 * G + ii * G + j]); } }
    float* rope = (float*)(c->ws + OFF_ROPE);
    for (int i = bid * 512 + tid; i < T * 32; i += nblk * 512) {
        const int t = i >> 5, j = i & 31; const float inv = powf(10000.f, -(float)j / 32.f); const float ang = (float)t * inv;
        rope[2 * i] = cosf(ang); rope[2 * i + 1] = sinf(ang);
    }
}
DI void norm_row(const float* xrow, const float* g, bf16_t* hrow, int lane) {
    float4 v[4]; float ss = 0.f;
#pragma unroll
    for (int j = 0; j < 4; ++j) { v[j] = *(const float4*)(xrow + j * 256 + lane * 4); ss += v[j].x * v[j].x + v[j].y * v[j].y + v[j].z * v[j].z + v[j].w * v[j].w; }
    ss = wave_sum(ss); const float rs = rsqrtf(ss * (1.f / D) + 1e-6f);
#pragma unroll
    for (int j = 0; j < 4; ++j) { const float4 gg = *(const float4*)(g + j * 256 + lane * 4);
        uint2 o; o.x = f2bf(v[j].x * rs * gg.x) | ((unsigned)f2bf(v[j].y * rs * gg.y) << 16); o.y = f2bf(v[j].z * rs * gg.z) | ((unsigned)f2bf(v[j].w * rs * gg.w) << 16);
        *(uint2*)(hrow + j * 256 + lane * 4) = o; }
}
DI void s_prenorm(CtxP c, int l, int slab, float* lds, int bid, int nblk) {
    const int lane = otid() & 63, gw = bid * 8 + (otid() >> 6), NGW = nblk * 8;
    for (int r = gw; r < MS; r += NGW) { const int b = r / TS, tl = r % TS; const size_t grow = (size_t)b * T + slab * TS + tl;
        norm_row(c->x + grow * D, c->norm_pre, (bf16_t*)(c->ws + OFF_H) + (size_t)r * D, lane); }
}
DI float ret_logg(int h) { return log1pf(-exp2f(-5.f - (float)h)); }
DI void s_stepB(CtxP c, int l, int slab, float* lds, int bid, int nblk) {
    const int tid = otid();
    for (int item = bid; item < 288 + 256 + 4; item += nblk) {
        if (item < 288) {
            const int bh = item / 9, part = item % 9, el = part * 512 + tid; const bool on = el < 4160;
            float* CA = (float*)(c->ws + OFF_CARRY + l * CARRY_L + CA_OFF) + (size_t)bh * SAU; float* S0 = (float*)(c->ws + OFF_SA) + (size_t)(bh * NCS) * SAU;
            float m = slab == 0 ? 0.f : CA[4160 + slab - 1]; float val = (slab == 0 || !on) ? 0.f : CA[el];
            float loc[NCS], ml[NCS], tt[NCS];
#pragma unroll
            for (int cl = 0; cl < NCS; ++cl) { const float* S = S0 + (size_t)cl * SAU; ml[cl] = S[4160]; tt[cl] = S[4161]; loc[cl] = on ? S[el] : 0.f; }
#pragma unroll
            for (int cl = 0; cl < NCS; ++cl) { float* S = S0 + (size_t)cl * SAU;
                if (on) S[el] = val;
                if (el == 0) S[4162] = m;
                const float mn = fmaxf(tt[cl] + m, ml[cl]); val = expf(tt[cl] + m - mn) * val + expf(ml[cl] - mn) * loc[cl]; m = mn; }
            if (on) CA[el] = val;
            if (el == 0) CA[4160 + slab] = m;
        } else if (item < 288 + 256) {
            const int it = item - 288, bh = it / 8, el = (it % 8) * 512 + tid; const float gch = expf(ret_logg(bh % NH) * 64.f);
            float* CD = (float*)(c->ws + OFF_CARRY + l * CARRY_L + CD_OFF) + (size_t)bh * 4096; float* S0 = (float*)(c->ws + OFF_SD) + (size_t)(bh * NCS) * 4096;
            float val = slab == 0 ? 0.f : CD[el]; float loc[NCS];
#pragma unroll
            for (int cl = 0; cl < NCS; ++cl) loc[cl] = S0[(size_t)cl * 4096 + el];
#pragma unroll
            for (int cl = 0; cl < NCS; ++cl) { S0[(size_t)cl * 4096 + el] = val; val = gch * val + loc[cl]; }
            CD[el] = val;
        } else {
            const int i = (item - 544) * 512 + tid, b = i / G, ch = i % G; float* CC = (float*)(c->ws + OFF_CARRY + l * CARRY_L + CC_OFF);
            float hc = slab == 0 ? 0.f : CC[i]; float2 v[NCS];
#pragma unroll
            for (int cl = 0; cl < NCS; ++cl) v[cl] = *(const float2*)((const float*)(c->ws + OFF_LS) + ((size_t)(b * NCS + cl) * G + ch) * 2);
#pragma unroll
            for (int cl = 0; cl < NCS; ++cl) { ((float*)(c->ws + OFF_LS))[((size_t)(b * NCS + cl) * G + ch) * 2] = hc; hc = v[cl].x * hc + v[cl].y; }
            CC[i] = hc;
        }
    }
}
typedef short bf16x8 __attribute__((ext_vector_type(8)));
typedef float f32x16 __attribute__((ext_vector_type(16)));
typedef float f32x2_t __attribute__((ext_vector_type(2)));
typedef __bf16 bf16x2_t __attribute__((ext_vector_type(2)));
DI unsigned pk2(float lo, float hi) { f32x2_t v = {lo, hi}; bf16x2_t b = __builtin_convertvector(v, bf16x2_t); return __builtin_bit_cast(unsigned, b); }
DI bf16x8 pack8(const float* v) { uint4 u; u.x = pk2(v[0], v[1]); u.y = pk2(v[2], v[3]); u.z = pk2(v[4], v[5]); u.w = pk2(v[6], v[7]); return __builtin_bit_cast(bf16x8, u); }
DI void unpack8(uint4 u, float* v) { v[0] = __uint_as_float(u.x << 16); v[1] = __uint_as_float(u.x & 0xffff0000u); v[2] = __uint_as_float(u.y << 16); v[3] = __uint_as_float(u.y & 0xffff0000u);
    v[4] = __uint_as_float(u.z << 16); v[5] = __uint_as_float(u.z & 0xffff0000u); v[6] = __uint_as_float(u.w << 16); v[7] = __uint_as_float(u.w & 0xffff0000u); }
#define MFMA32(a, b, c) __builtin_amdgcn_mfma_f32_32x32x16_bf16((a), (b), (c), 0, 0, 0)
#define WSYNC() do { __builtin_amdgcn_fence(__ATOMIC_RELEASE, "wavefront"); __builtin_amdgcn_wave_barrier(); __builtin_amdgcn_fence(__ATOMIC_ACQUIRE, "wavefront"); } while (0)
DI float wave_psum(float v, int lane) {
#pragma unroll
    for (int o = 1; o < 64; o <<= 1) { const float t = __shfl_up(v, o); if (lane >= o) v += t; }
    return v;
}
DI float wave_pmax(float v, int lane) {
#pragma unroll
    for (int o = 1; o < 64; o <<= 1) { const float t = __shfl_up(v, o); if (lane >= o) v = fmaxf(v, t); }
    return v;
}
DI float wave_max(float v) {
#pragma unroll
    for (int o = 1; o < 64; o <<= 1) v = fmaxf(v, __shfl_xor(v, o));
    return v;
}
constexpr int TP = 144;
constexpr int WLDS = 19456;
#define TILE_K(NR) (((NR) * 8 + 63) / 64)
typedef unsigned u32x4 __attribute__((ext_vector_type(4)));
template <int NR> DI void tile_load(u32x4 (&tv)[TILE_K(NR)], const bf16_t* rb  , int tl_first, int col, int lane) {
#pragma unroll
    for (int k = 0; k < (NR * 8 + 63) / 64; ++k) { const int i = lane + 64 * k; int r = i >> 3; r = r < NR ? r : NR - 1; const int ch = i & 7;
        tv[k] = *(const u32x4*)(rb + (tl_first + r) * PP + col + ch * 8); }
}
template <int NR> DI void tile_store(const u32x4 (&tv)[TILE_K(NR)], unsigned char* tile, int lane) {
#pragma unroll
    for (int k = 0; k < (NR * 8 + 63) / 64; ++k) { const int i = lane + 64 * k; const int r = i >> 3, ch = i & 7;
        if (i < NR * 8) *(u32x4*)(tile + r * TP + ch * 16) = tv[k]; }
    WSYNC();
}
DI void proc_conv_tile(unsigned char* tile, const float* cw, int cws, const float* cb, float scale, int lane) {
    const int ch = lane & 7; float w[4][8], bb[8];
#pragma unroll
    for (int t = 0; t < 4; ++t) { const float4 a = *(const float4*)(cw + t * cws + ch * 8), d = *(const float4*)(cw + t * cws + ch * 8 + 4);
        w[t][0] = a.x; w[t][1] = a.y; w[t][2] = a.z; w[t][3] = a.w; w[t][4] = d.x; w[t][5] = d.y; w[t][6] = d.z; w[t][7] = d.w; }
    { const float4 a = *(const float4*)(cb + ch * 8), d = *(const float4*)(cb + ch * 8 + 4); bb[0] = a.x; bb[1] = a.y; bb[2] = a.z; bb[3] = a.w; bb[4] = d.x; bb[5] = d.y; bb[6] = d.z; bb[7] = d.w; }
#pragma unroll
    for (int k = 0; k < 8; ++k) { const int row = (lane >> 3) + 8 * k; float acc[8];
#pragma unroll
        for (int i = 0; i < 8; ++i) acc[i] = bb[i];
#pragma unroll
        for (int t = 0; t < 4; ++t) { float x[8]; unpack8(*(const uint4*)(tile + (row + t) * TP + ch * 16), x);
#pragma unroll
            for (int i = 0; i < 8; ++i) acc[i] += x[i] * w[t][i]; }
#pragma unroll
        for (int i = 0; i < 8; ++i) acc[i] = siluf(acc[i]) * scale;
        const bf16x8 res = pack8(acc); WSYNC();
        *(bf16x8*)(tile + row * TP + ch * 16) = res; }
    WSYNC();
}
DI void proc_rope_tile(unsigned char* tile, const float* ropet, int pos0, float scale, int lane) {
    const int p = lane & 3;
#pragma unroll
    for (int k = 0; k < 4; ++k) { const int row = (lane >> 2) + 16 * k; float x1[8], x2[8], o1[8], o2[8];
        unpack8(*(const uint4*)(tile + row * TP + p * 16), x1); unpack8(*(const uint4*)(tile + row * TP + (p + 4) * 16), x2);
        const float* cs = ropet + ((size_t)(pos0 + row) * 32 + p * 8) * 2;
#pragma unroll
        for (int q = 0; q < 4; ++q) { const float4 v = *(const float4*)(cs + 4 * q);
            o1[2 * q] = (x1[2 * q] * v.x - x2[2 * q] * v.y) * scale; o2[2 * q] = (x2[2 * q] * v.x + x1[2 * q] * v.y) * scale;
            o1[2 * q + 1] = (x1[2 * q + 1] * v.z - x2[2 * q + 1] * v.w) * scale; o2[2 * q + 1] = (x2[2 * q + 1] * v.z + x1[2 * q + 1] * v.w) * scale; }
        *(bf16x8*)(tile + row * TP + p * 16) = pack8(o1); *(bf16x8*)(tile + row * TP + (p + 4) * 16) = pack8(o2); asm volatile("" ::: "memory"); }
    WSYNC();
}
DI bf16x8 frag_nat(const unsigned char* tile, int row, int ch) { return *(const bf16x8*)(tile + row * TP + ch * 16); }
DI float tile_at(const unsigned char* tile, int row, int col) { return bf2f(*(const bf16_t*)(tile + row * TP + col * 2)); }

template <bool RET> DI void w_chunkA(CtxP c, int l, int slab, int u, unsigned char* wl, int lane) {
    const int bh = u / NCS, cl = u % NCS, b = bh >> 3, h = bh & 7, tl0 = cl * 64, hs = lane >> 5, li = lane & 31;
    unsigned char* tile = wl; float* tab = (float*)(wl + 9728); const bf16_t* rb = (const bf16_t*)(c->ws + OFF_P) + prow_off(b, 0);
    float* S = RET ? (float*)(c->ws + OFF_SD) + (size_t)u * 4096 : (float*)(c->ws + OFF_SA) + (size_t)u * SAU;
    float mloc = 0.f, tot = 0.f;
    u32x4 rk64[TILE_K(64)], rv64[TILE_K(64)], rk67[TILE_K(67)];
    if (RET) tile_load<64>(rk64, rb, tl0, D_K + h * 64, lane); else tile_load<67>(rk67, rb, tl0 - 3, A_K + h * 64, lane);
    tile_load<64>(rv64, rb, tl0, (RET ? D_V : A_V) + h * 64, lane);
    if (RET) { tab[lane] = expf(ret_logg(h) * (float)(63 - lane)); }
    else { const bf16_t* gr = (const bf16_t*)(c->ws + OFF_P) + prow_off(b, tl0 + lane);
        const float ig = bf2f(gr[A_I + h]) + c->mi_bias[l * NH + h]; const float lf = -softplusf(-(bf2f(gr[A_F + h]) + c->mf_bias[l * NH + h]));
        const float cum = wave_psum(lf, lane); tot = __shfl(cum, 63); const float lw = tot - cum + ig; mloc = wave_max(lw); tab[lane] = expf(lw - mloc); }
    if (RET) { tile_store<64>(rk64, tile, lane); proc_rope_tile(tile, (const float*)(c->ws + OFF_ROPE), slab * TS + tl0, 0.125f, lane); }
    else { tile_store<67>(rk67, tile, lane); proc_conv_tile(tile, c->mconv_w + l * 4096 + 512 + h * 64, 1024, c->mconv_b + l * 1024 + 512 + h * 64, 0.125f, lane); }
    bf16x8 kf[2][4]; float nl[2] = {0.f, 0.f};
#pragma unroll
    for (int db = 0; db < 2; ++db)
#pragma unroll
        for (int ks = 0; ks < 4; ++ks) { float v[8];
#pragma unroll
            for (int j = 0; j < 8; ++j) { const int t = 16 * ks + 8 * hs + j; v[j] = tile_at(tile, t, 32 * db + li); nl[db] += tab[t] * v[j]; }
            kf[db][ks] = pack8(v); }
    WSYNC();
    tile_store<64>(rv64, tile, lane);
    f32x16 acc[2][2];
#pragma unroll
    for (int eb = 0; eb < 2; ++eb)
#pragma unroll
        for (int db = 0; db < 2; ++db)
#pragma unroll
            for (int r = 0; r < 16; ++r) acc[eb][db][r] = 0.f;
#pragma unroll
    for (int eb = 0; eb < 2; ++eb)
#pragma unroll
        for (int ks = 0; ks < 4; ++ks) { float v[8];
#pragma unroll
            for (int j = 0; j < 8; ++j) { const int t = 16 * ks + 8 * hs + j; v[j] = tile_at(tile, t, 32 * eb + li) * tab[t]; }
            const bf16x8 vf = pack8(v);
#pragma unroll
            for (int db = 0; db < 2; ++db) acc[eb][db] = MFMA32(vf, kf[db][ks], acc[eb][db]); }
#pragma unroll
    for (int eb = 0; eb < 2; ++eb)
#pragma unroll
        for (int db = 0; db < 2; ++db)
#pragma unroll
            for (int r = 0; r < 16; ++r) S[(32 * eb + (r & 3) + 8 * (r >> 2) + 4 * hs) * 64 + 32 * db + li] = acc[eb][db][r];
    if (!RET) {
#pragma unroll
        for (int db = 0; db < 2; ++db) { nl[db] += __shfl_xor(nl[db], 32); if (hs == 0) S[4096 + 32 * db + li] = nl[db]; }
        if (lane == 0) { S[4160] = mloc; S[4161] = tot; } }
    WSYNC();
}
template <bool RET> DI void w_chunkC(CtxP c, int l, int slab, int u, unsigned char* wl, int lane) {
    const int bh = u / NCS, cl = u % NCS, b = bh >> 3, h = bh & 7, tl0 = cl * 64, hs = lane >> 5, li = lane & 31;
    unsigned char* tile = wl; float* tab = (float*)(wl + 9728); const bf16_t* rb = (const bf16_t*)(c->ws + OFF_P) + prow_off(b, 0);
    const float* S = RET ? (const float*)(c->ws + OFF_SD) + (size_t)u * 4096 : (const float*)(c->ws + OFF_SA) + (size_t)u * SAU;
    const float lg = RET ? ret_logg(h) : 0.f;
    float mx_t[2] = {0.f, 0.f}, sc_t[2], dnf_t[2] = {0.f, 0.f};
    if (RET) { sc_t[0] = expf(lg * (float)(li + 1)); sc_t[1] = expf(lg * (float)(li + 33)); }
    else { const bf16_t* gr = (const bf16_t*)(c->ws + OFF_P) + prow_off(b, tl0 + lane);
        const float ig = bf2f(gr[A_I + h]) + c->mi_bias[l * NH + h]; const float lf = -softplusf(-(bf2f(gr[A_F + h]) + c->mf_bias[l * NH + h]));
        const float cum = wave_psum(lf, lane); const float a = ig - cum; const float g = wave_pmax(a, lane);
        const float mst = S[4162]; const float mx = fmaxf(mst, g); const float sint = expf(mst - mx); const float dnf = expf(-(cum + mx));
        tab[lane] = a;
        mx_t[0] = __shfl(mx, li); mx_t[1] = __shfl(mx, 32 + li); sc_t[0] = __shfl(sint, li); sc_t[1] = __shfl(sint, 32 + li); dnf_t[0] = __shfl(dnf, li); dnf_t[1] = __shfl(dnf, 32 + li); }
    u32x4 rk64[TILE_K(64)], rq64[TILE_K(64)], rv64[TILE_K(64)], rk67[TILE_K(67)], rq67[TILE_K(67)];
    if (RET) { tile_load<64>(rk64, rb, tl0, D_K + h * 64, lane); tile_load<64>(rq64, rb, tl0, D_Q + h * 64, lane); }
    else { tile_load<67>(rk67, rb, tl0 - 3, A_K + h * 64, lane); tile_load<67>(rq67, rb, tl0 - 3, A_Q + h * 64, lane); }
    bf16x8 kf[2][4], qf[2][4], cf[2][4];
#pragma unroll
    for (int eb = 0; eb < 2; ++eb)
#pragma unroll
        for (int ks = 0; ks < 4; ++ks) { const float* cp = S + (32 * eb + li) * 64 + 16 * ks + 8 * hs; const float4 c0 = *(const float4*)cp, c1 = *(const float4*)(cp + 4);
            const float cv[8] = {c0.x, c0.y, c0.z, c0.w, c1.x, c1.y, c1.z, c1.w}; cf[eb][ks] = pack8(cv); }
    do { asm volatile("" ::: "memory"); __builtin_amdgcn_sched_barrier(0); } while (0);
    if (RET) { tile_store<64>(rk64, tile, lane); proc_rope_tile(tile, (const float*)(c->ws + OFF_ROPE), slab * TS + tl0, 0.125f, lane); }
    else { tile_store<67>(rk67, tile, lane); proc_conv_tile(tile, c->mconv_w + l * 4096 + 512 + h * 64, 1024, c->mconv_b + l * 1024 + 512 + h * 64, 0.125f, lane); }
#pragma unroll
    for (int mb = 0; mb < 2; ++mb)
#pragma unroll
        for (int ks = 0; ks < 4; ++ks) kf[mb][ks] = frag_nat(tile, 32 * mb + li, 2 * ks + hs);
    WSYNC(); __builtin_amdgcn_sched_barrier(0);
    tile_load<64>(rv64, rb, tl0, (RET ? D_V : A_V) + h * 64, lane);
    if (RET) { tile_store<64>(rq64, tile, lane); proc_rope_tile(tile, (const float*)(c->ws + OFF_ROPE), slab * TS + tl0, 1.f, lane); }
    else { tile_store<67>(rq67, tile, lane); proc_conv_tile(tile, c->mconv_w + l * 4096 + h * 64, 1024, c->mconv_b + l * 1024 + h * 64, 1.f, lane); }
#pragma unroll
    for (int nb = 0; nb < 2; ++nb)
#pragma unroll
        for (int ks = 0; ks < 4; ++ks) qf[nb][ks] = frag_nat(tile, 32 * nb + li, 2 * ks + hs);
    WSYNC(); __builtin_amdgcn_sched_barrier(0);
    tile_store<64>(rv64, tile, lane);
    const int zc = (RET ? ZD : ZA) + h * 64; const float* nw = (RET ? c->retnorm_w : c->mnorm_w) + l * G + h * 64;
#pragma unroll
    for (int nb = 0; nb < 2; ++nb) {
        bf16_t* prw = (bf16_t*)(c->ws + OFF_P) + prow_off(b, tl0 + 32 * nb + li);
        uint2 ogr[2][4], zvr[2][4];
#pragma unroll
        for (int eb = 0; eb < 2; ++eb)
#pragma unroll
            for (int rg = 0; rg < 4; ++rg) { const int e0 = 32 * eb + 8 * rg + 4 * hs; zvr[eb][rg] = *(const uint2*)(prw + zc + e0); ogr[eb][rg] = RET ? make_uint2(0u, 0u) : *(const uint2*)(prw + A_O + h * 64 + e0); }
        bf16x8 xf[2][2]; float csum = 0.f;
#pragma unroll
        for (int mb = 0; mb < 2; ++mb) {
            if (!RET && mb == 1 && nb == 0) continue;
            f32x16 sa;
#pragma unroll
            for (int r = 0; r < 16; ++r) sa[r] = 0.f;
#pragma unroll
            for (int ks = 0; ks < 4; ++ks) sa = MFMA32(kf[mb][ks], qf[nb][ks], sa);
            float xv[16];
#pragma unroll
            for (int rg = 0; rg < 4; ++rg) { float av[4] = {0.f, 0.f, 0.f, 0.f};
                if (!RET) { const float4 t4 = *(const float4*)(tab + 32 * mb + 8 * rg + 4 * hs); av[0] = t4.x; av[1] = t4.y; av[2] = t4.z; av[3] = t4.w; }
#pragma unroll
                for (int i = 0; i < 4; ++i) { const int r = 4 * rg + i, s = 32 * mb + 8 * rg + 4 * hs + i, t = 32 * nb + li;
                    float w;
                    if (RET) w = __expf(lg * fabsf((float)(t - s))); else w = s <= t ? __expf(av[i] - mx_t[nb]) : 0.f;
                    xv[r] = sa[r] * w; csum += xv[r]; } }
            xf[mb][0] = pack8(xv); xf[mb][1] = pack8(xv + 8); __builtin_amdgcn_sched_barrier(0); }
        f32x16 o[2];
#pragma unroll
        for (int eb = 0; eb < 2; ++eb) {
#pragma unroll
            for (int r = 0; r < 16; ++r) o[eb][r] = 0.f;
#pragma unroll
            for (int ks = 0; ks < 4; ++ks) o[eb] = MFMA32(cf[eb][ks], qf[nb][ks], o[eb]);
#pragma unroll
            for (int r = 0; r < 16; ++r) o[eb][r] *= sc_t[nb]; }
        __builtin_amdgcn_sched_barrier(0);
        float dn = 1.f;
        if (!RET) { float qn = 0.f;
#pragma unroll
            for (int ks = 0; ks < 4; ++ks) { const float4 n0 = *(const float4*)(S + 4096 + 16 * ks + 8 * hs), n1 = *(const float4*)(S + 4096 + 16 * ks + 8 * hs + 4);
                const float nv[8] = {n0.x, n0.y, n0.z, n0.w, n1.x, n1.y, n1.z, n1.w}; float qv[8]; unpack8(__builtin_bit_cast(uint4, qf[nb][ks]), qv);
#pragma unroll
                for (int j = 0; j < 8; ++j) qn += qv[j] * nv[j]; }
            qn += __shfl_xor(qn, 32); csum += __shfl_xor(csum, 32); dn = fmaxf(fabsf(csum + sc_t[nb] * qn), dnf_t[nb]); }
#pragma unroll
        for (int eb = 0; eb < 2; ++eb)
#pragma unroll
            for (int sb = 0; sb < 2; ++sb) {
                if (!RET && sb == 1 && nb == 0) continue;
#pragma unroll
                for (int st = 0; st < 2; ++st) { bf16x8 vf;
#pragma unroll
                    for (int j = 0; j < 8; ++j) vf[j] = (short)*(const bf16_t*)(tile + (32 * sb + 16 * st + 8 * (j >> 2) + 4 * hs + (j & 3)) * TP + (32 * eb + li) * 2);
                    o[eb] = MFMA32(vf, xf[sb][st], o[eb]); }
                do { asm volatile("" ::: "memory"); __builtin_amdgcn_sched_barrier(0); } while (0); }
        do { asm volatile("" ::: "memory"); __builtin_amdgcn_sched_barrier(0); } while (0);
        const float inv = 1.f / dn; float sum = 0.f;
#pragma unroll
        for (int eb = 0; eb < 2; ++eb)
#pragma unroll
            for (int rg = 0; rg < 4; ++rg) { const int e0 = 32 * eb + 8 * rg + 4 * hs; float og[4] = {1.f, 1.f, 1.f, 1.f};
                if (!RET) { const uint2 ov = ogr[eb][rg]; og[0] = sigm(__uint_as_float(ov.x << 16)); og[1] = sigm(__uint_as_float(ov.x & 0xffff0000u)); og[2] = sigm(__uint_as_float(ov.y << 16)); og[3] = sigm(__uint_as_float(ov.y & 0xffff0000u)); }
#pragma unroll
                for (int i = 0; i < 4; ++i) { const float v = o[eb][4 * rg + i] * inv * og[i]; o[eb][4 * rg + i] = v; sum += v; } }
        sum += __shfl_xor(sum, 32); const float mu = sum * (1.f / 64.f); float vs = 0.f;
#pragma unroll
        for (int eb = 0; eb < 2; ++eb)
#pragma unroll
            for (int r = 0; r < 16; ++r) { const float d = o[eb][r] - mu; vs += d * d; }
        vs += __shfl_xor(vs, 32); const float rstd = rsqrtf(vs * (1.f / 64.f) + 1e-5f);
#pragma unroll
        for (int eb = 0; eb < 2; ++eb)
#pragma unroll
            for (int rg = 0; rg < 4; ++rg) { const int e0 = 32 * eb + 8 * rg + 4 * hs; const uint2 zv = zvr[eb][rg]; const float4 w4 = *(const float4*)(nw + e0);
                const float z[4] = {__uint_as_float(zv.x << 16), __uint_as_float(zv.x & 0xffff0000u), __uint_as_float(zv.y << 16), __uint_as_float(zv.y & 0xffff0000u)}; const float wv[4] = {w4.x, w4.y, w4.z, w4.w}; float y[4];
#pragma unroll
                for (int i = 0; i < 4; ++i) y[i] = (o[eb][4 * rg + i] - mu) * rstd * wv[i] * siluf(z[i]);
                uint2 ov; ov.x = pk2(y[0], y[1]); ov.y = pk2(y[2], y[3]); *(uint2*)(prw + zc + e0) = ov; }
        do { asm volatile("" ::: "memory"); __builtin_amdgcn_sched_barrier(0); } while (0);
    }
    WSYNC(); __builtin_amdgcn_sched_barrier(0);
}
DI void proc_conv_tile_lin(unsigned char* tile, const float* cw, int cws, const float* cb, int lane) {
    const int ch = lane & 7; float w[4][8], bb[8];
#pragma unroll
    for (int t = 0; t < 4; ++t) { const float4 a = *(const float4*)(cw + t * cws + ch * 8), d = *(const float4*)(cw + t * cws + ch * 8 + 4);
        w[t][0] = a.x; w[t][1] = a.y; w[t][2] = a.z; w[t][3] = a.w; w[t][4] = d.x; w[t][5] = d.y; w[t][6] = d.z; w[t][7] = d.w; }
    { const float4 a = *(const float4*)(cb + ch * 8), d = *(const float4*)(cb + ch * 8 + 4); bb[0] = a.x; bb[1] = a.y; bb[2] = a.z; bb[3] = a.w; bb[4] = d.x; bb[5] = d.y; bb[6] = d.z; bb[7] = d.w; }
#pragma unroll
    for (int k = 0; k < 8; ++k) { const int row = (lane >> 3) + 8 * k; float acc[8];
#pragma unroll
        for (int i = 0; i < 8; ++i) acc[i] = bb[i];
#pragma unroll
        for (int t = 0; t < 4; ++t) { float x[8]; unpack8(*(const uint4*)(tile + (row + t) * TP + ch * 16), x);
#pragma unroll
            for (int i = 0; i < 8; ++i) acc[i] += x[i] * w[t][i]; }
        const bf16x8 res = pack8(acc); WSYNC();
        *(bf16x8*)(tile + row * TP + ch * 16) = res; }
    WSYNC();
}
DI void lru_gates(CtxP c, int l, int h, int jb, const unsigned char* tile, const bf16x8 (&xf)[2][4], float (&a)[2][16], float (&u)[2][16], int li, int hs) {
    const int j = 32 * jb + li, ch = h * 64 + j;
    const bf16_t* wr = (const bf16_t*)(c->ws + OFF_WRT) + ((size_t)(l * NH + h) * 64 + j) * 64; const bf16_t* wi = (const bf16_t*)(c->ws + OFF_WIT) + ((size_t)(l * NH + h) * 64 + j) * 64;
    bf16x8 wrf[4], wif[4];
#pragma unroll
    for (int ks = 0; ks < 4; ++ks) { wrf[ks] = *(const bf16x8*)(wr + 16 * ks + 8 * hs); wif[ks] = *(const bf16x8*)(wi + 16 * ks + 8 * hs); }
    const float br = c->lb_r[l * G + ch], bi = c->lb_i[l * G + ch], sp8 = -8.f * softplusf(-c->llam[l * G + ch]);
#pragma unroll
    for (int tb = 0; tb < 2; ++tb) { f32x16 ar, ai;
#pragma unroll
        for (int r = 0; r < 16; ++r) { ar[r] = 0.f; ai[r] = 0.f; }
#pragma unroll
        for (int ks = 0; ks < 4; ++ks) { ar = MFMA32(xf[tb][ks], wrf[ks], ar); ai = MFMA32(xf[tb][ks], wif[ks], ai); }
#pragma unroll
        for (int r = 0; r < 16; ++r) { const int t = 32 * tb + (r & 3) + 8 * (r >> 2) + 4 * hs; const float x = tile_at(tile, t, j);
            const float la = sp8 * sigm(ar[r] + br); a[tb][r] = __expf(la); u[tb][r] = sqrtf(-expm1f(2.f * la)) * (sigm(ai[r] + bi) * x); } }
}
template <bool STEP_C> DI void w_lru(CtxP c, int l, int slab, int u_, unsigned char* wl, int lane, int jb_lo, int jb_hi) {
    const int bh = u_ / NCS, cl = u_ % NCS, b = bh >> 3, h = bh & 7, tl0 = cl * 64, hs = lane >> 5, li = lane & 31;
    unsigned char* tile = wl; const bf16_t* rb = (const bf16_t*)(c->ws + OFF_P) + prow_off(b, 0);
    { u32x4 rx[TILE_K(67)]; tile_load<67>(rx, rb, tl0 - 3, C_X + h * 64, lane); tile_store<67>(rx, tile, lane); }
    proc_conv_tile_lin(tile, c->lconv_w + l * 2048 + h * 64, 512, c->lconv_b + l * 512 + h * 64, lane);
    bf16x8 xf[2][4];
#pragma unroll
    for (int tb = 0; tb < 2; ++tb)
#pragma unroll
        for (int ks = 0; ks < 4; ++ks) xf[tb][ks] = frag_nat(tile, 32 * tb + li, 2 * ks + hs);
#pragma unroll 1
    for (int jb = jb_lo; jb < jb_hi; ++jb) {
        float a[2][16], u[2][16];
        lru_gates(c, l, h, jb, tile, xf, a, u, li, hs);
        const int ch = h * 64 + 32 * jb + li; float* LS = (float*)(c->ws + OFF_LS) + ((size_t)(b * NCS + cl) * G + ch) * 2;
        float cst = STEP_C ? LS[0] : 0.f, pr = 1.f;
#pragma unroll
        for (int tb = 0; tb < 2; ++tb)
#pragma unroll
            for (int q = 0; q < 4; ++q) {
                float ga = 1.f, gu = 0.f;
#pragma unroll
                for (int i = 0; i < 4; ++i) { gu = a[tb][4 * q + i] * gu + u[tb][4 * q + i]; ga *= a[tb][4 * q + i]; }
                const float pa = __shfl_xor(ga, 32), pu = __shfl_xor(gu, 32);
                const float a0 = hs ? pa : ga, u0 = hs ? pu : gu, a1 = hs ? ga : pa, u1 = hs ? gu : pu;
                if (STEP_C) { float hv = hs ? a0 * cst + u0 : cst;
#pragma unroll
                    for (int i = 0; i < 4; ++i) { hv = a[tb][4 * q + i] * hv + u[tb][4 * q + i]; u[tb][4 * q + i] = hv; } }
                cst = a1 * (a0 * cst + u0) + u1; pr *= a0 * a1; }
        if (!STEP_C) { if (hs == 0) { LS[0] = pr; LS[1] = cst; } }
        else {
#pragma unroll
            for (int tb = 0; tb < 2; ++tb)
#pragma unroll
                for (int r = 0; r < 16; ++r) { const int t = 32 * tb + (r & 3) + 8 * (r >> 2) + 4 * hs; bf16_t* pz = (bf16_t*)(c->ws + OFF_P) + prow_off(b, tl0 + t) + ZC + ch;
                    *pz = f2bf(u[tb][r] * siluf(bf2f(*pz))); } }
        asm volatile("" ::: "memory"); __builtin_amdgcn_sched_barrier(0);
    }
    WSYNC();
}
#define DPP_ADD(v, ctrl) v += __builtin_bit_cast(float, __builtin_amdgcn_update_dpp(0, __builtin_bit_cast(int, v), ctrl, 0xF, 0xF, true))
DI float allred16(float v) { DPP_ADD(v, 0xB1); DPP_ADD(v, 0x4E); DPP_ADD(v, 0x141); DPP_ADD(v, 0x140); return v; }
DI float allred32(float v) { v = allred16(v); v += __shfl_xor(v, 16); return v; }
template <bool TANH> DI void proc_shift_tile(unsigned char* tile, const float* mu, int lane) {
    const int ch = lane & 7; float m[8];
    { const float4 a = *(const float4*)(mu + ch * 8), d = *(const float4*)(mu + ch * 8 + 4); m[0] = a.x; m[1] = a.y; m[2] = a.z; m[3] = a.w; m[4] = d.x; m[5] = d.y; m[6] = d.z; m[7] = d.w; }
#pragma unroll
    for (int k = 0; k < 8; ++k) { const int row = (lane >> 3) + 8 * k; float xp[8], x[8];
        unpack8(*(const uint4*)(tile + row * TP + ch * 16), xp); unpack8(*(const uint4*)(tile + (row + 1) * TP + ch * 16), x);
#pragma unroll
        for (int i = 0; i < 8; ++i) { const float v = x[i] + m[i] * (xp[i] - x[i]); x[i] = TANH ? tanhf(v) : v; }
        const bf16x8 res = pack8(x); WSYNC();
        *(bf16x8*)(tile + row * TP + ch * 16) = res; }
    WSYNC();
}
DI void w_bprep(CtxP c, int l, int slab, int u_, unsigned char* wl, int lane) {
    const int bh = u_ / NCS, cl = u_ % NCS, b = bh >> 3, h = bh & 7, tl0 = cl * 64, hs = lane >> 5, li = lane & 31;
    unsigned char* T0 = wl; unsigned char* T1 = wl + 10096;
    const float* mu = c->rmu + l * 1664; const bf16_t* rb = (const bf16_t*)(c->ws + OFF_P) + prow_off(b, 0);
    bf16x8 wlf[2][4], alf[2][4];
    u32x4 rw[TILE_K(65)], ra[TILE_K(65)], rr_[TILE_K(65)], rk_[TILE_K(65)];
    tile_load<65>(rw, rb, tl0 - 1, B_WLO, lane); tile_load<65>(ra, rb, tl0 - 1, B_ALO, lane);
    tile_store<65>(rw, T0, lane);
    tile_load<65>(rr_, rb, tl0 - 1, B_R + h * 64, lane); tile_load<65>(rk_, rb, tl0 - 1, B_K + h * 64, lane);
    proc_shift_tile<true>(T0, mu + 1536, lane);
#pragma unroll
    for (int tb = 0; tb < 2; ++tb)
#pragma unroll
        for (int ks = 0; ks < 4; ++ks) wlf[tb][ks] = frag_nat(T0, 32 * tb + li, 2 * ks + hs);
    WSYNC();
    tile_store<65>(ra, T0, lane); proc_shift_tile<false>(T0, mu + 1600, lane);
#pragma unroll
    for (int tb = 0; tb < 2; ++tb)
#pragma unroll
        for (int ks = 0; ks < 4; ++ks) alf[tb][ks] = frag_nat(T0, 32 * tb + li, 2 * ks + hs);
    WSYNC();
    tile_store<65>(rr_, T0, lane); tile_store<65>(rk_, T1, lane);
    __builtin_amdgcn_sched_barrier(0);
#pragma unroll
    for (int tb = 0; tb < 2; ++tb) {
        float rs[16], bonp[16];
        { float kk[2], mk[2];
#pragma unroll
          for (int jb = 0; jb < 2; ++jb) { kk[jb] = c->rk_k[l * G + h * 64 + 32 * jb + li]; mk[jb] = mu[512 + h * 64 + 32 * jb + li]; }
#pragma unroll
          for (int r = 0; r < 16; ++r) { const int t = 32 * tb + (r & 3) + 8 * (r >> 2) + 4 * hs; float ss = 0.f;
#pragma unroll
              for (int jb = 0; jb < 2; ++jb) { const float x = tile_at(T1, t + 1, 32 * jb + li), xp = tile_at(T1, t, 32 * jb + li); const float kap = (x + mk[jb] * (xp - x)) * kk[jb]; ss += kap * kap; }
              rs[r] = rsqrtf(allred32(ss) + 1e-12f); bonp[r] = 0.f; } }
        __builtin_amdgcn_sched_barrier(0);
#pragma unroll
        for (int jb = 0; jb < 2; ++jb) {
            const int j = 32 * jb + li, ch = h * 64 + j;
            const bf16_t* wu = (const bf16_t*)(c->ws + OFF_WUT) + ((size_t)l * G + ch) * 64; const bf16_t* au = (const bf16_t*)(c->ws + OFF_AUT) + ((size_t)l * G + ch) * 64;
            bf16x8 wuf[4], auf[4];
#pragma unroll
            for (int ks = 0; ks < 4; ++ks) { wuf[ks] = *(const bf16x8*)(wu + 16 * ks + 8 * hs); auf[ks] = *(const bf16x8*)(au + 16 * ks + 8 * hs); }
            const float w0 = c->rw0[l * G + ch], a0 = c->ra0[l * G + ch], kkj = c->rk_k[l * G + ch], kaj = c->rk_a[l * G + ch], rkj = c->rr_k[l * G + ch], mr = mu[ch], mk = mu[512 + ch];
            f32x16 dl, da;
#pragma unroll
            for (int r = 0; r < 16; ++r) { dl[r] = 0.f; da[r] = 0.f; }
#pragma unroll
            for (int ks = 0; ks < 4; ++ks) { dl = MFMA32(wlf[tb][ks], wuf[ks], dl); da = MFMA32(alf[tb][ks], auf[ks], da); }
            __builtin_amdgcn_sched_barrier(0);
            unsigned char* ckb = c->ws + OFF_CK + (size_t)(bh * TS + tl0) * 768;
#pragma unroll
            for (int r = 0; r < 16; ++r) { const int t = 32 * tb + (r & 3) + 8 * (r >> 2) + 4 * hs;
                const float w = __expf(-0.606531f * sigm(w0 + dl[r])); const float a = sigm(a0 + da[r]);
                float x = tile_at(T0, t + 1, j), xp = tile_at(T0, t, j); const float rm = x + mr * (xp - x);
                x = tile_at(T1, t + 1, j); xp = tile_at(T1, t, j); const float km = x + mk * (xp - x);
                const float kh = km * kkj * rs[r], kt = km * (1.f + (a - 1.f) * kaj);
                bonp[r] += rm * rkj * kt;
                const unsigned o4 = (unsigned)t * 768u + (unsigned)j * 4u, o2 = (unsigned)t * 768u + 256u + (unsigned)j * 2u;
                *(float*)(ckb + o4) = w; *(bf16_t*)(ckb + o2) = f2bf(kh); *(bf16_t*)(ckb + o2 + 128u) = f2bf(a * kh); *(bf16_t*)(ckb + o2 + 256u) = f2bf(kt); *(bf16_t*)(ckb + o2 + 384u) = f2bf(rm);
                if ((r & 3) == 3) { asm volatile("" ::: "memory"); __builtin_amdgcn_sched_barrier(0); } }
        }
#pragma unroll
        for (int r = 0; r < 16; ++r) { const float bsum = allred32(bonp[r]); const int t = 32 * tb + (r & 3) + 8 * (r >> 2) + 4 * hs;
            if (li == 0) ((float*)(c->ws + OFF_BON))[(size_t)(b * TS + tl0 + t) * NH + h] = bsum; }
        asm volatile("" ::: "memory"); __builtin_amdgcn_sched_barrier(0);
    }
    WSYNC();
}
DI void s_phase2(CtxP c, int l, int slab, float* lds, int bid, int nblk) {
    const int tid = otid(), lane = tid & 63, wave = tid >> 6; unsigned char* wl = (unsigned char*)lds + wave * WLDS;
    { const int u = bid * 4 + (wave & 3); int ln = lane;
        if (wave < 4) w_bprep(c, l, slab, u, wl, ln); else w_lru<false>(c, l, slab, u, wl, ln, 0, 2);
        asm volatile("" : "+v"(ln) :: "memory"); __builtin_amdgcn_sched_barrier(0);
        if (wave < 4) w_chunkA<false>(c, l, slab, u, wl, ln); else w_chunkA<true>(c, l, slab, u, wl, ln); }
    if (slab == 0) { bf16_t* halo = (bf16_t*)(c->ws + OFF_CARRY + l * CARRY_L + HALO_OFF);
        for (int i = bid * 512 + tid; i < NB * 3 * PP; i += nblk * 512) { const int b = i / (3 * PP), r = (i / PP) % 3, col = i % PP;
            halo[i] = ((const bf16_t*)(c->ws + OFF_P))[prow_off(b, TS - 3 + r) + col]; } }
}
DI void s_phase3c(CtxP c, int l, int slab, float* lds, int bid, int nblk) {
    const int tid = otid(), lane = tid & 63, wave = tid >> 6; unsigned char* wl = (unsigned char*)lds + wave * WLDS;
    { const int u = bid * 4 + (wave & 3); int ln = lane;
        if (wave < 4) w_chunkC<false>(c, l, slab, u, wl, ln); else w_chunkC<true>(c, l, slab, u, wl, ln);
        asm volatile("" : "+v"(ln) :: "memory"); __builtin_amdgcn_sched_barrier(0);
        w_lru<true>(c, l, slab, u, wl, ln, wave >> 2, (wave >> 2) + 1); }
}
typedef float f2v __attribute__((ext_vector_type(2)));
constexpr int SC_CH = 32, SC_REC = 1280, SC_BUF = SC_CH * SC_REC, SC_VMF = SC_CH * 8;
DI void s_bscan(CtxP c, int l, int slab, float* lds, int bid) {
    const int tid = otid(), lane = tid & 63, wave = tid >> 6;
    const int bh = (bid & 7) * 4 + (bid >> 6), rg8 = (bid >> 3) & 7, b = bh >> 3, h = bh & 7;
    unsigned char* ring = (unsigned char*)lds; float* vmr = (float*)(ring + 2 * SC_BUF);
    const unsigned char* ck = c->ws + OFF_CK + (size_t)bh * TS * 768;
    const int rr = lane >> 4, kg = lane & 15, row = rg8 * 8 + (wave & 1) * 4 + rr;
    float* CB = (float*)(c->ws + OFF_CARRY + l * CARRY_L + CB_OFF) + ((size_t)bh * 64 + row) * 64 + kg * 4;
    f2v S01 = {0.f, 0.f}, S23 = {0.f, 0.f};
    if (wave < 2 && slab != 0) { S01.x = CB[0]; S01.y = CB[1]; S23.x = CB[2]; S23.y = CB[3]; }
    const int p = tid - 256, pst = p >> 3, prq = p & 1; const int vcol = B_V + h * 64 + rg8 * 8 + prq * 4;
    float4 muv = make_float4(0.f, 0.f, 0.f, 0.f);
    if (wave >= 4) muv = *(const float4*)(c->rmu + l * 1664 + 1024 + h * 64 + rg8 * 8 + prq * 4);
    uint4 pt[6]; uint2 pvc = make_uint2(0u, 0u), pvp = make_uint2(0u, 0u);
    auto pload = [&](int ch) {
        const uint4* src = (const uint4*)(ck + (size_t)ch * (SC_CH * 768));
#pragma unroll
        for (int k = 0; k < 6; ++k) pt[k] = src[p + 256 * k];
        const int tl = ch * SC_CH + pst;
        if ((p & 6) == 0) { const bf16_t* pr = (const bf16_t*)(c->ws + OFF_P) + prow_off(b, tl) + vcol; pvc = *(const uint2*)pr; pvp = *(const uint2*)(pr - PP); }
    };
    auto pwrite = [&](int ch) {
        unsigned char* dst = ring + (ch & 1) * SC_BUF;
#pragma unroll
        for (int k = 0; k < 6; ++k) { const int idx = p + 256 * k, st = idx / 48, w = idx % 48; unsigned char* r = dst + st * SC_REC;
            if (w < 16) *(uint4*)(r + w * 16) = pt[k];
            else { float f[8]; unpack8(pt[k], f); float* d = (float*)(r + 256) + (w - 16) * 8; *(float4*)d = make_float4(f[0], f[1], f[2], f[3]); *(float4*)(d + 4) = make_float4(f[4], f[5], f[6], f[7]); } }
        if ((p & 6) == 0) {
            const float v0 = __uint_as_float(pvc.x << 16), v1 = __uint_as_float(pvc.x & 0xffff0000u), v2 = __uint_as_float(pvc.y << 16), v3 = __uint_as_float(pvc.y & 0xffff0000u);
            const float q0 = __uint_as_float(pvp.x << 16), q1 = __uint_as_float(pvp.x & 0xffff0000u), q2 = __uint_as_float(pvp.y << 16), q3 = __uint_as_float(pvp.y & 0xffff0000u);
            *(float4*)(vmr + (ch & 1) * SC_VMF + pst * 8 + prq * 4) = make_float4(v0 + muv.x * (q0 - v0), v1 + muv.y * (q1 - v1), v2 + muv.z * (q2 - v2), v3 + muv.w * (q3 - v3)); }
    };
    if (wave >= 4) { pload(0); pwrite(0); pload(1); }
    asm volatile("s_waitcnt lgkmcnt(0)" ::: "memory"); __builtin_amdgcn_s_barrier();
    bf16_t* pbase = (bf16_t*)(c->ws + OFF_P) + prow_off(b, 0);
    float ykeep = 0.f;
    for (int ch = 0; ch < TS / SC_CH; ++ch) {
        if (wave >= 4) { if (ch + 1 < TS / SC_CH) { pwrite(ch + 1); if (ch + 2 < TS / SC_CH) pload(ch + 2); } }
        else if (wave < 2) {
            const unsigned char* rec = ring + (ch & 1) * SC_BUF + kg * 16; const float* vmp = vmr + (ch & 1) * SC_VMF + (wave & 1) * 4 + rr;
            float4 wv = *(const float4*)(rec), kh = *(const float4*)(rec + 256), ak = *(const float4*)(rec + 512), kt = *(const float4*)(rec + 768), rv = *(const float4*)(rec + 1024); float vm = vmp[0];
            float4 wv1 = *(const float4*)(rec + SC_REC), kh1 = *(const float4*)(rec + SC_REC + 256), ak1 = *(const float4*)(rec + SC_REC + 512), kt1 = *(const float4*)(rec + SC_REC + 768), rv1 = *(const float4*)(rec + SC_REC + 1024); float vm1 = vmp[8];
#pragma unroll 4
            for (int s = 0; s < SC_CH; ++s) {
                const int sn = s + 2 < SC_CH ? s + 2 : SC_CH - 1; const unsigned char* rn = rec + sn * SC_REC;
                const float4 wv2 = *(const float4*)(rn), kh2 = *(const float4*)(rn + 256), ak2 = *(const float4*)(rn + 512), kt2 = *(const float4*)(rn + 768), rv2 = *(const float4*)(rn + 1024); const float vm2_ = vmp[sn * 8];
                f2v pp = S01 * (f2v){kh.x, kh.y}; pp = S23 * (f2v){kh.z, kh.w} + pp;
                float sk = allred16(pp.x + pp.y);
                const f2v vm2 = {vm, vm}, nsk = {-sk, -sk};
                f2v t01 = S01 * (f2v){wv.x, wv.y} + vm2 * (f2v){kt.x, kt.y}, t23 = S23 * (f2v){wv.z, wv.w} + vm2 * (f2v){kt.z, kt.w};
                S01 = nsk * (f2v){ak.x, ak.y} + t01; S23 = nsk * (f2v){ak.z, ak.w} + t23;
                f2v qq = S01 * (f2v){rv.x, rv.y}; qq = S23 * (f2v){rv.z, rv.w} + qq;
                const float y = allred16(qq.x + qq.y);
                ykeep = ((s & 15) == kg) ? y : ykeep;
                if ((s & 15) == 15) ((float*)(pbase + (size_t)(ch * SC_CH + (s & 16) + kg) * PP + B_R))[h * 64 + row] = ykeep;
                wv = wv1; kh = kh1; ak = ak1; kt = kt1; rv = rv1; vm = vm1;
                wv1 = wv2; kh1 = kh2; ak1 = ak2; kt1 = kt2; rv1 = rv2; vm1 = vm2_;
            }
        }
        asm volatile("s_waitcnt lgkmcnt(0)" ::: "memory"); __builtin_amdgcn_s_barrier();
    }
    if (wave < 2) { CB[0] = S01.x; CB[1] = S01.y; CB[2] = S23.x; CB[3] = S23.y; }
}
DI float red8(float v) { DPP_ADD(v, 0xB1); DPP_ADD(v, 0x4E); DPP_ADD(v, 0x141); return v; }
DI void s_bpost(CtxP c, int l, int slab, float* lds, int bid, int nblk) {
    const int lane = otid() & 63, gw = bid * 8 + (otid() >> 6), NGW = nblk * 8; const int ch0 = lane * 8, h = lane >> 3;
    float gw8[8], gb8[8], mu8[8];
    { const float4 a0 = *(const float4*)(c->rgn_w + l * G + ch0), a1 = *(const float4*)(c->rgn_w + l * G + ch0 + 4), b0 = *(const float4*)(c->rgn_b + l * G + ch0), b1 = *(const float4*)(c->rgn_b + l * G + ch0 + 4),
          m0 = *(const float4*)(c->rmu + l * 1664 + 1024 + ch0), m1 = *(const float4*)(c->rmu + l * 1664 + 1024 + ch0 + 4);
      gw8[0] = a0.x; gw8[1] = a0.y; gw8[2] = a0.z; gw8[3] = a0.w; gw8[4] = a1.x; gw8[5] = a1.y; gw8[6] = a1.z; gw8[7] = a1.w;
      gb8[0] = b0.x; gb8[1] = b0.y; gb8[2] = b0.z; gb8[3] = b0.w; gb8[4] = b1.x; gb8[5] = b1.y; gb8[6] = b1.z; gb8[7] = b1.w;
      mu8[0] = m0.x; mu8[1] = m0.y; mu8[2] = m0.z; mu8[3] = m0.w; mu8[4] = m1.x; mu8[5] = m1.y; mu8[6] = m1.z; mu8[7] = m1.w; }
    for (int r0 = gw; r0 < MS; r0 += 2 * NGW) {
        float4 wa[2], wb[2]; uint4 xc[2], xq[2], zz[2]; float bon[2]; bf16_t* prw[2];
#pragma unroll
        for (int q = 0; q < 2; ++q) { int r = r0 + q * NGW; r = r < MS ? r : r0; const int b = r / TS, tl = r % TS; prw[q] = (bf16_t*)(c->ws + OFF_P) + prow_off(b, tl);
            wa[q] = *(const float4*)((const float*)(prw[q] + B_R) + ch0); wb[q] = *(const float4*)((const float*)(prw[q] + B_R) + ch0 + 4);
            xc[q] = *(const uint4*)(prw[q] + B_V + ch0); xq[q] = *(const uint4*)(prw[q] - PP + B_V + ch0); zz[q] = *(const uint4*)(prw[q] + ZB + ch0);
            bon[q] = ((const float*)(c->ws + OFF_BON))[(size_t)r * NH + h]; }
#pragma unroll
        for (int q = 0; q < 2; ++q) { if (r0 + q * NGW >= MS) break;
            float w[8] = {wa[q].x, wa[q].y, wa[q].z, wa[q].w, wb[q].x, wb[q].y, wb[q].z, wb[q].w}, x[8], xp[8], z[8], y[8];
            unpack8(xc[q], x); unpack8(xq[q], xp); unpack8(zz[q], z);
            float sm = 0.f;
#pragma unroll
            for (int i = 0; i < 8; ++i) sm += w[i];
            const float mean = red8(sm) * (1.f / 64.f); float vs = 0.f;
#pragma unroll
            for (int i = 0; i < 8; ++i) { w[i] -= mean; vs += w[i] * w[i]; }
            const float rstd = rsqrtf(red8(vs) * (1.f / 64.f) + 1e-5f);
#pragma unroll
            for (int i = 0; i < 8; ++i) { const float vm = x[i] + mu8[i] * (xp[i] - x[i]); y[i] = (w[i] * rstd * gw8[i] + gb8[i] + bon[q] * vm) * siluf(z[i]); }
            *(bf16x8*)(prw[q] + ZB + ch0) = pack8(y); }
    }
}
DI void s_post(CtxP c, int l, int slab, float* lds, int bid, int nblk) {
    const int lane = otid() & 63, gw = bid * 8 + (otid() >> 6), NGW = nblk * 8;
    for (int r0 = gw; r0 < MS; r0 += 2 * NGW) {
        float4 v[2][4], xx[2][4]; float* orow[2];
#pragma unroll
        for (int q = 0; q < 2; ++q) { int r = r0 + q * NGW; r = r < MS ? r : r0; const int b = r / TS, tl = r % TS; const size_t grow = (size_t)b * T + slab * TS + tl;
            const float* yrow = (const float*)(c->ws + OFF_Y) + (size_t)r * D; const float* xr = (l == 0 ? c->x : c->out) + grow * D; orow[q] = c->out + grow * D;
#pragma unroll
            for (int j = 0; j < 4; ++j) { v[q][j] = *(const float4*)(yrow + j * 256 + lane * 4); xx[q][j] = *(const float4*)(xr + j * 256 + lane * 4); } }
#pragma unroll
        for (int q = 0; q < 2; ++q) { const int r = r0 + q * NGW; if (r >= MS) break;
            float ss = 0.f;
#pragma unroll
            for (int j = 0; j < 4; ++j) ss += v[q][j].x * v[q][j].x + v[q][j].y * v[q][j].y + v[q][j].z * v[q][j].z + v[q][j].w * v[q][j].w;
            ss = wave_sum(ss); const float rs = rsqrtf(ss * (1.f / D) + 1e-6f); float s2 = 0.f;
#pragma unroll
            for (int j = 0; j < 4; ++j) { const float4 gg = *(const float4*)(c->norm_post + l * D + j * 256 + lane * 4); float4& o = v[q][j]; const float4 x4 = xx[q][j];
                o.x = x4.x + o.x * rs * gg.x; o.y = x4.y + o.y * rs * gg.y; o.z = x4.z + o.z * rs * gg.z; o.w = x4.w + o.w * rs * gg.w;
                *(float4*)(orow[q] + j * 256 + lane * 4) = o; s2 += o.x * o.x + o.y * o.y + o.z * o.z + o.w * o.w; }
            if (l == 0) { s2 = wave_sum(s2); const float r2 = rsqrtf(s2 * (1.f / D) + 1e-6f); bf16_t* hrow = (bf16_t*)(c->ws + OFF_H) + (size_t)r * D;
#pragma unroll
                for (int j = 0; j < 4; ++j) { const float4 gg = *(const float4*)(c->norm_pre + D + j * 256 + lane * 4); const float4 o = v[q][j];
                    uint2 w; w.x = pk2(o.x * r2 * gg.x, o.y * r2 * gg.y); w.y = pk2(o.z * r2 * gg.z, o.w * r2 * gg.w);
                    *(uint2*)(hrow + j * 256 + lane * 4) = w; } } }
    }
}
namespace pg8 {
#define PG8_LAS __attribute__((address_space(3)))
typedef unsigned short bf16_t;
typedef short bf16x8 __attribute__((ext_vector_type(8)));
typedef float f32x4 __attribute__((ext_vector_type(4)));
typedef unsigned u32x4 __attribute__((ext_vector_type(4)));
constexpr int BM = 256, BK = 64, HALF = 128, HTB = HALF * BK * 2  , STAGE_BYTES = 8 * HTB, NXCD = 8, WGM = 8;

__host__ __device__ __forceinline__ int lds_byte(int r, int c) { const int st = (r >> 4) * 2 + (c >> 5), rr = r & 15, cc = c & 31, ob = rr * 64 + cc * 2; return st * 1024 + (ob ^ (((ob >> 9) & 1) << 5)); }
__host__ __device__ __forceinline__ void stage_rc(int b, int& R, int& C) { const int st = b / 1024, sb = b % 1024, swz = sb ^ (((sb >> 9) & 1) << 5); R = (st >> 1) * 16 + swz / 64; C = (st & 1) * 32 + (swz % 64) / 2; }
__host__ __device__ __forceinline__ int perm32(int rho) { const int n = rho >> 4, i = rho & 15; return 8 * (i >> 2) + 4 * n + (i & 3); }

struct Unit { int pm, pn; };
struct Gemm { const bf16_t* A; const bf16_t* Bt; int M, N, K, lda; };

struct StaticOrder {
    int nM, nN, nwg, G, c;
    __host__ __device__ void init(int M, int N, int G_, int c_) { nM = M / BM; nN = N / BM; nwg = nM * nN; G = G_; c = c_; }
    __host__ __device__ bool next(int i, Unit& u) const {
        const long L = (long)i * G + c; if (L >= nwg) return false;
        int wgid = (int)L; { const int q = nwg / NXCD, r = nwg % NXCD, xcd = wgid % NXCD, off = wgid / NXCD; wgid = (xcd < r ? xcd * (q + 1) : r * (q + 1) + (xcd - r) * q) + off; }
        const int nig = WGM * nN, gid = wgid / nig, fm = gid * WGM, gsz = (nM - fm) < WGM ? (nM - fm) : WGM;
        u.pm = fm + ((wgid % nig) % gsz); u.pn = (wgid % nig) / gsz; return true;
    }
    __device__ __forceinline__ void a_ready(const Unit&) const {}
    __device__ __forceinline__ void done(const Unit&) const {}
};

__device__ __forceinline__ unsigned cvt_pk_bf16(float lo, float hi) { unsigned r; asm volatile("v_cvt_pk_bf16_f32 %0, %1, %2" : "=v"(r) : "v"(lo), "v"(hi)); return r; }
typedef float f32x2 __attribute__((ext_vector_type(2)));
__device__ __forceinline__ f32x2 gelu_pk(f32x2 v) {
    const f32x2 av = __builtin_elementwise_abs(v), d = av * 0.2316418882f + 1.0f;
    f32x2 t; t.x = __builtin_amdgcn_rcpf(d.x); t.y = __builtin_amdgcn_rcpf(d.y);
    f32x2 q = t * 0.5307027145f + (-0.7265760135f); q = q * t + 0.7107068705f; q = q * t + (-0.142248368f); q = q * t + 0.127414796f; q = q * t;
    const f32x2 s = (v * v) * (-0.72134752044f);
    f32x2 e; e.x = __builtin_amdgcn_exp2f(s.x); e.y = __builtin_amdgcn_exp2f(s.y);
    const f32x2 m = v * (q * e), r = v - m;
    f32x2 o; o.x = v.x < 0.f ? m.x : r.x; o.y = v.y < 0.f ? m.y : r.y; return o;
}

template <int ACT  > struct EpiBf16 {
    static constexpr bool PERM = true, AFTER_DRAIN = false; static_assert(ACT == 0 || ACT == 1, "EpiBf16: ACT is 0 (none) or 1 (gelu_pk)");
    bf16_t* O; int ldc; const float* bias; int split_cols; size_t split_stride; float scale0; int rskip;
    __device__ __forceinline__ void operator()(const f32x4 (&acc)[2][2][4][2], const Unit& u, int wr, int wc, int fr, int fq) const {
        const int row0 = u.pm * BM + wr * 64 + fr + (u.pm >> 3) * rskip; int colt = u.pn * BM; bf16_t* base = O;
        float sc = 1.f; if (split_cols) { const int t = colt / split_cols; base += (size_t)t * split_stride; colt -= t * split_cols; if (t == 0) sc = scale0; }
        const int col0 = colt + wc * 32 + 8 * fq, bcol0 = u.pn * BM + wc * 32 + 8 * fq;
        f32x4 bv[2][2];
#pragma unroll
        for (int bj = 0; bj < 2; ++bj)
#pragma unroll
            for (int n = 0; n < 2; ++n) bv[bj][n] = bias ? *(const f32x4*)(bias + bcol0 + bj * HALF + 4 * n) : (f32x4){0.f, 0.f, 0.f, 0.f};
#pragma unroll
        for (int ai = 0; ai < 2; ++ai)
#pragma unroll
            for (int m = 0; m < 4; ++m) { bf16_t* rowp = base + (size_t)(row0 + ai * HALF + m * 16) * ldc + col0;
#pragma unroll
                for (int bj = 0; bj < 2; ++bj) { f32x4 v0 = acc[ai][bj][m][0] + bv[bj][0], v1 = acc[ai][bj][m][1] + bv[bj][1];
                    if (ACT == 1) { f32x2 a = gelu_pk((f32x2){v0[0], v0[1]}), b = gelu_pk((f32x2){v0[2], v0[3]}), c = gelu_pk((f32x2){v1[0], v1[1]}), d = gelu_pk((f32x2){v1[2], v1[3]});
                        v0 = (f32x4){a.x, a.y, b.x, b.y}; v1 = (f32x4){c.x, c.y, d.x, d.y}; }
                    v0 = v0 * sc; v1 = v1 * sc; u32x4 w; w.x = cvt_pk_bf16(v0[0], v0[1]); w.y = cvt_pk_bf16(v0[2], v0[3]); w.z = cvt_pk_bf16(v1[0], v1[1]); w.w = cvt_pk_bf16(v1[2], v1[3]);
                    *(u32x4*)(rowp + bj * HALF) = w; } }
    }
};


struct EpiF32 {
    static constexpr bool PERM = false, AFTER_DRAIN = false;
    float* O; int ldc;
    __device__ __forceinline__ void operator()(const f32x4 (&acc)[2][2][4][2], const Unit& u, int wr, int wc, int fr, int fq) const {
        const int row0 = u.pm * BM + wr * 64 + fr, col0 = u.pn * BM + wc * 32 + 4 * fq;
#pragma unroll
        for (int ai = 0; ai < 2; ++ai)
#pragma unroll
            for (int m = 0; m < 4; ++m) { float* rowp = O + (size_t)(row0 + ai * HALF + m * 16) * ldc + col0;
#pragma unroll
                for (int bj = 0; bj < 2; ++bj)
#pragma unroll
                    for (int n = 0; n < 2; ++n) *(f32x4*)(rowp + bj * HALF + n * 16) = acc[ai][bj][m][n]; }
    }
};
template <class Epi, class Sched, bool ALIGN_EPI, bool SP2, int KK, int LDA, int ASKIP>
__device__ __forceinline__ void gemm_phase(PG8_LAS unsigned char* lds, const Gemm g, const Sched& S, const Epi& E) {
    const int tid = otid(), wid = __builtin_amdgcn_readfirstlane(tid >> 6), lane = tid & 63, wr = wid >> 2, wc = wid & 3, fr = lane & 15, fq = lane >> 4;
    constexpr int K = KK, nt = K / BK;
    unsigned voffA[2], voffB[2];
#pragma unroll
    for (int i = 0; i < 2; ++i) { int R, C; stage_rc(tid * 16 + i * 8192, R, C); const int Rb = Epi::PERM ? ((R & ~31) + perm32(R & 31)) : R;
        voffA[i] = (unsigned)(R * LDA + C) * 2u; voffB[i] = (unsigned)(Rb * K + C) * 2u; }
    constexpr size_t kstep = (size_t)(BK * 2);
    constexpr size_t hstepA = (size_t)HALF * LDA * 2, hstepB = (size_t)HALF * K * 2;
    constexpr size_t tstepA = 2 * hstepA, tstepB = 2 * hstepB;
    const unsigned ldsw = (unsigned)wid * 1024u;
    const int aoff = lds_byte(wr * 64 + fr, fq * 8), boff = lds_byte(wc * 32 + fr, fq * 8);
#define PG8_SA(b, h) (((b) * 2 + (h)) * HTB)
#define PG8_SB(b, h) ((4 + (b) * 2 + (h)) * HTB)
#define PG8_STAGE(bufoff, gbase, voff) do { _Pragma("unroll") for (int _i = 0; _i < 2; ++_i) \
        __builtin_amdgcn_global_load_lds((const unsigned*)((const char*)(gbase) + (voff)[_i]), (PG8_LAS unsigned*)(lds + (bufoff) + ldsw + _i * 8192), 16, 0, 0); } while (0)
#define PG8_LDA(dst, b, h) do { _Pragma("unroll") for (int m = 0; m < 4; ++m) _Pragma("unroll") for (int k = 0; k < 2; ++k) dst[m][k] = *(const PG8_LAS bf16x8*)(lds + PG8_SA(b, h) + aoff + m * 2048 + k * 1024); } while (0)
#define PG8_LDB(dst, b, h) do { _Pragma("unroll") for (int n = 0; n < 2; ++n) _Pragma("unroll") for (int k = 0; k < 2; ++k) dst[n][k] = *(const PG8_LAS bf16x8*)(lds + PG8_SB(b, h) + boff + n * 2048 + k * 1024); } while (0)
#define PG8_MMA(ai, bj, At, Bt) do { __builtin_amdgcn_s_setprio(1); _Pragma("unroll") for (int m = 0; m < 4; ++m) _Pragma("unroll") for (int n = 0; n < 2; ++n) _Pragma("unroll") for (int k = 0; k < 2; ++k) \
        acc[ai][bj][m][n] = __builtin_amdgcn_mfma_f32_16x16x32_bf16(Bt[n][k], At[m][k], acc[ai][bj][m][n], 0, 0, 0); __builtin_amdgcn_s_setprio(0); } while (0)
#define PG8_WAIT_V(n) asm volatile("s_waitcnt vmcnt(" #n ")" ::: "memory")
#define PG8_WAIT_L(n) asm volatile("s_waitcnt lgkmcnt(" #n ")" ::: "memory")
#define PG8_BAR __builtin_amdgcn_s_barrier()
#define PG8_SCHED __builtin_amdgcn_sched_barrier(0)
    Unit cur, nxt; int ui = 0;
    if (!S.next(0, cur)) return;
    f32x4 acc[2][2][4][2];
#pragma unroll
    for (int a = 0; a < 2; ++a)
#pragma unroll
        for (int b = 0; b < 2; ++b)
#pragma unroll
            for (int m = 0; m < 4; ++m)
#pragma unroll
                for (int n = 0; n < 2; ++n) acc[a][b][m][n] = (f32x4){0.f, 0.f, 0.f, 0.f};
    bf16x8 At[4][2], B0[2][2], B1[2][2];
    const char* cA = (const char*)g.A + (size_t)cur.pm * tstepA + (size_t)(cur.pm >> 3) * (ASKIP * LDA * 2); const char* cB = (const char*)g.Bt + (size_t)cur.pn * tstepB;
    S.a_ready(cur);
    if constexpr (SP2) {
        PG8_STAGE(PG8_SB(0, 0), cB, voffB); PG8_STAGE(PG8_SB(0, 1), cB + hstepB, voffB); PG8_STAGE(PG8_SA(0, 0), cA, voffA); PG8_STAGE(PG8_SA(0, 1), cA + hstepA, voffA);
        if (wr == 1) PG8_BAR;
        PG8_WAIT_V(2); PG8_BAR;
        PG8_STAGE(PG8_SB(1, 0), cB + kstep, voffB); PG8_STAGE(PG8_SA(1, 0), cA + kstep, voffA); PG8_STAGE(PG8_SB(1, 1), cB + hstepB + kstep, voffB);
        PG8_WAIT_V(6); PG8_BAR;
    } else {
        PG8_STAGE(PG8_SB(0, 0), cB, voffB); PG8_STAGE(PG8_SA(0, 0), cA, voffA); PG8_STAGE(PG8_SB(0, 1), cB + hstepB, voffB); PG8_STAGE(PG8_SA(0, 1), cA + hstepA, voffA);
        if (wr == 1) PG8_BAR;
        PG8_WAIT_V(4); PG8_BAR;
        PG8_STAGE(PG8_SB(1, 0), cB + kstep, voffB); PG8_STAGE(PG8_SA(1, 0), cA + kstep, voffA); PG8_STAGE(PG8_SB(1, 1), cB + hstepB + kstep, voffB);
        PG8_WAIT_V(6); PG8_BAR;
    }
    for (;;) {
        const bool has_next = S.next(ui + 1, nxt);
        const char* nA = has_next ? (const char*)g.A + (size_t)nxt.pm * tstepA + (size_t)(nxt.pm >> 3) * (ASKIP * LDA * 2) : cA; const char* nB = has_next ? (const char*)g.Bt + (size_t)nxt.pn * tstepB : cB;
        for (int t = 0; t < nt; t += 2) {
            const bool last = (t == nt - 2);
            const char* a1 = cA + (size_t)(t + 1) * kstep;
            const char* a2 = last ? nA : cA + (size_t)(t + 2) * kstep; const char* b2 = last ? nB : cB + (size_t)(t + 2) * kstep;
            const char* a3 = a2 + kstep; const char* b3 = b2 + kstep;
            if (last && has_next) S.a_ready(nxt);
            if constexpr (SP2) {
            PG8_LDB(B0, 0, 0); PG8_LDB(B1, 0, 1); PG8_SCHED; PG8_LDA(At, 0, 0); PG8_STAGE(PG8_SA(1, 1), a1 + hstepA, voffA);
            PG8_WAIT_V(8); PG8_WAIT_L(0); PG8_BAR; PG8_MMA(0, 0, At, B0); PG8_MMA(0, 1, At, B1); PG8_BAR; PG8_SCHED;
            PG8_LDA(At, 0, 1); PG8_STAGE(PG8_SB(0, 0), b2, voffB); PG8_STAGE(PG8_SB(0, 1), b2 + hstepB, voffB); PG8_STAGE(PG8_SA(0, 0), a2, voffA);
            PG8_WAIT_V(8); PG8_WAIT_L(0); PG8_BAR; PG8_MMA(1, 0, At, B0); PG8_MMA(1, 1, At, B1); PG8_BAR; PG8_SCHED;
            PG8_LDB(B0, 1, 0); PG8_LDB(B1, 1, 1); PG8_SCHED; PG8_LDA(At, 1, 0); PG8_STAGE(PG8_SA(0, 1), a2 + hstepA, voffA);
            PG8_WAIT_V(8); PG8_WAIT_L(0); PG8_BAR; PG8_MMA(0, 0, At, B0); PG8_MMA(0, 1, At, B1); PG8_BAR; PG8_SCHED;
            PG8_LDA(At, 1, 1); PG8_STAGE(PG8_SB(1, 0), b3, voffB); PG8_STAGE(PG8_SB(1, 1), b3 + hstepB, voffB); PG8_STAGE(PG8_SA(1, 0), a3, voffA);
            PG8_WAIT_V(8); PG8_WAIT_L(0); PG8_BAR; PG8_MMA(1, 0, At, B0); PG8_MMA(1, 1, At, B1); PG8_BAR; PG8_SCHED;
            } else {
            PG8_LDB(B0, 0, 0); PG8_SCHED; PG8_LDA(At, 0, 0); PG8_STAGE(PG8_SA(1, 1), a1 + hstepA, voffA);
            PG8_WAIT_L(8); PG8_BAR; PG8_WAIT_L(0); PG8_MMA(0, 0, At, B0); PG8_BAR; PG8_SCHED;
            PG8_LDB(B1, 0, 1); PG8_STAGE(PG8_SB(0, 0), b2, voffB);
            PG8_BAR; PG8_WAIT_L(0); PG8_MMA(0, 1, At, B1); PG8_BAR;
            PG8_LDA(At, 0, 1); PG8_STAGE(PG8_SA(0, 0), a2, voffA);
            PG8_BAR; PG8_WAIT_L(0); PG8_MMA(1, 0, At, B0); PG8_BAR; PG8_SCHED;
            PG8_STAGE(PG8_SB(0, 1), b2 + hstepB, voffB);
            PG8_WAIT_V(6); PG8_BAR; PG8_MMA(1, 1, At, B1); PG8_BAR;
            PG8_LDB(B0, 1, 0); PG8_SCHED; PG8_LDA(At, 1, 0); PG8_STAGE(PG8_SA(0, 1), a2 + hstepA, voffA);
            PG8_WAIT_L(8); PG8_BAR; PG8_WAIT_L(0); PG8_MMA(0, 0, At, B0); PG8_BAR; PG8_SCHED;
            PG8_LDB(B1, 1, 1); PG8_STAGE(PG8_SB(1, 0), b3, voffB);
            PG8_BAR; PG8_WAIT_L(0); PG8_MMA(0, 1, At, B1); PG8_BAR;
            PG8_LDA(At, 1, 1); PG8_STAGE(PG8_SA(1, 0), a3, voffA);
            PG8_BAR; PG8_WAIT_L(0); PG8_MMA(1, 0, At, B0); PG8_BAR; PG8_SCHED;
            PG8_STAGE(PG8_SB(1, 1), b3 + hstepB, voffB);
            PG8_WAIT_V(6); PG8_BAR; PG8_MMA(1, 1, At, B1); PG8_BAR;
            }
        }
        if constexpr (ALIGN_EPI) { if (wr == 0) PG8_BAR; }
        if constexpr (!Epi::AFTER_DRAIN) { E(acc, cur, wr, wc, fr, fq); S.done(cur); }
        if (!has_next) break;
#pragma unroll
        for (int a = 0; a < 2; ++a)
#pragma unroll
            for (int b = 0; b < 2; ++b)
#pragma unroll
                for (int m = 0; m < 4; ++m)
#pragma unroll
                    for (int n = 0; n < 2; ++n) acc[a][b][m][n] = (f32x4){0.f, 0.f, 0.f, 0.f};
        cur = nxt; cA = nA; cB = nB; ++ui;
        if constexpr (ALIGN_EPI) { if (wr == 1) PG8_BAR; }
    }
    PG8_WAIT_V(0);
    if constexpr (!ALIGN_EPI) { if (wr == 0) PG8_BAR; }
    PG8_BAR;
    if constexpr (Epi::AFTER_DRAIN) { E.fused(acc, cur, wr, wc, fr, fq, lds, wid, lane); S.done(cur); }
#undef PG8_SA
#undef PG8_SB
#undef PG8_STAGE
#undef PG8_LDA
#undef PG8_LDB
#undef PG8_MMA
#undef PG8_WAIT_V
#undef PG8_WAIT_L
#undef PG8_BAR
#undef PG8_SCHED
}
}

#define XB_TMO      128
#define XB_XCNT(j)  (256  + 64 * (j))
#define XB_XSUB(j)  (1280 + 64 * (j))
#define XB_XGEN(j)  (2304 + 64 * (j))
#define XB_TOP      3328
#define XB_TOPGEN   3392
#define XCD_BAR_WORDS 3456
#define XB_SPIN_CAP (1u << 18)
DI unsigned xb_ld(unsigned* p)              { return __hip_atomic_load(p, __ATOMIC_RELAXED, __HIP_MEMORY_SCOPE_AGENT); }
DI unsigned xb_add(unsigned* p, unsigned v) { return __hip_atomic_fetch_add(p, v, __ATOMIC_RELAXED, __HIP_MEMORY_SCOPE_AGENT); }
DI unsigned xb_xcc_id() { return (unsigned)__builtin_amdgcn_s_getreg((3 << 11) | 20) & 0xFu; }
#define XB_SPIN(cond, bar) do { unsigned _sp = 0; while (cond) { __builtin_amdgcn_s_sleep(1); \
    if ((++_sp & 255u) == 0u) { if (xb_ld(&(bar)[XB_TMO])) break; if (_sp > XB_SPIN_CAP) { atomicAdd(&(bar)[XB_TMO], 1u); break; } } } } while (0)
struct XcdBarrier { unsigned* bar; unsigned x; volatile LAS unsigned* st; };
DI XcdBarrier xcd_barrier_post(unsigned* bar, volatile LAS unsigned* st) {
    XcdBarrier b; b.bar = bar; b.x = (unsigned)__builtin_amdgcn_readfirstlane((int)xb_xcc_id()); b.st = st;
    if (threadIdx.x == 0) (void)xb_add(&bar[XB_XCNT(b.x)], 1u);
    return b;
}
DI void xcd_barrier_complete(unsigned* bar, unsigned x, unsigned& nloc, unsigned& nx) {
    const unsigned Gd = gridDim.x * gridDim.y * gridDim.z;
    unsigned sum, cnt, mine, sp = 0u;
    for (;;) {
        sum = 0u; cnt = 0u; mine = 0u;
#pragma unroll
        for (unsigned j = 0; j < 16; ++j) { const unsigned cc = xb_ld(&bar[XB_XCNT(j)]); sum += cc; cnt += (cc > 0u) ? 1u : 0u; mine = (j == x) ? cc : mine; }
        if (sum == Gd) break;
        __builtin_amdgcn_s_sleep(1);
        if ((++sp & 255u) == 0u) { if (xb_ld(&bar[XB_TMO])) break; if (sp > XB_SPIN_CAP) { atomicAdd(&bar[XB_TMO], 1u); break; } }
    }
    nloc = mine > 0u ? mine : 1u; nx = cnt > 0u ? cnt : 1u;
}
DI void xcd_barrier(const XcdBarrier& b) {
    asm volatile("s_waitcnt vmcnt(0)" ::: "memory");
    __syncthreads();
    if (threadIdx.x == 0) {
        unsigned* bar = b.bar; unsigned bx = b.x; asm volatile("" : "+s"(bar), "+s"(bx));
        __builtin_amdgcn_s_waitcnt(0);
        unsigned nloc = b.st[0], nx = b.st[1];
        if (nloc == 0u) { xcd_barrier_complete(bar, bx, nloc, nx); b.st[0] = nloc; b.st[1] = nx; }
        const unsigned old = xb_add(&bar[XB_XSUB(bx)], 1u);
        const unsigned gen = old / nloc;
        if (old + 1u == (gen + 1u) * nloc) {
            __builtin_amdgcn_fence(__ATOMIC_RELEASE, "agent");
            asm volatile("s_waitcnt vmcnt(0)" ::: "memory");
            const unsigned og = xb_add(&bar[XB_TOP], 1u);
            const unsigned tg = og / nx;
            if (og + 1u == (tg + 1u) * nx) xb_add(&bar[XB_TOPGEN], 1u);
            else XB_SPIN(xb_ld(&bar[XB_TOPGEN]) == tg, bar);
            __builtin_amdgcn_fence(__ATOMIC_ACQUIRE, "agent");
            xb_add(&bar[XB_XGEN(bx)], 1u);
            asm volatile("s_waitcnt vmcnt(0)" ::: "memory");
        } else {
            XB_SPIN(xb_ld(&bar[XB_XGEN(bx)]) == gen, bar);
            __builtin_amdgcn_fence(__ATOMIC_ACQUIRE, "agent");
            asm volatile("s_waitcnt vmcnt(0)" ::: "memory");
        }
    }
    __syncthreads();
}
constexpr int LDS_BYTES = 163840, MISC_OFF = 155648 + 320, CW_BAR = 4096;
__global__ void __launch_bounds__(512) mk_fwd(Ctx c_byval) {
    CtxP c = (CtxP)__builtin_amdgcn_kernarg_segment_ptr();
    extern __shared__ __attribute__((aligned(16))) unsigned char ldsraw[];
    float* lds = (float*)ldsraw;
    const int tid = threadIdx.x, bid = blockIdx.x, nblk = gridDim.x;
    volatile LAS unsigned* MISC = (volatile LAS unsigned*)((LAS unsigned char*)ldsraw + MISC_OFF);
    if (tid < 32) MISC[tid] = 0u;
    if ((tid & 63) == 0) ((volatile LAS int*)(unsigned long)WVTAB_OFF)[hw_slot()] = tid >> 6;
    __syncthreads();
    XcdBarrier bar = xcd_barrier_post((unsigned*)(c->ws + OFF_CTL) + CW_BAR, MISC + 8);
    s_p0(c, 0, 0, lds, bid, nblk);
    s_prenorm(c, 0, 0, lds, bid, nblk);
    xcd_barrier(bar);
    for (int slab_ = 0; slab_ < 2; ++slab_)
        for (int l_ = 0; l_ < NL; ++l_) {
            int l = l_, slab = slab_; asm volatile("" : "+s"(l), "+s"(slab));
            { const bf16_t* halo = (const bf16_t*)(c->ws + OFF_CARRY + l * CARRY_L + HALO_OFF); bf16_t* pp = (bf16_t*)(c->ws + OFF_P);
              for (int i = bid * 512 + otid(); i < NB * 3 * PP; i += nblk * 512) { const int b = i / (3 * PP), r = (i / PP) % 3, col = i % PP; pp[prow_off(b, r - 3) + col] = slab == 0 ? (bf16_t)0 : halo[i]; } }
            { pg8::Gemm g{(const bf16_t*)(c->ws + OFF_H), (const bf16_t*)(c->ws + OFF_WIN + l * WIN_L), MS, PP, D, D}; pg8::StaticOrder S; S.init(MS, PP, nblk, bid);
              pg8::EpiBf16<0> E{(bf16_t*)(c->ws + OFF_P) + 3 * PP, PP, nullptr, 0, 0, 1.f, 3};
              pg8::gemm_phase<pg8::EpiBf16<0>, pg8::StaticOrder, true, true, D, D, 0>((LAS unsigned char*)ldsraw, g, S, E); }
            xcd_barrier(bar);
            s_phase2(c, l, slab, lds, bid, nblk);
            xcd_barrier(bar);
            s_stepB(c, l, slab, lds, bid, nblk);
            xcd_barrier(bar);
            s_phase3c(c, l, slab, lds, bid, nblk); __syncthreads();
            if (nblk == 256) s_bscan(c, l, slab, lds, bid);
            xcd_barrier(bar);
            s_bpost(c, l, slab, lds, bid, nblk);
            xcd_barrier(bar);
            { pg8::Gemm g{(const bf16_t*)(c->ws + OFF_P) + 3 * PP + ZA, (const bf16_t*)(c->ws + OFF_WOUT + l * WOUT_L), MS, D, DMIX, PP}; pg8::StaticOrder S; S.init(MS, D, nblk, bid);
              pg8::EpiF32 E{(float*)(c->ws + OFF_Y), D};
              pg8::gemm_phase<pg8::EpiF32, pg8::StaticOrder, true, true, DMIX, PP, 3>((LAS unsigned char*)ldsraw, g, S, E); }
            xcd_barrier(bar);
            s_post(c, l, slab, lds, bid, nblk);
            if (l == 1 && slab == 0) s_prenorm(c, 0, 1, lds, bid, nblk);
            xcd_barrier(bar);
        }
}

extern "C" void kernel_launch(void* const* d_in, const int* in_sizes, int n_in, void* d_out, int out_size, void* d_ws, size_t ws_size, hipStream_t stream) {
    static int grid = 0;
    if (grid == 0) {
        int dev = 0, cus = 0, per_cu = 0;
        (void)hipGetDevice(&dev);
        (void)hipDeviceGetAttribute(&cus, hipDeviceAttributeMultiprocessorCount, dev);
        (void)hipFuncSetAttribute((const void*)mk_fwd, hipFuncAttributeMaxDynamicSharedMemorySize, LDS_BYTES);
        (void)hipOccupancyMaxActiveBlocksPerMultiprocessor(&per_cu, (const void*)mk_fwd, 512, LDS_BYTES);
        if (per_cu < 1) { fprintf(stderr, "kernel_launch: occupancy query says %d blocks/CU\n", per_cu); per_cu = 1; }
        grid = cus;
        if (grid != 256) fprintf(stderr, "kernel_launch: %d CUs (built for 256)\n", grid);
    }
    Ctx c{};
    const float** f = (const float**)&c;
    for (int i = 0; i < 28; ++i) f[i] = (const float*)d_in[i];
    c.out = (float*)d_out; c.ws = (unsigned char*)d_ws;
    (void)hipMemsetAsync(d_ws, 0, 1 * MiB, stream);
    void* args[] = {&c};
    hipError_t e = hipLaunchCooperativeKernel((const void*)mk_fwd, dim3(grid), dim3(512), args, LDS_BYTES, stream);
    if (e != hipSuccess) fprintf(stderr, "cooperative launch failed: %s (grid %d)\n", hipGetErrorString(e), grid);
}
```

```cpp
#include <hip/hip_runtime.h>
#include <cstdint>
#include <cstdio>

typedef unsigned short bf16_t;
#define DI __device__ __forceinline__
#define LAS __attribute__((address_space(3)))

constexpr int NB = 4, T = 4096, D = 1024, NL = 2, G = 512, NH = 8;
constexpr int TS = 2048, MS = NB * TS, NCS = TS / 64, TSP = TS + 3;
constexpr int DIN = 7824, PP = 7936, DMIX = 2048;
constexpr int A_Q = 0, A_K = 512, A_V = 1024, A_O = 1536, B_R = 2048, B_K = 2560, B_V = 3072, B_WLO = 3584, B_ALO = 3648, C_X = 3712,
              D_Q = 4224, D_K = 4736, D_V = 5248, ZA = 5760, ZB = 6272, ZC = 6784, ZD = 7296, A_I = 7808, A_F = 7816;
constexpr size_t MiB = 1u << 20;
constexpr size_t OFF_CTL = 0, OFF_ZROW = 512 * 1024, OFF_WIN = 1 * MiB, OFF_WOUT = 32 * MiB, OFF_ROPE = 40 * MiB, OFF_CARRY = 41 * MiB,
                 OFF_LS = 45 * MiB, OFF_BON = 45 * MiB + 512 * 1024, OFF_P = 45 * MiB + 768 * 1024, OFF_SA = 170 * MiB, OFF_H = 170 * MiB,
                 OFF_SD = 170 * MiB + 17301504, OFF_CK = 203 * MiB, OFF_Y = 203 * MiB, OFF_Y2 = 235 * MiB,
                 OFF_WRT = 251 * MiB, OFF_WIT = OFF_WRT + 262144, OFF_WUT = OFF_WIT + 262144, OFF_AUT = OFF_WUT + 262144;
constexpr size_t WIN_L = (size_t)PP * D * 2, WOUT_L = (size_t)D * DMIX * 2;
constexpr size_t CARRY_L = 2 * MiB, CA_OFF = 0, CD_OFF = 540672, CB_OFF = CD_OFF + 524288, CC_OFF = CB_OFF + 524288, HALO_OFF = CC_OFF + 8192;
constexpr int SAU = 4224;

struct Ctx {
    const float *x, *norm_pre, *norm_post, *w_in, *w_out, *mconv_w, *mconv_b, *mi_bias, *mf_bias, *mnorm_w, *rmu, *rw_up, *rw0, *ra_up, *ra0,
        *rk_k, *rk_a, *rr_k, *rgn_w, *rgn_b, *lconv_w, *lconv_b, *lw_r, *lb_r, *lw_i, *lb_i, *llam, *retnorm_w;
    float* out; unsigned char* ws;
};
typedef const __attribute__((address_space(4))) Ctx* CtxP;


constexpr int WVTAB_OFF = 155648 + 512;
DI int hw_slot() { return __builtin_amdgcn_s_getreg((5 << 11) | 4) & 63; }
DI int otid() { int lane; asm volatile("v_mbcnt_lo_u32_b32 %0, -1, 0\n\tv_mbcnt_hi_u32_b32 %0, -1, %0" : "=v"(lane));
    const int wv = __builtin_amdgcn_readfirstlane(((volatile LAS int*)(unsigned long)WVTAB_OFF)[hw_slot()]);
    int t = (wv << 6) | lane; asm volatile("" : "+v"(t)); return t; }
DI size_t prow_off(int b, int tl) { return (size_t)(b * TSP + 3 + tl) * PP; }
DI float bf2f(bf16_t v) { return __uint_as_float(((unsigned)v) << 16); }
DI bf16_t f2bf(float f) { unsigned u = __float_as_uint(f); u += 0x7fffu + ((u >> 16) & 1u); return (bf16_t)(u >> 16); }
DI float sigm(float x) { return __builtin_amdgcn_rcpf(1.f + __expf(-x)); }
DI float siluf(float x) { return x * __builtin_amdgcn_rcpf(1.f + __expf(-x)); }
DI float softplusf(float x) { return fmaxf(x, 0.f) + log1pf(expf(-fabsf(x))); }
DI float wave_sum(float v) {
#pragma unroll
    for (int o = 1; o < 64; o <<= 1) v += __shfl_xor(v, o);
    return v;
}
DI int srccol(int n) {
    if (n < 2048) return n;
    if (n < 3712) return n + 528;
    if (n < 4224) return n + 1040;
    if (n < 5760) return n + 1552;
    if (n < 6272) return n - 3712;
    if (n < 6784) return n - 2032;
    if (n < 7296) return n - 1520;
    if (n < 7808) return n + 16;
    if (n < 7824) return n - 5248;
    return -1;
}
DI void wt_item(const float* W, int K, int N, bf16_t* WT, bool permute, float* scr, int item, int lane, bool ksplit = false) {
    const int nblk = (permute ? PP : N) / 32, kb = item / nblk, nb = item % nblk, k0 = 64 * kb, n0 = 32 * nb;
    const int nn = n0 + (lane & 31); const int sc = permute ? srccol(nn) : nn;
    for (int i = 0; i < 32; ++i) { const int kk = 2 * i + (lane >> 5); scr[kk * 33 + (lane & 31)] = sc >= 0 ? W[(size_t)(k0 + kk) * N + sc] : 0.f; }
    __builtin_amdgcn_s_waitcnt(0); __builtin_amdgcn_wave_barrier();
    const int c = lane & 7;
    for (int j = 0; j < 4; ++j) { const int n = (lane >> 3) + 8 * j; const float* s = scr + (8 * c) * 33 + n;
        uint4 o; o.x = f2bf(s[0]) | ((unsigned)f2bf(s[33]) << 16); o.y = f2bf(s[66]) | ((unsigned)f2bf(s[99]) << 16);
        o.z = f2bf(s[132]) | ((unsigned)f2bf(s[165]) << 16); o.w = f2bf(s[198]) | ((unsigned)f2bf(s[231]) << 16);
        if (ksplit) *(uint4*)(WT + (size_t)((k0 >> 10) * N + n0 + n) * (K / 2) + (k0 & 1023) + 8 * c) = o;
        else *(uint4*)(WT + (size_t)(n0 + n) * K + k0 + 8 * c) = o; }
    __builtin_amdgcn_s_waitcnt(0); __builtin_amdgcn_wave_barrier();
}
DI void s_p0(CtxP c, int l, int slab, float* lds, int bid, int nblk) {
    const int tid = otid(), lane = tid & 63, wave = tid >> 6;
    float* scr = lds + wave * (64 * 33);
    const int gw = bid * 8 + wave, NGW = nblk * 8;
    constexpr int I_IN = (D / 64) * (PP / 32), I_OUT = (DMIX / 64) * (D / 32);
    for (int it = gw; it < NL * (I_IN + I_OUT); it += NGW) {
        const int l = it / (I_IN + I_OUT); int r = it % (I_IN + I_OUT);
        if (r < I_IN) wt_item(c->w_in + (size_t)l * D * DIN, D, DIN, (bf16_t*)(c->ws + OFF_WIN + l * WIN_L), true, scr, r, lane);
        else wt_item(c->w_out + (size_t)l * DMIX * D, DMIX, D, (bf16_t*)(c->ws + OFF_WOUT + l * WOUT_L), false, scr, r - I_IN, lane, true);
    }
    { bf16_t* wrt = (bf16_t*)(c->ws + OFF_WRT); bf16_t* wit = (bf16_t*)(c->ws + OFF_WIT); bf16_t* wut = (bf16_t*)(c->ws + OFF_WUT); bf16_t* aut = (bf16_t*)(c->ws + OFF_AUT);
      for (int i = bid * 512 + tid; i < NL * NH * 4096; i += nblk * 512) { const int lh = i >> 12, j = (i >> 6) & 63, ii = i & 63;
          wrt[i] = f2bf(c->lw_r[(size_t)lh * 4096 + ii * 64 + j]); wit[i] = f2bf(c->lw_i[(size_t)lh * 4096 + ii * 64 + j]); }
      for (int i = bid * 512 + tid; i < NL * G * 64; i += nblk * 512) { const int l2 = i / (G * 64), j = (i >> 6) % G, ii = i & 63;
          wut[i] = f2bf(c->rw_up[(size_t)l2 * 64 * G + ii * G + j]); aut[i] = f2bf(c->ra_up[(size_t)l2 * 64 * G + ii * G + j]); } }
    float* rope = (float*)(c->ws + OFF_ROPE);
    for (int i = bid * 512 + tid; i < T * 32; i += nblk * 512) {
        const int t = i >> 5, j = i & 31; const float inv = powf(10000.f, -(float)j / 32.f); const float ang = (float)t * inv;
        rope[2 * i] = cosf(ang); rope[2 * i + 1] = sinf(ang);
    }
}
DI void norm_row(const float* xrow, const float* g, bf16_t* hrow, int lane) {
    float4 v[4]; float ss = 0.f;
#pragma unroll
    for (int j = 0; j < 4; ++j) { v[j] = *(const float4*)(xrow + j * 256 + lane * 4); ss += v[j].x * v[j].x + v[j].y * v[j].y + v[j].z * v[j].z + v[j].w * v[j].w; }
    ss = wave_sum(ss); const float rs = rsqrtf(ss * (1.f / D) + 1e-6f);
#pragma unroll
    for (int j = 0; j < 4; ++j) { const float4 gg = *(const float4*)(g + j * 256 + lane * 4);
        uint2 o; o.x = f2bf(v[j].x * rs * gg.x) | ((unsigned)f2bf(v[j].y * rs * gg.y) << 16); o.y = f2bf(v[j].z * rs * gg.z) | ((unsigned)f2bf(v[j].w * rs * gg.w) << 16);
        *(uint2*)(hrow + j * 256 + lane * 4) = o; }
}
DI void s_prenorm(CtxP c, int l, int slab, float* lds, int bid, int nblk) {
    const int lane = otid() & 63, gw = bid * 8 + (otid() >> 6), NGW = nblk * 8;
    for (int r = gw; r < MS; r += NGW) { const int b = r / TS, tl = r % TS; const size_t grow = (size_t)b * T + slab * TS + tl;
        norm_row(c->x + grow * D, c->norm_pre, (bf16_t*)(c->ws + OFF_H) + (size_t)r * D, lane); }
}
DI float ret_logg(int h) { return log1pf(-exp2f(-5.f - (float)h)); }
DI void s_stepB(CtxP c, int l, int slab, float* lds, int bid, int nblk) {
    const int tid = otid();
    for (int item = bid; item < 288 + 256 + 4; item += nblk) {
        if (item < 288) {
            const int bh = item / 9, part = item % 9, el = part * 512 + tid; const bool on = el < 4160;
            float* CA = (float*)(c->ws + OFF_CARRY + l * CARRY_L + CA_OFF) + (size_t)bh * SAU; float* S0 = (float*)(c->ws + OFF_SA) + (size_t)(bh * NCS) * SAU;
            float m = slab == 0 ? 0.f : CA[4160 + slab - 1]; float val = (slab == 0 || !on) ? 0.f : CA[el];
            float loc[NCS], ml[NCS], tt[NCS];
#pragma unroll
            for (int cl = 0; cl < NCS; ++cl) { const float* S = S0 + (size_t)cl * SAU; ml[cl] = S[4160]; tt[cl] = S[4161]; loc[cl] = on ? S[el] : 0.f; }
#pragma unroll
            for (int cl = 0; cl < NCS; ++cl) { float* S = S0 + (size_t)cl * SAU;
                if (on) S[el] = val;
                if (el == 0) S[4162] = m;
                const float mn = fmaxf(tt[cl] + m, ml[cl]); val = expf(tt[cl] + m - mn) * val + expf(ml[cl] - mn) * loc[cl]; m = mn; }
            if (on) CA[el] = val;
            if (el == 0) CA[4160 + slab] = m;
        } else if (item < 288 + 256) {
            const int it = item - 288, bh = it / 8, el = (it % 8) * 512 + tid; const float gch = expf(ret_logg(bh % NH) * 64.f);
            float* CD = (float*)(c->ws + OFF_CARRY + l * CARRY_L + CD_OFF) + (size_t)bh * 4096; float* S0 = (float*)(c->ws + OFF_SD) + (size_t)(bh * NCS) * 4096;
            float val = slab == 0 ? 0.f : CD[el]; float loc[NCS];
#pragma unroll
            for (int cl = 0; cl < NCS; ++cl) loc[cl] = S0[(size_t)cl * 4096 + el];
#pragma unroll
            for (int cl = 0; cl < NCS; ++cl) { S0[(size_t)cl * 4096 + el] = val; val = gch * val + loc[cl]; }
            CD[el] = val;
        } else {
            const int i = (item - 544) * 512 + tid, b = i / G, ch = i % G; float* CC = (float*)(c->ws + OFF_CARRY + l * CARRY_L + CC_OFF);
            float hc = slab == 0 ? 0.f : CC[i]; float2 v[NCS];
#pragma unroll
            for (int cl = 0; cl < NCS; ++cl) v[cl] = *(const float2*)((const float*)(c->ws + OFF_LS) + ((size_t)(b * NCS + cl) * G + ch) * 2);
#pragma unroll
            for (int cl = 0; cl < NCS; ++cl) { ((float*)(c->ws + OFF_LS))[((size_t)(b * NCS + cl) * G + ch) * 2] = hc; hc = v[cl].x * hc + v[cl].y; }
            CC[i] = hc;
        }
    }
}
typedef short bf16x8 __attribute__((ext_vector_type(8)));
typedef float f32x16 __attribute__((ext_vector_type(16)));
typedef float f32x2_t __attribute__((ext_vector_type(2)));
typedef __bf16 bf16x2_t __attribute__((ext_vector_type(2)));
DI unsigned pk2(float lo, float hi) { f32x2_t v = {lo, hi}; bf16x2_t b = __builtin_convertvector(v, bf16x2_t); return __builtin_bit_cast(unsigned, b); }
DI bf16x8 pack8(const float* v) { uint4 u; u.x = pk2(v[0], v[1]); u.y = pk2(v[2], v[3]); u.z = pk2(v[4], v[5]); u.w = pk2(v[6], v[7]); return __builtin_bit_cast(bf16x8, u); }
DI void unpack8(uint4 u, float* v) { v[0] = __uint_as_float(u.x << 16); v[1] = __uint_as_float(u.x & 0xffff0000u); v[2] = __uint_as_float(u.y << 16); v[3] = __uint_as_float(u.y & 0xffff0000u);
    v[4] = __uint_as_float(u.z << 16); v[5] = __uint_as_float(u.z & 0xffff0000u); v[6] = __uint_as_float(u.w << 16); v[7] = __uint_as_float(u.w & 0xffff0000u); }
#define MFMA32(a, b, c) __builtin_amdgcn_mfma_f32_32x32x16_bf16((a), (b), (c), 0, 0, 0)
#define WSYNC() do { __builtin_amdgcn_fence(__ATOMIC_RELEASE, "wavefront"); __builtin_amdgcn_wave_barrier(); __builtin_amdgcn_fence(__ATOMIC_ACQUIRE, "wavefront"); } while (0)
DI float wave_psum(float v, int lane) {
#pragma unroll
    for (int o = 1; o < 64; o <<= 1) { const float t = __shfl_up(v, o); if (lane >= o) v += t; }
    return v;
}
DI float wave_pmax(float v, int lane) {
#pragma unroll
    for (int o = 1; o < 64; o <<= 1) { const float t = __shfl_up(v, o); if (lane >= o) v = fmaxf(v, t); }
    return v;
}
DI float wave_max(float v) {
#pragma unroll
    for (int o = 1; o < 64; o <<= 1) v = fmaxf(v, __shfl_xor(v, o));
    return v;
}
constexpr int TP = 144;
constexpr int WLDS = 19456;
#define TILE_K(NR) (((NR) * 8 + 63) / 64)
typedef unsigned u32x4 __attribute__((ext_vector_type(4)));
template <int NR> DI void tile_load(u32x4 (&tv)[TILE_K(NR)], const bf16_t* rb  , int tl_first, int col, int lane) {
#pragma unroll
    for (int k = 0; k < (NR * 8 + 63) / 64; ++k) { const int i = lane + 64 * k; int r = i >> 3; r = r < NR ? r : NR - 1; const int ch = i & 7;
        tv[k] = *(const u32x4*)(rb + (tl_first + r) * PP + col + ch * 8); }
}
template <int NR> DI void tile_store(const u32x4 (&tv)[TILE_K(NR)], unsigned char* tile, int lane) {
#pragma unroll
    for (int k = 0; k < (NR * 8 + 63) / 64; ++k) { const int i = lane + 64 * k; const int r = i >> 3, ch = i & 7;
        if (i < NR * 8) *(u32x4*)(tile + r * TP + ch * 16) = tv[k]; }
    WSYNC();
}
DI void proc_conv_tile(unsigned char* tile, const float* cw, int cws, const float* cb, float scale, int lane) {
    const int ch = lane & 7; float w[4][8], bb[8];
#pragma unroll
    for (int t = 0; t < 4; ++t) { const float4 a = *(const float4*)(cw + t * cws + ch * 8), d = *(const float4*)(cw + t * cws + ch * 8 + 4);
        w[t][0] = a.x; w[t][1] = a.y; w[t][2] = a.z; w[t][3] = a.w; w[t][4] = d.x; w[t][5] = d.y; w[t][6] = d.z; w[t][7] = d.w; }
    { const float4 a = *(const float4*)(cb + ch * 8), d = *(const float4*)(cb + ch * 8 + 4); bb[0] = a.x; bb[1] = a.y; bb[2] = a.z; bb[3] = a.w; bb[4] = d.x; bb[5] = d.y; bb[6] = d.z; bb[7] = d.w; }
#pragma unroll
    for (int k = 0; k < 8; ++k) { const int row = (lane >> 3) + 8 * k; float acc[8];
#pragma unroll
        for (int i = 0; i < 8; ++i) acc[i] = bb[i];
#pragma unroll
        for (int t = 0; t < 4; ++t) { float x[8]; unpack8(*(const uint4*)(tile + (row + t) * TP + ch * 16), x);
#pragma unroll
            for (int i = 0; i < 8; ++i) acc[i] += x[i] * w[t][i]; }
#pragma unroll
        for (int i = 0; i < 8; ++i) acc[i] = siluf(acc[i]) * scale;
        const bf16x8 res = pack8(acc); WSYNC();
        *(bf16x8*)(tile + row * TP + ch * 16) = res; }
    WSYNC();
}
DI void proc_rope_tile(unsigned char* tile, const float* ropet, int pos0, float scale, int lane) {
    const int p = lane & 3;
#pragma unroll
    for (int k = 0; k < 4; ++k) { const int row = (lane >> 2) + 16 * k; float x1[8], x2[8], o1[8], o2[8];
        unpack8(*(const uint4*)(tile + row * TP + p * 16), x1); unpack8(*(const uint4*)(tile + row * TP + (p + 4) * 16), x2);
        const float* cs = ropet + ((size_t)(pos0 + row) * 32 + p * 8) * 2;
#pragma unroll
        for (int q = 0; q < 4; ++q) { const float4 v = *(const float4*)(cs + 4 * q);
            o1[2 * q] = (x1[2 * q] * v.x - x2[2 * q] * v.y) * scale; o2[2 * q] = (x2[2 * q] * v.x + x1[2 * q] * v.y) * scale;
            o1[2 * q + 1] = (x1[2 * q + 1] * v.z - x2[2 * q + 1] * v.w) * scale; o2[2 * q + 1] = (x2[2 * q + 1] * v.z + x1[2 * q + 1] * v.w) * scale; }
        *(bf16x8*)(tile + row * TP + p * 16) = pack8(o1); *(bf16x8*)(tile + row * TP + (p + 4) * 16) = pack8(o2); asm volatile("" ::: "memory"); }
    WSYNC();
}
DI bf16x8 frag_nat(const unsigned char* tile, int row, int ch) { return *(const bf16x8*)(tile + row * TP + ch * 16); }
DI float tile_at(const unsigned char* tile, int row, int col) { return bf2f(*(const bf16_t*)(tile + row * TP + col * 2)); }

template <bool RET> DI void w_chunkA(CtxP c, int l, int slab, int u, unsigned char* wl, int lane) {
    const int bh = u / NCS, cl = u % NCS, b = bh >> 3, h = bh & 7, tl0 = cl * 64, hs = lane >> 5, li = lane & 31;
    unsigned char* tile = wl; float* tab = (float*)(wl + 9728); const bf16_t* rb = (const bf16_t*)(c->ws + OFF_P) + prow_off(b, 0);
    float* S = RET ? (float*)(c->ws + OFF_SD) + (size_t)u * 4096 : (float*)(c->ws + OFF_SA) + (size_t)u * SAU;
    float mloc = 0.f, tot = 0.f;
    u32x4 rk64[TILE_K(64)], rv64[TILE_K(64)], rk67[TILE_K(67)];
    if (RET) tile_load<64>(rk64, rb, tl0, D_K + h * 64, lane); else tile_load<67>(rk67, rb, tl0 - 3, A_K + h * 64, lane);
    tile_load<64>(rv64, rb, tl0, (RET ? D_V : A_V) + h * 64, lane);
    if (RET) { tab[lane] = expf(ret_logg(h) * (float)(63 - lane)); }
    else { const bf16_t* gr = (const bf16_t*)(c->ws + OFF_P) + prow_off(b, tl0 + lane);
        const float ig = bf2f(gr[A_I + h]) + c->mi_bias[l * NH + h]; const float lf = -softplusf(-(bf2f(gr[A_F + h]) + c->mf_bias[l * NH + h]));
        const float cum = wave_psum(lf, lane); tot = __shfl(cum, 63); const float lw = tot - cum + ig; mloc = wave_max(lw); tab[lane] = expf(lw - mloc); }
    if (RET) { tile_store<64>(rk64, tile, lane); proc_rope_tile(tile, (const float*)(c->ws + OFF_ROPE), slab * TS + tl0, 0.125f, lane); }
    else { tile_store<67>(rk67, tile, lane); proc_conv_tile(tile, c->mconv_w + l * 4096 + 512 + h * 64, 1024, c->mconv_b + l * 1024 + 512 + h * 64, 0.125f, lane); }
    bf16x8 kf[2][4]; float nl[2] = {0.f, 0.f};
#pragma unroll
    for (int db = 0; db < 2; ++db)
#pragma unroll
        for (int ks = 0; ks < 4; ++ks) { float v[8];
#pragma unroll
            for (int j = 0; j < 8; ++j) { const int t = 16 * ks + 8 * hs + j; v[j] = tile_at(tile, t, 32 * db + li); nl[db] += tab[t] * v[j]; }
            kf[db][ks] = pack8(v); }
    WSYNC();
    tile_store<64>(rv64, tile, lane);
    f32x16 acc[2][2];
#pragma unroll
    for (int eb = 0; eb < 2; ++eb)
#pragma unroll
        for (int db = 0; db < 2; ++db)
#pragma unroll
            for (int r = 0; r < 16; ++r) acc[eb][db][r] = 0.f;
#pragma unroll
    for (int eb = 0; eb < 2; ++eb)
#pragma unroll
        for (int ks = 0; ks < 4; ++ks) { float v[8];
#pragma unroll
            for (int j = 0; j < 8; ++j) { const int t = 16 * ks + 8 * hs + j; v[j] = tile_at(tile, t, 32 * eb + li) * tab[t]; }
            const bf16x8 vf = pack8(v);
#pragma unroll
            for (int db = 0; db < 2; ++db) acc[eb][db] = MFMA32(vf, kf[db][ks], acc[eb][db]); }
#pragma unroll
    for (int eb = 0; eb < 2; ++eb)
#pragma unroll
        for (int db = 0; db < 2; ++db)
#pragma unroll
            for (int r = 0; r < 16; ++r) S[(32 * eb + (r & 3) + 8 * (r >> 2) + 4 * hs) * 64 + 32 * db + li] = acc[eb][db][r];
    if (!RET) {
#pragma unroll
        for (int db = 0; db < 2; ++db) { nl[db] += __shfl_xor(nl[db], 32); if (hs == 0) S[4096 + 32 * db + li] = nl[db]; }
        if (lane == 0) { S[4160] = mloc; S[4161] = tot; } }
    WSYNC();
}
template <bool RET> DI void w_chunkC(CtxP c, int l, int slab, int u, unsigned char* wl, int lane) {
    const int bh = u / NCS, cl = u % NCS, b = bh >> 3, h = bh & 7, tl0 = cl * 64, hs = lane >> 5, li = lane & 31;
    unsigned char* tile = wl; float* tab = (float*)(wl + 9728); const bf16_t* rb = (const bf16_t*)(c->ws + OFF_P) + prow_off(b, 0);
    const float* S = RET ? (const float*)(c->ws + OFF_SD) + (size_t)u * 4096 : (const float*)(c->ws + OFF_SA) + (size_t)u * SAU;
    const float lg = RET ? ret_logg(h) : 0.f;
    float mx_t[2] = {0.f, 0.f}, sc_t[2], dnf_t[2] = {0.f, 0.f};
    if (RET) { sc_t[0] = expf(lg * (float)(li + 1)); sc_t[1] = expf(lg * (float)(li + 33)); }
    else { const bf16_t* gr = (const bf16_t*)(c->ws + OFF_P) + prow_off(b, tl0 + lane);
        const float ig = bf2f(gr[A_I + h]) + c->mi_bias[l * NH + h]; const float lf = -softplusf(-(bf2f(gr[A_F + h]) + c->mf_bias[l * NH + h]));
        const float cum = wave_psum(lf, lane); const float a = ig - cum; const float g = wave_pmax(a, lane);
        const float mst = S[4162]; const float mx = fmaxf(mst, g); const float sint = expf(mst - mx); const float dnf = expf(-(cum + mx));
        tab[lane] = a;
        mx_t[0] = __shfl(mx, li); mx_t[1] = __shfl(mx, 32 + li); sc_t[0] = __shfl(sint, li); sc_t[1] = __shfl(sint, 32 + li); dnf_t[0] = __shfl(dnf, li); dnf_t[1] = __shfl(dnf, 32 + li); }
    u32x4 rk64[TILE_K(64)], rq64[TILE_K(64)], rv64[TILE_K(64)], rk67[TILE_K(67)], rq67[TILE_K(67)];
    if (RET) { tile_load<64>(rk64, rb, tl0, D_K + h * 64, lane); tile_load<64>(rq64, rb, tl0, D_Q + h * 64, lane); }
    else { tile_load<67>(rk67, rb, tl0 - 3, A_K + h * 64, lane); tile_load<67>(rq67, rb, tl0 - 3, A_Q + h * 64, lane); }
    bf16x8 kf[2][4], qf[2][4], cf[2][4];
#pragma unroll
    for (int eb = 0; eb < 2; ++eb)
#pragma unroll
        for (int ks = 0; ks < 4; ++ks) { const float* cp = S + (32 * eb + li) * 64 + 16 * ks + 8 * hs; const float4 c0 = *(const float4*)cp, c1 = *(const float4*)(cp + 4);
            const float cv[8] = {c0.x, c0.y, c0.z, c0.w, c1.x, c1.y, c1.z, c1.w}; cf[eb][ks] = pack8(cv); }
    do { asm volatile("" ::: "memory"); __builtin_amdgcn_sched_barrier(0); } while (0);
    if (RET) { tile_store<64>(rk64, tile, lane); proc_rope_tile(tile, (const float*)(c->ws + OFF_ROPE), slab * TS + tl0, 0.125f, lane); }
    else { tile_store<67>(rk67, tile, lane); proc_conv_tile(tile, c->mconv_w + l * 4096 + 512 + h * 64, 1024, c->mconv_b + l * 1024 + 512 + h * 64, 0.125f, lane); }
#pragma unroll
    for (int mb = 0; mb < 2; ++mb)
#pragma unroll
        for (int ks = 0; ks < 4; ++ks) kf[mb][ks] = frag_nat(tile, 32 * mb + li, 2 * ks + hs);
    WSYNC(); __builtin_amdgcn_sched_barrier(0);
    tile_load<64>(rv64, rb, tl0, (RET ? D_V : A_V) + h * 64, lane);
    if (RET) { tile_store<64>(rq64, tile, lane); proc_rope_tile(tile, (const float*)(c->ws + OFF_ROPE), slab * TS + tl0, 1.f, lane); }
    else { tile_store<67>(rq67, tile, lane); proc_conv_tile(tile, c->mconv_w + l * 4096 + h * 64, 1024, c->mconv_b + l * 1024 + h * 64, 1.f, lane); }
#pragma unroll
    for (int nb = 0; nb < 2; ++nb)
#pragma unroll
        for (int ks = 0; ks < 4; ++ks) qf[nb][ks] = frag_nat(tile, 32 * nb + li, 2 * ks + hs);
    WSYNC(); __builtin_amdgcn_sched_barrier(0);
    tile_store<64>(rv64, tile, lane);
    const int zc = (RET ? ZD : ZA) + h * 64; const float* nw = (RET ? c->retnorm_w : c->mnorm_w) + l * G + h * 64;
#pragma unroll
    for (int nb = 0; nb < 2; ++nb) {
        bf16_t* prw = (bf16_t*)(c->ws + OFF_P) + prow_off(b, tl0 + 32 * nb + li);
        uint2 ogr[2][4], zvr[2][4];
#pragma unroll
        for (int eb = 0; eb < 2; ++eb)
#pragma unroll
            for (int rg = 0; rg < 4; ++rg) { const int e0 = 32 * eb + 8 * rg + 4 * hs; zvr[eb][rg] = *(const uint2*)(prw + zc + e0); ogr[eb][rg] = RET ? make_uint2(0u, 0u) : *(const uint2*)(prw + A_O + h * 64 + e0); }
        bf16x8 xf[2][2]; float csum = 0.f;
#pragma unroll
        for (int mb = 0; mb < 2; ++mb) {
            if (!RET && mb == 1 && nb == 0) continue;
            f32x16 sa;
#pragma unroll
            for (int r = 0; r < 16; ++r) sa[r] = 0.f;
#pragma unroll
            for (int ks = 0; ks < 4; ++ks) sa = MFMA32(kf[mb][ks], qf[nb][ks], sa);
            float xv[16];
#pragma unroll
            for (int rg = 0; rg < 4; ++rg) { float av[4] = {0.f, 0.f, 0.f, 0.f};
                if (!RET) { const float4 t4 = *(const float4*)(tab + 32 * mb + 8 * rg + 4 * hs); av[0] = t4.x; av[1] = t4.y; av[2] = t4.z; av[3] = t4.w; }
#pragma unroll
                for (int i = 0; i < 4; ++i) { const int r = 4 * rg + i, s = 32 * mb + 8 * rg + 4 * hs + i, t = 32 * nb + li;
                    float w;
                    if (RET) w = __expf(lg * fabsf((float)(t - s))); else w = s <= t ? __expf(av[i] - mx_t[nb]) : 0.f;
                    xv[r] = sa[r] * w; csum += xv[r]; } }
            xf[mb][0] = pack8(xv); xf[mb][1] = pack8(xv + 8); __builtin_amdgcn_sched_barrier(0); }
        f32x16 o[2];
#pragma unroll
        for (int eb = 0; eb < 2; ++eb) {
#pragma unroll
            for (int r = 0; r < 16; ++r) o[eb][r] = 0.f;
#pragma unroll
            for (int ks = 0; ks < 4; ++ks) o[eb] = MFMA32(cf[eb][ks], qf[nb][ks], o[eb]);
#pragma unroll
            for (int r = 0; r < 16; ++r) o[eb][r] *= sc_t[nb]; }
        __builtin_amdgcn_sched_barrier(0);
        float dn = 1.f;
        if (!RET) { float qn = 0.f;
#pragma unroll
            for (int ks = 0; ks < 4; ++ks) { const float4 n0 = *(const float4*)(S + 4096 + 16 * ks + 8 * hs), n1 = *(const float4*)(S + 4096 + 16 * ks + 8 * hs + 4);
                const float nv[8] = {n0.x, n0.y, n0.z, n0.w, n1.x, n1.y, n1.z, n1.w}; float qv[8]; unpack8(__builtin_bit_cast(uint4, qf[nb][ks]), qv);
#pragma unroll
                for (int j = 0; j < 8; ++j) qn += qv[j] * nv[j]; }
            qn += __shfl_xor(qn, 32); csum += __shfl_xor(csum, 32); dn = fmaxf(fabsf(csum + sc_t[nb] * qn), dnf_t[nb]); }
#pragma unroll
        for (int eb = 0; eb < 2; ++eb)
#pragma unroll
            for (int sb = 0; sb < 2; ++sb) {
                if (!RET && sb == 1 && nb == 0) continue;
#pragma unroll
                for (int st = 0; st < 2; ++st) { bf16x8 vf;
#pragma unroll
                    for (int j = 0; j < 8; ++j) vf[j] = (short)*(const bf16_t*)(tile + (32 * sb + 16 * st + 8 * (j >> 2) + 4 * hs + (j & 3)) * TP + (32 * eb + li) * 2);
                    o[eb] = MFMA32(vf, xf[sb][st], o[eb]); }
                do { asm volatile("" ::: "memory"); __builtin_amdgcn_sched_barrier(0); } while (0); }
        do { asm volatile("" ::: "memory"); __builtin_amdgcn_sched_barrier(0); } while (0);
        const float inv = 1.f / dn; float sum = 0.f;
#pragma unroll
        for (int eb = 0; eb < 2; ++eb)
#pragma unroll
            for (int rg = 0; rg < 4; ++rg) { const int e0 = 32 * eb + 8 * rg + 4 * hs; float og[4] = {1.f, 1.f, 1.f, 1.f};
                if (!RET) { const uint2 ov = ogr[eb][rg]; og[0] = sigm(__uint_as_float(ov.x << 16)); og[1] = sigm(__uint_as_float(ov.x & 0xffff0000u)); og[2] = sigm(__uint_as_float(ov.y << 16)); og[3] = sigm(__uint_as_float(ov.y & 0xffff0000u)); }
#pragma unroll
                for (int i = 0; i < 4; ++i) { const float v = o[eb][4 * rg + i] * inv * og[i]; o[eb][4 * rg + i] = v; sum += v; } }
        sum += __shfl_xor(sum, 32); const float mu = sum * (1.f / 64.f); float vs = 0.f;
#pragma unroll
        for (int eb = 0; eb < 2; ++eb)
#pragma unroll
            for (int r = 0; r < 16; ++r) { const float d = o[eb][r] - mu; vs += d * d; }
        vs += __shfl_xor(vs, 32); const float rstd = rsqrtf(vs * (1.f / 64.f) + 1e-5f);
#pragma unroll
        for (int eb = 0; eb < 2; ++eb)
#pragma unroll
            for (int rg = 0; rg < 4; ++rg) { const int e0 = 32 * eb + 8 * rg + 4 * hs; const uint2 zv = zvr[eb][rg]; const float4 w4 = *(const float4*)(nw + e0);
                const float z[4] = {__uint_as_float(zv.x << 16), __uint_as_float(zv.x & 0xffff0000u), __uint_as_float(zv.y << 16), __uint_as_float(zv.y & 0xffff0000u)}; const float wv[4] = {w4.x, w4.y, w4.z, w4.w}; float y[4];
#pragma unroll
                for (int i = 0; i < 4; ++i) y[i] = (o[eb][4 * rg + i] - mu) * rstd * wv[i] * siluf(z[i]);
                uint2 ov; ov.x = pk2(y[0], y[1]); ov.y = pk2(y[2], y[3]); *(uint2*)(prw + zc + e0) = ov; }
        do { asm volatile("" ::: "memory"); __builtin_amdgcn_sched_barrier(0); } while (0);
    }
    WSYNC(); __builtin_amdgcn_sched_barrier(0);
}
DI void proc_conv_tile_lin(unsigned char* tile, const float* cw, int cws, const float* cb, int lane) {
    const int ch = lane & 7; float w[4][8], bb[8];
#pragma unroll
    for (int t = 0; t < 4; ++t) { const float4 a = *(const float4*)(cw + t * cws + ch * 8), d = *(const float4*)(cw + t * cws + ch * 8 + 4);
        w[t][0] = a.x; w[t][1] = a.y; w[t][2] = a.z; w[t][3] = a.w; w[t][4] = d.x; w[t][5] = d.y; w[t][6] = d.z; w[t][7] = d.w; }
    { const float4 a = *(const float4*)(cb + ch * 8), d = *(const float4*)(cb + ch * 8 + 4); bb[0] = a.x; bb[1] = a.y; bb[2] = a.z; bb[3] = a.w; bb[4] = d.x; bb[5] = d.y; bb[6] = d.z; bb[7] = d.w; }
#pragma unroll
    for (int k = 0; k < 8; ++k) { const int row = (lane >> 3) + 8 * k; float acc[8];
#pragma unroll
        for (int i = 0; i < 8; ++i) acc[i] = bb[i];
#pragma unroll
        for (int t = 0; t < 4; ++t) { float x[8]; unpack8(*(const uint4*)(tile + (row + t) * TP + ch * 16), x);
#pragma unroll
            for (int i = 0; i < 8; ++i) acc[i] += x[i] * w[t][i]; }
        const bf16x8 res = pack8(acc); WSYNC();
        *(bf16x8*)(tile + row * TP + ch * 16) = res; }
    WSYNC();
}
DI void lru_gates(CtxP c, int l, int h, int jb, const unsigned char* tile, const bf16x8 (&xf)[2][4], float (&a)[2][16], float (&u)[2][16], int li, int hs) {
    const int j = 32 * jb + li, ch = h * 64 + j;
    const bf16_t* wr = (const bf16_t*)(c->ws + OFF_WRT) + ((size_t)(l * NH + h) * 64 + j) * 64; const bf16_t* wi = (const bf16_t*)(c->ws + OFF_WIT) + ((size_t)(l * NH + h) * 64 + j) * 64;
    bf16x8 wrf[4], wif[4];
#pragma unroll
    for (int ks = 0; ks < 4; ++ks) { wrf[ks] = *(const bf16x8*)(wr + 16 * ks + 8 * hs); wif[ks] = *(const bf16x8*)(wi + 16 * ks + 8 * hs); }
    const float br = c->lb_r[l * G + ch], bi = c->lb_i[l * G + ch], sp8 = -8.f * softplusf(-c->llam[l * G + ch]);
#pragma unroll
    for (int tb = 0; tb < 2; ++tb) { f32x16 ar, ai;
#pragma unroll
        for (int r = 0; r < 16; ++r) { ar[r] = 0.f; ai[r] = 0.f; }
#pragma unroll
        for (int ks = 0; ks < 4; ++ks) { ar = MFMA32(xf[tb][ks], wrf[ks], ar); ai = MFMA32(xf[tb][ks], wif[ks], ai); }
#pragma unroll
        for (int r = 0; r < 16; ++r) { const int t = 32 * tb + (r & 3) + 8 * (r >> 2) + 4 * hs; const float x = tile_at(tile, t, j);
            const float la = sp8 * sigm(ar[r] + br); a[tb][r] = __expf(la); u[tb][r] = sqrtf(-expm1f(2.f * la)) * (sigm(ai[r] + bi) * x); } }
}
template <bool STEP_C> DI void w_lru(CtxP c, int l, int slab, int u_, unsigned char* wl, int lane, int jb_lo, int jb_hi) {
    const int bh = u_ / NCS, cl = u_ % NCS, b = bh >> 3, h = bh & 7, tl0 = cl * 64, hs = lane >> 5, li = lane & 31;
    unsigned char* tile = wl; const bf16_t* rb = (const bf16_t*)(c->ws + OFF_P) + prow_off(b, 0);
    { u32x4 rx[TILE_K(67)]; tile_load<67>(rx, rb, tl0 - 3, C_X + h * 64, lane); tile_store<67>(rx, tile, lane); }
    proc_conv_tile_lin(tile, c->lconv_w + l * 2048 + h * 64, 512, c->lconv_b + l * 512 + h * 64, lane);
    bf16x8 xf[2][4];
#pragma unroll
    for (int tb = 0; tb < 2; ++tb)
#pragma unroll
        for (int ks = 0; ks < 4; ++ks) xf[tb][ks] = frag_nat(tile, 32 * tb + li, 2 * ks + hs);
#pragma unroll 1
    for (int jb = jb_lo; jb < jb_hi; ++jb) {
        float a[2][16], u[2][16];
        lru_gates(c, l, h, jb, tile, xf, a, u, li, hs);
        const int ch = h * 64 + 32 * jb + li; float* LS = (float*)(c->ws + OFF_LS) + ((size_t)(b * NCS + cl) * G + ch) * 2;
        float cst = STEP_C ? LS[0] : 0.f, pr = 1.f;
#pragma unroll
        for (int tb = 0; tb < 2; ++tb)
#pragma unroll
            for (int q = 0; q < 4; ++q) {
                float ga = 1.f, gu = 0.f;
#pragma unroll
                for (int i = 0; i < 4; ++i) { gu = a[tb][4 * q + i] * gu + u[tb][4 * q + i]; ga *= a[tb][4 * q + i]; }
                const float pa = __shfl_xor(ga, 32), pu = __shfl_xor(gu, 32);
                const float a0 = hs ? pa : ga, u0 = hs ? pu : gu, a1 = hs ? ga : pa, u1 = hs ? gu : pu;
                if (STEP_C) { float hv = hs ? a0 * cst + u0 : cst;
#pragma unroll
                    for (int i = 0; i < 4; ++i) { hv = a[tb][4 * q + i] * hv + u[tb][4 * q + i]; u[tb][4 * q + i] = hv; } }
                cst = a1 * (a0 * cst + u0) + u1; pr *= a0 * a1; }
        if (!STEP_C) { if (hs == 0) { LS[0] = pr; LS[1] = cst; } }
        else {
#pragma unroll
            for (int tb = 0; tb < 2; ++tb)
#pragma unroll
                for (int r = 0; r < 16; ++r) { const int t = 32 * tb + (r & 3) + 8 * (r >> 2) + 4 * hs; bf16_t* pz = (bf16_t*)(c->ws + OFF_P) + prow_off(b, tl0 + t) + ZC + ch;
                    *pz = f2bf(u[tb][r] * siluf(bf2f(*pz))); } }
        asm volatile("" ::: "memory"); __builtin_amdgcn_sched_barrier(0);
    }
    WSYNC();
}
#define DPP_ADD(v, ctrl) v += __builtin_bit_cast(float, __builtin_amdgcn_update_dpp(0, __builtin_bit_cast(int, v), ctrl, 0xF, 0xF, true))
DI float allred16(float v) { DPP_ADD(v, 0xB1); DPP_ADD(v, 0x4E); DPP_ADD(v, 0x141); DPP_ADD(v, 0x140); return v; }
DI float allred32(float v) { v = allred16(v); v += __shfl_xor(v, 16); return v; }
template <bool TANH> DI void proc_shift_tile(unsigned char* tile, const float* mu, int lane) {
    const int ch = lane & 7; float m[8];
    { const float4 a = *(const float4*)(mu + ch * 8), d = *(const float4*)(mu + ch * 8 + 4); m[0] = a.x; m[1] = a.y; m[2] = a.z; m[3] = a.w; m[4] = d.x; m[5] = d.y; m[6] = d.z; m[7] = d.w; }
#pragma unroll
    for (int k = 0; k < 8; ++k) { const int row = (lane >> 3) + 8 * k; float xp[8], x[8];
        unpack8(*(const uint4*)(tile + row * TP + ch * 16), xp); unpack8(*(const uint4*)(tile + (row + 1) * TP + ch * 16), x);
#pragma unroll
        for (int i = 0; i < 8; ++i) { const float v = x[i] + m[i] * (xp[i] - x[i]); x[i] = TANH ? tanhf(v) : v; }
        const bf16x8 res = pack8(x); WSYNC();
        *(bf16x8*)(tile + row * TP + ch * 16) = res; }
    WSYNC();
}
DI void w_bprep(CtxP c, int l, int slab, int u_, unsigned char* wl, int lane) {
    const int bh = u_ / NCS, cl = u_ % NCS, b = bh >> 3, h = bh & 7, tl0 = cl * 64, hs = lane >> 5, li = lane & 31;
    unsigned char* T0 = wl; unsigned char* T1 = wl + 10096;
    const float* mu = c->rmu + l * 1664; const bf16_t* rb = (const bf16_t*)(c->ws + OFF_P) + prow_off(b, 0);
    bf16x8 wlf[2][4], alf[2][4];
    u32x4 rw[TILE_K(65)], ra[TILE_K(65)], rr_[TILE_K(65)], rk_[TILE_K(65)];
    tile_load<65>(rw, rb, tl0 - 1, B_WLO, lane); tile_load<65>(ra, rb, tl0 - 1, B_ALO, lane);
    tile_store<65>(rw, T0, lane);
    tile_load<65>(rr_, rb, tl0 - 1, B_R + h * 64, lane); tile_load<65>(rk_, rb, tl0 - 1, B_K + h * 64, lane);
    proc_shift_tile<true>(T0, mu + 1536, lane);
#pragma unroll
    for (int tb = 0; tb < 2; ++tb)
#pragma unroll
        for (int ks = 0; ks < 4; ++ks) wlf[tb][ks] = frag_nat(T0, 32 * tb + li, 2 * ks + hs);
    WSYNC();
    tile_store<65>(ra, T0, lane); proc_shift_tile<false>(T0, mu + 1600, lane);
#pragma unroll
    for (int tb = 0; tb < 2; ++tb)
#pragma unroll
        for (int ks = 0; ks < 4; ++ks) alf[tb][ks] = frag_nat(T0, 32 * tb + li, 2 * ks + hs);
    WSYNC();
    tile_store<65>(rr_, T0, lane); tile_store<65>(rk_, T1, lane);
    __builtin_amdgcn_sched_barrier(0);
#pragma unroll
    for (int tb = 0; tb < 2; ++tb) {
        float rs[16], bonp[16];
        { float kk[2], mk[2];
#pragma unroll
          for (int jb = 0; jb < 2; ++jb) { kk[jb] = c->rk_k[l * G + h * 64 + 32 * jb + li]; mk[jb] = mu[512 + h * 64 + 32 * jb + li]; }
#pragma unroll
          for (int r = 0; r < 16; ++r) { const int t = 32 * tb + (r & 3) + 8 * (r >> 2) + 4 * hs; float ss = 0.f;
#pragma unroll
              for (int jb = 0; jb < 2; ++jb) { const float x = tile_at(T1, t + 1, 32 * jb + li), xp = tile_at(T1, t, 32 * jb + li); const float kap = (x + mk[jb] * (xp - x)) * kk[jb]; ss += kap * kap; }
              rs[r] = rsqrtf(allred32(ss) + 1e-12f); bonp[r] = 0.f; } }
        __builtin_amdgcn_sched_barrier(0);
#pragma unroll
        for (int jb = 0; jb < 2; ++jb) {
            const int j = 32 * jb + li, ch = h * 64 + j;
            const bf16_t* wu = (const bf16_t*)(c->ws + OFF_WUT) + ((size_t)l * G + ch) * 64; const bf16_t* au = (const bf16_t*)(c->ws + OFF_AUT) + ((size_t)l * G + ch) * 64;
            bf16x8 wuf[4], auf[4];
#pragma unroll
            for (int ks = 0; ks < 4; ++ks) { wuf[ks] = *(const bf16x8*)(wu + 16 * ks + 8 * hs); auf[ks] = *(const bf16x8*)(au + 16 * ks + 8 * hs); }
            const float w0 = c->rw0[l * G + ch], a0 = c->ra0[l * G + ch], kkj = c->rk_k[l * G + ch], kaj = c->rk_a[l * G + ch], rkj = c->rr_k[l * G + ch], mr = mu[ch], mk = mu[512 + ch];
            f32x16 dl, da;
#pragma unroll
            for (int r = 0; r < 16; ++r) { dl[r] = 0.f; da[r] = 0.f; }
#pragma unroll
            for (int ks = 0; ks < 4; ++ks) { dl = MFMA32(wlf[tb][ks], wuf[ks], dl); da = MFMA32(alf[tb][ks], auf[ks], da); }
            __builtin_amdgcn_sched_barrier(0);
            unsigned char* ckb = c->ws + OFF_CK + (size_t)(bh * TS + tl0) * 768;
#pragma unroll
            for (int r = 0; r < 16; ++r) { const int t = 32 * tb + (r & 3) + 8 * (r >> 2) + 4 * hs;
                const float w = __expf(-0.606531f * sigm(w0 + dl[r])); const float a = sigm(a0 + da[r]);
                float x = tile_at(T0, t + 1, j), xp = tile_at(T0, t, j); const float rm = x + mr * (xp - x);
                x = tile_at(T1, t + 1, j); xp = tile_at(T1, t, j); const float km = x + mk * (xp - x);
                const float kh = km * kkj * rs[r], kt = km * (1.f + (a - 1.f) * kaj);
                bonp[r] += rm * rkj * kt;
                const unsigned o4 = (unsigned)t * 768u + (unsigned)j * 4u, o2 = (unsigned)t * 768u + 256u + (unsigned)j * 2u;
                *(float*)(ckb + o4) = w; *(bf16_t*)(ckb + o2) = f2bf(kh); *(bf16_t*)(ckb + o2 + 128u) = f2bf(a * kh); *(bf16_t*)(ckb + o2 + 256u) = f2bf(kt); *(bf16_t*)(ckb + o2 + 384u) = f2bf(rm);
                if ((r & 3) == 3) { asm volatile("" ::: "memory"); __builtin_amdgcn_sched_barrier(0); } }
        }
#pragma unroll
        for (int r = 0; r < 16; ++r) { const float bsum = allred32(bonp[r]); const int t = 32 * tb + (r & 3) + 8 * (r >> 2) + 4 * hs;
            if (li == 0) ((float*)(c->ws + OFF_BON))[(size_t)(b * TS + tl0 + t) * NH + h] = bsum; }
        asm volatile("" ::: "memory"); __builtin_amdgcn_sched_barrier(0);
    }
    WSYNC();
}
DI void s_phase2(CtxP c, int l, int slab, float* lds, int bid, int nblk) {
    const int tid = otid(), lane = tid & 63, wave = tid >> 6; unsigned char* wl = (unsigned char*)lds + wave * WLDS;
    { const int u = __builtin_amdgcn_readfirstlane(bid * 4 + (wave & 3)); int ln = lane;
        if (wave < 4) w_bprep(c, l, slab, u, wl, ln); else w_lru<false>(c, l, slab, u, wl, ln, 0, 2);
        asm volatile("" : "+v"(ln) :: "memory"); __builtin_amdgcn_sched_barrier(0);
        if (wave < 4) w_chunkA<false>(c, l, slab, u, wl, ln); else w_chunkA<true>(c, l, slab, u, wl, ln); }
    if (slab == 0) { bf16_t* halo = (bf16_t*)(c->ws + OFF_CARRY + l * CARRY_L + HALO_OFF);
        for (int i = bid * 512 + tid; i < NB * 3 * PP; i += nblk * 512) { const int b = i / (3 * PP), r = (i / PP) % 3, col = i % PP;
            halo[i] = ((const bf16_t*)(c->ws + OFF_P))[prow_off(b, TS - 3 + r) + col]; } }
}
typedef float f2v __attribute__((ext_vector_type(2)));
constexpr int SC_CH = 16, SC_REC = 1280, SC_BUF = SC_CH * SC_REC, SC_R1 = 4 * WLDS, SC_VM = SC_BUF, SC_FLAGS = SC_BUF + 1024, SC_NCH = TS / SC_CH;
static_assert(SC_FLAGS + 64 <= 2 * WLDS, "scan ring slot 0 inside the LDS regions of waves 0,1 (slot 1: waves 4,5)");
DI int lds_ld(volatile LAS int* p) { return *p; }
DI void s_scan_roles(CtxP c, int l, int slab, float* lds, int bid, int wave, int lane) {
    const int bh = (bid & 7) * 4 + (bid >> 6), rg8 = (bid >> 3) & 7, b = bh >> 3, h = bh & 7;
    unsigned char* ring = (unsigned char*)lds;
    volatile LAS int* F = (volatile LAS int*)((LAS unsigned char*)(unsigned long)SC_FLAGS);
    if (wave >= 4) {
        const int pw = wave - 4, p = pw * 64 + lane, pst = p >> 1, prq = p & 1; const int vcol = B_V + h * 64 + rg8 * 8 + prq * 4;
        const unsigned char* ck = c->ws + OFF_CK + (size_t)bh * TS * 768;
        float4 muv = *(const float4*)(c->rmu + l * 1664 + 1024 + h * 64 + rg8 * 8 + prq * 4);
        uint4 pt[6]; uint2 pvc = make_uint2(0u, 0u), pvp = make_uint2(0u, 0u);
        auto pload = [&](int ch) {
            const uint4* src = (const uint4*)(ck + (size_t)ch * (SC_CH * 768));
#pragma unroll
            for (int k = 0; k < 6; ++k) pt[k] = src[p + 128 * k];
            if (p < 32) { const bf16_t* pr = (const bf16_t*)(c->ws + OFF_P) + prow_off(b, ch * SC_CH + pst) + vcol; pvc = *(const uint2*)pr; pvp = *(const uint2*)(pr - PP); }
        };
        auto pwrite = [&](int ch) {
            unsigned char* dst = ring + (ch & 1) * SC_R1;
#pragma unroll
            for (int k = 0; k < 6; ++k) { const int idx = p + 128 * k, st = idx / 48, w = idx % 48; unsigned char* r = dst + st * SC_REC;
                if (w < 16) *(uint4*)(r + w * 16) = pt[k];
                else { float f[8]; unpack8(pt[k], f); float* d = (float*)(r + 256) + (w - 16) * 8; *(float4*)d = make_float4(f[0], f[1], f[2], f[3]); *(float4*)(d + 4) = make_float4(f[4], f[5], f[6], f[7]); } }
            if (p < 32) {
                const float v0 = __uint_as_float(pvc.x << 16), v1 = __uint_as_float(pvc.x & 0xffff0000u), v2 = __uint_as_float(pvc.y << 16), v3 = __uint_as_float(pvc.y & 0xffff0000u);
                const float q0 = __uint_as_float(pvp.x << 16), q1 = __uint_as_float(pvp.x & 0xffff0000u), q2 = __uint_as_float(pvp.y << 16), q3 = __uint_as_float(pvp.y & 0xffff0000u);
                *(float4*)((float*)(dst + SC_VM) + pst * 8 + prq * 4) = make_float4(v0 + muv.x * (q0 - v0), v1 + muv.y * (q1 - v1), v2 + muv.z * (q2 - v2), v3 + muv.w * (q3 - v3)); }
        };
        pload(0);
        for (int ch = 0; ch < SC_NCH; ++ch) {
            while (min(lds_ld(F + 2), lds_ld(F + 3)) < ch - 1) __builtin_amdgcn_s_sleep(1);
            pwrite(ch);
            asm volatile("s_waitcnt lgkmcnt(0)" ::: "memory");
            if (lane == 0) F[pw] = ch + 1;
            if (ch + 1 < SC_NCH) pload(ch + 1);
        }
    } else {
        const int rr = lane >> 4, kg = lane & 15, row = rg8 * 8 + wave * 4 + rr;
        float* CB = (float*)(c->ws + OFF_CARRY + l * CARRY_L + CB_OFF) + ((size_t)bh * 64 + row) * 64 + kg * 4;
        f2v S01 = {0.f, 0.f}, S23 = {0.f, 0.f};
        if (slab != 0) { S01.x = CB[0]; S01.y = CB[1]; S23.x = CB[2]; S23.y = CB[3]; }
        bf16_t* pbase = (bf16_t*)(c->ws + OFF_P) + prow_off(b, 0);
#define SB __builtin_amdgcn_sched_barrier(0)
        float ykeep = 0.f, yv = 0.f, x = 0.f;
        for (int ch = 0; ch < SC_NCH; ++ch) {
            while (min(lds_ld(F + 0), lds_ld(F + 1)) < ch + 1) __builtin_amdgcn_s_sleep(1);
            asm volatile("" ::: "memory");
            const unsigned char* rec = ring + (ch & 1) * SC_R1 + kg * 16; const float* vmp = (const float*)(ring + (ch & 1) * SC_R1 + SC_VM) + wave * 4 + rr;
            float4 wv = *(const float4*)(rec), kh = *(const float4*)(rec + 256), ak = *(const float4*)(rec + 512), kt = *(const float4*)(rec + 768), rv = *(const float4*)(rec + 1024); float vm = vmp[0];
            float4 wv1 = *(const float4*)(rec + SC_REC), kh1 = *(const float4*)(rec + SC_REC + 256), ak1 = *(const float4*)(rec + SC_REC + 512), kt1 = *(const float4*)(rec + SC_REC + 768), rv1 = *(const float4*)(rec + SC_REC + 1024); float vm1 = vmp[8];
            { f2v pp = S01 * (f2v){kh.x, kh.y}; pp = S23 * (f2v){kh.z, kh.w} + pp; x = pp.x + pp.y; }
            SB;
#pragma unroll
            for (int s = 0; s < SC_CH; ++s) {
                const int sn = s + 2 < SC_CH ? s + 2 : SC_CH - 1; const unsigned char* rn = rec + sn * SC_REC;
                const float4 wv2 = *(const float4*)(rn), kh2 = *(const float4*)(rn + 256), ak2 = *(const float4*)(rn + 512), kt2 = *(const float4*)(rn + 768), rv2 = *(const float4*)(rn + 1024); const float vm2_ = vmp[sn * 8];
                const f2v vm2 = {vm, vm};
                DPP_ADD(x, 0xB1); DPP_ADD(yv, 0xB1); const f2v k01 = vm2 * (f2v){kt.x, kt.y}, k23 = vm2 * (f2v){kt.z, kt.w};
                SB;
                DPP_ADD(x, 0x4E); DPP_ADD(yv, 0x4E); const f2v t01 = S01 * (f2v){wv.x, wv.y} + k01, t23 = S23 * (f2v){wv.z, wv.w} + k23;
                SB;
                DPP_ADD(x, 0x141); DPP_ADD(yv, 0x141);
                SB;
                DPP_ADD(x, 0x140); DPP_ADD(yv, 0x140);
                SB;
                ykeep = (kg == ((s + 15) & 15)) ? yv : ykeep;
                if (s == 0 && ch > 0) ((float*)(pbase + (size_t)((ch - 1) * SC_CH + kg) * PP + B_R))[h * 64 + row] = ykeep;
                const f2v nsk = {-x, -x};
                S01 = nsk * (f2v){ak.x, ak.y} + t01; S23 = nsk * (f2v){ak.z, ak.w} + t23;
                SB;
                { f2v qq = S01 * (f2v){rv.x, rv.y}; f2v pp = S01 * (f2v){kh1.x, kh1.y}; qq = S23 * (f2v){rv.z, rv.w} + qq; pp = S23 * (f2v){kh1.z, kh1.w} + pp; yv = qq.x + qq.y; x = pp.x + pp.y; }
                SB;
                wv = wv1; kh = kh1; ak = ak1; kt = kt1; rv = rv1; vm = vm1;
                wv1 = wv2; kh1 = kh2; ak1 = ak2; kt1 = kt2; rv1 = rv2; vm1 = vm2_;
            }
            asm volatile("s_waitcnt lgkmcnt(0)" ::: "memory");
            if (lane == 0) F[2 + wave] = ch + 1;
        }
        yv = allred16(yv); ykeep = (kg == 15) ? yv : ykeep;
        ((float*)(pbase + (size_t)((SC_NCH - 1) * SC_CH + kg) * PP + B_R))[h * 64 + row] = ykeep;
#undef SB
        CB[0] = S01.x; CB[1] = S01.y; CB[2] = S23.x; CB[3] = S23.y;
    }
}
DI void s_phase3(CtxP c, int l, int slab, float* lds, int bid) {
    const int tid = otid(), lane = tid & 63, wave = tid >> 6;
    if (tid < 4) ((volatile LAS int*)((LAS unsigned char*)(unsigned long)SC_FLAGS))[tid] = 0;
    __syncthreads();
    if ((wave & 2) == 0) s_scan_roles(c, l, slab, lds, bid, wave, lane);
    else { const int u = __builtin_amdgcn_readfirstlane(bid * 4 + (wave & 1) + 2 * (wave >> 2)); unsigned char* wl = (unsigned char*)lds + wave * WLDS; int ln = lane;
        w_chunkC<false>(c, l, slab, u, wl, ln);
        asm volatile("" : "+v"(ln) :: "memory"); __builtin_amdgcn_sched_barrier(0);
        w_chunkC<true>(c, l, slab, u, wl, ln);
        asm volatile("" : "+v"(ln) :: "memory"); __builtin_amdgcn_sched_barrier(0);
        w_lru<true>(c, l, slab, u, wl, ln, 0, 2); }
}
DI float red8(float v) { DPP_ADD(v, 0xB1); DPP_ADD(v, 0x4E); DPP_ADD(v, 0x141); return v; }
DI void s_bpost(CtxP c, int l, int slab, float* lds, int bid, int nblk) {
    const int lane = otid() & 63, gw = bid * 8 + (otid() >> 6), NGW = nblk * 8; const int ch0 = lane * 8, h = lane >> 3;
    float gw8[8], gb8[8], mu8[8];
    { const float4 a0 = *(const float4*)(c->rgn_w + l * G + ch0), a1 = *(const float4*)(c->rgn_w + l * G + ch0 + 4), b0 = *(const float4*)(c->rgn_b + l * G + ch0), b1 = *(const float4*)(c->rgn_b + l * G + ch0 + 4),
          m0 = *(const float4*)(c->rmu + l * 1664 + 1024 + ch0), m1 = *(const float4*)(c->rmu + l * 1664 + 1024 + ch0 + 4);
      gw8[0] = a0.x; gw8[1] = a0.y; gw8[2] = a0.z; gw8[3] = a0.w; gw8[4] = a1.x; gw8[5] = a1.y; gw8[6] = a1.z; gw8[7] = a1.w;
      gb8[0] = b0.x; gb8[1] = b0.y; gb8[2] = b0.z; gb8[3] = b0.w; gb8[4] = b1.x; gb8[5] = b1.y; gb8[6] = b1.z; gb8[7] = b1.w;
      mu8[0] = m0.x; mu8[1] = m0.y; mu8[2] = m0.z; mu8[3] = m0.w; mu8[4] = m1.x; mu8[5] = m1.y; mu8[6] = m1.z; mu8[7] = m1.w; }
    for (int r0 = gw; r0 < MS; r0 += 2 * NGW) {
        float4 wa[2], wb[2]; uint4 xc[2], xq[2], zz[2]; float bon[2]; bf16_t* prw[2];
#pragma unroll
        for (int q = 0; q < 2; ++q) { int r = r0 + q * NGW; r = r < MS ? r : r0; const int b = r / TS, tl = r % TS; prw[q] = (bf16_t*)(c->ws + OFF_P) + prow_off(b, tl);
            wa[q] = *(const float4*)((const float*)(prw[q] + B_R) + ch0); wb[q] = *(const float4*)((const float*)(prw[q] + B_R) + ch0 + 4);
            xc[q] = *(const uint4*)(prw[q] + B_V + ch0); xq[q] = *(const uint4*)(prw[q] - PP + B_V + ch0); zz[q] = *(const uint4*)(prw[q] + ZB + ch0);
            bon[q] = ((const float*)(c->ws + OFF_BON))[(size_t)r * NH + h]; }
#pragma unroll
        for (int q = 0; q < 2; ++q) { if (r0 + q * NGW >= MS) break;
            float w[8] = {wa[q].x, wa[q].y, wa[q].z, wa[q].w, wb[q].x, wb[q].y, wb[q].z, wb[q].w}, x[8], xp[8], z[8], y[8];
            unpack8(xc[q], x); unpack8(xq[q], xp); unpack8(zz[q], z);
            float sm = 0.f;
#pragma unroll
            for (int i = 0; i < 8; ++i) sm += w[i];
            const float mean = red8(sm) * (1.f / 64.f); float vs = 0.f;
#pragma unroll
            for (int i = 0; i < 8; ++i) { w[i] -= mean; vs += w[i] * w[i]; }
            const float rstd = rsqrtf(red8(vs) * (1.f / 64.f) + 1e-5f);
#pragma unroll
            for (int i = 0; i < 8; ++i) { const float vm = x[i] + mu8[i] * (xp[i] - x[i]); y[i] = (w[i] * rstd * gw8[i] + gb8[i] + bon[q] * vm) * siluf(z[i]); }
            *(bf16x8*)(prw[q] + ZB + ch0) = pack8(y); }
    }
}
DI void s_post(CtxP c, int l, int slab, float* lds, int bid, int nblk) {
    const int lane = otid() & 63, gw = bid * 8 + (otid() >> 6), NGW = nblk * 8;
    for (int r0 = gw; r0 < MS; r0 += 2 * NGW) {
        float4 v[2][4], xx[2][4]; float* orow[2];
#pragma unroll
        for (int q = 0; q < 2; ++q) { int r = r0 + q * NGW; r = r < MS ? r : r0; const int b = r / TS, tl = r % TS; const size_t grow = (size_t)b * T + slab * TS + tl;
            const float* yrow = (const float*)(c->ws + OFF_Y) + (size_t)r * D; const bf16_t* y2row = (const bf16_t*)(c->ws + OFF_Y2) + (size_t)r * D;
            const float* xr = (l == 0 ? c->x : c->out) + grow * D; orow[q] = c->out + grow * D;
#pragma unroll
            for (int j = 0; j < 4; ++j) { v[q][j] = *(const float4*)(yrow + j * 256 + lane * 4); xx[q][j] = *(const float4*)(xr + j * 256 + lane * 4);
                const uint2 h2 = *(const uint2*)(y2row + j * 256 + lane * 4);
                v[q][j].x += __uint_as_float(h2.x << 16); v[q][j].y += __uint_as_float(h2.x & 0xffff0000u); v[q][j].z += __uint_as_float(h2.y << 16); v[q][j].w += __uint_as_float(h2.y & 0xffff0000u); } }
#pragma unroll
        for (int q = 0; q < 2; ++q) { const int r = r0 + q * NGW; if (r >= MS) break;
            float ss = 0.f;
#pragma unroll
            for (int j = 0; j < 4; ++j) ss += v[q][j].x * v[q][j].x + v[q][j].y * v[q][j].y + v[q][j].z * v[q][j].z + v[q][j].w * v[q][j].w;
            ss = wave_sum(ss); const float rs = rsqrtf(ss * (1.f / D) + 1e-6f); float s2 = 0.f;
#pragma unroll
            for (int j = 0; j < 4; ++j) { const float4 gg = *(const float4*)(c->norm_post + l * D + j * 256 + lane * 4); float4& o = v[q][j]; const float4 x4 = xx[q][j];
                o.x = x4.x + o.x * rs * gg.x; o.y = x4.y + o.y * rs * gg.y; o.z = x4.z + o.z * rs * gg.z; o.w = x4.w + o.w * rs * gg.w;
                *(float4*)(orow[q] + j * 256 + lane * 4) = o; s2 += o.x * o.x + o.y * o.y + o.z * o.z + o.w * o.w; }
            if (l == 0) { s2 = wave_sum(s2); const float r2 = rsqrtf(s2 * (1.f / D) + 1e-6f); bf16_t* hrow = (bf16_t*)(c->ws + OFF_H) + (size_t)r * D;
#pragma unroll
                for (int j = 0; j < 4; ++j) { const float4 gg = *(const float4*)(c->norm_pre + D + j * 256 + lane * 4); const float4 o = v[q][j];
                    uint2 w; w.x = pk2(o.x * r2 * gg.x, o.y * r2 * gg.y); w.y = pk2(o.z * r2 * gg.z, o.w * r2 * gg.w);
                    *(uint2*)(hrow + j * 256 + lane * 4) = w; } } }
    }
}
namespace pg8 {
#define PG8_LAS __attribute__((address_space(3)))
typedef unsigned short bf16_t;
typedef short bf16x8 __attribute__((ext_vector_type(8)));
typedef float f32x4 __attribute__((ext_vector_type(4)));
typedef unsigned u32x4 __attribute__((ext_vector_type(4)));
constexpr int BM = 256, BK = 64, HALF = 128, HTB = HALF * BK * 2  , STAGE_BYTES = 8 * HTB, NXCD = 8, WGM = 8;

__host__ __device__ __forceinline__ int lds_byte(int r, int c) { const int st = (r >> 4) * 2 + (c >> 5), rr = r & 15, cc = c & 31, ob = rr * 64 + cc * 2; return st * 1024 + (ob ^ (((ob >> 9) & 1) << 5)); }
__host__ __device__ __forceinline__ void stage_rc(int b, int& R, int& C) { const int st = b / 1024, sb = b % 1024, swz = sb ^ (((sb >> 9) & 1) << 5); R = (st >> 1) * 16 + swz / 64; C = (st & 1) * 32 + (swz % 64) / 2; }
__host__ __device__ __forceinline__ int perm32(int rho) { const int n = rho >> 4, i = rho & 15; return 8 * (i >> 2) + 4 * n + (i & 3); }

struct Unit { int pm, pn; };
struct Gemm { const bf16_t* A; const bf16_t* Bt; int M, N, K, lda; };

struct StaticOrder {
    int nM, nN, nwg, G, c;
    __host__ __device__ void init(int M, int N, int G_, int c_) { nM = M / BM; nN = N / BM; nwg = nM * nN; G = G_; c = c_; }
    __host__ __device__ bool next(int i, Unit& u) const {
        const long L = (long)i * G + c; if (L >= nwg) return false;
        int wgid = (int)L; { const int q = nwg / NXCD, r = nwg % NXCD, xcd = wgid % NXCD, off = wgid / NXCD; wgid = (xcd < r ? xcd * (q + 1) : r * (q + 1) + (xcd - r) * q) + off; }
        const int nig = WGM * nN, gid = wgid / nig, fm = gid * WGM, gsz = (nM - fm) < WGM ? (nM - fm) : WGM;
        u.pm = fm + ((wgid % nig) % gsz); u.pn = (wgid % nig) / gsz; return true;
    }
    __device__ __forceinline__ void a_ready(const Unit&) const {}
    __device__ __forceinline__ void done(const Unit&) const {}
};

__device__ __forceinline__ unsigned cvt_pk_bf16(float lo, float hi) { unsigned r; asm volatile("v_cvt_pk_bf16_f32 %0, %1, %2" : "=v"(r) : "v"(lo), "v"(hi)); return r; }
typedef float f32x2 __attribute__((ext_vector_type(2)));
__device__ __forceinline__ f32x2 gelu_pk(f32x2 v) {
    const f32x2 av = __builtin_elementwise_abs(v), d = av * 0.2316418882f + 1.0f;
    f32x2 t; t.x = __builtin_amdgcn_rcpf(d.x); t.y = __builtin_amdgcn_rcpf(d.y);
    f32x2 q = t * 0.5307027145f + (-0.7265760135f); q = q * t + 0.7107068705f; q = q * t + (-0.142248368f); q = q * t + 0.127414796f; q = q * t;
    const f32x2 s = (v * v) * (-0.72134752044f);
    f32x2 e; e.x = __builtin_amdgcn_exp2f(s.x); e.y = __builtin_amdgcn_exp2f(s.y);
    const f32x2 m = v * (q * e), r = v - m;
    f32x2 o; o.x = v.x < 0.f ? m.x : r.x; o.y = v.y < 0.f ? m.y : r.y; return o;
}

template <int ACT  > struct EpiBf16 {
    static constexpr bool PERM = true, AFTER_DRAIN = false; static_assert(ACT == 0 || ACT == 1, "EpiBf16: ACT is 0 (none) or 1 (gelu_pk)");
    bf16_t* O; int ldc; const float* bias; int split_cols; size_t split_stride; float scale0; int rskip;
    __device__ __forceinline__ void operator()(const f32x4 (&acc)[2][2][4][2], const Unit& u, int wr, int wc, int fr, int fq) const {
        const int row0 = u.pm * BM + wr * 64 + fr + (u.pm >> 3) * rskip; int colt = u.pn * BM; bf16_t* base = O;
        float sc = 1.f; if (split_cols) { const int t = colt / split_cols; base += (size_t)t * split_stride; colt -= t * split_cols; if (t == 0) sc = scale0; }
        const int col0 = colt + wc * 32 + 8 * fq, bcol0 = u.pn * BM + wc * 32 + 8 * fq;
        f32x4 bv[2][2];
#pragma unroll
        for (int bj = 0; bj < 2; ++bj)
#pragma unroll
            for (int n = 0; n < 2; ++n) bv[bj][n] = bias ? *(const f32x4*)(bias + bcol0 + bj * HALF + 4 * n) : (f32x4){0.f, 0.f, 0.f, 0.f};
#pragma unroll
        for (int ai = 0; ai < 2; ++ai)
#pragma unroll
            for (int m = 0; m < 4; ++m) { bf16_t* rowp = base + (size_t)(row0 + ai * HALF + m * 16) * ldc + col0;
#pragma unroll
                for (int bj = 0; bj < 2; ++bj) { f32x4 v0 = acc[ai][bj][m][0] + bv[bj][0], v1 = acc[ai][bj][m][1] + bv[bj][1];
                    if (ACT == 1) { f32x2 a = gelu_pk((f32x2){v0[0], v0[1]}), b = gelu_pk((f32x2){v0[2], v0[3]}), c = gelu_pk((f32x2){v1[0], v1[1]}), d = gelu_pk((f32x2){v1[2], v1[3]});
                        v0 = (f32x4){a.x, a.y, b.x, b.y}; v1 = (f32x4){c.x, c.y, d.x, d.y}; }
                    v0 = v0 * sc; v1 = v1 * sc; u32x4 w; w.x = cvt_pk_bf16(v0[0], v0[1]); w.y = cvt_pk_bf16(v0[2], v0[3]); w.z = cvt_pk_bf16(v1[0], v1[1]); w.w = cvt_pk_bf16(v1[2], v1[3]);
                    *(u32x4*)(rowp + bj * HALF) = w; } }
    }
};


struct EpiF32 {
    static constexpr bool PERM = false, AFTER_DRAIN = false;
    float* O; int ldc;
    __device__ __forceinline__ void operator()(const f32x4 (&acc)[2][2][4][2], const Unit& u, int wr, int wc, int fr, int fq) const {
        const int row0 = u.pm * BM + wr * 64 + fr, col0 = u.pn * BM + wc * 32 + 4 * fq;
#pragma unroll
        for (int ai = 0; ai < 2; ++ai)
#pragma unroll
            for (int m = 0; m < 4; ++m) { float* rowp = O + (size_t)(row0 + ai * HALF + m * 16) * ldc + col0;
#pragma unroll
                for (int bj = 0; bj < 2; ++bj)
#pragma unroll
                    for (int n = 0; n < 2; ++n) *(f32x4*)(rowp + bj * HALF + n * 16) = acc[ai][bj][m][n]; }
    }
};
struct EpiSplitK {
    static constexpr bool PERM = false, AFTER_DRAIN = false;
    float* O; bf16_t* O2; int ldc;
    __device__ __forceinline__ void operator()(const f32x4 (&acc)[2][2][4][2], const Unit& u, int wr, int wc, int fr, int fq) const {
        const int row0 = u.pm * BM + wr * 64 + fr, col0 = (u.pn & 3) * BM + wc * 32 + 4 * fq; const bool hi = u.pn >= 4;
#pragma unroll
        for (int ai = 0; ai < 2; ++ai)
#pragma unroll
            for (int m = 0; m < 4; ++m) { const size_t ro = (size_t)(row0 + ai * HALF + m * 16) * ldc + col0;
#pragma unroll
                for (int bj = 0; bj < 2; ++bj)
#pragma unroll
                    for (int n = 0; n < 2; ++n) { const f32x4 v = acc[ai][bj][m][n];
                        if (hi) { unsigned lo = cvt_pk_bf16(v[0], v[1]), hi2 = cvt_pk_bf16(v[2], v[3]); *(uint2*)(O2 + ro + bj * HALF + n * 16) = make_uint2(lo, hi2); }
                        else *(f32x4*)(O + ro + bj * HALF + n * 16) = v; } }
    }
};
template <class Epi, class Sched, bool ALIGN_EPI, bool SP2, int KK, int LDA, int ASKIP, int KSPLIT = 0>
__device__ __forceinline__ void gemm_phase(PG8_LAS unsigned char* lds, const Gemm g, const Sched& S, const Epi& E) {
    const int tid = otid(), wid = __builtin_amdgcn_readfirstlane(tid >> 6), lane = tid & 63, wr = wid >> 2, wc = wid & 3, fr = lane & 15, fq = lane >> 4;
    constexpr int K = KK, nt = K / BK;
    unsigned voffA[2], voffB[2];
#pragma unroll
    for (int i = 0; i < 2; ++i) { int R, C; stage_rc(tid * 16 + i * 8192, R, C); const int Rb = Epi::PERM ? ((R & ~31) + perm32(R & 31)) : R;
        voffA[i] = (unsigned)(R * LDA + C) * 2u; voffB[i] = (unsigned)(Rb * K + C) * 2u; }
    constexpr size_t kstep = (size_t)(BK * 2);
    constexpr size_t hstepA = (size_t)HALF * LDA * 2, hstepB = (size_t)HALF * K * 2;
    constexpr size_t tstepA = 2 * hstepA, tstepB = 2 * hstepB;
    const unsigned ldsw = (unsigned)wid * 1024u;
    const int aoff = lds_byte(wr * 64 + fr, fq * 8), boff = lds_byte(wc * 32 + fr, fq * 8);
#define PG8_SA(b, h) (((b) * 2 + (h)) * HTB)
#define PG8_SB(b, h) ((4 + (b) * 2 + (h)) * HTB)
#define PG8_STAGE(bufoff, gbase, voff) do { _Pragma("unroll") for (int _i = 0; _i < 2; ++_i) \
        __builtin_amdgcn_global_load_lds((const unsigned*)((const char*)(gbase) + (voff)[_i]), (PG8_LAS unsigned*)(lds + (bufoff) + ldsw + _i * 8192), 16, 0, 0); } while (0)
#define PG8_LDA(dst, b, h) do { _Pragma("unroll") for (int m = 0; m < 4; ++m) _Pragma("unroll") for (int k = 0; k < 2; ++k) dst[m][k] = *(const PG8_LAS bf16x8*)(lds + PG8_SA(b, h) + aoff + m * 2048 + k * 1024); } while (0)
#define PG8_LDB(dst, b, h) do { _Pragma("unroll") for (int n = 0; n < 2; ++n) _Pragma("unroll") for (int k = 0; k < 2; ++k) dst[n][k] = *(const PG8_LAS bf16x8*)(lds + PG8_SB(b, h) + boff + n * 2048 + k * 1024); } while (0)
#define PG8_MMA(ai, bj, At, Bt) do { __builtin_amdgcn_s_setprio(1); _Pragma("unroll") for (int m = 0; m < 4; ++m) _Pragma("unroll") for (int n = 0; n < 2; ++n) _Pragma("unroll") for (int k = 0; k < 2; ++k) \
        acc[ai][bj][m][n] = __builtin_amdgcn_mfma_f32_16x16x32_bf16(Bt[n][k], At[m][k], acc[ai][bj][m][n], 0, 0, 0); __builtin_amdgcn_s_setprio(0); } while (0)
#define PG8_WAIT_V(n) asm volatile("s_waitcnt vmcnt(" #n ")" ::: "memory")
#define PG8_WAIT_L(n) asm volatile("s_waitcnt lgkmcnt(" #n ")" ::: "memory")
#define PG8_BAR __builtin_amdgcn_s_barrier()
#define PG8_SCHED __builtin_amdgcn_sched_barrier(0)
    Unit cur, nxt; int ui = 0;
    if (!S.next(0, cur)) return;
    f32x4 acc[2][2][4][2];
#pragma unroll
    for (int a = 0; a < 2; ++a)
#pragma unroll
        for (int b = 0; b < 2; ++b)
#pragma unroll
            for (int m = 0; m < 4; ++m)
#pragma unroll
                for (int n = 0; n < 2; ++n) acc[a][b][m][n] = (f32x4){0.f, 0.f, 0.f, 0.f};
    bf16x8 At[4][2], B0[2][2], B1[2][2];
    const char* cA = (const char*)g.A + (size_t)cur.pm * tstepA + (size_t)(cur.pm >> 3) * (ASKIP * LDA * 2) + (size_t)(KSPLIT ? (cur.pn >> 2) : 0) * (KSPLIT * 2); const char* cB = (const char*)g.Bt + (size_t)cur.pn * tstepB;
    S.a_ready(cur);
    if constexpr (SP2) {
        PG8_STAGE(PG8_SB(0, 0), cB, voffB); PG8_STAGE(PG8_SB(0, 1), cB + hstepB, voffB); PG8_STAGE(PG8_SA(0, 0), cA, voffA); PG8_STAGE(PG8_SA(0, 1), cA + hstepA, voffA);
        if (wr == 1) PG8_BAR;
        PG8_WAIT_V(2); PG8_BAR;
        PG8_STAGE(PG8_SB(1, 0), cB + kstep, voffB); PG8_STAGE(PG8_SA(1, 0), cA + kstep, voffA); PG8_STAGE(PG8_SB(1, 1), cB + hstepB + kstep, voffB);
        PG8_WAIT_V(6); PG8_BAR;
    } else {
        PG8_STAGE(PG8_SB(0, 0), cB, voffB); PG8_STAGE(PG8_SA(0, 0), cA, voffA); PG8_STAGE(PG8_SB(0, 1), cB + hstepB, voffB); PG8_STAGE(PG8_SA(0, 1), cA + hstepA, voffA);
        if (wr == 1) PG8_BAR;
        PG8_WAIT_V(4); PG8_BAR;
        PG8_STAGE(PG8_SB(1, 0), cB + kstep, voffB); PG8_STAGE(PG8_SA(1, 0), cA + kstep, voffA); PG8_STAGE(PG8_SB(1, 1), cB + hstepB + kstep, voffB);
        PG8_WAIT_V(6); PG8_BAR;
    }
    for (;;) {
        const bool has_next = S.next(ui + 1, nxt);
        const char* nA = has_next ? (const char*)g.A + (size_t)nxt.pm * tstepA + (size_t)(nxt.pm >> 3) * (ASKIP * LDA * 2) + (size_t)(KSPLIT ? (nxt.pn >> 2) : 0) * (KSPLIT * 2) : cA; const char* nB = has_next ? (const char*)g.Bt + (size_t)nxt.pn * tstepB : cB;
        for (int t = 0; t < nt; t += 2) {
            const bool last = (t == nt - 2);
            const char* a1 = cA + (size_t)(t + 1) * kstep;
            const char* a2 = last ? nA : cA + (size_t)(t + 2) * kstep; const char* b2 = last ? nB : cB + (size_t)(t + 2) * kstep;
            const char* a3 = a2 + kstep; const char* b3 = b2 + kstep;
            if (last && has_next) S.a_ready(nxt);
            if constexpr (SP2) {
            PG8_LDB(B0, 0, 0); PG8_LDB(B1, 0, 1); PG8_SCHED; PG8_LDA(At, 0, 0); PG8_STAGE(PG8_SA(1, 1), a1 + hstepA, voffA);
            PG8_WAIT_V(8); PG8_WAIT_L(0); PG8_BAR; PG8_MMA(0, 0, At, B0); PG8_MMA(0, 1, At, B1); PG8_BAR; PG8_SCHED;
            PG8_LDA(At, 0, 1); PG8_STAGE(PG8_SB(0, 0), b2, voffB); PG8_STAGE(PG8_SB(0, 1), b2 + hstepB, voffB); PG8_STAGE(PG8_SA(0, 0), a2, voffA);
            PG8_WAIT_V(8); PG8_WAIT_L(0); PG8_BAR; PG8_MMA(1, 0, At, B0); PG8_MMA(1, 1, At, B1); PG8_BAR; PG8_SCHED;
            PG8_LDB(B0, 1, 0); PG8_LDB(B1, 1, 1); PG8_SCHED; PG8_LDA(At, 1, 0); PG8_STAGE(PG8_SA(0, 1), a2 + hstepA, voffA);
            PG8_WAIT_V(8); PG8_WAIT_L(0); PG8_BAR; PG8_MMA(0, 0, At, B0); PG8_MMA(0, 1, At, B1); PG8_BAR; PG8_SCHED;
            PG8_LDA(At, 1, 1); PG8_STAGE(PG8_SB(1, 0), b3, voffB); PG8_STAGE(PG8_SB(1, 1), b3 + hstepB, voffB); PG8_STAGE(PG8_SA(1, 0), a3, voffA);
            PG8_WAIT_V(8); PG8_WAIT_L(0); PG8_BAR; PG8_MMA(1, 0, At, B0); PG8_MMA(1, 1, At, B1); PG8_BAR; PG8_SCHED;
            } else {
            PG8_LDB(B0, 0, 0); PG8_SCHED; PG8_LDA(At, 0, 0); PG8_STAGE(PG8_SA(1, 1), a1 + hstepA, voffA);
            PG8_WAIT_L(8); PG8_BAR; PG8_WAIT_L(0); PG8_MMA(0, 0, At, B0); PG8_BAR; PG8_SCHED;
            PG8_LDB(B1, 0, 1); PG8_STAGE(PG8_SB(0, 0), b2, voffB);
            PG8_BAR; PG8_WAIT_L(0); PG8_MMA(0, 1, At, B1); PG8_BAR;
            PG8_LDA(At, 0, 1); PG8_STAGE(PG8_SA(0, 0), a2, voffA);
            PG8_BAR; PG8_WAIT_L(0); PG8_MMA(1, 0, At, B0); PG8_BAR; PG8_SCHED;
            PG8_STAGE(PG8_SB(0, 1), b2 + hstepB, voffB);
            PG8_WAIT_V(6); PG8_BAR; PG8_MMA(1, 1, At, B1); PG8_BAR;
            PG8_LDB(B0, 1, 0); PG8_SCHED; PG8_LDA(At, 1, 0); PG8_STAGE(PG8_SA(0, 1), a2 + hstepA, voffA);
            PG8_WAIT_L(8); PG8_BAR; PG8_WAIT_L(0); PG8_MMA(0, 0, At, B0); PG8_BAR; PG8_SCHED;
            PG8_LDB(B1, 1, 1); PG8_STAGE(PG8_SB(1, 0), b3, voffB);
            PG8_BAR; PG8_WAIT_L(0); PG8_MMA(0, 1, At, B1); PG8_BAR;
            PG8_LDA(At, 1, 1); PG8_STAGE(PG8_SA(1, 0), a3, voffA);
            PG8_BAR; PG8_WAIT_L(0); PG8_MMA(1, 0, At, B0); PG8_BAR; PG8_SCHED;
            PG8_STAGE(PG8_SB(1, 1), b3 + hstepB, voffB);
            PG8_WAIT_V(6); PG8_BAR; PG8_MMA(1, 1, At, B1); PG8_BAR;
            }
        }
        if constexpr (ALIGN_EPI) { if (wr == 0) PG8_BAR; }
        if constexpr (!Epi::AFTER_DRAIN) { E(acc, cur, wr, wc, fr, fq); S.done(cur); }
        if (!has_next) break;
#pragma unroll
        for (int a = 0; a < 2; ++a)
#pragma unroll
            for (int b = 0; b < 2; ++b)
#pragma unroll
                for (int m = 0; m < 4; ++m)
#pragma unroll
                    for (int n = 0; n < 2; ++n) acc[a][b][m][n] = (f32x4){0.f, 0.f, 0.f, 0.f};
        cur = nxt; cA = nA; cB = nB; ++ui;
        if constexpr (ALIGN_EPI) { if (wr == 1) PG8_BAR; }
    }
    PG8_WAIT_V(0);
    if constexpr (!ALIGN_EPI) { if (wr == 0) PG8_BAR; }
    PG8_BAR;
    if constexpr (Epi::AFTER_DRAIN) { E.fused(acc, cur, wr, wc, fr, fq, lds, wid, lane); S.done(cur); }
#undef PG8_SA
#undef PG8_SB
#undef PG8_STAGE
#undef PG8_LDA
#undef PG8_LDB
#undef PG8_MMA
#undef PG8_WAIT_V
#undef PG8_WAIT_L
#undef PG8_BAR
#undef PG8_SCHED
}
}

#define XB_TMO      128
#define XB_XCNT(j)  (256  + 64 * (j))
#define XB_XSUB(j)  (1280 + 64 * (j))
#define XB_XGEN(j)  (2304 + 64 * (j))
#define XB_TOP      3328
#define XB_TOPGEN   3392
#define XCD_BAR_WORDS 3456
#define XB_SPIN_CAP (1u << 18)
DI unsigned xb_ld(unsigned* p)              { return __hip_atomic_load(p, __ATOMIC_RELAXED, __HIP_MEMORY_SCOPE_AGENT); }
DI unsigned xb_add(unsigned* p, unsigned v) { return __hip_atomic_fetch_add(p, v, __ATOMIC_RELAXED, __HIP_MEMORY_SCOPE_AGENT); }
DI unsigned xb_xcc_id() { return (unsigned)__builtin_amdgcn_s_getreg((3 << 11) | 20) & 0xFu; }
#define XB_SPIN(cond, bar) do { unsigned _sp = 0; while (cond) { __builtin_amdgcn_s_sleep(1); \
    if ((++_sp & 255u) == 0u) { if (xb_ld(&(bar)[XB_TMO])) break; if (_sp > XB_SPIN_CAP) { atomicAdd(&(bar)[XB_TMO], 1u); break; } } } } while (0)
struct XcdBarrier { unsigned* bar; unsigned x; volatile LAS unsigned* st; };
DI XcdBarrier xcd_barrier_post(unsigned* bar, volatile LAS unsigned* st) {
    XcdBarrier b; b.bar = bar; b.x = (unsigned)__builtin_amdgcn_readfirstlane((int)xb_xcc_id()); b.st = st;
    if (threadIdx.x == 0) (void)xb_add(&bar[XB_XCNT(b.x)], 1u);
    return b;
}
DI void xcd_barrier_complete(unsigned* bar, unsigned x, unsigned& nloc, unsigned& nx) {
    const unsigned Gd = gridDim.x * gridDim.y * gridDim.z;
    unsigned sum, cnt, mine, sp = 0u;
    for (;;) {
        sum = 0u; cnt = 0u; mine = 0u;
#pragma unroll
        for (unsigned j = 0; j < 16; ++j) { const unsigned cc = xb_ld(&bar[XB_XCNT(j)]); sum += cc; cnt += (cc > 0u) ? 1u : 0u; mine = (j == x) ? cc : mine; }
        if (sum == Gd) break;
        __builtin_amdgcn_s_sleep(1);
        if ((++sp & 255u) == 0u) { if (xb_ld(&bar[XB_TMO])) break; if (sp > XB_SPIN_CAP) { atomicAdd(&bar[XB_TMO], 1u); break; } }
    }
    nloc = mine > 0u ? mine : 1u; nx = cnt > 0u ? cnt : 1u;
}
DI void xcd_barrier(const XcdBarrier& b) {
    asm volatile("s_waitcnt vmcnt(0)" ::: "memory");
    __syncthreads();
    if (threadIdx.x == 0) {
        unsigned* bar = b.bar; unsigned bx = b.x; asm volatile("" : "+s"(bar), "+s"(bx));
        __builtin_amdgcn_s_waitcnt(0);
        unsigned nloc = b.st[0], nx = b.st[1];
        if (nloc == 0u) { xcd_barrier_complete(bar, bx, nloc, nx); b.st[0] = nloc; b.st[1] = nx; }
        const unsigned old = xb_add(&bar[XB_XSUB(bx)], 1u);
        const unsigned gen = old / nloc;
        if (old + 1u == (gen + 1u) * nloc) {
            __builtin_amdgcn_fence(__ATOMIC_RELEASE, "agent");
            asm volatile("s_waitcnt vmcnt(0)" ::: "memory");
            const unsigned og = xb_add(&bar[XB_TOP], 1u);
            const unsigned tg = og / nx;
            if (og + 1u == (tg + 1u) * nx) xb_add(&bar[XB_TOPGEN], 1u);
            else XB_SPIN(xb_ld(&bar[XB_TOPGEN]) == tg, bar);
            __builtin_amdgcn_fence(__ATOMIC_ACQUIRE, "agent");
            xb_add(&bar[XB_XGEN(bx)], 1u);
            asm volatile("s_waitcnt vmcnt(0)" ::: "memory");
        } else {
            XB_SPIN(xb_ld(&bar[XB_XGEN(bx)]) == gen, bar);
            __builtin_amdgcn_fence(__ATOMIC_ACQUIRE, "agent");
            asm volatile("s_waitcnt vmcnt(0)" ::: "memory");
        }
    }
    __syncthreads();
}
constexpr int LDS_BYTES = 163840, MISC_OFF = 155648 + 320, CW_BAR = 4096;
__global__ void __launch_bounds__(512) mk_fwd(Ctx c_byval) {
    CtxP c = (CtxP)__builtin_amdgcn_kernarg_segment_ptr();
    extern __shared__ __attribute__((aligned(16))) unsigned char ldsraw[];
    float* lds = (float*)ldsraw;
    const int tid = threadIdx.x, bid = blockIdx.x, nblk = gridDim.x;
    volatile LAS unsigned* MISC = (volatile LAS unsigned*)((LAS unsigned char*)ldsraw + MISC_OFF);
    if (tid < 32) MISC[tid] = 0u;
    if ((tid & 63) == 0) ((volatile LAS int*)(unsigned long)WVTAB_OFF)[hw_slot()] = tid >> 6;
    __syncthreads();
    XcdBarrier bar = xcd_barrier_post((unsigned*)(c->ws + OFF_CTL) + CW_BAR, MISC + 8);
    s_p0(c, 0, 0, lds, bid, nblk);
    s_prenorm(c, 0, 0, lds, bid, nblk);
    xcd_barrier(bar);
    for (int slab_ = 0; slab_ < 2; ++slab_)
        for (int l_ = 0; l_ < NL; ++l_) {
            int l = l_, slab = slab_; asm volatile("" : "+s"(l), "+s"(slab));
            { const bf16_t* halo = (const bf16_t*)(c->ws + OFF_CARRY + l * CARRY_L + HALO_OFF); bf16_t* pp = (bf16_t*)(c->ws + OFF_P);
              for (int i = bid * 512 + otid(); i < NB * 3 * PP; i += nblk * 512) { const int b = i / (3 * PP), r = (i / PP) % 3, col = i % PP; pp[prow_off(b, r - 3) + col] = slab == 0 ? (bf16_t)0 : halo[i]; } }
            { pg8::Gemm g{(const bf16_t*)(c->ws + OFF_H), (const bf16_t*)(c->ws + OFF_WIN + l * WIN_L), MS, PP, D, D}; pg8::StaticOrder S; S.init(MS, PP, nblk, bid);
              pg8::EpiBf16<0> E{(bf16_t*)(c->ws + OFF_P) + 3 * PP, PP, nullptr, 0, 0, 1.f, 3};
              pg8::gemm_phase<pg8::EpiBf16<0>, pg8::StaticOrder, true, true, D, D, 0>((LAS unsigned char*)ldsraw, g, S, E); }
            xcd_barrier(bar);
            s_phase2(c, l, slab, lds, bid, nblk);
            xcd_barrier(bar);
            s_stepB(c, l, slab, lds, bid, nblk);
            xcd_barrier(bar);
            if (nblk == 256) s_phase3(c, l, slab, lds, bid);
            xcd_barrier(bar);
            s_bpost(c, l, slab, lds, bid, nblk);
            xcd_barrier(bar);
            { pg8::Gemm g{(const bf16_t*)(c->ws + OFF_P) + 3 * PP + ZA, (const bf16_t*)(c->ws + OFF_WOUT + l * WOUT_L), MS, 2 * D, DMIX / 2, PP}; pg8::StaticOrder S; S.init(MS, 2 * D, nblk, bid);
              pg8::EpiSplitK E{(float*)(c->ws + OFF_Y), (bf16_t*)(c->ws + OFF_Y2), D};
              pg8::gemm_phase<pg8::EpiSplitK, pg8::StaticOrder, true, true, DMIX / 2, PP, 3, DMIX / 2>((LAS unsigned char*)ldsraw, g, S, E); }
            xcd_barrier(bar);
            s_post(c, l, slab, lds, bid, nblk);
            if (l == 1 && slab == 0) s_prenorm(c, 0, 1, lds, bid, nblk);
            xcd_barrier(bar);
        }
}

extern "C" void kernel_launch(void* const* d_in, const int* in_sizes, int n_in, void* d_out, int out_size, void* d_ws, size_t ws_size, hipStream_t stream) {
    static int grid = 0;
    if (grid == 0) {
        int dev = 0, cus = 0, per_cu = 0;
        (void)hipGetDevice(&dev);
        (void)hipDeviceGetAttribute(&cus, hipDeviceAttributeMultiprocessorCount, dev);
        (void)hipFuncSetAttribute((const void*)mk_fwd, hipFuncAttributeMaxDynamicSharedMemorySize, LDS_BYTES);
        (void)hipOccupancyMaxActiveBlocksPerMultiprocessor(&per_cu, (const void*)mk_fwd, 512, LDS_BYTES);
        if (per_cu < 1) { fprintf(stderr, "kernel_launch: occupancy query says %d blocks/CU\n", per_cu); per_cu = 1; }
        grid = cus;
        if (grid != 256) fprintf(stderr, "kernel_launch: %d CUs (built for 256)\n", grid);
    }
    Ctx c{};
    const float** f = (const float**)&c;
    for (int i = 0; i < 28; ++i) f[i] = (const float*)d_in[i];
    c.out = (float*)d_out; c.ws = (unsigned char*)d_ws;
    (void)hipMemsetAsync(d_ws, 0, 1 * MiB, stream);
    void* args[] = {&c};
    hipError_t e = hipLaunchCooperativeKernel((const void*)mk_fwd, dim3(grid), dim3(512), args, LDS_BYTES, stream);
    if (e != hipSuccess) fprintf(stderr, "cooperative launch failed: %s (grid %d)\n", hipGetErrorString(e), grid);
}
```

```cpp
#include <hip/hip_runtime.h>
#include <cstdint>
#include <cstdio>

typedef unsigned short bf16_t;
#define DI __device__ __forceinline__
#define LAS __attribute__((address_space(3)))

constexpr int NB = 4, T = 4096, D = 1024, NL = 2, G = 512, NH = 8;
constexpr int TS = 2048, MS = NB * TS, NCS = TS / 64, TSP = TS + 3;
constexpr int DIN = 7824, PP = 7936, DMIX = 2048;
constexpr int A_Q = 0, A_K = 512, A_V = 1024, A_O = 1536, B_R = 2048, B_K = 2560, B_V = 3072, B_WLO = 3584, B_ALO = 3648, C_X = 3712,
              D_Q = 4224, D_K = 4736, D_V = 5248, ZA = 5760, ZB = 6272, ZC = 6784, ZD = 7296, A_I = 7808, A_F = 7816;
constexpr size_t MiB = 1u << 20;
constexpr size_t OFF_CTL = 0, OFF_ZROW = 512 * 1024, OFF_WIN = 1 * MiB, OFF_WOUT = 32 * MiB, OFF_ROPE = 40 * MiB, OFF_CARRY = 41 * MiB,
                 OFF_LS = 45 * MiB, OFF_BON = 45 * MiB + 512 * 1024, OFF_P = 45 * MiB + 768 * 1024, OFF_SA = 170 * MiB, OFF_H = 170 * MiB,
                 OFF_SD = 170 * MiB + 17301504, OFF_CK = 203 * MiB, OFF_Y = 203 * MiB, OFF_Y2 = 235 * MiB,
                 OFF_WRT = 251 * MiB, OFF_WIT = OFF_WRT + 262144, OFF_WUT = OFF_WIT + 262144, OFF_AUT = OFF_WUT + 262144;
constexpr size_t WIN_L = (size_t)PP * D * 2, WOUT_L = (size_t)D * DMIX * 2;
constexpr size_t CARRY_L = 2 * MiB, CA_OFF = 0, CD_OFF = 540672, CB_OFF = CD_OFF + 524288, CC_OFF = CB_OFF + 524288, HALO_OFF = CC_OFF + 8192;
constexpr int SAU = 4224;

struct Ctx {
    const float *x, *norm_pre, *norm_post, *w_in, *w_out, *mconv_w, *mconv_b, *mi_bias, *mf_bias, *mnorm_w, *rmu, *rw_up, *rw0, *ra_up, *ra0,
        *rk_k, *rk_a, *rr_k, *rgn_w, *rgn_b, *lconv_w, *lconv_b, *lw_r, *lb_r, *lw_i, *lb_i, *llam, *retnorm_w;
    float* out; unsigned char* ws;
};
typedef const __attribute__((address_space(4))) Ctx* CtxP;


constexpr int WVTAB_OFF = 155648 + 512;
DI int hw_slot() { return __builtin_amdgcn_s_getreg((5 << 11) | 4) & 63; }
DI int otid() { int lane; asm volatile("v_mbcnt_lo_u32_b32 %0, -1, 0\n\tv_mbcnt_hi_u32_b32 %0, -1, %0" : "=v"(lane));
    const int wv = __builtin_amdgcn_readfirstlane(((volatile LAS int*)(unsigned long)WVTAB_OFF)[hw_slot()]);
    int t = (wv << 6) | lane; asm volatile("" : "+v"(t)); return t; }
DI size_t prow_off(int b, int tl) { return (size_t)(b * TSP + 3 + tl) * PP; }
DI float bf2f(bf16_t v) { return __uint_as_float(((unsigned)v) << 16); }
DI bf16_t f2bf(float f) { unsigned u = __float_as_uint(f); u += 0x7fffu + ((u >> 16) & 1u); return (bf16_t)(u >> 16); }
DI float sigm(float x) { return __builtin_amdgcn_rcpf(1.f + __expf(-x)); }
DI float siluf(float x) { return x * __builtin_amdgcn_rcpf(1.f + __expf(-x)); }
DI float softplusf(float x) { return fmaxf(x, 0.f) + log1pf(expf(-fabsf(x))); }
DI float wave_sum(float v) {
#pragma unroll
    for (int o = 1; o < 64; o <<= 1) v += __shfl_xor(v, o);
    return v;
}
DI int srccol(int n) {
    if (n < 2048) return n;
    if (n < 3712) return n + 528;
    if (n < 4224) return n + 1040;
    if (n < 5760) return n + 1552;
    if (n < 6272) return n - 3712;
    if (n < 6784) return n - 2032;
    if (n < 7296) return n - 1520;
    if (n < 7808) return n + 16;
    if (n < 7824) return n - 5248;
    return -1;
}
DI void wt_item(const float* W, int K, int N, bf16_t* WT, bool permute, float* scr, int item, int lane, bool ksplit = false) {
    const int nblk = (permute ? PP : N) / 32, kb = item / nblk, nb = item % nblk, k0 = 64 * kb, n0 = 32 * nb;
    const int nn = n0 + (lane & 31); const int sc = permute ? srccol(nn) : nn;
    for (int i = 0; i < 32; ++i) { const int kk = 2 * i + (lane >> 5); scr[kk * 33 + (lane & 31)] = sc >= 0 ? W[(size_t)(k0 + kk) * N + sc] : 0.f; }
    __builtin_amdgcn_s_waitcnt(0); __builtin_amdgcn_wave_barrier();
    const int c = lane & 7;
    for (int j = 0; j < 4; ++j) { const int n = (lane >> 3) + 8 * j; const float* s = scr + (8 * c) * 33 + n;
        uint4 o; o.x = f2bf(s[0]) | ((unsigned)f2bf(s[33]) << 16); o.y = f2bf(s[66]) | ((unsigned)f2bf(s[99]) << 16);
        o.z = f2bf(s[132]) | ((unsigned)f2bf(s[165]) << 16); o.w = f2bf(s[198]) | ((unsigned)f2bf(s[231]) << 16);
        if (ksplit) *(uint4*)(WT + (size_t)((k0 >> 10) * N + n0 + n) * (K / 2) + (k0 & 1023) + 8 * c) = o;
        else *(uint4*)(WT + (size_t)(n0 + n) * K + k0 + 8 * c) = o; }
    __builtin_amdgcn_s_waitcnt(0); __builtin_amdgcn_wave_barrier();
}
DI void s_p0(CtxP c, int l, int slab, float* lds, int bid, int nblk) {
    const int tid = otid(), lane = tid & 63, wave = tid >> 6;
    float* scr = lds + wave * (64 * 33);
    const int gw = bid * 8 + wave, NGW = nblk * 8;
    constexpr int I_IN = (D / 64) * (PP / 32), I_OUT = (DMIX / 64) * (D / 32);
    for (int it = gw; it < NL * (I_IN + I_OUT); it += NGW) {
        const int l = it / (I_IN + I_OUT); int r = it % (I_IN + I_OUT);
        if (r < I_IN) wt_item(c->w_in + (size_t)l * D * DIN, D, DIN, (bf16_t*)(c->ws + OFF_WIN + l * WIN_L), true, scr, r, lane);
        else wt_item(c->w_out + (size_t)l * DMIX * D, DMIX, D, (bf16_t*)(c->ws + OFF_WOUT + l * WOUT_L), false, scr, r - I_IN, lane, true);
    }
    { bf16_t* wrt = (bf16_t*)(c->ws + OFF_WRT); bf16_t* wit = (bf16_t*)(c->ws + OFF_WIT); bf16_t* wut = (bf16_t*)(c->ws + OFF_WUT); bf16_t* aut = (bf16_t*)(c->ws + OFF_AUT);
      for (int i = bid * 512 + tid; i < NL * NH * 4096; i += nblk * 512) { const int lh = i >> 12, j = (i >> 6) & 63, ii = i & 63;
          wrt[i] = f2bf(c->lw_r[(size_t)lh * 4096 + ii * 64 + j]); wit[i] = f2bf(c->lw_i[(size_t)lh * 4096 + ii * 64 + j]); }
      for (int i = bid * 512 + tid; i < NL * G * 64; i += nblk * 512) { const int l2 = i / (G * 64), j = (i >> 6) % G, ii = i & 63;
          wut[i] = f2bf(c->rw_up[(size_t)l2 * 64 * G + ii * G + j]); aut[i] = f2bf(c->ra_up[(size_t)l2 * 64 * G + ii * G + j]); } }
    float* rope = (float*)(c->ws + OFF_ROPE);
    for (int i = bid * 512 + tid; i < T * 32; i += nblk * 512) {
        const int t = i >> 5, j = i & 31; const float inv = powf(10000.f, -(float)j / 32.f); const float ang = (float)t * inv;
        rope[2 * i] = cosf(ang); rope[2 * i + 1] = sinf(ang);
    }
}
DI void norm_row(const float* xrow, const float* g, bf16_t* hrow, int lane) {
    float4 v[4]; float ss = 0.f;
#pragma unroll
    for (int j = 0; j < 4; ++j) { v[j] = *(const float4*)(xrow + j * 256 + lane * 4); ss += v[j].x * v[j].x + v[j].y * v[j].y + v[j].z * v[j].z + v[j].w * v[j].w; }
    ss = wave_sum(ss); const float rs = rsqrtf(ss * (1.f / D) + 1e-6f);
#pragma unroll
    for (int j = 0; j < 4; ++j) { const float4 gg = *(const float4*)(g + j * 256 + lane * 4);
        uint2 o; o.x = f2bf(v[j].x * rs * gg.x) | ((unsigned)f2bf(v[j].y * rs * gg.y) << 16); o.y = f2bf(v[j].z * rs * gg.z) | ((unsigned)f2bf(v[j].w * rs * gg.w) << 16);
        *(uint2*)(hrow + j * 256 + lane * 4) = o; }
}
DI void s_prenorm(CtxP c, int l, int slab, float* lds, int bid, int nblk) {
    const int lane = otid() & 63, gw = bid * 8 + (otid() >> 6), NGW = nblk * 8;
    for (int r = gw; r < MS; r += NGW) { const int b = r / TS, tl = r % TS; const size_t grow = (size_t)b * T + slab * TS + tl;
        norm_row(c->x + grow * D, c->norm_pre, (bf16_t*)(c->ws + OFF_H) + (size_t)r * D, lane); }
}
DI float ret_logg(int h) { return log1pf(-exp2f(-5.f - (float)h)); }
DI void s_stepB(CtxP c, int l, int slab, float* lds, int bid, int nblk) {
    const int tid = otid();
    for (int item = bid; item < 288 + 256 + 4; item += nblk) {
        if (item < 288) {
            const int bh = item / 9, part = item % 9, el = part * 512 + tid; const bool on = el < 4160;
            float* CA = (float*)(c->ws + OFF_CARRY + l * CARRY_L + CA_OFF) + (size_t)bh * SAU; float* S0 = (float*)(c->ws + OFF_SA) + (size_t)(bh * NCS) * SAU;
            float m = slab == 0 ? 0.f : CA[4160 + slab - 1]; float val = (slab == 0 || !on) ? 0.f : CA[el];
            float loc[NCS], ml[NCS], tt[NCS];
#pragma unroll
            for (int cl = 0; cl < NCS; ++cl) { const float* S = S0 + (size_t)cl * SAU; ml[cl] = S[4160]; tt[cl] = S[4161]; loc[cl] = on ? S[el] : 0.f; }
#pragma unroll
            for (int cl = 0; cl < NCS; ++cl) { float* S = S0 + (size_t)cl * SAU;
                if (on) S[el] = val;
                if (el == 0) S[4162] = m;
                const float mn = fmaxf(tt[cl] + m, ml[cl]); val = expf(tt[cl] + m - mn) * val + expf(ml[cl] - mn) * loc[cl]; m = mn; }
            if (on) CA[el] = val;
            if (el == 0) CA[4160 + slab] = m;
        } else if (item < 288 + 256) {
            const int it = item - 288, bh = it / 8, el = (it % 8) * 512 + tid; const float gch = expf(ret_logg(bh % NH) * 64.f);
            float* CD = (float*)(c->ws + OFF_CARRY + l * CARRY_L + CD_OFF) + (size_t)bh * 4096; float* S0 = (float*)(c->ws + OFF_SD) + (size_t)(bh * NCS) * 4096;
            float val = slab == 0 ? 0.f : CD[el]; float loc[NCS];
#pragma unroll
            for (int cl = 0; cl < NCS; ++cl) loc[cl] = S0[(size_t)cl * 4096 + el];
#pragma unroll
            for (int cl = 0; cl < NCS; ++cl) { S0[(size_t)cl * 4096 + el] = val; val = gch * val + loc[cl]; }
            CD[el] = val;
        } else {
            const int i = (item - 544) * 512 + tid, b = i / G, ch = i % G; float* CC = (float*)(c->ws + OFF_CARRY + l * CARRY_L + CC_OFF);
            float hc = slab == 0 ? 0.f : CC[i]; float2 v[NCS];
#pragma unroll
            for (int cl = 0; cl < NCS; ++cl) v[cl] = *(const float2*)((const float*)(c->ws + OFF_LS) + ((size_t)(b * NCS + cl) * G + ch) * 2);
#pragma unroll
            for (int cl = 0; cl < NCS; ++cl) { ((float*)(c->ws + OFF_LS))[((size_t)(b * NCS + cl) * G + ch) * 2] = hc; hc = v[cl].x * hc + v[cl].y; }
            CC[i] = hc;
        }
    }
}
typedef short bf16x8 __attribute__((ext_vector_type(8)));
typedef float f32x16 __attribute__((ext_vector_type(16)));
typedef float f32x2_t __attribute__((ext_vector_type(2)));
typedef __bf16 bf16x2_t __attribute__((ext_vector_type(2)));
DI unsigned pk2(float lo, float hi) { f32x2_t v = {lo, hi}; bf16x2_t b = __builtin_convertvector(v, bf16x2_t); return __builtin_bit_cast(unsigned, b); }
DI bf16x8 pack8(const float* v) { uint4 u; u.x = pk2(v[0], v[1]); u.y = pk2(v[2], v[3]); u.z = pk2(v[4], v[5]); u.w = pk2(v[6], v[7]); return __builtin_bit_cast(bf16x8, u); }
DI void unpack8(uint4 u, float* v) { v[0] = __uint_as_float(u.x << 16); v[1] = __uint_as_float(u.x & 0xffff0000u); v[2] = __uint_as_float(u.y << 16); v[3] = __uint_as_float(u.y & 0xffff0000u);
    v[4] = __uint_as_float(u.z << 16); v[5] = __uint_as_float(u.z & 0xffff0000u); v[6] = __uint_as_float(u.w << 16); v[7] = __uint_as_float(u.w & 0xffff0000u); }
#define MFMA32(a, b, c) __builtin_amdgcn_mfma_f32_32x32x16_bf16((a), (b), (c), 0, 0, 0)
#define WSYNC() do { __builtin_amdgcn_fence(__ATOMIC_RELEASE, "wavefront"); __builtin_amdgcn_wave_barrier(); __builtin_amdgcn_fence(__ATOMIC_ACQUIRE, "wavefront"); } while (0)
DI float wave_psum(float v, int lane) {
#pragma unroll
    for (int o = 1; o < 64; o <<= 1) { const float t = __shfl_up(v, o); if (lane >= o) v += t; }
    return v;
}
DI float wave_pmax(float v, int lane) {
#pragma unroll
    for (int o = 1; o < 64; o <<= 1) { const float t = __shfl_up(v, o); if (lane >= o) v = fmaxf(v, t); }
    return v;
}
DI float wave_max(float v) {
#pragma unroll
    for (int o = 1; o < 64; o <<= 1) v = fmaxf(v, __shfl_xor(v, o));
    return v;
}
constexpr int TP = 144;
constexpr int WLDS = 19456;
#define TILE_K(NR) (((NR) * 8 + 63) / 64)
typedef unsigned u32x4 __attribute__((ext_vector_type(4)));
template <int NR> DI void tile_load(u32x4 (&tv)[TILE_K(NR)], const bf16_t* rb  , int tl_first, int col, int lane) {
#pragma unroll
    for (int k = 0; k < (NR * 8 + 63) / 64; ++k) { const int i = lane + 64 * k; int r = i >> 3; r = r < NR ? r : NR - 1; const int ch = i & 7;
        tv[k] = *(const u32x4*)(rb + (tl_first + r) * PP + col + ch * 8); }
}
template <int NR> DI void tile_store(const u32x4 (&tv)[TILE_K(NR)], unsigned char* tile, int lane) {
#pragma unroll
    for (int k = 0; k < (NR * 8 + 63) / 64; ++k) { const int i = lane + 64 * k; const int r = i >> 3, ch = i & 7;
        if (i < NR * 8) *(u32x4*)(tile + r * TP + ch * 16) = tv[k]; }
    WSYNC();
}
DI void proc_conv_tile(unsigned char* tile, const float* cw, int cws, const float* cb, float scale, int lane) {
    const int ch = lane & 7; float w[4][8], bb[8];
#pragma unroll
    for (int t = 0; t < 4; ++t) { const float4 a = *(const float4*)(cw + t * cws + ch * 8), d = *(const float4*)(cw + t * cws + ch * 8 + 4);
        w[t][0] = a.x; w[t][1] = a.y; w[t][2] = a.z; w[t][3] = a.w; w[t][4] = d.x; w[t][5] = d.y; w[t][6] = d.z; w[t][7] = d.w; }
    { const float4 a = *(const float4*)(cb + ch * 8), d = *(const float4*)(cb + ch * 8 + 4); bb[0] = a.x; bb[1] = a.y; bb[2] = a.z; bb[3] = a.w; bb[4] = d.x; bb[5] = d.y; bb[6] = d.z; bb[7] = d.w; }
#pragma unroll
    for (int k = 0; k < 8; ++k) { const int row = (lane >> 3) + 8 * k; float acc[8];
#pragma unroll
        for (int i = 0; i < 8; ++i) acc[i] = bb[i];
#pragma unroll
        for (int t = 0; t < 4; ++t) { float x[8]; unpack8(*(const uint4*)(tile + (row + t) * TP + ch * 16), x);
#pragma unroll
            for (int i = 0; i < 8; ++i) acc[i] += x[i] * w[t][i]; }
#pragma unroll
        for (int i = 0; i < 8; ++i) acc[i] = siluf(acc[i]) * scale;
        const bf16x8 res = pack8(acc); WSYNC();
        *(bf16x8*)(tile + row * TP + ch * 16) = res; }
    WSYNC();
}
DI void proc_rope_tile(unsigned char* tile, const float* ropet, int pos0, float scale, int lane) {
    const int p = lane & 3;
#pragma unroll
    for (int k = 0; k < 4; ++k) { const int row = (lane >> 2) + 16 * k; float x1[8], x2[8], o1[8], o2[8];
        unpack8(*(const uint4*)(tile + row * TP + p * 16), x1); unpack8(*(const uint4*)(tile + row * TP + (p + 4) * 16), x2);
        const float* cs = ropet + ((size_t)(pos0 + row) * 32 + p * 8) * 2;
#pragma unroll
        for (int q = 0; q < 4; ++q) { const float4 v = *(const float4*)(cs + 4 * q);
            o1[2 * q] = (x1[2 * q] * v.x - x2[2 * q] * v.y) * scale; o2[2 * q] = (x2[2 * q] * v.x + x1[2 * q] * v.y) * scale;
            o1[2 * q + 1] = (x1[2 * q + 1] * v.z - x2[2 * q + 1] * v.w) * scale; o2[2 * q + 1] = (x2[2 * q + 1] * v.z + x1[2 * q + 1] * v.w) * scale; }
        *(bf16x8*)(tile + row * TP + p * 16) = pack8(o1); *(bf16x8*)(tile + row * TP + (p + 4) * 16) = pack8(o2); asm volatile("" ::: "memory"); }
    WSYNC();
}
DI bf16x8 frag_nat(const unsigned char* tile, int row, int ch) { return *(const bf16x8*)(tile + row * TP + ch * 16); }
DI float tile_at(const unsigned char* tile, int row, int col) { return bf2f(*(const bf16_t*)(tile + row * TP + col * 2)); }

template <bool RET> DI void w_chunkA(CtxP c, int l, int slab, int u, unsigned char* wl, int lane) {
    const int bh = u / NCS, cl = u % NCS, b = bh >> 3, h = bh & 7, tl0 = cl * 64, hs = lane >> 5, li = lane & 31;
    unsigned char* tile = wl; float* tab = (float*)(wl + 9728); const bf16_t* rb = (const bf16_t*)(c->ws + OFF_P) + prow_off(b, 0);
    float* S = RET ? (float*)(c->ws + OFF_SD) + (size_t)u * 4096 : (float*)(c->ws + OFF_SA) + (size_t)u * SAU;
    float mloc = 0.f, tot = 0.f;
    u32x4 rk64[TILE_K(64)], rv64[TILE_K(64)], rk67[TILE_K(67)];
    if (RET) tile_load<64>(rk64, rb, tl0, D_K + h * 64, lane); else tile_load<67>(rk67, rb, tl0 - 3, A_K + h * 64, lane);
    tile_load<64>(rv64, rb, tl0, (RET ? D_V : A_V) + h * 64, lane);
    if (RET) { tab[lane] = expf(ret_logg(h) * (float)(63 - lane)); }
    else { const bf16_t* gr = (const bf16_t*)(c->ws + OFF_P) + prow_off(b, tl0 + lane);
        const float ig = bf2f(gr[A_I + h]) + c->mi_bias[l * NH + h]; const float lf = -softplusf(-(bf2f(gr[A_F + h]) + c->mf_bias[l * NH + h]));
        const float cum = wave_psum(lf, lane); tot = __shfl(cum, 63); const float lw = tot - cum + ig; mloc = wave_max(lw); tab[lane] = expf(lw - mloc); }
    if (RET) { tile_store<64>(rk64, tile, lane); proc_rope_tile(tile, (const float*)(c->ws + OFF_ROPE), slab * TS + tl0, 0.125f, lane); }
    else { tile_store<67>(rk67, tile, lane); proc_conv_tile(tile, c->mconv_w + l * 4096 + 512 + h * 64, 1024, c->mconv_b + l * 1024 + 512 + h * 64, 0.125f, lane); }
    bf16x8 kf[2][4]; float nl[2] = {0.f, 0.f};
#pragma unroll
    for (int db = 0; db < 2; ++db)
#pragma unroll
        for (int ks = 0; ks < 4; ++ks) { float v[8];
#pragma unroll
            for (int j = 0; j < 8; ++j) { const int t = 16 * ks + 8 * hs + j; v[j] = tile_at(tile, t, 32 * db + li); nl[db] += tab[t] * v[j]; }
            kf[db][ks] = pack8(v); }
    WSYNC();
    tile_store<64>(rv64, tile, lane);
    f32x16 acc[2][2];
#pragma unroll
    for (int eb = 0; eb < 2; ++eb)
#pragma unroll
        for (int db = 0; db < 2; ++db)
#pragma unroll
            for (int r = 0; r < 16; ++r) acc[eb][db][r] = 0.f;
#pragma unroll
    for (int eb = 0; eb < 2; ++eb)
#pragma unroll
        for (int ks = 0; ks < 4; ++ks) { float v[8];
#pragma unroll
            for (int j = 0; j < 8; ++j) { const int t = 16 * ks + 8 * hs + j; v[j] = tile_at(tile, t, 32 * eb + li) * tab[t]; }
            const bf16x8 vf = pack8(v);
#pragma unroll
            for (int db = 0; db < 2; ++db) acc[eb][db] = MFMA32(vf, kf[db][ks], acc[eb][db]); }
#pragma unroll
    for (int eb = 0; eb < 2; ++eb)
#pragma unroll
        for (int db = 0; db < 2; ++db)
#pragma unroll
            for (int r = 0; r < 16; ++r) S[(32 * eb + (r & 3) + 8 * (r >> 2) + 4 * hs) * 64 + 32 * db + li] = acc[eb][db][r];
    if (!RET) {
#pragma unroll
        for (int db = 0; db < 2; ++db) { nl[db] += __shfl_xor(nl[db], 32); if (hs == 0) S[4096 + 32 * db + li] = nl[db]; }
        if (lane == 0) { S[4160] = mloc; S[4161] = tot; } }
    WSYNC();
}
template <bool RET> DI void w_chunkC(CtxP c, int l, int slab, int u, unsigned char* wl, int lane) {
    const int bh = u / NCS, cl = u % NCS, b = bh >> 3, h = bh & 7, tl0 = cl * 64, hs = lane >> 5, li = lane & 31;
    unsigned char* tile = wl; float* tab = (float*)(wl + 9728); const bf16_t* rb = (const bf16_t*)(c->ws + OFF_P) + prow_off(b, 0);
    const float* S = RET ? (const float*)(c->ws + OFF_SD) + (size_t)u * 4096 : (const float*)(c->ws + OFF_SA) + (size_t)u * SAU;
    const float lg = RET ? ret_logg(h) : 0.f;
    float mx_t[2] = {0.f, 0.f}, sc_t[2], dnf_t[2] = {0.f, 0.f};
    if (RET) { sc_t[0] = expf(lg * (float)(li + 1)); sc_t[1] = expf(lg * (float)(li + 33)); }
    else { const bf16_t* gr = (const bf16_t*)(c->ws + OFF_P) + prow_off(b, tl0 + lane);
        const float ig = bf2f(gr[A_I + h]) + c->mi_bias[l * NH + h]; const float lf = -softplusf(-(bf2f(gr[A_F + h]) + c->mf_bias[l * NH + h]));
        const float cum = wave_psum(lf, lane); const float a = ig - cum; const float g = wave_pmax(a, lane);
        const float mst = S[4162]; const float mx = fmaxf(mst, g); const float sint = expf(mst - mx); const float dnf = expf(-(cum + mx));
        tab[lane] = a;
        mx_t[0] = __shfl(mx, li); mx_t[1] = __shfl(mx, 32 + li); sc_t[0] = __shfl(sint, li); sc_t[1] = __shfl(sint, 32 + li); dnf_t[0] = __shfl(dnf, li); dnf_t[1] = __shfl(dnf, 32 + li); }
    u32x4 rk64[TILE_K(64)], rq64[TILE_K(64)], rv64[TILE_K(64)], rk67[TILE_K(67)], rq67[TILE_K(67)];
    if (RET) { tile_load<64>(rk64, rb, tl0, D_K + h * 64, lane); tile_load<64>(rq64, rb, tl0, D_Q + h * 64, lane); }
    else { tile_load<67>(rk67, rb, tl0 - 3, A_K + h * 64, lane); tile_load<67>(rq67, rb, tl0 - 3, A_Q + h * 64, lane); }
    bf16x8 kf[2][4], qf[2][4], cf[2][4];
#pragma unroll
    for (int eb = 0; eb < 2; ++eb)
#pragma unroll
        for (int ks = 0; ks < 4; ++ks) { const float* cp = S + (32 * eb + li) * 64 + 16 * ks + 8 * hs; const float4 c0 = *(const float4*)cp, c1 = *(const float4*)(cp + 4);
            const float cv[8] = {c0.x, c0.y, c0.z, c0.w, c1.x, c1.y, c1.z, c1.w}; cf[eb][ks] = pack8(cv); }
    do { asm volatile("" ::: "memory"); __builtin_amdgcn_sched_barrier(0); } while (0);
    if (RET) { tile_store<64>(rk64, tile, lane); proc_rope_tile(tile, (const float*)(c->ws + OFF_ROPE), slab * TS + tl0, 0.125f, lane); }
    else { tile_store<67>(rk67, tile, lane); proc_conv_tile(tile, c->mconv_w + l * 4096 + 512 + h * 64, 1024, c->mconv_b + l * 1024 + 512 + h * 64, 0.125f, lane); }
#pragma unroll
    for (int mb = 0; mb < 2; ++mb)
#pragma unroll
        for (int ks = 0; ks < 4; ++ks) kf[mb][ks] = frag_nat(tile, 32 * mb + li, 2 * ks + hs);
    WSYNC(); __builtin_amdgcn_sched_barrier(0);
    tile_load<64>(rv64, rb, tl0, (RET ? D_V : A_V) + h * 64, lane);
    if (RET) { tile_store<64>(rq64, tile, lane); proc_rope_tile(tile, (const float*)(c->ws + OFF_ROPE), slab * TS + tl0, 1.f, lane); }
    else { tile_store<67>(rq67, tile, lane); proc_conv_tile(tile, c->mconv_w + l * 4096 + h * 64, 1024, c->mconv_b + l * 1024 + h * 64, 1.f, lane); }
#pragma unroll
    for (int nb = 0; nb < 2; ++nb)
#pragma unroll
        for (int ks = 0; ks < 4; ++ks) qf[nb][ks] = frag_nat(tile, 32 * nb + li, 2 * ks + hs);
    WSYNC(); __builtin_amdgcn_sched_barrier(0);
    tile_store<64>(rv64, tile, lane);
    const int zc = (RET ? ZD : ZA) + h * 64; const float* nw = (RET ? c->retnorm_w : c->mnorm_w) + l * G + h * 64;
#pragma unroll
    for (int nb = 0; nb < 2; ++nb) {
        bf16_t* prw = (bf16_t*)(c->ws + OFF_P) + prow_off(b, tl0 + 32 * nb + li);
        uint2 ogr[2][4], zvr[2][4];
#pragma unroll
        for (int eb = 0; eb < 2; ++eb)
#pragma unroll
            for (int rg = 0; rg < 4; ++rg) { const int e0 = 32 * eb + 8 * rg + 4 * hs; zvr[eb][rg] = *(const uint2*)(prw + zc + e0); ogr[eb][rg] = RET ? make_uint2(0u, 0u) : *(const uint2*)(prw + A_O + h * 64 + e0); }
        bf16x8 xf[2][2]; float csum = 0.f;
#pragma unroll
        for (int mb = 0; mb < 2; ++mb) {
            if (!RET && mb == 1 && nb == 0) continue;
            f32x16 sa;
#pragma unroll
            for (int r = 0; r < 16; ++r) sa[r] = 0.f;
#pragma unroll
            for (int ks = 0; ks < 4; ++ks) sa = MFMA32(kf[mb][ks], qf[nb][ks], sa);
            float xv[16];
#pragma unroll
            for (int rg = 0; rg < 4; ++rg) { float av[4] = {0.f, 0.f, 0.f, 0.f};
                if (!RET) { const float4 t4 = *(const float4*)(tab + 32 * mb + 8 * rg + 4 * hs); av[0] = t4.x; av[1] = t4.y; av[2] = t4.z; av[3] = t4.w; }
#pragma unroll
                for (int i = 0; i < 4; ++i) { const int r = 4 * rg + i, s = 32 * mb + 8 * rg + 4 * hs + i, t = 32 * nb + li;
                    float w;
                    if (RET) w = __expf(lg * fabsf((float)(t - s))); else w = s <= t ? __expf(av[i] - mx_t[nb]) : 0.f;
                    xv[r] = sa[r] * w; csum += xv[r]; } }
            xf[mb][0] = pack8(xv); xf[mb][1] = pack8(xv + 8); __builtin_amdgcn_sched_barrier(0); }
        f32x16 o[2];
#pragma unroll
        for (int eb = 0; eb < 2; ++eb) {
#pragma unroll
            for (int r = 0; r < 16; ++r) o[eb][r] = 0.f;
#pragma unroll
            for (int ks = 0; ks < 4; ++ks) o[eb] = MFMA32(cf[eb][ks], qf[nb][ks], o[eb]);
#pragma unroll
            for (int r = 0; r < 16; ++r) o[eb][r] *= sc_t[nb]; }
        __builtin_amdgcn_sched_barrier(0);
        float dn = 1.f;
        if (!RET) { float qn = 0.f;
#pragma unroll
            for (int ks = 0; ks < 4; ++ks) { const float4 n0 = *(const float4*)(S + 4096 + 16 * ks + 8 * hs), n1 = *(const float4*)(S + 4096 + 16 * ks + 8 * hs + 4);
                const float nv[8] = {n0.x, n0.y, n0.z, n0.w, n1.x, n1.y, n1.z, n1.w}; float qv[8]; unpack8(__builtin_bit_cast(uint4, qf[nb][ks]), qv);
#pragma unroll
                for (int j = 0; j < 8; ++j) qn += qv[j] * nv[j]; }
            qn += __shfl_xor(qn, 32); csum += __shfl_xor(csum, 32); dn = fmaxf(fabsf(csum + sc_t[nb] * qn), dnf_t[nb]); }
#pragma unroll
        for (int eb = 0; eb < 2; ++eb)
#pragma unroll
            for (int sb = 0; sb < 2; ++sb) {
                if (!RET && sb == 1 && nb == 0) continue;
#pragma unroll
                for (int st = 0; st < 2; ++st) { bf16x8 vf;
#pragma unroll
                    for (int j = 0; j < 8; ++j) vf[j] = (short)*(const bf16_t*)(tile + (32 * sb + 16 * st + 8 * (j >> 2) + 4 * hs + (j & 3)) * TP + (32 * eb + li) * 2);
                    o[eb] = MFMA32(vf, xf[sb][st], o[eb]); }
                do { asm volatile("" ::: "memory"); __builtin_amdgcn_sched_barrier(0); } while (0); }
        do { asm volatile("" ::: "memory"); __builtin_amdgcn_sched_barrier(0); } while (0);
        const float inv = 1.f / dn; float sum = 0.f;
#pragma unroll
        for (int eb = 0; eb < 2; ++eb)
#pragma unroll
            for (int rg = 0; rg < 4; ++rg) { const int e0 = 32 * eb + 8 * rg + 4 * hs; float og[4] = {1.f, 1.f, 1.f, 1.f};
                if (!RET) { const uint2 ov = ogr[eb][rg]; og[0] = sigm(__uint_as_float(ov.x << 16)); og[1] = sigm(__uint_as_float(ov.x & 0xffff0000u)); og[2] = sigm(__uint_as_float(ov.y << 16)); og[3] = sigm(__uint_as_float(ov.y & 0xffff0000u)); }
#pragma unroll
                for (int i = 0; i < 4; ++i) { const float v = o[eb][4 * rg + i] * inv * og[i]; o[eb][4 * rg + i] = v; sum += v; } }
        sum += __shfl_xor(sum, 32); const float mu = sum * (1.f / 64.f); float vs = 0.f;
#pragma unroll
        for (int eb = 0; eb < 2; ++eb)
#pragma unroll
            for (int r = 0; r < 16; ++r) { const float d = o[eb][r] - mu; vs += d * d; }
        vs += __shfl_xor(vs, 32); const float rstd = rsqrtf(vs * (1.f / 64.f) + 1e-5f);
#pragma unroll
        for (int eb = 0; eb < 2; ++eb)
#pragma unroll
            for (int rg = 0; rg < 4; ++rg) { const int e0 = 32 * eb + 8 * rg + 4 * hs; const uint2 zv = zvr[eb][rg]; const float4 w4 = *(const float4*)(nw + e0);
                const float z[4] = {__uint_as_float(zv.x << 16), __uint_as_float(zv.x & 0xffff0000u), __uint_as_float(zv.y << 16), __uint_as_float(zv.y & 0xffff0000u)}; const float wv[4] = {w4.x, w4.y, w4.z, w4.w}; float y[4];
#pragma unroll
                for (int i = 0; i < 4; ++i) y[i] = (o[eb][4 * rg + i] - mu) * rstd * wv[i] * siluf(z[i]);
                uint2 ov; ov.x = pk2(y[0], y[1]); ov.y = pk2(y[2], y[3]); *(uint2*)(prw + zc + e0) = ov; }
        do { asm volatile("" ::: "memory"); __builtin_amdgcn_sched_barrier(0); } while (0);
    }
    WSYNC(); __builtin_amdgcn_sched_barrier(0);
}
DI void proc_conv_tile_lin(unsigned char* tile, const float* cw, int cws, const float* cb, int lane) {
    const int ch = lane & 7; float w[4][8], bb[8];
#pragma unroll
    for (int t = 0; t < 4; ++t) { const float4 a = *(const float4*)(cw + t * cws + ch * 8), d = *(const float4*)(cw + t * cws + ch * 8 + 4);
        w[t][0] = a.x; w[t][1] = a.y; w[t][2] = a.z; w[t][3] = a.w; w[t][4] = d.x; w[t][5] = d.y; w[t][6] = d.z; w[t][7] = d.w; }
    { const float4 a = *(const float4*)(cb + ch * 8), d = *(const float4*)(cb + ch * 8 + 4); bb[0] = a.x; bb[1] = a.y; bb[2] = a.z; bb[3] = a.w; bb[4] = d.x; bb[5] = d.y; bb[6] = d.z; bb[7] = d.w; }
#pragma unroll
    for (int k = 0; k < 8; ++k) { const int row = (lane >> 3) + 8 * k; float acc[8];
#pragma unroll
        for (int i = 0; i < 8; ++i) acc[i] = bb[i];
#pragma unroll
        for (int t = 0; t < 4; ++t) { float x[8]; unpack8(*(const uint4*)(tile + (row + t) * TP + ch * 16), x);
#pragma unroll
            for (int i = 0; i < 8; ++i) acc[i] += x[i] * w[t][i]; }
        const bf16x8 res = pack8(acc); WSYNC();
        *(bf16x8*)(tile + row * TP + ch * 16) = res; }
    WSYNC();
}
DI void lru_gates(CtxP c, int l, int h, int jb, const unsigned char* tile, const bf16x8 (&xf)[2][4], float (&a)[2][16], float (&u)[2][16], int li, int hs) {
    const int j = 32 * jb + li, ch = h * 64 + j;
    const bf16_t* wr = (const bf16_t*)(c->ws + OFF_WRT) + ((size_t)(l * NH + h) * 64 + j) * 64; const bf16_t* wi = (const bf16_t*)(c->ws + OFF_WIT) + ((size_t)(l * NH + h) * 64 + j) * 64;
    bf16x8 wrf[4], wif[4];
#pragma unroll
    for (int ks = 0; ks < 4; ++ks) { wrf[ks] = *(const bf16x8*)(wr + 16 * ks + 8 * hs); wif[ks] = *(const bf16x8*)(wi + 16 * ks + 8 * hs); }
    const float br = c->lb_r[l * G + ch], bi = c->lb_i[l * G + ch], sp8 = -8.f * softplusf(-c->llam[l * G + ch]);
#pragma unroll
    for (int tb = 0; tb < 2; ++tb) { f32x16 ar, ai;
#pragma unroll
        for (int r = 0; r < 16; ++r) { ar[r] = 0.f; ai[r] = 0.f; }
#pragma unroll
        for (int ks = 0; ks < 4; ++ks) { ar = MFMA32(xf[tb][ks], wrf[ks], ar); ai = MFMA32(xf[tb][ks], wif[ks], ai); }
#pragma unroll
        for (int r = 0; r < 16; ++r) { const int t = 32 * tb + (r & 3) + 8 * (r >> 2) + 4 * hs; const float x = tile_at(tile, t, j);
            const float la = sp8 * sigm(ar[r] + br); a[tb][r] = __expf(la); u[tb][r] = sqrtf(-expm1f(2.f * la)) * (sigm(ai[r] + bi) * x); } }
}
template <bool STEP_C> DI void w_lru(CtxP c, int l, int slab, int u_, unsigned char* wl, int lane, int jb_lo, int jb_hi) {
    const int bh = u_ / NCS, cl = u_ % NCS, b = bh >> 3, h = bh & 7, tl0 = cl * 64, hs = lane >> 5, li = lane & 31;
    unsigned char* tile = wl; const bf16_t* rb = (const bf16_t*)(c->ws + OFF_P) + prow_off(b, 0);
    { u32x4 rx[TILE_K(67)]; tile_load<67>(rx, rb, tl0 - 3, C_X + h * 64, lane); tile_store<67>(rx, tile, lane); }
    proc_conv_tile_lin(tile, c->lconv_w + l * 2048 + h * 64, 512, c->lconv_b + l * 512 + h * 64, lane);
    bf16x8 xf[2][4];
#pragma unroll
    for (int tb = 0; tb < 2; ++tb)
#pragma unroll
        for (int ks = 0; ks < 4; ++ks) xf[tb][ks] = frag_nat(tile, 32 * tb + li, 2 * ks + hs);
#pragma unroll 1
    for (int jb = jb_lo; jb < jb_hi; ++jb) {
        float a[2][16], u[2][16];
        lru_gates(c, l, h, jb, tile, xf, a, u, li, hs);
        const int ch = h * 64 + 32 * jb + li; float* LS = (float*)(c->ws + OFF_LS) + ((size_t)(b * NCS + cl) * G + ch) * 2;
        float cst = STEP_C ? LS[0] : 0.f, pr = 1.f;
#pragma unroll
        for (int tb = 0; tb < 2; ++tb)
#pragma unroll
            for (int q = 0; q < 4; ++q) {
                float ga = 1.f, gu = 0.f;
#pragma unroll
                for (int i = 0; i < 4; ++i) { gu = a[tb][4 * q + i] * gu + u[tb][4 * q + i]; ga *= a[tb][4 * q + i]; }
                const float pa = __shfl_xor(ga, 32), pu = __shfl_xor(gu, 32);
                const float a0 = hs ? pa : ga, u0 = hs ? pu : gu, a1 = hs ? ga : pa, u1 = hs ? gu : pu;
                if (STEP_C) { float hv = hs ? a0 * cst + u0 : cst;
#pragma unroll
                    for (int i = 0; i < 4; ++i) { hv = a[tb][4 * q + i] * hv + u[tb][4 * q + i]; u[tb][4 * q + i] = hv; } }
                cst = a1 * (a0 * cst + u0) + u1; pr *= a0 * a1; }
        if (!STEP_C) { if (hs == 0) { LS[0] = pr; LS[1] = cst; } }
        else {
#pragma unroll
            for (int tb = 0; tb < 2; ++tb)
#pragma unroll
                for (int r = 0; r < 16; ++r) { const int t = 32 * tb + (r & 3) + 8 * (r >> 2) + 4 * hs; bf16_t* pz = (bf16_t*)(c->ws + OFF_P) + prow_off(b, tl0 + t) + ZC + ch;
                    *pz = f2bf(u[tb][r] * siluf(bf2f(*pz))); } }
        asm volatile("" ::: "memory"); __builtin_amdgcn_sched_barrier(0);
    }
    WSYNC();
}
#define DPP_ADD(v, ctrl) v += __builtin_bit_cast(float, __builtin_amdgcn_update_dpp(0, __builtin_bit_cast(int, v), ctrl, 0xF, 0xF, true))
DI float allred16(float v) { DPP_ADD(v, 0xB1); DPP_ADD(v, 0x4E); DPP_ADD(v, 0x141); DPP_ADD(v, 0x140); return v; }
DI float shx(int lane, float v, int m) { return __builtin_bit_cast(float, __builtin_amdgcn_ds_bpermute((lane ^ m) << 2, __builtin_bit_cast(int, v))); }
DI float allred32(float v, int lane) { v = allred16(v); v += shx(lane, v, 16); return v; }
template <bool TANH> DI void proc_shift_tile(unsigned char* tile, const float* mu, int lane) {
    const int ch = lane & 7; float m[8];
    { const float4 a = *(const float4*)(mu + ch * 8), d = *(const float4*)(mu + ch * 8 + 4); m[0] = a.x; m[1] = a.y; m[2] = a.z; m[3] = a.w; m[4] = d.x; m[5] = d.y; m[6] = d.z; m[7] = d.w; }
#pragma unroll
    for (int k = 0; k < 8; ++k) { const int row = (lane >> 3) + 8 * k; float xp[8], x[8];
        unpack8(*(const uint4*)(tile + row * TP + ch * 16), xp); unpack8(*(const uint4*)(tile + (row + 1) * TP + ch * 16), x);
#pragma unroll
        for (int i = 0; i < 8; ++i) { const float v = x[i] + m[i] * (xp[i] - x[i]); x[i] = TANH ? tanhf(v) : v; }
        const bf16x8 res = pack8(x); WSYNC();
        *(bf16x8*)(tile + row * TP + ch * 16) = res; }
    WSYNC();
}
constexpr int RU_PT = 0, RU_QT = 8192, RU_YS = 12288, RU_YV = 16384, RU_VT = 18432, RU_BYTES = 22528, NC32 = TS / 32;
DI int kperm(int k) { return (k & ~12) | ((k & 4) << 1) | ((k & 8) >> 1); }
template <bool TANH> DI void proc_shift_tile32(unsigned char* tile, const float* mu, int lane) {
    const int ch = lane & 7; float m[8];
    { const float4 a = *(const float4*)(mu + ch * 8), d = *(const float4*)(mu + ch * 8 + 4); m[0] = a.x; m[1] = a.y; m[2] = a.z; m[3] = a.w; m[4] = d.x; m[5] = d.y; m[6] = d.z; m[7] = d.w; }
#pragma unroll
    for (int k = 0; k < 4; ++k) { const int row = (lane >> 3) + 8 * k; float xp[8], x[8];
        unpack8(*(const uint4*)(tile + row * TP + ch * 16), xp); unpack8(*(const uint4*)(tile + (row + 1) * TP + ch * 16), x);
#pragma unroll
        for (int i = 0; i < 8; ++i) { const float v = x[i] + m[i] * (xp[i] - x[i]); x[i] = TANH ? tanhf(v) : v; }
        const bf16x8 res = pack8(x); WSYNC();
        *(bf16x8*)(tile + row * TP + ch * 16) = res; }
    WSYNC();
}
#define V32(x, i) x[(i) >> 4][(i) & 15]
template <int T> struct FSub { static DI void run(f32x16 (&a0)[2], f32x16 (&a1)[2], f32x16 (&m)[2], const f32x16& N) {
    FSub<T - 1>::run(a0, a1, m, N);
#pragma unroll
    for (int j = 0; j < T; ++j) { const float nv = N[(j & 3) + 4 * (j >> 3)]; const float s = __int_as_float(__builtin_amdgcn_readlane(__float_as_int(nv), T + 32 * ((j >> 2) & 1)));
        V32(a0, T) -= V32(a0, j) * s; V32(a1, T) -= V32(a1, j) * s; V32(m, T) -= V32(m, j) * s; }
    if ((T & 3) == 3) __builtin_amdgcn_sched_barrier(0); } };
template <> struct FSub<0> { static DI void run(f32x16 (&)[2], f32x16 (&)[2], f32x16 (&)[2], const f32x16&) {} };
DI void w_rprep(CtxP c, int l, int slab, int u_, unsigned char* wl, int lane) {
    const int bh = u_ / NC32, c32 = u_ % NC32, b = bh >> 3, h = bh & 7, tl0 = c32 * 32, hs = lane >> 5, li = lane & 31;
    unsigned char *RA = wl, *RB = wl + 4752, *TA = wl + 9504, *TB = wl + 14112, *TK = wl, *TR = wl + 4608; float* TAB = (float*)(wl + 18720);
    unsigned char* UR = c->ws + OFF_CK + (size_t)u_ * RU_BYTES;
    const float* mu = c->rmu + l * 1664; const bf16_t* rb = (const bf16_t*)(c->ws + OFF_P) + prow_off(b, 0);
    bf16x8 wlf[4], alf[4];
    { u32x4 rw[TILE_K(33)], ra[TILE_K(33)], rr_[TILE_K(33)], rk_[TILE_K(33)];
      tile_load<33>(rw, rb, tl0 - 1, B_WLO, lane); tile_load<33>(ra, rb, tl0 - 1, B_ALO, lane);
      tile_store<33>(rw, RA, lane);
      tile_load<33>(rr_, rb, tl0 - 1, B_R + h * 64, lane); tile_load<33>(rk_, rb, tl0 - 1, B_K + h * 64, lane);
      proc_shift_tile32<true>(RA, mu + 1536, lane);
#pragma unroll
      for (int ks = 0; ks < 4; ++ks) wlf[ks] = frag_nat(RA, li, 2 * ks + hs);
      WSYNC();
      tile_store<33>(ra, RA, lane); proc_shift_tile32<false>(RA, mu + 1600, lane);
#pragma unroll
      for (int ks = 0; ks < 4; ++ks) alf[ks] = frag_nat(RA, li, 2 * ks + hs);
      WSYNC();
      tile_store<33>(rr_, RA, lane); tile_store<33>(rk_, RB, lane); }
    __builtin_amdgcn_sched_barrier(0);
    float rs[16], bonp[16];
    { float kk[2], mk[2];
#pragma unroll
      for (int jb = 0; jb < 2; ++jb) { kk[jb] = c->rk_k[l * G + h * 64 + 32 * jb + li]; mk[jb] = mu[512 + h * 64 + 32 * jb + li]; }
#pragma unroll
      for (int r = 0; r < 16; ++r) { const int t = (r & 3) + 8 * (r >> 2) + 4 * hs; float ss = 0.f;
#pragma unroll
          for (int jb = 0; jb < 2; ++jb) { const float x = tile_at(RB, t + 1, 32 * jb + li), xp = tile_at(RB, t, 32 * jb + li); const float kap = (x + mk[jb] * (xp - x)) * kk[jb]; ss += kap * kap; }
          rs[r] = rsqrtf(allred32(ss, lane) + 1e-12f); bonp[r] = 0.f; } }
    __builtin_amdgcn_sched_barrier(0);
    float kq[2][16], rq[2][16];
#pragma unroll
    for (int jb = 0; jb < 2; ++jb) {
        const int j = 32 * jb + li, ch = h * 64 + j;
        const bf16_t* wu = (const bf16_t*)(c->ws + OFF_WUT) + ((size_t)l * G + ch) * 64; const bf16_t* au = (const bf16_t*)(c->ws + OFF_AUT) + ((size_t)l * G + ch) * 64;
        bf16x8 wuf[4], auf[4];
#pragma unroll
        for (int ks = 0; ks < 4; ++ks) { wuf[ks] = *(const bf16x8*)(wu + 16 * ks + 8 * hs); auf[ks] = *(const bf16x8*)(au + 16 * ks + 8 * hs); }
        const float w0 = c->rw0[l * G + ch], a0 = c->ra0[l * G + ch], kkj = c->rk_k[l * G + ch], kaj = c->rk_a[l * G + ch], rkj = c->rr_k[l * G + ch], mr = mu[ch], mk = mu[512 + ch];
        f32x16 dl, da;
#pragma unroll
        for (int r = 0; r < 16; ++r) { dl[r] = 0.f; da[r] = 0.f; }
#pragma unroll
        for (int ks = 0; ks < 4; ++ks) { dl = MFMA32(wlf[ks], wuf[ks], dl); da = MFMA32(alf[ks], auf[ks], da); }
        __builtin_amdgcn_sched_barrier(0);
        float wq[16];
#pragma unroll
        for (int r = 0; r < 16; ++r) wq[r] = __expf(-0.606531f * sigm(w0 + dl[r]));
        float Gc[16];
        { float gp[4], pp[4];
#pragma unroll
          for (int q = 0; q < 4; ++q) { gp[q] = (wq[4 * q] * wq[4 * q + 1]) * (wq[4 * q + 2] * wq[4 * q + 3]); pp[q] = shx(lane, gp[q], 32); }
          float run = 1.f;
#pragma unroll
          for (int q = 0; q < 4; ++q) { const float g0 = hs ? pp[q] : gp[q], g1 = hs ? gp[q] : pp[q]; float cur = hs ? run * g0 : run;
#pragma unroll
              for (int i = 0; i < 4; ++i) { cur *= wq[4 * q + i]; Gc[4 * q + i] = cur; }
              run = run * g0 * g1; } }
        if (hs) TAB[j] = Gc[15];
#pragma unroll
        for (int r = 0; r < 16; ++r) { const int t = (r & 3) + 8 * (r >> 2) + 4 * hs;
            const float a = sigm(a0 + da[r]);
            float x = tile_at(RA, t + 1, j), xp = tile_at(RA, t, j); const float rm = x + mr * (xp - x);
            x = tile_at(RB, t + 1, j); xp = tile_at(RB, t, j); const float km = x + mk * (xp - x);
            const float kh = km * kkj * rs[r], kt = km * (1.f + (a - 1.f) * kaj);
            bonp[r] += rm * rkj * kt;
            const float gi = __builtin_amdgcn_rcpf(Gc[r]);
            *(bf16_t*)(TA + t * TP + j * 2) = f2bf((Gc[r] / wq[r]) * kh);
            *(bf16_t*)(TB + t * TP + j * 2) = f2bf(a * kh * gi);
            kq[jb][r] = kt * gi; rq[jb][r] = Gc[r] * rm;
            if ((r & 3) == 3) { asm volatile("" ::: "memory"); __builtin_amdgcn_sched_barrier(0); } }
    }
#pragma unroll
    for (int r = 0; r < 16; ++r) { const float bsum = allred32(bonp[r], lane); const int t = (r & 3) + 8 * (r >> 2) + 4 * hs;
        if (li == 0) ((float*)(c->ws + OFF_BON))[(size_t)(b * TS + tl0 + t) * NH + h] = bsum; }
    WSYNC();
#pragma unroll
    for (int jb = 0; jb < 2; ++jb)
#pragma unroll
        for (int r = 0; r < 16; ++r) { const int t = (r & 3) + 8 * (r >> 2) + 4 * hs, j = 32 * jb + li;
            *(bf16_t*)(TK + t * TP + j * 2) = f2bf(kq[jb][r]); *(bf16_t*)(TR + t * TP + j * 2) = f2bf(rq[jb][r]); }
    { const int vch = h * 64 + lane; const float muv = mu[1024 + vch]; const bf16_t* pv = rb + B_V + vch;
      float xs[33];
#pragma unroll
      for (int t = 0; t < 33; ++t) xs[t] = bf2f(pv[(size_t)(tl0 - 1 + t) * PP]);
      unsigned pk[16];
#pragma unroll
      for (int t = 0; t < 16; ++t) pk[t] = pk2(xs[2 * t + 1] + muv * (xs[2 * t] - xs[2 * t + 1]), xs[2 * t + 2] + muv * (xs[2 * t + 1] - xs[2 * t + 2]));
#pragma unroll
      for (int q = 0; q < 4; ++q) *(uint4*)(UR + RU_VT + lane * 64 + q * 16) = make_uint4(pk[4 * q], pk[4 * q + 1], pk[4 * q + 2], pk[4 * q + 3]); }
    WSYNC(); __builtin_amdgcn_sched_barrier(0);
    f32x16 Nacc, G1acc, MTacc, G2Tacc;
#pragma unroll
    for (int r = 0; r < 16; ++r) { Nacc[r] = 0.f; G1acc[r] = 0.f; MTacc[r] = 0.f; G2Tacc[r] = 0.f; }
#pragma unroll
    for (int ks = 0; ks < 4; ++ks) { const bf16x8 fA = frag_nat(TA, li, 2 * ks + hs), fB = frag_nat(TB, li, 2 * ks + hs), fK = frag_nat(TK, li, 2 * ks + hs), fR = frag_nat(TR, li, 2 * ks + hs);
        Nacc = MFMA32(fB, fA, Nacc); G1acc = MFMA32(fB, fR, G1acc); MTacc = MFMA32(fA, fK, MTacc); G2Tacc = MFMA32(fR, fK, G2Tacc); }
#pragma unroll
    for (int r = 0; r < 16; ++r) { const int rr = (r & 3) + 8 * (r >> 2) + 4 * hs;
        Nacc[r] = rr < li ? Nacc[r] : 0.f; G1acc[r] = rr <= li ? G1acc[r] : 0.f; MTacc[r] = li < rr ? MTacc[r] : 0.f; G2Tacc[r] = li <= rr ? G2Tacc[r] : 0.f; }
    __builtin_amdgcn_sched_barrier(0);
    f32x16 at0[2], at1[2], mt[2];
#pragma unroll
    for (int t = 0; t < 32; ++t) { V32(at0, t) = tile_at(TA, t, li); V32(at1, t) = tile_at(TA, t, 32 + li); }
#pragma unroll
    for (int r = 0; r < 16; ++r) { const float own = MTacc[r], oth = shx(lane, own, 32); const int t0 = (r & 3) + 8 * (r >> 2), t1 = t0 + 4;
        V32(mt, t0) = hs ? oth : own; V32(mt, t1) = hs ? own : oth; }
    FSub<31>::run(at0, at1, mt, Nacc);
    bf16x8 atn[2][2], mtn[2], atp[2][2], mtp[2];
#pragma unroll
    for (int s = 0; s < 2; ++s) { float v0[8], v1[8], vm[8], p0[8], p1[8], pm[8];
#pragma unroll
        for (int i = 0; i < 8; ++i) { const int jn = 16 * s + i, jp = 16 * s + 8 * (i >> 2) + (i & 3);
            v0[i] = hs ? V32(at0, jn + 8) : V32(at0, jn); v1[i] = hs ? V32(at1, jn + 8) : V32(at1, jn); vm[i] = hs ? V32(mt, jn + 8) : V32(mt, jn);
            p0[i] = hs ? V32(at0, jp + 4) : V32(at0, jp); p1[i] = hs ? V32(at1, jp + 4) : V32(at1, jp); pm[i] = hs ? V32(mt, jp + 4) : V32(mt, jp); }
        atn[0][s] = pack8(v0); atn[1][s] = pack8(v1); mtn[s] = pack8(vm); atp[0][s] = pack8(p0); atp[1][s] = pack8(p1); mtp[s] = pack8(pm); }
    __builtin_amdgcn_sched_barrier(0);
    { bf16x8 g1f[2]; { float g[16];
#pragma unroll
        for (int r = 0; r < 16; ++r) g[r] = G1acc[r];
        g1f[0] = pack8(g); g1f[1] = pack8(g + 8); }
#pragma unroll
      for (int ct = 0; ct < 2; ++ct) { f32x16 acc;
#pragma unroll
          for (int r = 0; r < 16; ++r) acc[r] = 0.f;
          acc = MFMA32(g1f[0], atp[ct][0], acc); acc = MFMA32(g1f[1], atp[ct][1], acc);
#pragma unroll
          for (int r = 0; r < 16; ++r) { const int t = (r & 3) + 8 * (r >> 2) + 4 * hs, k = 32 * ct + li;
              *(bf16_t*)(UR + RU_YS + (t * 64 + kperm(k)) * 2) = f2bf(tile_at(TR, t, k) - acc[r]); } }
      { f32x16 acc;
#pragma unroll
        for (int r = 0; r < 16; ++r) acc[r] = 0.f;
        acc = MFMA32(g1f[0], mtp[0], acc); acc = MFMA32(g1f[1], mtp[1], acc);
#pragma unroll
        for (int r = 0; r < 16; ++r) { const int t = (r & 3) + 8 * (r >> 2) + 4 * hs; *(bf16_t*)(UR + RU_YV + (t * 32 + li) * 2) = f2bf(G2Tacc[r] - acc[r]); } } }
    __builtin_amdgcn_sched_barrier(0);
#pragma unroll
    for (int rt = 0; rt < 2; ++rt) { bf16x8 bmf[2];
#pragma unroll
        for (int ks = 0; ks < 2; ++ks)
#pragma unroll
            for (int i = 0; i < 8; ++i) bmf[ks][i] = (short)*(const bf16_t*)(TB + (16 * ks + 8 * hs + i) * TP + (32 * rt + li) * 2);
        float g31[16];
#pragma unroll
        for (int q = 0; q < 4; ++q) { const float4 g4 = *(const float4*)(TAB + 32 * rt + 8 * q + 4 * hs); g31[4 * q] = g4.x; g31[4 * q + 1] = g4.y; g31[4 * q + 2] = g4.z; g31[4 * q + 3] = g4.w; }
#pragma unroll
        for (int ct = 0; ct < 2; ++ct) { f32x16 acc;
#pragma unroll
            for (int r = 0; r < 16; ++r) acc[r] = 0.f;
            acc = MFMA32(bmf[0], atn[ct][0], acc); acc = MFMA32(bmf[1], atn[ct][1], acc);
#pragma unroll
            for (int r = 0; r < 16; ++r) { const int kp = 32 * rt + (r & 3) + 8 * (r >> 2) + 4 * hs, k = 32 * ct + li;
                *(bf16_t*)(UR + RU_PT + (kp * 64 + kperm(k)) * 2) = f2bf(g31[r] * ((kp == k ? 1.f : 0.f) - acc[r])); } }
        { f32x16 acc;
#pragma unroll
          for (int r = 0; r < 16; ++r) acc[r] = 0.f;
          acc = MFMA32(bmf[0], mtn[0], acc); acc = MFMA32(bmf[1], mtn[1], acc);
#pragma unroll
          for (int r = 0; r < 16; ++r) { const int kp = 32 * rt + (r & 3) + 8 * (r >> 2) + 4 * hs;
              *(bf16_t*)(UR + RU_QT + (kp * 32 + li) * 2) = f2bf(g31[r] * (tile_at(TK, li, kp) - acc[r])); } }
        __builtin_amdgcn_sched_barrier(0); }
    WSYNC();
}
DI int lds_ld(volatile LAS int* p) { return *p; }
constexpr int RS_SLOT1 = 4 * WLDS, RS_FLAGS = RU_BYTES + 256;
static_assert(RS_FLAGS + 64 <= 2 * WLDS, "ring slot 0 and its flags sit inside the LDS regions of waves 0,1");
DI void s_rscan_roles(CtxP c, int l, int slab, float* lds, int bh, int wave, int lane) {
    unsigned char* ring = (unsigned char*)lds; const int b = bh >> 3, h = bh & 7;
    volatile LAS int* F = (volatile LAS int*)((LAS unsigned char*)(unsigned long)RS_FLAGS);
    const unsigned char* ur0 = c->ws + OFF_CK + (size_t)(bh * NC32) * RU_BYTES;
    if (wave >= 4) {
        const int pw = wave - 4, p = pw * 64 + lane; u32x4 pt[11];
        auto pload = [&](int ch) { const u32x4* src = (const u32x4*)(ur0 + (size_t)ch * RU_BYTES);
#pragma unroll
            for (int k = 0; k < 11; ++k) pt[k] = src[p + 128 * k]; };
        pload(0);
        for (int ch = 0; ch < NC32; ++ch) {
            while (min(lds_ld(F + 2), lds_ld(F + 3)) < ch - 1) __builtin_amdgcn_s_sleep(1);
            u32x4* dst = (u32x4*)(ring + (ch & 1) * RS_SLOT1);
#pragma unroll
            for (int k = 0; k < 11; ++k) dst[p + 128 * k] = pt[k];
            asm volatile("s_waitcnt lgkmcnt(0)" ::: "memory");
            if (lane == 0) F[pw] = ch + 1;
            if (ch + 1 < NC32) pload(ch + 1);
        }
    } else {
        const int hs = lane >> 5, li = lane & 31, v = 32 * wave + li;
        float* CB = (float*)(c->ws + OFF_CARRY + l * CARRY_L + CB_OFF) + ((size_t)bh * 64 + v) * 64;
        f32x16 xa[2];
#pragma unroll
        for (int rt = 0; rt < 2; ++rt)
#pragma unroll
            for (int r = 0; r < 16; ++r) xa[rt][r] = slab == 0 ? 0.f : CB[32 * rt + (r & 3) + 8 * (r >> 2) + 4 * hs];
        float* ybase = (float*)((bf16_t*)(c->ws + OFF_P) + prow_off(b, 0) + B_R) + h * 64 + v;
        for (int ch = 0; ch < NC32; ++ch) {
            while (min(lds_ld(F + 0), lds_ld(F + 1)) < ch + 1) __builtin_amdgcn_s_sleep(1);
            asm volatile("" ::: "memory");
            const unsigned char* base = ring + (ch & 1) * RS_SLOT1;
            bf16x8 xb[4];
#pragma unroll
            for (int rt = 0; rt < 2; ++rt) { float g[16];
#pragma unroll
                for (int r = 0; r < 16; ++r) g[r] = xa[rt][r];
                xb[2 * rt] = pack8(g); xb[2 * rt + 1] = pack8(g + 8); }
            bf16x8 vt[2];
#pragma unroll
            for (int js = 0; js < 2; ++js) vt[js] = *(const bf16x8*)(base + RU_VT + (v * 32 + 16 * js + 8 * hs) * 2);
            f32x16 ya;
#pragma unroll
            for (int r = 0; r < 16; ++r) ya[r] = 0.f;
#pragma unroll
            for (int kk = 0; kk < 4; ++kk) ya = MFMA32(*(const bf16x8*)(base + RU_YS + (li * 64 + 16 * kk + 8 * hs) * 2), xb[kk], ya);
#pragma unroll
            for (int js = 0; js < 2; ++js) ya = MFMA32(*(const bf16x8*)(base + RU_YV + (li * 32 + 16 * js + 8 * hs) * 2), vt[js], ya);
            f32x16 xn[2];
#pragma unroll
            for (int rt = 0; rt < 2; ++rt) {
#pragma unroll
                for (int r = 0; r < 16; ++r) xn[rt][r] = 0.f;
#pragma unroll
                for (int kk = 0; kk < 4; ++kk) xn[rt] = MFMA32(*(const bf16x8*)(base + RU_PT + ((32 * rt + li) * 64 + 16 * kk + 8 * hs) * 2), xb[kk], xn[rt]);
#pragma unroll
                for (int js = 0; js < 2; ++js) xn[rt] = MFMA32(*(const bf16x8*)(base + RU_QT + ((32 * rt + li) * 32 + 16 * js + 8 * hs) * 2), vt[js], xn[rt]); }
            asm volatile("s_waitcnt lgkmcnt(0)" ::: "memory");
            if (lane == 0) F[2 + wave] = ch + 1;
#pragma unroll
            for (int r = 0; r < 16; ++r) { const int t = ch * 32 + (r & 3) + 8 * (r >> 2) + 4 * hs; *(float*)((bf16_t*)ybase + (size_t)t * PP) = ya[r]; }
            xa[0] = xn[0]; xa[1] = xn[1];
        }
#pragma unroll
        for (int rt = 0; rt < 2; ++rt)
#pragma unroll
            for (int r = 0; r < 16; ++r) CB[32 * rt + (r & 3) + 8 * (r >> 2) + 4 * hs] = xa[rt][r];
    }
}
DI void s_phase2(CtxP c, int l, int slab, float* lds, int bid, int nblk) {
    const int tid = otid(), lane = tid & 63, wave = tid >> 6; unsigned char* wl = (unsigned char*)lds + wave * WLDS;
    const int gw = __builtin_amdgcn_readfirstlane(bid * 8 + wave);
    { int ln = lane; w_rprep(c, l, slab, gw, wl, ln); }
#pragma unroll 1
    for (int tk = gw; tk < 3 * NB * NH * NCS; tk += 2048) { int ln = lane; asm volatile("" : "+v"(ln) :: "memory"); __builtin_amdgcn_sched_barrier(0);
        const int kind = tk >> 10, u = tk & 1023;
        if (kind == 0) w_chunkA<false>(c, l, slab, u, wl, ln); else if (kind == 1) w_chunkA<true>(c, l, slab, u, wl, ln); else w_lru<false>(c, l, slab, u, wl, ln, 0, 2); }
    if (slab == 0) { bf16_t* halo = (bf16_t*)(c->ws + OFF_CARRY + l * CARRY_L + HALO_OFF);
        for (int i = bid * 512 + tid; i < NB * 3 * PP; i += nblk * 512) { const int b = i / (3 * PP), r = (i / PP) % 3, col = i % PP;
            halo[i] = ((const bf16_t*)(c->ws + OFF_P))[prow_off(b, TS - 3 + r) + col]; } }
}
DI void s_phase3(CtxP c, int l, int slab, float* lds, int bid) {
    const int tid = otid(), lane = tid & 63, wave = tid >> 6;
    if (tid < 8) ((volatile LAS int*)((LAS unsigned char*)(unsigned long)RS_FLAGS))[tid] = 0;
    __syncthreads();
    if (bid < 32 && (wave & 2) == 0) { s_rscan_roles(c, l, slab, lds, bid, wave, lane); return; }
    const int ws = __builtin_amdgcn_readfirstlane(bid < 32 ? bid * 4 + (wave & 1) + 2 * (wave >> 2) : 128 + (bid - 32) * 8 + wave);
    unsigned char* wl = (unsigned char*)lds + wave * WLDS;
#pragma unroll 1
    for (int tk = ws; tk < 3 * NB * NH * NCS; tk += 1920) { int ln = lane; asm volatile("" : "+v"(ln) :: "memory"); __builtin_amdgcn_sched_barrier(0);
        const int kind = tk >> 10, u = tk & 1023;
        if (kind == 0) w_chunkC<false>(c, l, slab, u, wl, ln); else if (kind == 1) w_chunkC<true>(c, l, slab, u, wl, ln); else w_lru<true>(c, l, slab, u, wl, ln, 0, 2); }
}
DI float red8(float v) { DPP_ADD(v, 0xB1); DPP_ADD(v, 0x4E); DPP_ADD(v, 0x141); return v; }
DI void s_bpost(CtxP c, int l, int slab, float* lds, int bid, int nblk) {
    const int lane = otid() & 63, gw = bid * 8 + (otid() >> 6), NGW = nblk * 8; const int ch0 = lane * 8, h = lane >> 3;
    float gw8[8], gb8[8], mu8[8];
    { const float4 a0 = *(const float4*)(c->rgn_w + l * G + ch0), a1 = *(const float4*)(c->rgn_w + l * G + ch0 + 4), b0 = *(const float4*)(c->rgn_b + l * G + ch0), b1 = *(const float4*)(c->rgn_b + l * G + ch0 + 4),
          m0 = *(const float4*)(c->rmu + l * 1664 + 1024 + ch0), m1 = *(const float4*)(c->rmu + l * 1664 + 1024 + ch0 + 4);
      gw8[0] = a0.x; gw8[1] = a0.y; gw8[2] = a0.z; gw8[3] = a0.w; gw8[4] = a1.x; gw8[5] = a1.y; gw8[6] = a1.z; gw8[7] = a1.w;
      gb8[0] = b0.x; gb8[1] = b0.y; gb8[2] = b0.z; gb8[3] = b0.w; gb8[4] = b1.x; gb8[5] = b1.y; gb8[6] = b1.z; gb8[7] = b1.w;
      mu8[0] = m0.x; mu8[1] = m0.y; mu8[2] = m0.z; mu8[3] = m0.w; mu8[4] = m1.x; mu8[5] = m1.y; mu8[6] = m1.z; mu8[7] = m1.w; }
    for (int r0 = gw; r0 < MS; r0 += 2 * NGW) {
        float4 wa[2], wb[2]; uint4 xc[2], xq[2], zz[2]; float bon[2]; bf16_t* prw[2];
#pragma unroll
        for (int q = 0; q < 2; ++q) { int r = r0 + q * NGW; r = r < MS ? r : r0; const int b = r / TS, tl = r % TS; prw[q] = (bf16_t*)(c->ws + OFF_P) + prow_off(b, tl);
            wa[q] = *(const float4*)((const float*)(prw[q] + B_R) + ch0); wb[q] = *(const float4*)((const float*)(prw[q] + B_R) + ch0 + 4);
            xc[q] = *(const uint4*)(prw[q] + B_V + ch0); xq[q] = *(const uint4*)(prw[q] - PP + B_V + ch0); zz[q] = *(const uint4*)(prw[q] + ZB + ch0);
            bon[q] = ((const float*)(c->ws + OFF_BON))[(size_t)r * NH + h]; }
#pragma unroll
        for (int q = 0; q < 2; ++q) { if (r0 + q * NGW >= MS) break;
            float w[8] = {wa[q].x, wa[q].y, wa[q].z, wa[q].w, wb[q].x, wb[q].y, wb[q].z, wb[q].w}, x[8], xp[8], z[8], y[8];
            unpack8(xc[q], x); unpack8(xq[q], xp); unpack8(zz[q], z);
            float sm = 0.f;
#pragma unroll
            for (int i = 0; i < 8; ++i) sm += w[i];
            const float mean = red8(sm) * (1.f / 64.f); float vs = 0.f;
#pragma unroll
            for (int i = 0; i < 8; ++i) { w[i] -= mean; vs += w[i] * w[i]; }
            const float rstd = rsqrtf(red8(vs) * (1.f / 64.f) + 1e-5f);
#pragma unroll
            for (int i = 0; i < 8; ++i) { const float vm = x[i] + mu8[i] * (xp[i] - x[i]); y[i] = (w[i] * rstd * gw8[i] + gb8[i] + bon[q] * vm) * siluf(z[i]); }
            *(bf16x8*)(prw[q] + ZB + ch0) = pack8(y); }
    }
}
DI void s_post(CtxP c, int l, int slab, float* lds, int bid, int nblk) {
    const int lane = otid() & 63, gw = bid * 8 + (otid() >> 6), NGW = nblk * 8;
    for (int r0 = gw; r0 < MS; r0 += 2 * NGW) {
        float4 v[2][4], xx[2][4]; float* orow[2];
#pragma unroll
        for (int q = 0; q < 2; ++q) { int r = r0 + q * NGW; r = r < MS ? r : r0; const int b = r / TS, tl = r % TS; const size_t grow = (size_t)b * T + slab * TS + tl;
            const float* yrow = (const float*)(c->ws + OFF_Y) + (size_t)r * D; const bf16_t* y2row = (const bf16_t*)(c->ws + OFF_Y2) + (size_t)r * D;
            const float* xr = (l == 0 ? c->x : c->out) + grow * D; orow[q] = c->out + grow * D;
#pragma unroll
            for (int j = 0; j < 4; ++j) { v[q][j] = *(const float4*)(yrow + j * 256 + lane * 4); xx[q][j] = *(const float4*)(xr + j * 256 + lane * 4);
                const uint2 h2 = *(const uint2*)(y2row + j * 256 + lane * 4);
                v[q][j].x += __uint_as_float(h2.x << 16); v[q][j].y += __uint_as_float(h2.x & 0xffff0000u); v[q][j].z += __uint_as_float(h2.y << 16); v[q][j].w += __uint_as_float(h2.y & 0xffff0000u); } }
#pragma unroll
        for (int q = 0; q < 2; ++q) { const int r = r0 + q * NGW; if (r >= MS) break;
            float ss = 0.f;
#pragma unroll
            for (int j = 0; j < 4; ++j) ss += v[q][j].x * v[q][j].x + v[q][j].y * v[q][j].y + v[q][j].z * v[q][j].z + v[q][j].w * v[q][j].w;
            ss = wave_sum(ss); const float rs = rsqrtf(ss * (1.f / D) + 1e-6f); float s2 = 0.f;
#pragma unroll
            for (int j = 0; j < 4; ++j) { const float4 gg = *(const float4*)(c->norm_post + l * D + j * 256 + lane * 4); float4& o = v[q][j]; const float4 x4 = xx[q][j];
                o.x = x4.x + o.x * rs * gg.x; o.y = x4.y + o.y * rs * gg.y; o.z = x4.z + o.z * rs * gg.z; o.w = x4.w + o.w * rs * gg.w;
                *(float4*)(orow[q] + j * 256 + lane * 4) = o; s2 += o.x * o.x + o.y * o.y + o.z * o.z + o.w * o.w; }
            if (l == 0) { s2 = wave_sum(s2); const float r2 = rsqrtf(s2 * (1.f / D) + 1e-6f); bf16_t* hrow = (bf16_t*)(c->ws + OFF_H) + (size_t)r * D;
#pragma unroll
                for (int j = 0; j < 4; ++j) { const float4 gg = *(const float4*)(c->norm_pre + D + j * 256 + lane * 4); const float4 o = v[q][j];
                    uint2 w; w.x = pk2(o.x * r2 * gg.x, o.y * r2 * gg.y); w.y = pk2(o.z * r2 * gg.z, o.w * r2 * gg.w);
                    *(uint2*)(hrow + j * 256 + lane * 4) = w; } } }
    }
}
namespace pg8 {
#define PG8_LAS __attribute__((address_space(3)))
typedef unsigned short bf16_t;
typedef short bf16x8 __attribute__((ext_vector_type(8)));
typedef float f32x4 __attribute__((ext_vector_type(4)));
typedef unsigned u32x4 __attribute__((ext_vector_type(4)));
constexpr int BM = 256, BK = 64, HALF = 128, HTB = HALF * BK * 2  , STAGE_BYTES = 8 * HTB, NXCD = 8, WGM = 8;

__host__ __device__ __forceinline__ int lds_byte(int r, int c) { const int st = (r >> 4) * 2 + (c >> 5), rr = r & 15, cc = c & 31, ob = rr * 64 + cc * 2; return st * 1024 + (ob ^ (((ob >> 9) & 1) << 5)); }
__host__ __device__ __forceinline__ void stage_rc(int b, int& R, int& C) { const int st = b / 1024, sb = b % 1024, swz = sb ^ (((sb >> 9) & 1) << 5); R = (st >> 1) * 16 + swz / 64; C = (st & 1) * 32 + (swz % 64) / 2; }
__host__ __device__ __forceinline__ int perm32(int rho) { const int n = rho >> 4, i = rho & 15; return 8 * (i >> 2) + 4 * n + (i & 3); }

struct Unit { int pm, pn; };
struct Gemm { const bf16_t* A; const bf16_t* Bt; int M, N, K, lda; };

struct StaticOrder {
    int nM, nN, nwg, G, c;
    __host__ __device__ void init(int M, int N, int G_, int c_) { nM = M / BM; nN = N / BM; nwg = nM * nN; G = G_; c = c_; }
    __host__ __device__ bool next(int i, Unit& u) const {
        const long L = (long)i * G + c; if (L >= nwg) return false;
        int wgid = (int)L; { const int q = nwg / NXCD, r = nwg % NXCD, xcd = wgid % NXCD, off = wgid / NXCD; wgid = (xcd < r ? xcd * (q + 1) : r * (q + 1) + (xcd - r) * q) + off; }
        const int nig = WGM * nN, gid = wgid / nig, fm = gid * WGM, gsz = (nM - fm) < WGM ? (nM - fm) : WGM;
        u.pm = fm + ((wgid % nig) % gsz); u.pn = (wgid % nig) / gsz; return true;
    }
    __device__ __forceinline__ void a_ready(const Unit&) const {}
    __device__ __forceinline__ void done(const Unit&) const {}
};

__device__ __forceinline__ unsigned cvt_pk_bf16(float lo, float hi) { unsigned r; asm volatile("v_cvt_pk_bf16_f32 %0, %1, %2" : "=v"(r) : "v"(lo), "v"(hi)); return r; }
typedef float f32x2 __attribute__((ext_vector_type(2)));
__device__ __forceinline__ f32x2 gelu_pk(f32x2 v) {
    const f32x2 av = __builtin_elementwise_abs(v), d = av * 0.2316418882f + 1.0f;
    f32x2 t; t.x = __builtin_amdgcn_rcpf(d.x); t.y = __builtin_amdgcn_rcpf(d.y);
    f32x2 q = t * 0.5307027145f + (-0.7265760135f); q = q * t + 0.7107068705f; q = q * t + (-0.142248368f); q = q * t + 0.127414796f; q = q * t;
    const f32x2 s = (v * v) * (-0.72134752044f);
    f32x2 e; e.x = __builtin_amdgcn_exp2f(s.x); e.y = __builtin_amdgcn_exp2f(s.y);
    const f32x2 m = v * (q * e), r = v - m;
    f32x2 o; o.x = v.x < 0.f ? m.x : r.x; o.y = v.y < 0.f ? m.y : r.y; return o;
}

template <int ACT  > struct EpiBf16 {
    static constexpr bool PERM = true, AFTER_DRAIN = false; static_assert(ACT == 0 || ACT == 1, "EpiBf16: ACT is 0 (none) or 1 (gelu_pk)");
    bf16_t* O; int ldc; const float* bias; int split_cols; size_t split_stride; float scale0; int rskip;
    __device__ __forceinline__ void operator()(const f32x4 (&acc)[2][2][4][2], const Unit& u, int wr, int wc, int fr, int fq) const {
        const int row0 = u.pm * BM + wr * 64 + fr + (u.pm >> 3) * rskip; int colt = u.pn * BM; bf16_t* base = O;
        float sc = 1.f; if (split_cols) { const int t = colt / split_cols; base += (size_t)t * split_stride; colt -= t * split_cols; if (t == 0) sc = scale0; }
        const int col0 = colt + wc * 32 + 8 * fq, bcol0 = u.pn * BM + wc * 32 + 8 * fq;
        f32x4 bv[2][2];
#pragma unroll
        for (int bj = 0; bj < 2; ++bj)
#pragma unroll
            for (int n = 0; n < 2; ++n) bv[bj][n] = bias ? *(const f32x4*)(bias + bcol0 + bj * HALF + 4 * n) : (f32x4){0.f, 0.f, 0.f, 0.f};
#pragma unroll
        for (int ai = 0; ai < 2; ++ai)
#pragma unroll
            for (int m = 0; m < 4; ++m) { bf16_t* rowp = base + (size_t)(row0 + ai * HALF + m * 16) * ldc + col0;
#pragma unroll
                for (int bj = 0; bj < 2; ++bj) { f32x4 v0 = acc[ai][bj][m][0] + bv[bj][0], v1 = acc[ai][bj][m][1] + bv[bj][1];
                    if (ACT == 1) { f32x2 a = gelu_pk((f32x2){v0[0], v0[1]}), b = gelu_pk((f32x2){v0[2], v0[3]}), c = gelu_pk((f32x2){v1[0], v1[1]}), d = gelu_pk((f32x2){v1[2], v1[3]});
                        v0 = (f32x4){a.x, a.y, b.x, b.y}; v1 = (f32x4){c.x, c.y, d.x, d.y}; }
                    v0 = v0 * sc; v1 = v1 * sc; u32x4 w; w.x = cvt_pk_bf16(v0[0], v0[1]); w.y = cvt_pk_bf16(v0[2], v0[3]); w.z = cvt_pk_bf16(v1[0], v1[1]); w.w = cvt_pk_bf16(v1[2], v1[3]);
                    *(u32x4*)(rowp + bj * HALF) = w; } }
    }
};


struct EpiF32 {
    static constexpr bool PERM = false, AFTER_DRAIN = false;
    float* O; int ldc;
    __device__ __forceinline__ void operator()(const f32x4 (&acc)[2][2][4][2], const Unit& u, int wr, int wc, int fr, int fq) const {
        const int row0 = u.pm * BM + wr * 64 + fr, col0 = u.pn * BM + wc * 32 + 4 * fq;
#pragma unroll
        for (int ai = 0; ai < 2; ++ai)
#pragma unroll
            for (int m = 0; m < 4; ++m) { float* rowp = O + (size_t)(row0 + ai * HALF + m * 16) * ldc + col0;
#pragma unroll
                for (int bj = 0; bj < 2; ++bj)
#pragma unroll
                    for (int n = 0; n < 2; ++n) *(f32x4*)(rowp + bj * HALF + n * 16) = acc[ai][bj][m][n]; }
    }
};
struct EpiSplitK {
    static constexpr bool PERM = false, AFTER_DRAIN = false;
    float* O; bf16_t* O2; int ldc;
    __device__ __forceinline__ void operator()(const f32x4 (&acc)[2][2][4][2], const Unit& u, int wr, int wc, int fr, int fq) const {
        const int row0 = u.pm * BM + wr * 64 + fr, col0 = (u.pn & 3) * BM + wc * 32 + 4 * fq; const bool hi = u.pn >= 4;
#pragma unroll
        for (int ai = 0; ai < 2; ++ai)
#pragma unroll
            for (int m = 0; m < 4; ++m) { const size_t ro = (size_t)(row0 + ai * HALF + m * 16) * ldc + col0;
#pragma unroll
                for (int bj = 0; bj < 2; ++bj)
#pragma unroll
                    for (int n = 0; n < 2; ++n) { const f32x4 v = acc[ai][bj][m][n];
                        if (hi) { unsigned lo = cvt_pk_bf16(v[0], v[1]), hi2 = cvt_pk_bf16(v[2], v[3]); *(uint2*)(O2 + ro + bj * HALF + n * 16) = make_uint2(lo, hi2); }
                        else *(f32x4*)(O + ro + bj * HALF + n * 16) = v; } }
    }
};
template <class Epi, class Sched, bool ALIGN_EPI, bool SP2, int KK, int LDA, int ASKIP, int KSPLIT = 0>
__device__ __forceinline__ void gemm_phase(PG8_LAS unsigned char* lds, const Gemm g, const Sched& S, const Epi& E) {
    const int tid = otid(), wid = __builtin_amdgcn_readfirstlane(tid >> 6), lane = tid & 63, wr = wid >> 2, wc = wid & 3, fr = lane & 15, fq = lane >> 4;
    constexpr int K = KK, nt = K / BK;
    unsigned voffA[2], voffB[2];
#pragma unroll
    for (int i = 0; i < 2; ++i) { int R, C; stage_rc(tid * 16 + i * 8192, R, C); const int Rb = Epi::PERM ? ((R & ~31) + perm32(R & 31)) : R;
        voffA[i] = (unsigned)(R * LDA + C) * 2u; voffB[i] = (unsigned)(Rb * K + C) * 2u; }
    constexpr size_t kstep = (size_t)(BK * 2);
    constexpr size_t hstepA = (size_t)HALF * LDA * 2, hstepB = (size_t)HALF * K * 2;
    constexpr size_t tstepA = 2 * hstepA, tstepB = 2 * hstepB;
    const unsigned ldsw = (unsigned)wid * 1024u;
    const int aoff = lds_byte(wr * 64 + fr, fq * 8), boff = lds_byte(wc * 32 + fr, fq * 8);
#define PG8_SA(b, h) (((b) * 2 + (h)) * HTB)
#define PG8_SB(b, h) ((4 + (b) * 2 + (h)) * HTB)
#define PG8_STAGE(bufoff, gbase, voff) do { _Pragma("unroll") for (int _i = 0; _i < 2; ++_i) \
        __builtin_amdgcn_global_load_lds((const unsigned*)((const char*)(gbase) + (voff)[_i]), (PG8_LAS unsigned*)(lds + (bufoff) + ldsw + _i * 8192), 16, 0, 0); } while (0)
#define PG8_LDA(dst, b, h) do { _Pragma("unroll") for (int m = 0; m < 4; ++m) _Pragma("unroll") for (int k = 0; k < 2; ++k) dst[m][k] = *(const PG8_LAS bf16x8*)(lds + PG8_SA(b, h) + aoff + m * 2048 + k * 1024); } while (0)
#define PG8_LDB(dst, b, h) do { _Pragma("unroll") for (int n = 0; n < 2; ++n) _Pragma("unroll") for (int k = 0; k < 2; ++k) dst[n][k] = *(const PG8_LAS bf16x8*)(lds + PG8_SB(b, h) + boff + n * 2048 + k * 1024); } while (0)
#define PG8_MMA(ai, bj, At, Bt) do { __builtin_amdgcn_s_setprio(1); _Pragma("unroll") for (int m = 0; m < 4; ++m) _Pragma("unroll") for (int n = 0; n < 2; ++n) _Pragma("unroll") for (int k = 0; k < 2; ++k) \
        acc[ai][bj][m][n] = __builtin_amdgcn_mfma_f32_16x16x32_bf16(Bt[n][k], At[m][k], acc[ai][bj][m][n], 0, 0, 0); __builtin_amdgcn_s_setprio(0); } while (0)
#define PG8_WAIT_V(n) asm volatile("s_waitcnt vmcnt(" #n ")" ::: "memory")
#define PG8_WAIT_L(n) asm volatile("s_waitcnt lgkmcnt(" #n ")" ::: "memory")
#define PG8_BAR __builtin_amdgcn_s_barrier()
#define PG8_SCHED __builtin_amdgcn_sched_barrier(0)
    Unit cur, nxt; int ui = 0;
    if (!S.next(0, cur)) return;
    f32x4 acc[2][2][4][2];
#pragma unroll
    for (int a = 0; a < 2; ++a)
#pragma unroll
        for (int b = 0; b < 2; ++b)
#pragma unroll
            for (int m = 0; m < 4; ++m)
#pragma unroll
                for (int n = 0; n < 2; ++n) acc[a][b][m][n] = (f32x4){0.f, 0.f, 0.f, 0.f};
    bf16x8 At[4][2], B0[2][2], B1[2][2];
    const char* cA = (const char*)g.A + (size_t)cur.pm * tstepA + (size_t)(cur.pm >> 3) * (ASKIP * LDA * 2) + (size_t)(KSPLIT ? (cur.pn >> 2) : 0) * (KSPLIT * 2); const char* cB = (const char*)g.Bt + (size_t)cur.pn * tstepB;
    S.a_ready(cur);
    if constexpr (SP2) {
        PG8_STAGE(PG8_SB(0, 0), cB, voffB); PG8_STAGE(PG8_SB(0, 1), cB + hstepB, voffB); PG8_STAGE(PG8_SA(0, 0), cA, voffA); PG8_STAGE(PG8_SA(0, 1), cA + hstepA, voffA);
        if (wr == 1) PG8_BAR;
        PG8_WAIT_V(2); PG8_BAR;
        PG8_STAGE(PG8_SB(1, 0), cB + kstep, voffB); PG8_STAGE(PG8_SA(1, 0), cA + kstep, voffA); PG8_STAGE(PG8_SB(1, 1), cB + hstepB + kstep, voffB);
        PG8_WAIT_V(6); PG8_BAR;
    } else {
        PG8_STAGE(PG8_SB(0, 0), cB, voffB); PG8_STAGE(PG8_SA(0, 0), cA, voffA); PG8_STAGE(PG8_SB(0, 1), cB + hstepB, voffB); PG8_STAGE(PG8_SA(0, 1), cA + hstepA, voffA);
        if (wr == 1) PG8_BAR;
        PG8_WAIT_V(4); PG8_BAR;
        PG8_STAGE(PG8_SB(1, 0), cB + kstep, voffB); PG8_STAGE(PG8_SA(1, 0), cA + kstep, voffA); PG8_STAGE(PG8_SB(1, 1), cB + hstepB + kstep, voffB);
        PG8_WAIT_V(6); PG8_BAR;
    }
    for (;;) {
        const bool has_next = S.next(ui + 1, nxt);
        const char* nA = has_next ? (const char*)g.A + (size_t)nxt.pm * tstepA + (size_t)(nxt.pm >> 3) * (ASKIP * LDA * 2) + (size_t)(KSPLIT ? (nxt.pn >> 2) : 0) * (KSPLIT * 2) : cA; const char* nB = has_next ? (const char*)g.Bt + (size_t)nxt.pn * tstepB : cB;
        for (int t = 0; t < nt; t += 2) {
            const bool last = (t == nt - 2);
            const char* a1 = cA + (size_t)(t + 1) * kstep;
            const char* a2 = last ? nA : cA + (size_t)(t + 2) * kstep; const char* b2 = last ? nB : cB + (size_t)(t + 2) * kstep;
            const char* a3 = a2 + kstep; const char* b3 = b2 + kstep;
            if (last && has_next) S.a_ready(nxt);
            if constexpr (SP2) {
            PG8_LDB(B0, 0, 0); PG8_LDB(B1, 0, 1); PG8_SCHED; PG8_LDA(At, 0, 0); PG8_STAGE(PG8_SA(1, 1), a1 + hstepA, voffA);
            PG8_WAIT_V(8); PG8_WAIT_L(0); PG8_BAR; PG8_MMA(0, 0, At, B0); PG8_MMA(0, 1, At, B1); PG8_BAR; PG8_SCHED;
            PG8_LDA(At, 0, 1); PG8_STAGE(PG8_SB(0, 0), b2, voffB); PG8_STAGE(PG8_SB(0, 1), b2 + hstepB, voffB); PG8_STAGE(PG8_SA(0, 0), a2, voffA);
            PG8_WAIT_V(8); PG8_WAIT_L(0); PG8_BAR; PG8_MMA(1, 0, At, B0); PG8_MMA(1, 1, At, B1); PG8_BAR; PG8_SCHED;
            PG8_LDB(B0, 1, 0); PG8_LDB(B1, 1, 1); PG8_SCHED; PG8_LDA(At, 1, 0); PG8_STAGE(PG8_SA(0, 1), a2 + hstepA, voffA);
            PG8_WAIT_V(8); PG8_WAIT_L(0); PG8_BAR; PG8_MMA(0, 0, At, B0); PG8_MMA(0, 1, At, B1); PG8_BAR; PG8_SCHED;
            PG8_LDA(At, 1, 1); PG8_STAGE(PG8_SB(1, 0), b3, voffB); PG8_STAGE(PG8_SB(1, 1), b3 + hstepB, voffB); PG8_STAGE(PG8_SA(1, 0), a3, voffA);
            PG8_WAIT_V(8); PG8_WAIT_L(0); PG8_BAR; PG8_MMA(1, 0, At, B0); PG8_MMA(1, 1, At, B1); PG8_BAR; PG8_SCHED;
            } else {
            PG8_LDB(B0, 0, 0); PG8_SCHED; PG8_LDA(At, 0, 0); PG8_STAGE(PG8_SA(1, 1), a1 + hstepA, voffA);
            PG8_WAIT_L(8); PG8_BAR; PG8_WAIT_L(0); PG8_MMA(0, 0, At, B0); PG8_BAR; PG8_SCHED;
            PG8_LDB(B1, 0, 1); PG8_STAGE(PG8_SB(0, 0), b2, voffB);
            PG8_BAR; PG8_WAIT_L(0); PG8_MMA(0, 1, At, B1); PG8_BAR;
            PG8_LDA(At, 0, 1); PG8_STAGE(PG8_SA(0, 0), a2, voffA);
            PG8_BAR; PG8_WAIT_L(0); PG8_MMA(1, 0, At, B0); PG8_BAR; PG8_SCHED;
            PG8_STAGE(PG8_SB(0, 1), b2 + hstepB, voffB);
            PG8_WAIT_V(6); PG8_BAR; PG8_MMA(1, 1, At, B1); PG8_BAR;
            PG8_LDB(B0, 1, 0); PG8_SCHED; PG8_LDA(At, 1, 0); PG8_STAGE(PG8_SA(0, 1), a2 + hstepA, voffA);
            PG8_WAIT_L(8); PG8_BAR; PG8_WAIT_L(0); PG8_MMA(0, 0, At, B0); PG8_BAR; PG8_SCHED;
            PG8_LDB(B1, 1, 1); PG8_STAGE(PG8_SB(1, 0), b3, voffB);
            PG8_BAR; PG8_WAIT_L(0); PG8_MMA(0, 1, At, B1); PG8_BAR;
            PG8_LDA(At, 1, 1); PG8_STAGE(PG8_SA(1, 0), a3, voffA);
            PG8_BAR; PG8_WAIT_L(0); PG8_MMA(1, 0, At, B0); PG8_BAR; PG8_SCHED;
            PG8_STAGE(PG8_SB(1, 1), b3 + hstepB, voffB);
            PG8_WAIT_V(6); PG8_BAR; PG8_MMA(1, 1, At, B1); PG8_BAR;
            }
        }
        if constexpr (ALIGN_EPI) { if (wr == 0) PG8_BAR; }
        if constexpr (!Epi::AFTER_DRAIN) { E(acc, cur, wr, wc, fr, fq); S.done(cur); }
        if (!has_next) break;
#pragma unroll
        for (int a = 0; a < 2; ++a)
#pragma unroll
            for (int b = 0; b < 2; ++b)
#pragma unroll
                for (int m = 0; m < 4; ++m)
#pragma unroll
                    for (int n = 0; n < 2; ++n) acc[a][b][m][n] = (f32x4){0.f, 0.f, 0.f, 0.f};
        cur = nxt; cA = nA; cB = nB; ++ui;
        if constexpr (ALIGN_EPI) { if (wr == 1) PG8_BAR; }
    }
    PG8_WAIT_V(0);
    if constexpr (!ALIGN_EPI) { if (wr == 0) PG8_BAR; }
    PG8_BAR;
    if constexpr (Epi::AFTER_DRAIN) { E.fused(acc, cur, wr, wc, fr, fq, lds, wid, lane); S.done(cur); }
#undef PG8_SA
#undef PG8_SB
#undef PG8_STAGE
#undef PG8_LDA
#undef PG8_LDB
#undef PG8_MMA
#undef PG8_WAIT_V
#undef PG8_WAIT_L
#undef PG8_BAR
#undef PG8_SCHED
}
}

#define XB_TMO      128
#define XB_XCNT(j)  (256  + 64 * (j))
#define XB_XSUB(j)  (1280 + 64 * (j))
#define XB_XGEN(j)  (2304 + 64 * (j))
#define XB_TOP      3328
#define XB_TOPGEN   3392
#define XCD_BAR_WORDS 3456
#define XB_SPIN_CAP (1u << 18)
DI unsigned xb_ld(unsigned* p)              { return __hip_atomic_load(p, __ATOMIC_RELAXED, __HIP_MEMORY_SCOPE_AGENT); }
DI unsigned xb_add(unsigned* p, unsigned v) { return __hip_atomic_fetch_add(p, v, __ATOMIC_RELAXED, __HIP_MEMORY_SCOPE_AGENT); }
DI unsigned xb_xcc_id() { return (unsigned)__builtin_amdgcn_s_getreg((3 << 11) | 20) & 0xFu; }
#define XB_SPIN(cond, bar) do { unsigned _sp = 0; while (cond) { __builtin_amdgcn_s_sleep(1); \
    if ((++_sp & 255u) == 0u) { if (xb_ld(&(bar)[XB_TMO])) break; if (_sp > XB_SPIN_CAP) { atomicAdd(&(bar)[XB_TMO], 1u); break; } } } } while (0)
struct XcdBarrier { unsigned* bar; unsigned x; volatile LAS unsigned* st; };
DI XcdBarrier xcd_barrier_post(unsigned* bar, volatile LAS unsigned* st) {
    XcdBarrier b; b.bar = bar; b.x = (unsigned)__builtin_amdgcn_readfirstlane((int)xb_xcc_id()); b.st = st;
    if (threadIdx.x == 0) (void)xb_add(&bar[XB_XCNT(b.x)], 1u);
    return b;
}
DI void xcd_barrier_complete(unsigned* bar, unsigned x, unsigned& nloc, unsigned& nx) {
    const unsigned Gd = gridDim.x * gridDim.y * gridDim.z;
    unsigned sum, cnt, mine, sp = 0u;
    for (;;) {
        sum = 0u; cnt = 0u; mine = 0u;
#pragma unroll
        for (unsigned j = 0; j < 16; ++j) { const unsigned cc = xb_ld(&bar[XB_XCNT(j)]); sum += cc; cnt += (cc > 0u) ? 1u : 0u; mine = (j == x) ? cc : mine; }
        if (sum == Gd) break;
        __builtin_amdgcn_s_sleep(1);
        if ((++sp & 255u) == 0u) { if (xb_ld(&bar[XB_TMO])) break; if (sp > XB_SPIN_CAP) { atomicAdd(&bar[XB_TMO], 1u); break; } }
    }
    nloc = mine > 0u ? mine : 1u; nx = cnt > 0u ? cnt : 1u;
}
DI void xcd_barrier(const XcdBarrier& b) {
    asm volatile("s_waitcnt vmcnt(0)" ::: "memory");
    __syncthreads();
    if (threadIdx.x == 0) {
        unsigned* bar = b.bar; unsigned bx = b.x; asm volatile("" : "+s"(bar), "+s"(bx));
        __builtin_amdgcn_s_waitcnt(0);
        unsigned nloc = b.st[0], nx = b.st[1];
        if (nloc == 0u) { xcd_barrier_complete(bar, bx, nloc, nx); b.st[0] = nloc; b.st[1] = nx; }
        const unsigned old = xb_add(&bar[XB_XSUB(bx)], 1u);
        const unsigned gen = old / nloc;
        if (old + 1u == (gen + 1u) * nloc) {
            __builtin_amdgcn_fence(__ATOMIC_RELEASE, "agent");
            asm volatile("s_waitcnt vmcnt(0)" ::: "memory");
            const unsigned og = xb_add(&bar[XB_TOP], 1u);
            const unsigned tg = og / nx;
            if (og + 1u == (tg + 1u) * nx) xb_add(&bar[XB_TOPGEN], 1u);
            else XB_SPIN(xb_ld(&bar[XB_TOPGEN]) == tg, bar);
            __builtin_amdgcn_fence(__ATOMIC_ACQUIRE, "agent");
            xb_add(&bar[XB_XGEN(bx)], 1u);
            asm volatile("s_waitcnt vmcnt(0)" ::: "memory");
        } else {
            XB_SPIN(xb_ld(&bar[XB_XGEN(bx)]) == gen, bar);
            __builtin_amdgcn_fence(__ATOMIC_ACQUIRE, "agent");
            asm volatile("s_waitcnt vmcnt(0)" ::: "memory");
        }
    }
    __syncthreads();
}
constexpr int LDS_BYTES = 163840, MISC_OFF = 155648 + 320, CW_BAR = 4096;
__global__ void __launch_bounds__(512) mk_fwd(Ctx c_byval) {
    CtxP c = (CtxP)__builtin_amdgcn_kernarg_segment_ptr();
    extern __shared__ __attribute__((aligned(16))) unsigned char ldsraw[];
    float* lds = (float*)ldsraw;
    const int tid = threadIdx.x, bid = blockIdx.x, nblk = gridDim.x;
    volatile LAS unsigned* MISC = (volatile LAS unsigned*)((LAS unsigned char*)ldsraw + MISC_OFF);
    if (tid < 32) MISC[tid] = 0u;
    if ((tid & 63) == 0) ((volatile LAS int*)(unsigned long)WVTAB_OFF)[hw_slot()] = tid >> 6;
    __syncthreads();
    XcdBarrier bar = xcd_barrier_post((unsigned*)(c->ws + OFF_CTL) + CW_BAR, MISC + 8);
    s_p0(c, 0, 0, lds, bid, nblk);
    s_prenorm(c, 0, 0, lds, bid, nblk);
    xcd_barrier(bar);
    for (int slab_ = 0; slab_ < 2; ++slab_)
        for (int l_ = 0; l_ < NL; ++l_) {
            int l = l_, slab = slab_; asm volatile("" : "+s"(l), "+s"(slab));
            { const bf16_t* halo = (const bf16_t*)(c->ws + OFF_CARRY + l * CARRY_L + HALO_OFF); bf16_t* pp = (bf16_t*)(c->ws + OFF_P);
              for (int i = bid * 512 + otid(); i < NB * 3 * PP; i += nblk * 512) { const int b = i / (3 * PP), r = (i / PP) % 3, col = i % PP; pp[prow_off(b, r - 3) + col] = slab == 0 ? (bf16_t)0 : halo[i]; } }
            { pg8::Gemm g{(const bf16_t*)(c->ws + OFF_H), (const bf16_t*)(c->ws + OFF_WIN + l * WIN_L), MS, PP, D, D}; pg8::StaticOrder S; S.init(MS, PP, nblk, bid);
              pg8::EpiBf16<0> E{(bf16_t*)(c->ws + OFF_P) + 3 * PP, PP, nullptr, 0, 0, 1.f, 3};
              pg8::gemm_phase<pg8::EpiBf16<0>, pg8::StaticOrder, true, true, D, D, 0>((LAS unsigned char*)ldsraw, g, S, E); }
            xcd_barrier(bar);
            s_phase2(c, l, slab, lds, bid, nblk);
            xcd_barrier(bar);
            s_stepB(c, l, slab, lds, bid, nblk);
            xcd_barrier(bar);
            if (nblk == 256) s_phase3(c, l, slab, lds, bid);
            xcd_barrier(bar);
            s_bpost(c, l, slab, lds, bid, nblk);
            xcd_barrier(bar);
            { pg8::Gemm g{(const bf16_t*)(c->ws + OFF_P) + 3 * PP + ZA, (const bf16_t*)(c->ws + OFF_WOUT + l * WOUT_L), MS, 2 * D, DMIX / 2, PP}; pg8::StaticOrder S; S.init(MS, 2 * D, nblk, bid);
              pg8::EpiSplitK E{(float*)(c->ws + OFF_Y), (bf16_t*)(c->ws + OFF_Y2), D};
              pg8::gemm_phase<pg8::EpiSplitK, pg8::StaticOrder, true, true, DMIX / 2, PP, 3, DMIX / 2>((LAS unsigned char*)ldsraw, g, S, E); }
            xcd_barrier(bar);
            s_post(c, l, slab, lds, bid, nblk);
            if (l == 1 && slab == 0) s_prenorm(c, 0, 1, lds, bid, nblk);
            xcd_barrier(bar);
        }
}

extern "C" void kernel_launch(void* const* d_in, const int* in_sizes, int n_in, void* d_out, int out_size, void* d_ws, size_t ws_size, hipStream_t stream) {
    static int grid = 0;
    if (grid == 0) {
        int dev = 0, cus = 0, per_cu = 0;
        (void)hipGetDevice(&dev);
        (void)hipDeviceGetAttribute(&cus, hipDeviceAttributeMultiprocessorCount, dev);
        (void)hipFuncSetAttribute((const void*)mk_fwd, hipFuncAttributeMaxDynamicSharedMemorySize, LDS_BYTES);
        (void)hipOccupancyMaxActiveBlocksPerMultiprocessor(&per_cu, (const void*)mk_fwd, 512, LDS_BYTES);
        if (per_cu < 1) { fprintf(stderr, "kernel_launch: occupancy query says %d blocks/CU\n", per_cu); per_cu = 1; }
        grid = cus;
        if (grid != 256) fprintf(stderr, "kernel_launch: %d CUs (built for 256)\n", grid);
    }
    Ctx c{};
    const float** f = (const float**)&c;
    for (int i = 0; i < 28; ++i) f[i] = (const float*)d_in[i];
    c.out = (float*)d_out; c.ws = (unsigned char*)d_ws;
    (void)hipMemsetAsync(d_ws, 0, 1 * MiB, stream);
    void* args[] = {&c};
    hipError_t e = hipLaunchCooperativeKernel((const void*)mk_fwd, dim3(grid), dim3(512), args, LDS_BYTES, stream);
    if (e != hipSuccess) fprintf(stderr, "cooperative launch failed: %s (grid %d)\n", hipGetErrorString(e), grid);
}
```

```cpp
#include <hip/hip_runtime.h>
#include <cstdint>
#include <cstdio>

typedef unsigned short bf16_t;
#define DI __device__ __forceinline__
#define LAS __attribute__((address_space(3)))

constexpr int NB = 4, T = 4096, D = 1024, NL = 2, G = 512, NH = 8;
constexpr int TS = 2048, MS = NB * TS, NCS = TS / 64, TSP = TS + 3;
constexpr int DIN = 7824, PP = 7936, DMIX = 2048;
constexpr int A_Q = 0, A_K = 512, A_V = 1024, A_O = 1536, B_R = 2048, B_K = 2560, B_V = 3072, B_WLO = 3584, B_ALO = 3648, C_X = 3712,
              D_Q = 4224, D_K = 4736, D_V = 5248, ZA = 5760, ZB = 6272, ZC = 6784, ZD = 7296, A_I = 7808, A_F = 7816;
constexpr size_t MiB = 1u << 20;
constexpr size_t OFF_CTL = 0, OFF_ZROW = 512 * 1024, OFF_WIN = 1 * MiB, OFF_WOUT = 32 * MiB, OFF_ROPE = 40 * MiB, OFF_CARRY = 41 * MiB,
                 OFF_LS = 45 * MiB, OFF_BON = 45 * MiB + 512 * 1024, OFF_P = 45 * MiB + 768 * 1024, OFF_SA = 170 * MiB, OFF_H = 170 * MiB,
                 OFF_SD = 170 * MiB + 17301504, OFF_CK = 203 * MiB, OFF_Y = 203 * MiB, OFF_Y2 = 235 * MiB,
                 OFF_WRT = 251 * MiB, OFF_WIT = OFF_WRT + 262144, OFF_WUT = OFF_WIT + 262144, OFF_AUT = OFF_WUT + 262144;
constexpr size_t WIN_L = (size_t)PP * D * 2, WOUT_L = (size_t)D * DMIX * 2;
constexpr size_t CARRY_L = 2 * MiB, CA_OFF = 0, CD_OFF = 540672, CB_OFF = CD_OFF + 524288, CC_OFF = CB_OFF + 524288, HALO_OFF = CC_OFF + 8192;
constexpr int SAU = 4224;

struct Ctx {
    const float *x, *norm_pre, *norm_post, *w_in, *w_out, *mconv_w, *mconv_b, *mi_bias, *mf_bias, *mnorm_w, *rmu, *rw_up, *rw0, *ra_up, *ra0,
        *rk_k, *rk_a, *rr_k, *rgn_w, *rgn_b, *lconv_w, *lconv_b, *lw_r, *lb_r, *lw_i, *lb_i, *llam, *retnorm_w;
    float* out; unsigned char* ws;
};
typedef const __attribute__((address_space(4))) Ctx* CtxP;


constexpr int WVTAB_OFF = 155648 + 512;
DI int hw_slot() { return __builtin_amdgcn_s_getreg((5 << 11) | 4) & 63; }
DI int otid() { int lane; asm volatile("v_mbcnt_lo_u32_b32 %0, -1, 0\n\tv_mbcnt_hi_u32_b32 %0, -1, %0" : "=v"(lane));
    const int wv = __builtin_amdgcn_readfirstlane(((volatile LAS int*)(unsigned long)WVTAB_OFF)[hw_slot()]);
    int t = (wv << 6) | lane; asm volatile("" : "+v"(t)); return t; }
DI size_t prow_off(int b, int tl) { return (size_t)(b * TSP + 3 + tl) * PP; }
DI float bf2f(bf16_t v) { return __uint_as_float(((unsigned)v) << 16); }
DI bf16_t f2bf(float f) { unsigned u = __float_as_uint(f); u += 0x7fffu + ((u >> 16) & 1u); return (bf16_t)(u >> 16); }
DI float sigm(float x) { return __builtin_amdgcn_rcpf(1.f + __expf(-x)); }
DI float siluf(float x) { return x * __builtin_amdgcn_rcpf(1.f + __expf(-x)); }
DI float softplusf(float x) { return fmaxf(x, 0.f) + log1pf(expf(-fabsf(x))); }
DI float wave_sum(float v) {
#pragma unroll
    for (int o = 1; o < 64; o <<= 1) v += __shfl_xor(v, o);
    return v;
}
DI int srccol(int n) {
    if (n < 2048) return n;
    if (n < 3712) return n + 528;
    if (n < 4224) return n + 1040;
    if (n < 5760) return n + 1552;
    if (n < 6272) return n - 3712;
    if (n < 6784) return n - 2032;
    if (n < 7296) return n - 1520;
    if (n < 7808) return n + 16;
    if (n < 7824) return n - 5248;
    return -1;
}
DI void wt_item(const float* W, int K, int N, bf16_t* WT, bool permute, float* scr, int item, int lane, bool ksplit = false) {
    const int nblk = (permute ? PP : N) / 32, kb = item / nblk, nb = item % nblk, k0 = 64 * kb, n0 = 32 * nb;
    const int nn = n0 + (lane & 31); const int sc = permute ? srccol(nn) : nn;
    for (int i = 0; i < 32; ++i) { const int kk = 2 * i + (lane >> 5); scr[kk * 33 + (lane & 31)] = sc >= 0 ? W[(size_t)(k0 + kk) * N + sc] : 0.f; }
    __builtin_amdgcn_s_waitcnt(0); __builtin_amdgcn_wave_barrier();
    const int c = lane & 7;
    for (int j = 0; j < 4; ++j) { const int n = (lane >> 3) + 8 * j; const float* s = scr + (8 * c) * 33 + n;
        uint4 o; o.x = f2bf(s[0]) | ((unsigned)f2bf(s[33]) << 16); o.y = f2bf(s[66]) | ((unsigned)f2bf(s[99]) << 16);
        o.z = f2bf(s[132]) | ((unsigned)f2bf(s[165]) << 16); o.w = f2bf(s[198]) | ((unsigned)f2bf(s[231]) << 16);
        if (ksplit) *(uint4*)(WT + (size_t)((k0 >> 10) * N + n0 + n) * (K / 2) + (k0 & 1023) + 8 * c) = o;
        else *(uint4*)(WT + (size_t)(n0 + n) * K + k0 + 8 * c) = o; }
    __builtin_amdgcn_s_waitcnt(0); __builtin_amdgcn_wave_barrier();
}
DI void s_p0(CtxP c, int l, int slab, float* lds, int bid, int nblk) {
    const int tid = otid(), lane = tid & 63, wave = tid >> 6;
    float* scr = lds + wave * (64 * 33);
    const int gw = bid * 8 + wave, NGW = nblk * 8;
    constexpr int I_IN = (D / 64) * (PP / 32), I_OUT = (DMIX / 64) * (D / 32);
    for (int it = gw; it < NL * (I_IN + I_OUT); it += NGW) {
        const int l = it / (I_IN + I_OUT); int r = it % (I_IN + I_OUT);
        if (r < I_IN) wt_item(c->w_in + (size_t)l * D * DIN, D, DIN, (bf16_t*)(c->ws + OFF_WIN + l * WIN_L), true, scr, r, lane);
        else wt_item(c->w_out + (size_t)l * DMIX * D, DMIX, D, (bf16_t*)(c->ws + OFF_WOUT + l * WOUT_L), false, scr, r - I_IN, lane, true);
    }
    { bf16_t* wrt = (bf16_t*)(c->ws + OFF_WRT); bf16_t* wit = (bf16_t*)(c->ws + OFF_WIT); bf16_t* wut = (bf16_t*)(c->ws + OFF_WUT); bf16_t* aut = (bf16_t*)(c->ws + OFF_AUT);
      for (int i = bid * 512 + tid; i < NL * NH * 4096; i += nblk * 512) { const int lh = i >> 12, j = (i >> 6) & 63, ii = i & 63;
          wrt[i] = f2bf(c->lw_r[(size_t)lh * 4096 + ii * 64 + j]); wit[i] = f2bf(c->lw_i[(size_t)lh * 4096 + ii * 64 + j]); }
      for (int i = bid * 512 + tid; i < NL * G * 64; i += nblk * 512) { const int l2 = i / (G * 64), j = (i >> 6) % G, ii = i & 63;
          wut[i] = f2bf(c->rw_up[(size_t)l2 * 64 * G + ii * G + j]); aut[i] = f2bf(c->ra_up[(size_t)l2 * 64 * G + ii * G + j]); } }
    float* rope = (float*)(c->ws + OFF_ROPE);
    for (int i = bid * 512 + tid; i < T * 32; i += nblk * 512) {
        const int t = i >> 5, j = i & 31; const float inv = powf(10000.f, -(float)j / 32.f); const float ang = (float)t * inv;
        rope[2 * i] = cosf(ang); rope[2 * i + 1] = sinf(ang);
    }
}
DI void norm_row(const float* xrow, const float* g, bf16_t* hrow, int lane) {
    float4 v[4]; float ss = 0.f;
#pragma unroll
    for (int j = 0; j < 4; ++j) { v[j] = *(const float4*)(xrow + j * 256 + lane * 4); ss += v[j].x * v[j].x + v[j].y * v[j].y + v[j].z * v[j].z + v[j].w * v[j].w; }
    ss = wave_sum(ss); const float rs = rsqrtf(ss * (1.f / D) + 1e-6f);
#pragma unroll
    for (int j = 0; j < 4; ++j) { const float4 gg = *(const float4*)(g + j * 256 + lane * 4);
        uint2 o; o.x = f2bf(v[j].x * rs * gg.x) | ((unsigned)f2bf(v[j].y * rs * gg.y) << 16); o.y = f2bf(v[j].z * rs * gg.z) | ((unsigned)f2bf(v[j].w * rs * gg.w) << 16);
        *(uint2*)(hrow + j * 256 + lane * 4) = o; }
}
DI void s_prenorm(CtxP c, int l, int slab, float* lds, int bid, int nblk) {
    const int lane = otid() & 63, gw = bid * 8 + (otid() >> 6), NGW = nblk * 8;
    for (int r = gw; r < MS; r += NGW) { const int b = r / TS, tl = r % TS; const size_t grow = (size_t)b * T + slab * TS + tl;
        norm_row(c->x + grow * D, c->norm_pre, (bf16_t*)(c->ws + OFF_H) + (size_t)r * D, lane); }
}
DI float ret_logg(int h) { return log1pf(-exp2f(-5.f - (float)h)); }
DI void s_stepB(CtxP c, int l, int slab, float* lds, int bid, int nblk) {
    const int tid = otid();
    for (int item = bid; item < 288 + 256 + 4; item += nblk) {
        if (item < 288) {
            const int bh = item / 9, part = item % 9, el = part * 512 + tid; const bool on = el < 4160;
            float* CA = (float*)(c->ws + OFF_CARRY + l * CARRY_L + CA_OFF) + (size_t)bh * SAU; float* S0 = (float*)(c->ws + OFF_SA) + (size_t)(bh * NCS) * SAU;
            float m = slab == 0 ? 0.f : CA[4160 + slab - 1]; float val = (slab == 0 || !on) ? 0.f : CA[el];
            float loc[NCS], ml[NCS], tt[NCS];
#pragma unroll
            for (int cl = 0; cl < NCS; ++cl) { const float* S = S0 + (size_t)cl * SAU; ml[cl] = S[4160]; tt[cl] = S[4161]; loc[cl] = on ? S[el] : 0.f; }
#pragma unroll
            for (int cl = 0; cl < NCS; ++cl) { float* S = S0 + (size_t)cl * SAU;
                if (on) S[el] = val;
                if (el == 0) S[4162] = m;
                const float mn = fmaxf(tt[cl] + m, ml[cl]); val = expf(tt[cl] + m - mn) * val + expf(ml[cl] - mn) * loc[cl]; m = mn; }
            if (on) CA[el] = val;
            if (el == 0) CA[4160 + slab] = m;
        } else if (item < 288 + 256) {
            const int it = item - 288, bh = it / 8, el = (it % 8) * 512 + tid; const float gch = expf(ret_logg(bh % NH) * 64.f);
            float* CD = (float*)(c->ws + OFF_CARRY + l * CARRY_L + CD_OFF) + (size_t)bh * 4096; float* S0 = (float*)(c->ws + OFF_SD) + (size_t)(bh * NCS) * 4096;
            float val = slab == 0 ? 0.f : CD[el]; float loc[NCS];
#pragma unroll
            for (int cl = 0; cl < NCS; ++cl) loc[cl] = S0[(size_t)cl * 4096 + el];
#pragma unroll
            for (int cl = 0; cl < NCS; ++cl) { S0[(size_t)cl * 4096 + el] = val; val = gch * val + loc[cl]; }
            CD[el] = val;
        } else {
            const int i = (item - 544) * 512 + tid, b = i / G, ch = i % G; float* CC = (float*)(c->ws + OFF_CARRY + l * CARRY_L + CC_OFF);
            float hc = slab == 0 ? 0.f : CC[i]; float2 v[NCS];
#pragma unroll
            for (int cl = 0; cl < NCS; ++cl) v[cl] = *(const float2*)((const float*)(c->ws + OFF_LS) + ((size_t)(b * NCS + cl) * G + ch) * 2);
#pragma unroll
            for (int cl = 0; cl < NCS; ++cl) { ((float*)(c->ws + OFF_LS))[((size_t)(b * NCS + cl) * G + ch) * 2] = hc; hc = v[cl].x * hc + v[cl].y; }
            CC[i] = hc;
        }
    }
}
typedef short bf16x8 __attribute__((ext_vector_type(8)));
typedef float f32x16 __attribute__((ext_vector_type(16)));
typedef float f32x2_t __attribute__((ext_vector_type(2)));
typedef __bf16 bf16x2_t __attribute__((ext_vector_type(2)));
DI unsigned pk2(float lo, float hi) { f32x2_t v = {lo, hi}; bf16x2_t b = __builtin_convertvector(v, bf16x2_t); return __builtin_bit_cast(unsigned, b); }
DI bf16x8 pack8(const float* v) { uint4 u; u.x = pk2(v[0], v[1]); u.y = pk2(v[2], v[3]); u.z = pk2(v[4], v[5]); u.w = pk2(v[6], v[7]); return __builtin_bit_cast(bf16x8, u); }
DI void unpack8(uint4 u, float* v) { v[0] = __uint_as_float(u.x << 16); v[1] = __uint_as_float(u.x & 0xffff0000u); v[2] = __uint_as_float(u.y << 16); v[3] = __uint_as_float(u.y & 0xffff0000u);
    v[4] = __uint_as_float(u.z << 16); v[5] = __uint_as_float(u.z & 0xffff0000u); v[6] = __uint_as_float(u.w << 16); v[7] = __uint_as_float(u.w & 0xffff0000u); }
#define MFMA32(a, b, c) __builtin_amdgcn_mfma_f32_32x32x16_bf16((a), (b), (c), 0, 0, 0)
#define WSYNC() do { __builtin_amdgcn_fence(__ATOMIC_RELEASE, "wavefront"); __builtin_amdgcn_wave_barrier(); __builtin_amdgcn_fence(__ATOMIC_ACQUIRE, "wavefront"); } while (0)
DI float wave_psum(float v, int lane) {
#pragma unroll
    for (int o = 1; o < 64; o <<= 1) { const float t = __shfl_up(v, o); if (lane >= o) v += t; }
    return v;
}
DI float wave_pmax(float v, int lane) {
#pragma unroll
    for (int o = 1; o < 64; o <<= 1) { const float t = __shfl_up(v, o); if (lane >= o) v = fmaxf(v, t); }
    return v;
}
DI float wave_max(float v) {
#pragma unroll
    for (int o = 1; o < 64; o <<= 1) v = fmaxf(v, __shfl_xor(v, o));
    return v;
}
constexpr int TP = 144;
constexpr int WLDS = 19456;
#define TILE_K(NR) (((NR) * 8 + 63) / 64)
typedef unsigned u32x4 __attribute__((ext_vector_type(4)));
template <int NR> DI void tile_load(u32x4 (&tv)[TILE_K(NR)], const bf16_t* rb  , int tl_first, int col, int lane) {
#pragma unroll
    for (int k = 0; k < (NR * 8 + 63) / 64; ++k) { const int i = lane + 64 * k; int r = i >> 3; r = r < NR ? r : NR - 1; const int ch = i & 7;
        tv[k] = *(const u32x4*)(rb + (tl_first + r) * PP + col + ch * 8); }
}
template <int NR> DI void tile_store(const u32x4 (&tv)[TILE_K(NR)], unsigned char* tile, int lane) {
#pragma unroll
    for (int k = 0; k < (NR * 8 + 63) / 64; ++k) { const int i = lane + 64 * k; const int r = i >> 3, ch = i & 7;
        if (i < NR * 8) *(u32x4*)(tile + r * TP + ch * 16) = tv[k]; }
    WSYNC();
}
DI void proc_conv_tile(unsigned char* tile, const float* cw, int cws, const float* cb, float scale, int lane) {
    const int ch = lane & 7; float w[4][8], bb[8];
#pragma unroll
    for (int t = 0; t < 4; ++t) { const float4 a = *(const float4*)(cw + t * cws + ch * 8), d = *(const float4*)(cw + t * cws + ch * 8 + 4);
        w[t][0] = a.x; w[t][1] = a.y; w[t][2] = a.z; w[t][3] = a.w; w[t][4] = d.x; w[t][5] = d.y; w[t][6] = d.z; w[t][7] = d.w; }
    { const float4 a = *(const float4*)(cb + ch * 8), d = *(const float4*)(cb + ch * 8 + 4); bb[0] = a.x; bb[1] = a.y; bb[2] = a.z; bb[3] = a.w; bb[4] = d.x; bb[5] = d.y; bb[6] = d.z; bb[7] = d.w; }
#pragma unroll
    for (int k = 0; k < 8; ++k) { const int row = (lane >> 3) + 8 * k; float acc[8];
#pragma unroll
        for (int i = 0; i < 8; ++i) acc[i] = bb[i];
#pragma unroll
        for (int t = 0; t < 4; ++t) { float x[8]; unpack8(*(const uint4*)(tile + (row + t) * TP + ch * 16), x);
#pragma unroll
            for (int i = 0; i < 8; ++i) acc[i] += x[i] * w[t][i]; }
#pragma unroll
        for (int i = 0; i < 8; ++i) acc[i] = siluf(acc[i]) * scale;
        const bf16x8 res = pack8(acc); WSYNC();
        *(bf16x8*)(tile + row * TP + ch * 16) = res; }
    WSYNC();
}
DI void proc_rope_tile(unsigned char* tile, const float* ropet, int pos0, float scale, int lane) {
    const int p = lane & 3;
#pragma unroll
    for (int k = 0; k < 4; ++k) { const int row = (lane >> 2) + 16 * k; float x1[8], x2[8], o1[8], o2[8];
        unpack8(*(const uint4*)(tile + row * TP + p * 16), x1); unpack8(*(const uint4*)(tile + row * TP + (p + 4) * 16), x2);
        const float* cs = ropet + ((size_t)(pos0 + row) * 32 + p * 8) * 2;
#pragma unroll
        for (int q = 0; q < 4; ++q) { const float4 v = *(const float4*)(cs + 4 * q);
            o1[2 * q] = (x1[2 * q] * v.x - x2[2 * q] * v.y) * scale; o2[2 * q] = (x2[2 * q] * v.x + x1[2 * q] * v.y) * scale;
            o1[2 * q + 1] = (x1[2 * q + 1] * v.z - x2[2 * q + 1] * v.w) * scale; o2[2 * q + 1] = (x2[2 * q + 1] * v.z + x1[2 * q + 1] * v.w) * scale; }
        *(bf16x8*)(tile + row * TP + p * 16) = pack8(o1); *(bf16x8*)(tile + row * TP + (p + 4) * 16) = pack8(o2); asm volatile("" ::: "memory"); }
    WSYNC();
}
DI bf16x8 frag_nat(const unsigned char* tile, int row, int ch) { return *(const bf16x8*)(tile + row * TP + ch * 16); }
DI float tile_at(const unsigned char* tile, int row, int col) { return bf2f(*(const bf16_t*)(tile + row * TP + col * 2)); }

template <bool RET> DI void w_chunkA(CtxP c, int l, int slab, int u, unsigned char* wl, int lane) {
    const int bh = u / NCS, cl = u % NCS, b = bh >> 3, h = bh & 7, tl0 = cl * 64, hs = lane >> 5, li = lane & 31;
    unsigned char* tile = wl; float* tab = (float*)(wl + 9728); const bf16_t* rb = (const bf16_t*)(c->ws + OFF_P) + prow_off(b, 0);
    float* S = RET ? (float*)(c->ws + OFF_SD) + (size_t)u * 4096 : (float*)(c->ws + OFF_SA) + (size_t)u * SAU;
    float mloc = 0.f, tot = 0.f;
    u32x4 rk64[TILE_K(64)], rv64[TILE_K(64)], rk67[TILE_K(67)];
    if (RET) tile_load<64>(rk64, rb, tl0, D_K + h * 64, lane); else tile_load<67>(rk67, rb, tl0 - 3, A_K + h * 64, lane);
    tile_load<64>(rv64, rb, tl0, (RET ? D_V : A_V) + h * 64, lane);
    if (RET) { tab[lane] = expf(ret_logg(h) * (float)(63 - lane)); }
    else { const bf16_t* gr = (const bf16_t*)(c->ws + OFF_P) + prow_off(b, tl0 + lane);
        const float ig = bf2f(gr[A_I + h]) + c->mi_bias[l * NH + h]; const float lf = -softplusf(-(bf2f(gr[A_F + h]) + c->mf_bias[l * NH + h]));
        const float cum = wave_psum(lf, lane); tot = __int_as_float(__builtin_amdgcn_readlane(__float_as_int(cum), 63)); const float lw = tot - cum + ig; mloc = wave_max(lw); tab[lane] = expf(lw - mloc); }
    if (RET) { tile_store<64>(rk64, tile, lane); proc_rope_tile(tile, (const float*)(c->ws + OFF_ROPE), slab * TS + tl0, 0.125f, lane); }
    else { tile_store<67>(rk67, tile, lane); proc_conv_tile(tile, c->mconv_w + l * 4096 + 512 + h * 64, 1024, c->mconv_b + l * 1024 + 512 + h * 64, 0.125f, lane); }
    bf16x8 kf[2][4]; float nl[2] = {0.f, 0.f};
#pragma unroll
    for (int db = 0; db < 2; ++db)
#pragma unroll
        for (int ks = 0; ks < 4; ++ks) { float v[8];
#pragma unroll
            for (int j = 0; j < 8; ++j) { const int t = 16 * ks + 8 * hs + j; v[j] = tile_at(tile, t, 32 * db + li); nl[db] += tab[t] * v[j]; }
            kf[db][ks] = pack8(v); }
    WSYNC();
    tile_store<64>(rv64, tile, lane);
    f32x16 acc[2][2];
#pragma unroll
    for (int eb = 0; eb < 2; ++eb)
#pragma unroll
        for (int db = 0; db < 2; ++db)
#pragma unroll
            for (int r = 0; r < 16; ++r) acc[eb][db][r] = 0.f;
#pragma unroll
    for (int eb = 0; eb < 2; ++eb)
#pragma unroll
        for (int ks = 0; ks < 4; ++ks) { float v[8];
#pragma unroll
            for (int j = 0; j < 8; ++j) { const int t = 16 * ks + 8 * hs + j; v[j] = tile_at(tile, t, 32 * eb + li) * tab[t]; }
            const bf16x8 vf = pack8(v);
#pragma unroll
            for (int db = 0; db < 2; ++db) acc[eb][db] = MFMA32(vf, kf[db][ks], acc[eb][db]); }
#pragma unroll
    for (int eb = 0; eb < 2; ++eb)
#pragma unroll
        for (int db = 0; db < 2; ++db)
#pragma unroll
            for (int r = 0; r < 16; ++r) S[(32 * eb + (r & 3) + 8 * (r >> 2) + 4 * hs) * 64 + 32 * db + li] = acc[eb][db][r];
    if (!RET) {
#pragma unroll
        for (int db = 0; db < 2; ++db) { nl[db] += __shfl_xor(nl[db], 32); if (hs == 0) S[4096 + 32 * db + li] = nl[db]; }
        if (lane == 0) { S[4160] = mloc; S[4161] = tot; } }
    WSYNC();
}
template <bool RET> DI void w_chunkC(CtxP c, int l, int slab, int u, unsigned char* wl, int lane) {
    const int bh = u / NCS, cl = u % NCS, b = bh >> 3, h = bh & 7, tl0 = cl * 64, hs = lane >> 5, li = lane & 31;
    unsigned char* tile = wl; float* tab = (float*)(wl + 9728); const bf16_t* rb = (const bf16_t*)(c->ws + OFF_P) + prow_off(b, 0);
    const float* S = RET ? (const float*)(c->ws + OFF_SD) + (size_t)u * 4096 : (const float*)(c->ws + OFF_SA) + (size_t)u * SAU;
    const float lg = RET ? ret_logg(h) : 0.f;
    float mx_t[2] = {0.f, 0.f}, sc_t[2], dnf_t[2] = {0.f, 0.f};
    if (RET) { sc_t[0] = expf(lg * (float)(li + 1)); sc_t[1] = expf(lg * (float)(li + 33)); }
    else { const bf16_t* gr = (const bf16_t*)(c->ws + OFF_P) + prow_off(b, tl0 + lane);
        const float ig = bf2f(gr[A_I + h]) + c->mi_bias[l * NH + h]; const float lf = -softplusf(-(bf2f(gr[A_F + h]) + c->mf_bias[l * NH + h]));
        const float cum = wave_psum(lf, lane); const float a = ig - cum; const float g = wave_pmax(a, lane);
        const float mst = S[4162]; const float mx = fmaxf(mst, g); const float sint = expf(mst - mx); const float dnf = expf(-(cum + mx));
        tab[lane] = a;
        mx_t[0] = __shfl(mx, li); mx_t[1] = __shfl(mx, 32 + li); sc_t[0] = __shfl(sint, li); sc_t[1] = __shfl(sint, 32 + li); dnf_t[0] = __shfl(dnf, li); dnf_t[1] = __shfl(dnf, 32 + li); }
    u32x4 rk64[TILE_K(64)], rq64[TILE_K(64)], rv64[TILE_K(64)], rk67[TILE_K(67)], rq67[TILE_K(67)];
    if (RET) { tile_load<64>(rk64, rb, tl0, D_K + h * 64, lane); tile_load<64>(rq64, rb, tl0, D_Q + h * 64, lane); }
    else { tile_load<67>(rk67, rb, tl0 - 3, A_K + h * 64, lane); tile_load<67>(rq67, rb, tl0 - 3, A_Q + h * 64, lane); }
    bf16x8 kf[2][4], qf[2][4], cf[2][4];
#pragma unroll
    for (int eb = 0; eb < 2; ++eb)
#pragma unroll
        for (int ks = 0; ks < 4; ++ks) { const float* cp = S + (32 * eb + li) * 64 + 16 * ks + 8 * hs; const float4 c0 = *(const float4*)cp, c1 = *(const float4*)(cp + 4);
            const float cv[8] = {c0.x, c0.y, c0.z, c0.w, c1.x, c1.y, c1.z, c1.w}; cf[eb][ks] = pack8(cv); }
    do { asm volatile("" ::: "memory"); __builtin_amdgcn_sched_barrier(0); } while (0);
    if (RET) { tile_store<64>(rk64, tile, lane); proc_rope_tile(tile, (const float*)(c->ws + OFF_ROPE), slab * TS + tl0, 0.125f, lane); }
    else { tile_store<67>(rk67, tile, lane); proc_conv_tile(tile, c->mconv_w + l * 4096 + 512 + h * 64, 1024, c->mconv_b + l * 1024 + 512 + h * 64, 0.125f, lane); }
#pragma unroll
    for (int mb = 0; mb < 2; ++mb)
#pragma unroll
        for (int ks = 0; ks < 4; ++ks) kf[mb][ks] = frag_nat(tile, 32 * mb + li, 2 * ks + hs);
    WSYNC(); __builtin_amdgcn_sched_barrier(0);
    tile_load<64>(rv64, rb, tl0, (RET ? D_V : A_V) + h * 64, lane);
    if (RET) { tile_store<64>(rq64, tile, lane); proc_rope_tile(tile, (const float*)(c->ws + OFF_ROPE), slab * TS + tl0, 1.f, lane); }
    else { tile_store<67>(rq67, tile, lane); proc_conv_tile(tile, c->mconv_w + l * 4096 + h * 64, 1024, c->mconv_b + l * 1024 + h * 64, 1.f, lane); }
#pragma unroll
    for (int nb = 0; nb < 2; ++nb)
#pragma unroll
        for (int ks = 0; ks < 4; ++ks) qf[nb][ks] = frag_nat(tile, 32 * nb + li, 2 * ks + hs);
    WSYNC(); __builtin_amdgcn_sched_barrier(0);
    tile_store<64>(rv64, tile, lane);
    const int zc = (RET ? ZD : ZA) + h * 64; const float* nw = (RET ? c->retnorm_w : c->mnorm_w) + l * G + h * 64;
#pragma unroll
    for (int nb = 0; nb < 2; ++nb) {
        bf16_t* prw = (bf16_t*)(c->ws + OFF_P) + prow_off(b, tl0 + 32 * nb + li);
        uint2 ogr[2][4], zvr[2][4];
#pragma unroll
        for (int eb = 0; eb < 2; ++eb)
#pragma unroll
            for (int rg = 0; rg < 4; ++rg) { const int e0 = 32 * eb + 8 * rg + 4 * hs; zvr[eb][rg] = *(const uint2*)(prw + zc + e0); ogr[eb][rg] = RET ? make_uint2(0u, 0u) : *(const uint2*)(prw + A_O + h * 64 + e0); }
        bf16x8 xf[2][2]; float csum = 0.f;
#pragma unroll
        for (int mb = 0; mb < 2; ++mb) {
            if (!RET && mb == 1 && nb == 0) continue;
            f32x16 sa;
#pragma unroll
            for (int r = 0; r < 16; ++r) sa[r] = 0.f;
#pragma unroll
            for (int ks = 0; ks < 4; ++ks) sa = MFMA32(kf[mb][ks], qf[nb][ks], sa);
            float xv[16];
#pragma unroll
            for (int rg = 0; rg < 4; ++rg) { float av[4] = {0.f, 0.f, 0.f, 0.f};
                if (!RET) { const float4 t4 = *(const float4*)(tab + 32 * mb + 8 * rg + 4 * hs); av[0] = t4.x; av[1] = t4.y; av[2] = t4.z; av[3] = t4.w; }
#pragma unroll
                for (int i = 0; i < 4; ++i) { const int r = 4 * rg + i, s = 32 * mb + 8 * rg + 4 * hs + i, t = 32 * nb + li;
                    float w;
                    if (RET) w = __expf(lg * fabsf((float)(t - s))); else w = s <= t ? __expf(av[i] - mx_t[nb]) : 0.f;
                    xv[r] = sa[r] * w; csum += xv[r]; } }
            xf[mb][0] = pack8(xv); xf[mb][1] = pack8(xv + 8); __builtin_amdgcn_sched_barrier(0); }
        f32x16 o[2];
#pragma unroll
        for (int eb = 0; eb < 2; ++eb) {
#pragma unroll
            for (int r = 0; r < 16; ++r) o[eb][r] = 0.f;
#pragma unroll
            for (int ks = 0; ks < 4; ++ks) o[eb] = MFMA32(cf[eb][ks], qf[nb][ks], o[eb]);
#pragma unroll
            for (int r = 0; r < 16; ++r) o[eb][r] *= sc_t[nb]; }
        __builtin_amdgcn_sched_barrier(0);
        float dn = 1.f;
        if (!RET) { float qn = 0.f;
#pragma unroll
            for (int ks = 0; ks < 4; ++ks) { const float4 n0 = *(const float4*)(S + 4096 + 16 * ks + 8 * hs), n1 = *(const float4*)(S + 4096 + 16 * ks + 8 * hs + 4);
                const float nv[8] = {n0.x, n0.y, n0.z, n0.w, n1.x, n1.y, n1.z, n1.w}; float qv[8]; unpack8(__builtin_bit_cast(uint4, qf[nb][ks]), qv);
#pragma unroll
                for (int j = 0; j < 8; ++j) qn += qv[j] * nv[j]; }
            qn += __shfl_xor(qn, 32); csum += __shfl_xor(csum, 32); dn = fmaxf(fabsf(csum + sc_t[nb] * qn), dnf_t[nb]); }
#pragma unroll
        for (int eb = 0; eb < 2; ++eb)
#pragma unroll
            for (int sb = 0; sb < 2; ++sb) {
                if (!RET && sb == 1 && nb == 0) continue;
#pragma unroll
                for (int st = 0; st < 2; ++st) { bf16x8 vf;
#pragma unroll
                    for (int j = 0; j < 8; ++j) vf[j] = (short)*(const bf16_t*)(tile + (32 * sb + 16 * st + 8 * (j >> 2) + 4 * hs + (j & 3)) * TP + (32 * eb + li) * 2);
                    o[eb] = MFMA32(vf, xf[sb][st], o[eb]); }
                do { asm volatile("" ::: "memory"); __builtin_amdgcn_sched_barrier(0); } while (0); }
        do { asm volatile("" ::: "memory"); __builtin_amdgcn_sched_barrier(0); } while (0);
        const float inv = 1.f / dn; float sum = 0.f;
#pragma unroll
        for (int eb = 0; eb < 2; ++eb)
#pragma unroll
            for (int rg = 0; rg < 4; ++rg) { const int e0 = 32 * eb + 8 * rg + 4 * hs; float og[4] = {1.f, 1.f, 1.f, 1.f};
                if (!RET) { const uint2 ov = ogr[eb][rg]; og[0] = sigm(__uint_as_float(ov.x << 16)); og[1] = sigm(__uint_as_float(ov.x & 0xffff0000u)); og[2] = sigm(__uint_as_float(ov.y << 16)); og[3] = sigm(__uint_as_float(ov.y & 0xffff0000u)); }
#pragma unroll
                for (int i = 0; i < 4; ++i) { const float v = o[eb][4 * rg + i] * inv * og[i]; o[eb][4 * rg + i] = v; sum += v; } }
        sum += __shfl_xor(sum, 32); const float mu = sum * (1.f / 64.f); float vs = 0.f;
#pragma unroll
        for (int eb = 0; eb < 2; ++eb)
#pragma unroll
            for (int r = 0; r < 16; ++r) { const float d = o[eb][r] - mu; vs += d * d; }
        vs += __shfl_xor(vs, 32); const float rstd = rsqrtf(vs * (1.f / 64.f) + 1e-5f);
#pragma unroll
        for (int eb = 0; eb < 2; ++eb)
#pragma unroll
            for (int rg = 0; rg < 4; ++rg) { const int e0 = 32 * eb + 8 * rg + 4 * hs; const uint2 zv = zvr[eb][rg]; const float4 w4 = *(const float4*)(nw + e0);
                const float z[4] = {__uint_as_float(zv.x << 16), __uint_as_float(zv.x & 0xffff0000u), __uint_as_float(zv.y << 16), __uint_as_float(zv.y & 0xffff0000u)}; const float wv[4] = {w4.x, w4.y, w4.z, w4.w}; float y[4];
#pragma unroll
                for (int i = 0; i < 4; ++i) y[i] = (o[eb][4 * rg + i] - mu) * rstd * wv[i] * siluf(z[i]);
                uint2 ov; ov.x = pk2(y[0], y[1]); ov.y = pk2(y[2], y[3]); *(uint2*)(prw + zc + e0) = ov; }
        do { asm volatile("" ::: "memory"); __builtin_amdgcn_sched_barrier(0); } while (0);
    }
    WSYNC(); __builtin_amdgcn_sched_barrier(0);
}
DI void proc_conv_tile_lin(unsigned char* tile, const float* cw, int cws, const float* cb, int lane) {
    const int ch = lane & 7; float w[4][8], bb[8];
#pragma unroll
    for (int t = 0; t < 4; ++t) { const float4 a = *(const float4*)(cw + t * cws + ch * 8), d = *(const float4*)(cw + t * cws + ch * 8 + 4);
        w[t][0] = a.x; w[t][1] = a.y; w[t][2] = a.z; w[t][3] = a.w; w[t][4] = d.x; w[t][5] = d.y; w[t][6] = d.z; w[t][7] = d.w; }
    { const float4 a = *(const float4*)(cb + ch * 8), d = *(const float4*)(cb + ch * 8 + 4); bb[0] = a.x; bb[1] = a.y; bb[2] = a.z; bb[3] = a.w; bb[4] = d.x; bb[5] = d.y; bb[6] = d.z; bb[7] = d.w; }
#pragma unroll
    for (int k = 0; k < 8; ++k) { const int row = (lane >> 3) + 8 * k; float acc[8];
#pragma unroll
        for (int i = 0; i < 8; ++i) acc[i] = bb[i];
#pragma unroll
        for (int t = 0; t < 4; ++t) { float x[8]; unpack8(*(const uint4*)(tile + (row + t) * TP + ch * 16), x);
#pragma unroll
            for (int i = 0; i < 8; ++i) acc[i] += x[i] * w[t][i]; }
        const bf16x8 res = pack8(acc); WSYNC();
        *(bf16x8*)(tile + row * TP + ch * 16) = res; }
    WSYNC();
}
DI void lru_gates(CtxP c, int l, int h, int jb, const unsigned char* tile, const bf16x8 (&xf)[2][4], float (&a)[2][16], float (&u)[2][16], int li, int hs) {
    const int j = 32 * jb + li, ch = h * 64 + j;
    const bf16_t* wr = (const bf16_t*)(c->ws + OFF_WRT) + ((size_t)(l * NH + h) * 64 + j) * 64; const bf16_t* wi = (const bf16_t*)(c->ws + OFF_WIT) + ((size_t)(l * NH + h) * 64 + j) * 64;
    bf16x8 wrf[4], wif[4];
#pragma unroll
    for (int ks = 0; ks < 4; ++ks) { wrf[ks] = *(const bf16x8*)(wr + 16 * ks + 8 * hs); wif[ks] = *(const bf16x8*)(wi + 16 * ks + 8 * hs); }
    const float br = c->lb_r[l * G + ch], bi = c->lb_i[l * G + ch], sp8 = -8.f * softplusf(-c->llam[l * G + ch]);
#pragma unroll
    for (int tb = 0; tb < 2; ++tb) { f32x16 ar, ai;
#pragma unroll
        for (int r = 0; r < 16; ++r) { ar[r] = 0.f; ai[r] = 0.f; }
#pragma unroll
        for (int ks = 0; ks < 4; ++ks) { ar = MFMA32(xf[tb][ks], wrf[ks], ar); ai = MFMA32(xf[tb][ks], wif[ks], ai); }
#pragma unroll
        for (int r = 0; r < 16; ++r) { const int t = 32 * tb + (r & 3) + 8 * (r >> 2) + 4 * hs; const float x = tile_at(tile, t, j);
            const float la = sp8 * sigm(ar[r] + br); a[tb][r] = __expf(la); u[tb][r] = sqrtf(-expm1f(2.f * la)) * (sigm(ai[r] + bi) * x); } }
}
template <bool STEP_C> DI void w_lru(CtxP c, int l, int slab, int u_, unsigned char* wl, int lane, int jb_lo, int jb_hi) {
    const int bh = u_ / NCS, cl = u_ % NCS, b = bh >> 3, h = bh & 7, tl0 = cl * 64, hs = lane >> 5, li = lane & 31;
    unsigned char* tile = wl; const bf16_t* rb = (const bf16_t*)(c->ws + OFF_P) + prow_off(b, 0);
    { u32x4 rx[TILE_K(67)]; tile_load<67>(rx, rb, tl0 - 3, C_X + h * 64, lane); tile_store<67>(rx, tile, lane); }
    proc_conv_tile_lin(tile, c->lconv_w + l * 2048 + h * 64, 512, c->lconv_b + l * 512 + h * 64, lane);
    bf16x8 xf[2][4];
#pragma unroll
    for (int tb = 0; tb < 2; ++tb)
#pragma unroll
        for (int ks = 0; ks < 4; ++ks) xf[tb][ks] = frag_nat(tile, 32 * tb + li, 2 * ks + hs);
#pragma unroll 1
    for (int jb = jb_lo; jb < jb_hi; ++jb) {
        float a[2][16], u[2][16];
        lru_gates(c, l, h, jb, tile, xf, a, u, li, hs);
        const int ch = h * 64 + 32 * jb + li; float* LS = (float*)(c->ws + OFF_LS) + ((size_t)(b * NCS + cl) * G + ch) * 2;
        float cst = STEP_C ? LS[0] : 0.f, pr = 1.f;
#pragma unroll
        for (int tb = 0; tb < 2; ++tb)
#pragma unroll
            for (int q = 0; q < 4; ++q) {
                float ga = 1.f, gu = 0.f;
#pragma unroll
                for (int i = 0; i < 4; ++i) { gu = a[tb][4 * q + i] * gu + u[tb][4 * q + i]; ga *= a[tb][4 * q + i]; }
                const float pa = __shfl_xor(ga, 32), pu = __shfl_xor(gu, 32);
                const float a0 = hs ? pa : ga, u0 = hs ? pu : gu, a1 = hs ? ga : pa, u1 = hs ? gu : pu;
                if (STEP_C) { float hv = hs ? a0 * cst + u0 : cst;
#pragma unroll
                    for (int i = 0; i < 4; ++i) { hv = a[tb][4 * q + i] * hv + u[tb][4 * q + i]; u[tb][4 * q + i] = hv; } }
                cst = a1 * (a0 * cst + u0) + u1; pr *= a0 * a1; }
        if (!STEP_C) { if (hs == 0) { LS[0] = pr; LS[1] = cst; } }
        else {
#pragma unroll
            for (int tb = 0; tb < 2; ++tb)
#pragma unroll
                for (int r = 0; r < 16; ++r) { const int t = 32 * tb + (r & 3) + 8 * (r >> 2) + 4 * hs; bf16_t* pz = (bf16_t*)(c->ws + OFF_P) + prow_off(b, tl0 + t) + ZC + ch;
                    *pz = f2bf(u[tb][r] * siluf(bf2f(*pz))); } }
        asm volatile("" ::: "memory"); __builtin_amdgcn_sched_barrier(0);
    }
    WSYNC();
}
#define DPP_ADD(v, ctrl) v += __builtin_bit_cast(float, __builtin_amdgcn_update_dpp(0, __builtin_bit_cast(int, v), ctrl, 0xF, 0xF, true))
DI float allred16(float v) { DPP_ADD(v, 0xB1); DPP_ADD(v, 0x4E); DPP_ADD(v, 0x141); DPP_ADD(v, 0x140); return v; }
DI float shx(int lane, float v, int m) { return __builtin_bit_cast(float, __builtin_amdgcn_ds_bpermute((lane ^ m) << 2, __builtin_bit_cast(int, v))); }
DI float allred32(float v, int lane) { v = allred16(v); v += shx(lane, v, 16); return v; }
template <bool TANH> DI void proc_shift_tile(unsigned char* tile, const float* mu, int lane) {
    const int ch = lane & 7; float m[8];
    { const float4 a = *(const float4*)(mu + ch * 8), d = *(const float4*)(mu + ch * 8 + 4); m[0] = a.x; m[1] = a.y; m[2] = a.z; m[3] = a.w; m[4] = d.x; m[5] = d.y; m[6] = d.z; m[7] = d.w; }
#pragma unroll
    for (int k = 0; k < 8; ++k) { const int row = (lane >> 3) + 8 * k; float xp[8], x[8];
        unpack8(*(const uint4*)(tile + row * TP + ch * 16), xp); unpack8(*(const uint4*)(tile + (row + 1) * TP + ch * 16), x);
#pragma unroll
        for (int i = 0; i < 8; ++i) { const float v = x[i] + m[i] * (xp[i] - x[i]); x[i] = TANH ? tanhf(v) : v; }
        const bf16x8 res = pack8(x); WSYNC();
        *(bf16x8*)(tile + row * TP + ch * 16) = res; }
    WSYNC();
}
constexpr int RU_PT = 0, RU_QT = 8192, RU_YS = 12288, RU_YV = 16384, RU_VT = 18432, RU_BYTES = 22528, NC32 = TS / 32;
DI int sw64(int row, int e) { return row * 64 + ((((e >> 3) ^ (row >> 1)) & 7) << 3) + (e & 7); }
DI int sw32(int row, int e) { return row * 32 + ((((e >> 3) ^ (row >> 2)) & 3) << 3) + (e & 7); }
DI int kperm(int k) { return (k & ~12) | ((k & 4) << 1) | ((k & 8) >> 1); }
template <bool TANH> DI void proc_shift_tile32(unsigned char* tile, const float* mu, int lane) {
    const int ch = lane & 7; float m[8];
    { const float4 a = *(const float4*)(mu + ch * 8), d = *(const float4*)(mu + ch * 8 + 4); m[0] = a.x; m[1] = a.y; m[2] = a.z; m[3] = a.w; m[4] = d.x; m[5] = d.y; m[6] = d.z; m[7] = d.w; }
#pragma unroll
    for (int k = 0; k < 4; ++k) { const int row = (lane >> 3) + 8 * k; float xp[8], x[8];
        unpack8(*(const uint4*)(tile + row * TP + ch * 16), xp); unpack8(*(const uint4*)(tile + (row + 1) * TP + ch * 16), x);
#pragma unroll
        for (int i = 0; i < 8; ++i) { const float v = x[i] + m[i] * (xp[i] - x[i]); x[i] = TANH ? tanhf(v) : v; }
        const bf16x8 res = pack8(x); WSYNC();
        *(bf16x8*)(tile + row * TP + ch * 16) = res; }
    WSYNC();
}
#define V32(x, i) x[(i) >> 4][(i) & 15]
template <int T> struct FSub { static DI void run(f32x16 (&a0)[2], f32x16 (&a1)[2], f32x16 (&m)[2], const f32x16& N) {
    FSub<T - 1>::run(a0, a1, m, N);
#pragma unroll
    for (int j = 0; j < T; ++j) { const float nv = N[(j & 3) + 4 * (j >> 3)]; const float s = __int_as_float(__builtin_amdgcn_readlane(__float_as_int(nv), T + 32 * ((j >> 2) & 1)));
        V32(a0, T) -= V32(a0, j) * s; V32(a1, T) -= V32(a1, j) * s; V32(m, T) -= V32(m, j) * s; }
    if ((T & 3) == 3) __builtin_amdgcn_sched_barrier(0); } };
template <> struct FSub<0> { static DI void run(f32x16 (&)[2], f32x16 (&)[2], f32x16 (&)[2], const f32x16&) {} };
DI void w_rprep(CtxP c, int l, int slab, int u_, unsigned char* wl, int lane) {
    const int bh = u_ / NC32, c32 = u_ % NC32, b = bh >> 3, h = bh & 7, tl0 = c32 * 32, hs = lane >> 5, li = lane & 31;
    unsigned char *RA = wl, *RB = wl + 4752, *TA = wl + 9504, *TB = wl + 14112, *TK = wl, *TR = wl + 4608; float* TAB = (float*)(wl + 18720);
    unsigned char* UR = c->ws + OFF_CK + (size_t)u_ * RU_BYTES;
    const float* mu = c->rmu + l * 1664; const bf16_t* rb = (const bf16_t*)(c->ws + OFF_P) + prow_off(b, 0);
    bf16x8 wlf[4], alf[4];
    { u32x4 rw[TILE_K(33)], ra[TILE_K(33)], rr_[TILE_K(33)], rk_[TILE_K(33)];
      tile_load<33>(rw, rb, tl0 - 1, B_WLO, lane); tile_load<33>(ra, rb, tl0 - 1, B_ALO, lane);
      tile_store<33>(rw, RA, lane);
      tile_load<33>(rr_, rb, tl0 - 1, B_R + h * 64, lane); tile_load<33>(rk_, rb, tl0 - 1, B_K + h * 64, lane);
      proc_shift_tile32<true>(RA, mu + 1536, lane);
#pragma unroll
      for (int ks = 0; ks < 4; ++ks) wlf[ks] = frag_nat(RA, li, 2 * ks + hs);
      WSYNC();
      tile_store<33>(ra, RA, lane); proc_shift_tile32<false>(RA, mu + 1600, lane);
#pragma unroll
      for (int ks = 0; ks < 4; ++ks) alf[ks] = frag_nat(RA, li, 2 * ks + hs);
      WSYNC();
      tile_store<33>(rr_, RA, lane); tile_store<33>(rk_, RB, lane); }
    __builtin_amdgcn_sched_barrier(0);
    float rs[16], bonp[16];
    { float kk[2], mk[2];
#pragma unroll
      for (int jb = 0; jb < 2; ++jb) { kk[jb] = c->rk_k[l * G + h * 64 + 32 * jb + li]; mk[jb] = mu[512 + h * 64 + 32 * jb + li]; }
#pragma unroll
      for (int r = 0; r < 16; ++r) { const int t = (r & 3) + 8 * (r >> 2) + 4 * hs; float ss = 0.f;
#pragma unroll
          for (int jb = 0; jb < 2; ++jb) { const float x = tile_at(RB, t + 1, 32 * jb + li), xp = tile_at(RB, t, 32 * jb + li); const float kap = (x + mk[jb] * (xp - x)) * kk[jb]; ss += kap * kap; }
          rs[r] = rsqrtf(allred32(ss, lane) + 1e-12f); bonp[r] = 0.f; } }
    __builtin_amdgcn_sched_barrier(0);
    float kq[2][16], rq[2][16];
#pragma unroll
    for (int jb = 0; jb < 2; ++jb) {
        const int j = 32 * jb + li, ch = h * 64 + j;
        const bf16_t* wu = (const bf16_t*)(c->ws + OFF_WUT) + ((size_t)l * G + ch) * 64; const bf16_t* au = (const bf16_t*)(c->ws + OFF_AUT) + ((size_t)l * G + ch) * 64;
        bf16x8 wuf[4], auf[4];
#pragma unroll
        for (int ks = 0; ks < 4; ++ks) { wuf[ks] = *(const bf16x8*)(wu + 16 * ks + 8 * hs); auf[ks] = *(const bf16x8*)(au + 16 * ks + 8 * hs); }
        const float w0 = c->rw0[l * G + ch], a0 = c->ra0[l * G + ch], kkj = c->rk_k[l * G + ch], kaj = c->rk_a[l * G + ch], rkj = c->rr_k[l * G + ch], mr = mu[ch], mk = mu[512 + ch];
        f32x16 dl, da;
#pragma unroll
        for (int r = 0; r < 16; ++r) { dl[r] = 0.f; da[r] = 0.f; }
#pragma unroll
        for (int ks = 0; ks < 4; ++ks) { dl = MFMA32(wlf[ks], wuf[ks], dl); da = MFMA32(alf[ks], auf[ks], da); }
        __builtin_amdgcn_sched_barrier(0);
        float wq[16];
#pragma unroll
        for (int r = 0; r < 16; ++r) wq[r] = __expf(-0.606531f * sigm(w0 + dl[r]));
        float Gc[16];
        { float gp[4], pp[4];
#pragma unroll
          for (int q = 0; q < 4; ++q) { gp[q] = (wq[4 * q] * wq[4 * q + 1]) * (wq[4 * q + 2] * wq[4 * q + 3]); pp[q] = shx(lane, gp[q], 32); }
          float run = 1.f;
#pragma unroll
          for (int q = 0; q < 4; ++q) { const float g0 = hs ? pp[q] : gp[q], g1 = hs ? gp[q] : pp[q]; float cur = hs ? run * g0 : run;
#pragma unroll
              for (int i = 0; i < 4; ++i) { cur *= wq[4 * q + i]; Gc[4 * q + i] = cur; }
              run = run * g0 * g1; } }
        if (hs) TAB[j] = Gc[15];
#pragma unroll
        for (int r = 0; r < 16; ++r) { const int t = (r & 3) + 8 * (r >> 2) + 4 * hs;
            const float a = sigm(a0 + da[r]);
            float x = tile_at(RA, t + 1, j), xp = tile_at(RA, t, j); const float rm = x + mr * (xp - x);
            x = tile_at(RB, t + 1, j); xp = tile_at(RB, t, j); const float km = x + mk * (xp - x);
            const float kh = km * kkj * rs[r], kt = km * (1.f + (a - 1.f) * kaj);
            bonp[r] += rm * rkj * kt;
            const float gi = __builtin_amdgcn_rcpf(Gc[r]);
            *(bf16_t*)(TA + t * TP + j * 2) = f2bf((Gc[r] / wq[r]) * kh);
            *(bf16_t*)(TB + t * TP + j * 2) = f2bf(a * kh * gi);
            kq[jb][r] = kt * gi; rq[jb][r] = Gc[r] * rm;
            if ((r & 3) == 3) { asm volatile("" ::: "memory"); __builtin_amdgcn_sched_barrier(0); } }
    }
#pragma unroll
    for (int r = 0; r < 16; ++r) { const float bsum = allred32(bonp[r], lane); const int t = (r & 3) + 8 * (r >> 2) + 4 * hs;
        if (li == 0) ((float*)(c->ws + OFF_BON))[(size_t)(b * TS + tl0 + t) * NH + h] = bsum; }
    WSYNC();
#pragma unroll
    for (int jb = 0; jb < 2; ++jb)
#pragma unroll
        for (int r = 0; r < 16; ++r) { const int t = (r & 3) + 8 * (r >> 2) + 4 * hs, j = 32 * jb + li;
            *(bf16_t*)(TK + t * TP + j * 2) = f2bf(kq[jb][r]); *(bf16_t*)(TR + t * TP + j * 2) = f2bf(rq[jb][r]); }
    { const int vch = h * 64 + lane; const float muv = mu[1024 + vch]; const bf16_t* pv = rb + B_V + vch;
      float xs[33];
#pragma unroll
      for (int t = 0; t < 33; ++t) xs[t] = bf2f(pv[(size_t)(tl0 - 1 + t) * PP]);
      unsigned pk[16];
#pragma unroll
      for (int t = 0; t < 16; ++t) pk[t] = pk2(xs[2 * t + 1] + muv * (xs[2 * t] - xs[2 * t + 1]), xs[2 * t + 2] + muv * (xs[2 * t + 1] - xs[2 * t + 2]));
#pragma unroll
      for (int q = 0; q < 4; ++q) *(uint4*)(UR + RU_VT + sw32(lane, 8 * q) * 2) = make_uint4(pk[4 * q], pk[4 * q + 1], pk[4 * q + 2], pk[4 * q + 3]); }
    WSYNC(); __builtin_amdgcn_sched_barrier(0);
    f32x16 Nacc, G1acc, MTacc, G2Tacc;
#pragma unroll
    for (int r = 0; r < 16; ++r) { Nacc[r] = 0.f; G1acc[r] = 0.f; MTacc[r] = 0.f; G2Tacc[r] = 0.f; }
#pragma unroll
    for (int ks = 0; ks < 4; ++ks) { const bf16x8 fA = frag_nat(TA, li, 2 * ks + hs), fB = frag_nat(TB, li, 2 * ks + hs), fK = frag_nat(TK, li, 2 * ks + hs), fR = frag_nat(TR, li, 2 * ks + hs);
        Nacc = MFMA32(fB, fA, Nacc); G1acc = MFMA32(fB, fR, G1acc); MTacc = MFMA32(fA, fK, MTacc); G2Tacc = MFMA32(fR, fK, G2Tacc); }
#pragma unroll
    for (int r = 0; r < 16; ++r) { const int rr = (r & 3) + 8 * (r >> 2) + 4 * hs;
        Nacc[r] = rr < li ? Nacc[r] : 0.f; G1acc[r] = rr <= li ? G1acc[r] : 0.f; MTacc[r] = li < rr ? MTacc[r] : 0.f; G2Tacc[r] = li <= rr ? G2Tacc[r] : 0.f; }
    __builtin_amdgcn_sched_barrier(0);
    f32x16 at0[2], at1[2], mt[2];
#pragma unroll
    for (int t = 0; t < 32; ++t) { V32(at0, t) = tile_at(TA, t, li); V32(at1, t) = tile_at(TA, t, 32 + li); }
#pragma unroll
    for (int r = 0; r < 16; ++r) { const float own = MTacc[r], oth = shx(lane, own, 32); const int t0 = (r & 3) + 8 * (r >> 2), t1 = t0 + 4;
        V32(mt, t0) = hs ? oth : own; V32(mt, t1) = hs ? own : oth; }
    FSub<31>::run(at0, at1, mt, Nacc);
    bf16x8 atn[2][2], mtn[2], atp[2][2], mtp[2];
#pragma unroll
    for (int s = 0; s < 2; ++s) { float v0[8], v1[8], vm[8], p0[8], p1[8], pm[8];
#pragma unroll
        for (int i = 0; i < 8; ++i) { const int jn = 16 * s + i, jp = 16 * s + 8 * (i >> 2) + (i & 3);
            v0[i] = hs ? V32(at0, jn + 8) : V32(at0, jn); v1[i] = hs ? V32(at1, jn + 8) : V32(at1, jn); vm[i] = hs ? V32(mt, jn + 8) : V32(mt, jn);
            p0[i] = hs ? V32(at0, jp + 4) : V32(at0, jp); p1[i] = hs ? V32(at1, jp + 4) : V32(at1, jp); pm[i] = hs ? V32(mt, jp + 4) : V32(mt, jp); }
        atn[0][s] = pack8(v0); atn[1][s] = pack8(v1); mtn[s] = pack8(vm); atp[0][s] = pack8(p0); atp[1][s] = pack8(p1); mtp[s] = pack8(pm); }
    __builtin_amdgcn_sched_barrier(0);
    { bf16x8 g1f[2]; { float g[16];
#pragma unroll
        for (int r = 0; r < 16; ++r) g[r] = G1acc[r];
        g1f[0] = pack8(g); g1f[1] = pack8(g + 8); }
#pragma unroll
      for (int ct = 0; ct < 2; ++ct) { f32x16 acc;
#pragma unroll
          for (int r = 0; r < 16; ++r) acc[r] = 0.f;
          acc = MFMA32(g1f[0], atp[ct][0], acc); acc = MFMA32(g1f[1], atp[ct][1], acc);
#pragma unroll
          for (int r = 0; r < 16; ++r) { const int t = (r & 3) + 8 * (r >> 2) + 4 * hs, k = 32 * ct + li;
              *(bf16_t*)(UR + RU_YS + sw64(t, kperm(k)) * 2) = f2bf(tile_at(TR, t, k) - acc[r]); } }
      { f32x16 acc;
#pragma unroll
        for (int r = 0; r < 16; ++r) acc[r] = 0.f;
        acc = MFMA32(g1f[0], mtp[0], acc); acc = MFMA32(g1f[1], mtp[1], acc);
#pragma unroll
        for (int r = 0; r < 16; ++r) { const int t = (r & 3) + 8 * (r >> 2) + 4 * hs; *(bf16_t*)(UR + RU_YV + sw32(t, li) * 2) = f2bf(G2Tacc[r] - acc[r]); } } }
    __builtin_amdgcn_sched_barrier(0);
#pragma unroll
    for (int rt = 0; rt < 2; ++rt) { bf16x8 bmf[2];
#pragma unroll
        for (int ks = 0; ks < 2; ++ks)
#pragma unroll
            for (int i = 0; i < 8; ++i) bmf[ks][i] = (short)*(const bf16_t*)(TB + (16 * ks + 8 * hs + i) * TP + (32 * rt + li) * 2);
        float g31[16];
#pragma unroll
        for (int q = 0; q < 4; ++q) { const float4 g4 = *(const float4*)(TAB + 32 * rt + 8 * q + 4 * hs); g31[4 * q] = g4.x; g31[4 * q + 1] = g4.y; g31[4 * q + 2] = g4.z; g31[4 * q + 3] = g4.w; }
#pragma unroll
        for (int ct = 0; ct < 2; ++ct) { f32x16 acc;
#pragma unroll
            for (int r = 0; r < 16; ++r) acc[r] = 0.f;
            acc = MFMA32(bmf[0], atn[ct][0], acc); acc = MFMA32(bmf[1], atn[ct][1], acc);
#pragma unroll
            for (int r = 0; r < 16; ++r) { const int kp = 32 * rt + (r & 3) + 8 * (r >> 2) + 4 * hs, k = 32 * ct + li;
                *(bf16_t*)(UR + RU_PT + sw64(kp, kperm(k)) * 2) = f2bf(g31[r] * ((kp == k ? 1.f : 0.f) - acc[r])); } }
        { f32x16 acc;
#pragma unroll
          for (int r = 0; r < 16; ++r) acc[r] = 0.f;
          acc = MFMA32(bmf[0], mtn[0], acc); acc = MFMA32(bmf[1], mtn[1], acc);
#pragma unroll
          for (int r = 0; r < 16; ++r) { const int kp = 32 * rt + (r & 3) + 8 * (r >> 2) + 4 * hs;
              *(bf16_t*)(UR + RU_QT + sw32(kp, li) * 2) = f2bf(g31[r] * (tile_at(TK, li, kp) - acc[r])); } }
        __builtin_amdgcn_sched_barrier(0); }
    WSYNC();
}
DI int lds_ld(volatile LAS int* p) { return *p; }
constexpr int RS_SLOT1 = 4 * WLDS, RS_FLAGS = RU_BYTES + 256;
static_assert(RS_FLAGS + 64 <= 2 * WLDS, "ring slot 0 and its flags sit inside the LDS regions of waves 0,1");
DI void s_rscan_roles(CtxP c, int l, int slab, float* lds, int bh, int wave, int lane) {
    unsigned char* ring = (unsigned char*)lds; const int b = bh >> 3, h = bh & 7;
    volatile LAS int* F = (volatile LAS int*)((LAS unsigned char*)(unsigned long)RS_FLAGS);
    const unsigned char* ur0 = c->ws + OFF_CK + (size_t)(bh * NC32) * RU_BYTES;
    if (wave >= 4) {
        const int pw = wave - 4, p = pw * 64 + lane; u32x4 pt[4][11];
#define RS_PLOAD(s_, ch_) { const u32x4* src = (const u32x4*)(ur0 + (size_t)(ch_) * RU_BYTES); _Pragma("unroll") for (int k = 0; k < 11; ++k) pt[s_][k] = src[p + 128 * k]; }
        RS_PLOAD(0, 0) RS_PLOAD(1, 1) RS_PLOAD(2, 2) RS_PLOAD(3, 3)
#pragma unroll
        for (int ch0 = 0; ch0 < NC32; ch0 += 4) {
#pragma unroll
            for (int s = 0; s < 4; ++s) { const int ch = ch0 + s;
                while (min(lds_ld(F + 2), lds_ld(F + 3)) < ch - 1) __builtin_amdgcn_s_sleep(1);
                u32x4* dst = (u32x4*)(ring + (s & 1) * RS_SLOT1);
#pragma unroll
                for (int k = 0; k < 11; ++k) dst[p + 128 * k] = pt[s][k];
                asm volatile("s_waitcnt lgkmcnt(0)" ::: "memory");
                if (lane == 0) F[pw] = ch + 1;
                RS_PLOAD(s, min(ch + 4, NC32 - 1)) }
        }
#undef RS_PLOAD
    } else {
        const int hs = lane >> 5, li = lane & 31, v = 32 * wave + li;
        float* CB = (float*)(c->ws + OFF_CARRY + l * CARRY_L + CB_OFF) + ((size_t)bh * 64 + v) * 64;
        f32x16 xa[2];
#pragma unroll
        for (int rt = 0; rt < 2; ++rt)
#pragma unroll
            for (int r = 0; r < 16; ++r) xa[rt][r] = slab == 0 ? 0.f : CB[32 * rt + (r & 3) + 8 * (r >> 2) + 4 * hs];
        float* ybase = (float*)((bf16_t*)(c->ws + OFF_P) + prow_off(b, 0) + B_R) + h * 64 + v;
        for (int ch = 0; ch < NC32; ++ch) {
            while (min(lds_ld(F + 0), lds_ld(F + 1)) < ch + 1) __builtin_amdgcn_s_sleep(1);
            asm volatile("" ::: "memory");
            const unsigned char* base = ring + (ch & 1) * RS_SLOT1;
            bf16x8 vt[2], ays[4], ayv[2], apt[2][4], aqt[2][2];
#pragma unroll
            for (int kk = 0; kk < 4; ++kk) { apt[0][kk] = *(const bf16x8*)(base + RU_PT + sw64(li, 16 * kk + 8 * hs) * 2); apt[1][kk] = *(const bf16x8*)(base + RU_PT + sw64(32 + li, 16 * kk + 8 * hs) * 2);
                ays[kk] = *(const bf16x8*)(base + RU_YS + sw64(li, 16 * kk + 8 * hs) * 2); }
#pragma unroll
            for (int js = 0; js < 2; ++js) { vt[js] = *(const bf16x8*)(base + RU_VT + sw32(v, 16 * js + 8 * hs) * 2);
                aqt[0][js] = *(const bf16x8*)(base + RU_QT + sw32(li, 16 * js + 8 * hs) * 2); aqt[1][js] = *(const bf16x8*)(base + RU_QT + sw32(32 + li, 16 * js + 8 * hs) * 2);
                ayv[js] = *(const bf16x8*)(base + RU_YV + sw32(li, 16 * js + 8 * hs) * 2); }
            __builtin_amdgcn_sched_barrier(0);
            bf16x8 xb[4];
#pragma unroll
            for (int rt = 0; rt < 2; ++rt) { float g[16];
#pragma unroll
                for (int r = 0; r < 16; ++r) g[r] = xa[rt][r];
                xb[2 * rt] = pack8(g); xb[2 * rt + 1] = pack8(g + 8); }
            f32x16 ya, xn[2];
#pragma unroll
            for (int r = 0; r < 16; ++r) { ya[r] = 0.f; xn[0][r] = 0.f; xn[1][r] = 0.f; }
            __builtin_amdgcn_sched_barrier(0);
#pragma unroll
            for (int kk = 0; kk < 4; ++kk) { xn[0] = MFMA32(apt[0][kk], xb[kk], xn[0]); xn[1] = MFMA32(apt[1][kk], xb[kk], xn[1]); ya = MFMA32(ays[kk], xb[kk], ya); }
#pragma unroll
            for (int js = 0; js < 2; ++js) { xn[0] = MFMA32(aqt[0][js], vt[js], xn[0]); xn[1] = MFMA32(aqt[1][js], vt[js], xn[1]); ya = MFMA32(ayv[js], vt[js], ya); }
            asm volatile("s_waitcnt lgkmcnt(0)" ::: "memory");
            if (lane == 0) F[2 + wave] = ch + 1;
#pragma unroll
            for (int r = 0; r < 16; ++r) { const int t = ch * 32 + (r & 3) + 8 * (r >> 2) + 4 * hs; *(float*)((bf16_t*)ybase + (size_t)t * PP) = ya[r]; }
            xa[0] = xn[0]; xa[1] = xn[1];
        }
#pragma unroll
        for (int rt = 0; rt < 2; ++rt)
#pragma unroll
            for (int r = 0; r < 16; ++r) CB[32 * rt + (r & 3) + 8 * (r >> 2) + 4 * hs] = xa[rt][r];
    }
}
DI void s_phase2(CtxP c, int l, int slab, float* lds, int bid, int nblk) {
    const int tid = otid(), lane = tid & 63, wave = tid >> 6; unsigned char* wl = (unsigned char*)lds + wave * WLDS;
    const int gw = __builtin_amdgcn_readfirstlane(bid * 8 + wave);
    { int ln = lane; w_rprep(c, l, slab, gw, wl, ln); }
    { const int u = __builtin_amdgcn_readfirstlane(bid * 4 + (wave & 3)); int ln = lane;
        asm volatile("" : "+v"(ln) :: "memory"); __builtin_amdgcn_sched_barrier(0);
        if (wave < 4) w_lru<false>(c, l, slab, u, wl, ln, 0, 2); else w_chunkA<false>(c, l, slab, u, wl, ln);
        asm volatile("" : "+v"(ln) :: "memory"); __builtin_amdgcn_sched_barrier(0);
        if (wave >= 4) w_chunkA<true>(c, l, slab, u, wl, ln); }
    if (slab == 0) { bf16_t* halo = (bf16_t*)(c->ws + OFF_CARRY + l * CARRY_L + HALO_OFF);
        for (int i = bid * 512 + tid; i < NB * 3 * PP; i += nblk * 512) { const int b = i / (3 * PP), r = (i / PP) % 3, col = i % PP;
            halo[i] = ((const bf16_t*)(c->ws + OFF_P))[prow_off(b, TS - 3 + r) + col]; } }
}
DI void s_phaseSB(CtxP c, int l, int slab, float* lds, int bid, int nblk) {
    const int tid = otid(), lane = tid & 63, wave = tid >> 6;
    if (tid < 8) ((volatile LAS int*)((LAS unsigned char*)(unsigned long)RS_FLAGS))[tid] = 0;
    __syncthreads();
    if (bid < 32) { if ((wave & 2) == 0) s_rscan_roles(c, l, slab, lds, bid, wave, lane); }
    else s_stepB(c, l, slab, lds, bid - 32, nblk - 32);
}
DI void s_phase3(CtxP c, int l, int slab, float* lds, int bid) {
    const int tid = otid(), lane = tid & 63, wave = tid >> 6; unsigned char* wl = (unsigned char*)lds + wave * WLDS;
    { const int u = __builtin_amdgcn_readfirstlane(bid * 4 + (wave & 3)); int ln = lane;
        asm volatile("" : "+v"(ln) :: "memory"); __builtin_amdgcn_sched_barrier(0);
        if (wave < 4) w_lru<true>(c, l, slab, u, wl, ln, 0, 2); else w_chunkC<false>(c, l, slab, u, wl, ln);
        asm volatile("" : "+v"(ln) :: "memory"); __builtin_amdgcn_sched_barrier(0);
        if (wave >= 4) w_chunkC<true>(c, l, slab, u, wl, ln); }
}
DI float red8(float v) { DPP_ADD(v, 0xB1); DPP_ADD(v, 0x4E); DPP_ADD(v, 0x141); return v; }
DI void s_bpost(CtxP c, int l, int slab, float* lds, int bid, int nblk) {
    const int lane = otid() & 63, gw = bid * 8 + (otid() >> 6), NGW = nblk * 8; const int ch0 = lane * 8, h = lane >> 3;
    float gw8[8], gb8[8], mu8[8];
    { const float4 a0 = *(const float4*)(c->rgn_w + l * G + ch0), a1 = *(const float4*)(c->rgn_w + l * G + ch0 + 4), b0 = *(const float4*)(c->rgn_b + l * G + ch0), b1 = *(const float4*)(c->rgn_b + l * G + ch0 + 4),
          m0 = *(const float4*)(c->rmu + l * 1664 + 1024 + ch0), m1 = *(const float4*)(c->rmu + l * 1664 + 1024 + ch0 + 4);
      gw8[0] = a0.x; gw8[1] = a0.y; gw8[2] = a0.z; gw8[3] = a0.w; gw8[4] = a1.x; gw8[5] = a1.y; gw8[6] = a1.z; gw8[7] = a1.w;
      gb8[0] = b0.x; gb8[1] = b0.y; gb8[2] = b0.z; gb8[3] = b0.w; gb8[4] = b1.x; gb8[5] = b1.y; gb8[6] = b1.z; gb8[7] = b1.w;
      mu8[0] = m0.x; mu8[1] = m0.y; mu8[2] = m0.z; mu8[3] = m0.w; mu8[4] = m1.x; mu8[5] = m1.y; mu8[6] = m1.z; mu8[7] = m1.w; }
    for (int r0 = gw; r0 < MS; r0 += 2 * NGW) {
        float4 wa[2], wb[2]; uint4 xc[2], xq[2], zz[2]; float bon[2]; bf16_t* prw[2];
#pragma unroll
        for (int q = 0; q < 2; ++q) { int r = r0 + q * NGW; r = r < MS ? r : r0; const int b = r / TS, tl = r % TS; prw[q] = (bf16_t*)(c->ws + OFF_P) + prow_off(b, tl);
            wa[q] = *(const float4*)((const float*)(prw[q] + B_R) + ch0); wb[q] = *(const float4*)((const float*)(prw[q] + B_R) + ch0 + 4);
            xc[q] = *(const uint4*)(prw[q] + B_V + ch0); xq[q] = *(const uint4*)(prw[q] - PP + B_V + ch0); zz[q] = *(const uint4*)(prw[q] + ZB + ch0);
            bon[q] = ((const float*)(c->ws + OFF_BON))[(size_t)r * NH + h]; }
#pragma unroll
        for (int q = 0; q < 2; ++q) { if (r0 + q * NGW >= MS) break;
            float w[8] = {wa[q].x, wa[q].y, wa[q].z, wa[q].w, wb[q].x, wb[q].y, wb[q].z, wb[q].w}, x[8], xp[8], z[8], y[8];
            unpack8(xc[q], x); unpack8(xq[q], xp); unpack8(zz[q], z);
            float sm = 0.f;
#pragma unroll
            for (int i = 0; i < 8; ++i) sm += w[i];
            const float mean = red8(sm) * (1.f / 64.f); float vs = 0.f;
#pragma unroll
            for (int i = 0; i < 8; ++i) { w[i] -= mean; vs += w[i] * w[i]; }
            const float rstd = rsqrtf(red8(vs) * (1.f / 64.f) + 1e-5f);
#pragma unroll
            for (int i = 0; i < 8; ++i) { const float vm = x[i] + mu8[i] * (xp[i] - x[i]); y[i] = (w[i] * rstd * gw8[i] + gb8[i] + bon[q] * vm) * siluf(z[i]); }
            *(bf16x8*)(prw[q] + ZB + ch0) = pack8(y); }
    }
}
DI void s_post(CtxP c, int l, int slab, float* lds, int bid, int nblk) {
    const int lane = otid() & 63, gw = bid * 8 + (otid() >> 6), NGW = nblk * 8;
    for (int r0 = gw; r0 < MS; r0 += 2 * NGW) {
        float4 v[2][4], xx[2][4]; float* orow[2];
#pragma unroll
        for (int q = 0; q < 2; ++q) { int r = r0 + q * NGW; r = r < MS ? r : r0; const int b = r / TS, tl = r % TS; const size_t grow = (size_t)b * T + slab * TS + tl;
            const float* yrow = (const float*)(c->ws + OFF_Y) + (size_t)r * D; const bf16_t* y2row = (const bf16_t*)(c->ws + OFF_Y2) + (size_t)r * D;
            const float* xr = (l == 0 ? c->x : c->out) + grow * D; orow[q] = c->out + grow * D;
#pragma unroll
            for (int j = 0; j < 4; ++j) { v[q][j] = *(const float4*)(yrow + j * 256 + lane * 4); xx[q][j] = *(const float4*)(xr + j * 256 + lane * 4);
                const uint2 h2 = *(const uint2*)(y2row + j * 256 + lane * 4);
                v[q][j].x += __uint_as_float(h2.x << 16); v[q][j].y += __uint_as_float(h2.x & 0xffff0000u); v[q][j].z += __uint_as_float(h2.y << 16); v[q][j].w += __uint_as_float(h2.y & 0xffff0000u); } }
#pragma unroll
        for (int q = 0; q < 2; ++q) { const int r = r0 + q * NGW; if (r >= MS) break;
            float ss = 0.f;
#pragma unroll
            for (int j = 0; j < 4; ++j) ss += v[q][j].x * v[q][j].x + v[q][j].y * v[q][j].y + v[q][j].z * v[q][j].z + v[q][j].w * v[q][j].w;
            ss = wave_sum(ss); const float rs = rsqrtf(ss * (1.f / D) + 1e-6f); float s2 = 0.f;
#pragma unroll
            for (int j = 0; j < 4; ++j) { const float4 gg = *(const float4*)(c->norm_post + l * D + j * 256 + lane * 4); float4& o = v[q][j]; const float4 x4 = xx[q][j];
                o.x = x4.x + o.x * rs * gg.x; o.y = x4.y + o.y * rs * gg.y; o.z = x4.z + o.z * rs * gg.z; o.w = x4.w + o.w * rs * gg.w;
                *(float4*)(orow[q] + j * 256 + lane * 4) = o; s2 += o.x * o.x + o.y * o.y + o.z * o.z + o.w * o.w; }
            if (l == 0) { s2 = wave_sum(s2); const float r2 = rsqrtf(s2 * (1.f / D) + 1e-6f); bf16_t* hrow = (bf16_t*)(c->ws + OFF_H) + (size_t)r * D;
#pragma unroll
                for (int j = 0; j < 4; ++j) { const float4 gg = *(const float4*)(c->norm_pre + D + j * 256 + lane * 4); const float4 o = v[q][j];
                    uint2 w; w.x = pk2(o.x * r2 * gg.x, o.y * r2 * gg.y); w.y = pk2(o.z * r2 * gg.z, o.w * r2 * gg.w);
                    *(uint2*)(hrow + j * 256 + lane * 4) = w; } } }
    }
}
namespace pg8 {
#define PG8_LAS __attribute__((address_space(3)))
typedef unsigned short bf16_t;
typedef short bf16x8 __attribute__((ext_vector_type(8)));
typedef float f32x4 __attribute__((ext_vector_type(4)));
typedef unsigned u32x4 __attribute__((ext_vector_type(4)));
constexpr int BM = 256, BK = 64, HALF = 128, HTB = HALF * BK * 2  , STAGE_BYTES = 8 * HTB, NXCD = 8, WGM = 8;

__host__ __device__ __forceinline__ int lds_byte(int r, int c) { const int st = (r >> 4) * 2 + (c >> 5), rr = r & 15, cc = c & 31, ob = rr * 64 + cc * 2; return st * 1024 + (ob ^ (((ob >> 9) & 1) << 5)); }
__host__ __device__ __forceinline__ void stage_rc(int b, int& R, int& C) { const int st = b / 1024, sb = b % 1024, swz = sb ^ (((sb >> 9) & 1) << 5); R = (st >> 1) * 16 + swz / 64; C = (st & 1) * 32 + (swz % 64) / 2; }
__host__ __device__ __forceinline__ int perm32(int rho) { const int n = rho >> 4, i = rho & 15; return 8 * (i >> 2) + 4 * n + (i & 3); }

struct Unit { int pm, pn; };
struct Gemm { const bf16_t* A; const bf16_t* Bt; int M, N, K, lda; };

struct StaticOrder {
    int nM, nN, nwg, G, c;
    __host__ __device__ void init(int M, int N, int G_, int c_) { nM = M / BM; nN = N / BM; nwg = nM * nN; G = G_; c = c_; }
    __host__ __device__ bool next(int i, Unit& u) const {
        const long L = (long)i * G + c; if (L >= nwg) return false;
        int wgid = (int)L; { const int q = nwg / NXCD, r = nwg % NXCD, xcd = wgid % NXCD, off = wgid / NXCD; wgid = (xcd < r ? xcd * (q + 1) : r * (q + 1) + (xcd - r) * q) + off; }
        const int nig = WGM * nN, gid = wgid / nig, fm = gid * WGM, gsz = (nM - fm) < WGM ? (nM - fm) : WGM;
        u.pm = fm + ((wgid % nig) % gsz); u.pn = (wgid % nig) / gsz; return true;
    }
    __device__ __forceinline__ void a_ready(const Unit&) const {}
    __device__ __forceinline__ void done(const Unit&) const {}
};

__device__ __forceinline__ unsigned cvt_pk_bf16(float lo, float hi) { unsigned r; asm volatile("v_cvt_pk_bf16_f32 %0, %1, %2" : "=v"(r) : "v"(lo), "v"(hi)); return r; }
typedef float f32x2 __attribute__((ext_vector_type(2)));
__device__ __forceinline__ f32x2 gelu_pk(f32x2 v) {
    const f32x2 av = __builtin_elementwise_abs(v), d = av * 0.2316418882f + 1.0f;
    f32x2 t; t.x = __builtin_amdgcn_rcpf(d.x); t.y = __builtin_amdgcn_rcpf(d.y);
    f32x2 q = t * 0.5307027145f + (-0.7265760135f); q = q * t + 0.7107068705f; q = q * t + (-0.142248368f); q = q * t + 0.127414796f; q = q * t;
    const f32x2 s = (v * v) * (-0.72134752044f);
    f32x2 e; e.x = __builtin_amdgcn_exp2f(s.x); e.y = __builtin_amdgcn_exp2f(s.y);
    const f32x2 m = v * (q * e), r = v - m;
    f32x2 o; o.x = v.x < 0.f ? m.x : r.x; o.y = v.y < 0.f ? m.y : r.y; return o;
}

template <int ACT  > struct EpiBf16 {
    static constexpr bool PERM = true, AFTER_DRAIN = false; static_assert(ACT == 0 || ACT == 1, "EpiBf16: ACT is 0 (none) or 1 (gelu_pk)");
    bf16_t* O; int ldc; const float* bias; int split_cols; size_t split_stride; float scale0; int rskip;
    __device__ __forceinline__ void operator()(const f32x4 (&acc)[2][2][4][2], const Unit& u, int wr, int wc, int fr, int fq) const {
        const int row0 = u.pm * BM + wr * 64 + fr + (u.pm >> 3) * rskip; int colt = u.pn * BM; bf16_t* base = O;
        float sc = 1.f; if (split_cols) { const int t = colt / split_cols; base += (size_t)t * split_stride; colt -= t * split_cols; if (t == 0) sc = scale0; }
        const int col0 = colt + wc * 32 + 8 * fq, bcol0 = u.pn * BM + wc * 32 + 8 * fq;
        f32x4 bv[2][2];
#pragma unroll
        for (int bj = 0; bj < 2; ++bj)
#pragma unroll
            for (int n = 0; n < 2; ++n) bv[bj][n] = bias ? *(const f32x4*)(bias + bcol0 + bj * HALF + 4 * n) : (f32x4){0.f, 0.f, 0.f, 0.f};
#pragma unroll
        for (int ai = 0; ai < 2; ++ai)
#pragma unroll
            for (int m = 0; m < 4; ++m) { bf16_t* rowp = base + (size_t)(row0 + ai * HALF + m * 16) * ldc + col0;
#pragma unroll
                for (int bj = 0; bj < 2; ++bj) { f32x4 v0 = acc[ai][bj][m][0] + bv[bj][0], v1 = acc[ai][bj][m][1] + bv[bj][1];
                    if (ACT == 1) { f32x2 a = gelu_pk((f32x2){v0[0], v0[1]}), b = gelu_pk((f32x2){v0[2], v0[3]}), c = gelu_pk((f32x2){v1[0], v1[1]}), d = gelu_pk((f32x2){v1[2], v1[3]});
                        v0 = (f32x4){a.x, a.y, b.x, b.y}; v1 = (f32x4){c.x, c.y, d.x, d.y}; }
                    v0 = v0 * sc; v1 = v1 * sc; u32x4 w; w.x = cvt_pk_bf16(v0[0], v0[1]); w.y = cvt_pk_bf16(v0[2], v0[3]); w.z = cvt_pk_bf16(v1[0], v1[1]); w.w = cvt_pk_bf16(v1[2], v1[3]);
                    *(u32x4*)(rowp + bj * HALF) = w; } }
    }
};


struct EpiF32 {
    static constexpr bool PERM = false, AFTER_DRAIN = false;
    float* O; int ldc;
    __device__ __forceinline__ void operator()(const f32x4 (&acc)[2][2][4][2], const Unit& u, int wr, int wc, int fr, int fq) const {
        const int row0 = u.pm * BM + wr * 64 + fr, col0 = u.pn * BM + wc * 32 + 4 * fq;
#pragma unroll
        for (int ai = 0; ai < 2; ++ai)
#pragma unroll
            for (int m = 0; m < 4; ++m) { float* rowp = O + (size_t)(row0 + ai * HALF + m * 16) * ldc + col0;
#pragma unroll
                for (int bj = 0; bj < 2; ++bj)
#pragma unroll
                    for (int n = 0; n < 2; ++n) *(f32x4*)(rowp + bj * HALF + n * 16) = acc[ai][bj][m][n]; }
    }
};
struct EpiSplitK {
    static constexpr bool PERM = false, AFTER_DRAIN = false;
    float* O; bf16_t* O2; int ldc;
    __device__ __forceinline__ void operator()(const f32x4 (&acc)[2][2][4][2], const Unit& u, int wr, int wc, int fr, int fq) const {
        const int row0 = u.pm * BM + wr * 64 + fr, col0 = (u.pn & 3) * BM + wc * 32 + 4 * fq; const bool hi = u.pn >= 4;
#pragma unroll
        for (int ai = 0; ai < 2; ++ai)
#pragma unroll
            for (int m = 0; m < 4; ++m) { const size_t ro = (size_t)(row0 + ai * HALF + m * 16) * ldc + col0;
#pragma unroll
                for (int bj = 0; bj < 2; ++bj)
#pragma unroll
                    for (int n = 0; n < 2; ++n) { const f32x4 v = acc[ai][bj][m][n];
                        if (hi) { unsigned lo = cvt_pk_bf16(v[0], v[1]), hi2 = cvt_pk_bf16(v[2], v[3]); *(uint2*)(O2 + ro + bj * HALF + n * 16) = make_uint2(lo, hi2); }
                        else *(f32x4*)(O + ro + bj * HALF + n * 16) = v; } }
    }
};
template <class Epi, class Sched, bool ALIGN_EPI, bool SP2, int KK, int LDA, int ASKIP, int KSPLIT = 0>
__device__ __forceinline__ void gemm_phase(PG8_LAS unsigned char* lds, const Gemm g, const Sched& S, const Epi& E) {
    const int tid = otid(), wid = __builtin_amdgcn_readfirstlane(tid >> 6), lane = tid & 63, wr = wid >> 2, wc = wid & 3, fr = lane & 15, fq = lane >> 4;
    constexpr int K = KK, nt = K / BK;
    unsigned voffA[2], voffB[2];
#pragma unroll
    for (int i = 0; i < 2; ++i) { int R, C; stage_rc(tid * 16 + i * 8192, R, C); const int Rb = Epi::PERM ? ((R & ~31) + perm32(R & 31)) : R;
        voffA[i] = (unsigned)(R * LDA + C) * 2u; voffB[i] = (unsigned)(Rb * K + C) * 2u; }
    constexpr size_t kstep = (size_t)(BK * 2);
    constexpr size_t hstepA = (size_t)HALF * LDA * 2, hstepB = (size_t)HALF * K * 2;
    constexpr size_t tstepA = 2 * hstepA, tstepB = 2 * hstepB;
    const unsigned ldsw = (unsigned)wid * 1024u;
    const int aoff = lds_byte(wr * 64 + fr, fq * 8), boff = lds_byte(wc * 32 + fr, fq * 8);
#define PG8_SA(b, h) (((b) * 2 + (h)) * HTB)
#define PG8_SB(b, h) ((4 + (b) * 2 + (h)) * HTB)
#define PG8_STAGE(bufoff, gbase, voff) do { _Pragma("unroll") for (int _i = 0; _i < 2; ++_i) \
        __builtin_amdgcn_global_load_lds((const unsigned*)((const char*)(gbase) + (voff)[_i]), (PG8_LAS unsigned*)(lds + (bufoff) + ldsw + _i * 8192), 16, 0, 0); } while (0)
#define PG8_LDA(dst, b, h) do { _Pragma("unroll") for (int m = 0; m < 4; ++m) _Pragma("unroll") for (int k = 0; k < 2; ++k) dst[m][k] = *(const PG8_LAS bf16x8*)(lds + PG8_SA(b, h) + aoff + m * 2048 + k * 1024); } while (0)
#define PG8_LDB(dst, b, h) do { _Pragma("unroll") for (int n = 0; n < 2; ++n) _Pragma("unroll") for (int k = 0; k < 2; ++k) dst[n][k] = *(const PG8_LAS bf16x8*)(lds + PG8_SB(b, h) + boff + n * 2048 + k * 1024); } while (0)
#define PG8_MMA(ai, bj, At, Bt) do { __builtin_amdgcn_s_setprio(1); _Pragma("unroll") for (int m = 0; m < 4; ++m) _Pragma("unroll") for (int n = 0; n < 2; ++n) _Pragma("unroll") for (int k = 0; k < 2; ++k) \
        acc[ai][bj][m][n] = __builtin_amdgcn_mfma_f32_16x16x32_bf16(Bt[n][k], At[m][k], acc[ai][bj][m][n], 0, 0, 0); __builtin_amdgcn_s_setprio(0); } while (0)
#define PG8_WAIT_V(n) asm volatile("s_waitcnt vmcnt(" #n ")" ::: "memory")
#define PG8_WAIT_L(n) asm volatile("s_waitcnt lgkmcnt(" #n ")" ::: "memory")
#define PG8_BAR __builtin_amdgcn_s_barrier()
#define PG8_SCHED __builtin_amdgcn_sched_barrier(0)
    Unit cur, nxt; int ui = 0;
    if (!S.next(0, cur)) return;
    f32x4 acc[2][2][4][2];
#pragma unroll
    for (int a = 0; a < 2; ++a)
#pragma unroll
        for (int b = 0; b < 2; ++b)
#pragma unroll
            for (int m = 0; m < 4; ++m)
#pragma unroll
                for (int n = 0; n < 2; ++n) acc[a][b][m][n] = (f32x4){0.f, 0.f, 0.f, 0.f};
    bf16x8 At[4][2], B0[2][2], B1[2][2];
    const char* cA = (const char*)g.A + (size_t)cur.pm * tstepA + (size_t)(cur.pm >> 3) * (ASKIP * LDA * 2) + (size_t)(KSPLIT ? (cur.pn >> 2) : 0) * (KSPLIT * 2); const char* cB = (const char*)g.Bt + (size_t)cur.pn * tstepB;
    S.a_ready(cur);
    if constexpr (SP2) {
        PG8_STAGE(PG8_SB(0, 0), cB, voffB); PG8_STAGE(PG8_SB(0, 1), cB + hstepB, voffB); PG8_STAGE(PG8_SA(0, 0), cA, voffA); PG8_STAGE(PG8_SA(0, 1), cA + hstepA, voffA);
        if (wr == 1) PG8_BAR;
        PG8_WAIT_V(2); PG8_BAR;
        PG8_STAGE(PG8_SB(1, 0), cB + kstep, voffB); PG8_STAGE(PG8_SA(1, 0), cA + kstep, voffA); PG8_STAGE(PG8_SB(1, 1), cB + hstepB + kstep, voffB);
        PG8_WAIT_V(6); PG8_BAR;
    } else {
        PG8_STAGE(PG8_SB(0, 0), cB, voffB); PG8_STAGE(PG8_SA(0, 0), cA, voffA); PG8_STAGE(PG8_SB(0, 1), cB + hstepB, voffB); PG8_STAGE(PG8_SA(0, 1), cA + hstepA, voffA);
        if (wr == 1) PG8_BAR;
        PG8_WAIT_V(4); PG8_BAR;
        PG8_STAGE(PG8_SB(1, 0), cB + kstep, voffB); PG8_STAGE(PG8_SA(1, 0), cA + kstep, voffA); PG8_STAGE(PG8_SB(1, 1), cB + hstepB + kstep, voffB);
        PG8_WAIT_V(6); PG8_BAR;
    }
    for (;;) {
        const bool has_next = S.next(ui + 1, nxt);
        const char* nA = has_next ? (const char*)g.A + (size_t)nxt.pm * tstepA + (size_t)(nxt.pm >> 3) * (ASKIP * LDA * 2) + (size_t)(KSPLIT ? (nxt.pn >> 2) : 0) * (KSPLIT * 2) : cA; const char* nB = has_next ? (const char*)g.Bt + (size_t)nxt.pn * tstepB : cB;
        for (int t = 0; t < nt; t += 2) {
            const bool last = (t == nt - 2);
            const char* a1 = cA + (size_t)(t + 1) * kstep;
            const char* a2 = last ? nA : cA + (size_t)(t + 2) * kstep; const char* b2 = last ? nB : cB + (size_t)(t + 2) * kstep;
            const char* a3 = a2 + kstep; const char* b3 = b2 + kstep;
            if (last && has_next) S.a_ready(nxt);
            if constexpr (SP2) {
            PG8_LDB(B0, 0, 0); PG8_LDB(B1, 0, 1); PG8_SCHED; PG8_LDA(At, 0, 0); PG8_STAGE(PG8_SA(1, 1), a1 + hstepA, voffA);
            PG8_WAIT_V(8); PG8_WAIT_L(0); PG8_BAR; PG8_MMA(0, 0, At, B0); PG8_MMA(0, 1, At, B1); PG8_BAR; PG8_SCHED;
            PG8_LDA(At, 0, 1); PG8_STAGE(PG8_SB(0, 0), b2, voffB); PG8_STAGE(PG8_SB(0, 1), b2 + hstepB, voffB); PG8_STAGE(PG8_SA(0, 0), a2, voffA);
            PG8_WAIT_V(8); PG8_WAIT_L(0); PG8_BAR; PG8_MMA(1, 0, At, B0); PG8_MMA(1, 1, At, B1); PG8_BAR; PG8_SCHED;
            PG8_LDB(B0, 1, 0); PG8_LDB(B1, 1, 1); PG8_SCHED; PG8_LDA(At, 1, 0); PG8_STAGE(PG8_SA(0, 1), a2 + hstepA, voffA);
            PG8_WAIT_V(8); PG8_WAIT_L(0); PG8_BAR; PG8_MMA(0, 0, At, B0); PG8_MMA(0, 1, At, B1); PG8_BAR; PG8_SCHED;
            PG8_LDA(At, 1, 1); PG8_STAGE(PG8_SB(1, 0), b3, voffB); PG8_STAGE(PG8_SB(1, 1), b3 + hstepB, voffB); PG8_STAGE(PG8_SA(1, 0), a3, voffA);
            PG8_WAIT_V(8); PG8_WAIT_L(0); PG8_BAR; PG8_MMA(1, 0, At, B0); PG8_MMA(1, 1, At, B1); PG8_BAR; PG8_SCHED;
            } else {
            PG8_LDB(B0, 0, 0); PG8_SCHED; PG8_LDA(At, 0, 0); PG8_STAGE(PG8_SA(1, 1), a1 + hstepA, voffA);
            PG8_WAIT_L(8); PG8_BAR; PG8_WAIT_L(0); PG8_MMA(0, 0, At, B0); PG8_BAR; PG8_SCHED;
            PG8_LDB(B1, 0, 1); PG8_STAGE(PG8_SB(0, 0), b2, voffB);
            PG8_BAR; PG8_WAIT_L(0); PG8_MMA(0, 1, At, B1); PG8_BAR;
            PG8_LDA(At, 0, 1); PG8_STAGE(PG8_SA(0, 0), a2, voffA);
            PG8_BAR; PG8_WAIT_L(0); PG8_MMA(1, 0, At, B0); PG8_BAR; PG8_SCHED;
            PG8_STAGE(PG8_SB(0, 1), b2 + hstepB, voffB);
            PG8_WAIT_V(6); PG8_BAR; PG8_MMA(1, 1, At, B1); PG8_BAR;
            PG8_LDB(B0, 1, 0); PG8_SCHED; PG8_LDA(At, 1, 0); PG8_STAGE(PG8_SA(0, 1), a2 + hstepA, voffA);
            PG8_WAIT_L(8); PG8_BAR; PG8_WAIT_L(0); PG8_MMA(0, 0, At, B0); PG8_BAR; PG8_SCHED;
            PG8_LDB(B1, 1, 1); PG8_STAGE(PG8_SB(1, 0), b3, voffB);
            PG8_BAR; PG8_WAIT_L(0); PG8_MMA(0, 1, At, B1); PG8_BAR;
            PG8_LDA(At, 1, 1); PG8_STAGE(PG8_SA(1, 0), a3, voffA);
            PG8_BAR; PG8_WAIT_L(0); PG8_MMA(1, 0, At, B0); PG8_BAR; PG8_SCHED;
            PG8_STAGE(PG8_SB(1, 1), b3 + hstepB, voffB);
            PG8_WAIT_V(6); PG8_BAR; PG8_MMA(1, 1, At, B1); PG8_BAR;
            }
        }
        if constexpr (ALIGN_EPI) { if (wr == 0) PG8_BAR; }
        if constexpr (!Epi::AFTER_DRAIN) { E(acc, cur, wr, wc, fr, fq); S.done(cur); }
        if (!has_next) break;
#pragma unroll
        for (int a = 0; a < 2; ++a)
#pragma unroll
            for (int b = 0; b < 2; ++b)
#pragma unroll
                for (int m = 0; m < 4; ++m)
#pragma unroll
                    for (int n = 0; n < 2; ++n) acc[a][b][m][n] = (f32x4){0.f, 0.f, 0.f, 0.f};
        cur = nxt; cA = nA; cB = nB; ++ui;
        if constexpr (ALIGN_EPI) { if (wr == 1) PG8_BAR; }
    }
    PG8_WAIT_V(0);
    if constexpr (!ALIGN_EPI) { if (wr == 0) PG8_BAR; }
    PG8_BAR;
    if constexpr (Epi::AFTER_DRAIN) { E.fused(acc, cur, wr, wc, fr, fq, lds, wid, lane); S.done(cur); }
#undef PG8_SA
#undef PG8_SB
#undef PG8_STAGE
#undef PG8_LDA
#undef PG8_LDB
#undef PG8_MMA
#undef PG8_WAIT_V
#undef PG8_WAIT_L
#undef PG8_BAR
#undef PG8_SCHED
}
}

#define XB_TMO      128
#define XB_XCNT(j)  (256  + 64 * (j))
#define XB_XSUB(j)  (1280 + 64 * (j))
#define XB_XGEN(j)  (2304 + 64 * (j))
#define XB_TOP      3328
#define XB_TOPGEN   3392
#define XCD_BAR_WORDS 3456
#define XB_SPIN_CAP (1u << 18)
DI unsigned xb_ld(unsigned* p)              { return __hip_atomic_load(p, __ATOMIC_RELAXED, __HIP_MEMORY_SCOPE_AGENT); }
DI unsigned xb_add(unsigned* p, unsigned v) { return __hip_atomic_fetch_add(p, v, __ATOMIC_RELAXED, __HIP_MEMORY_SCOPE_AGENT); }
DI unsigned xb_xcc_id() { return (unsigned)__builtin_amdgcn_s_getreg((3 << 11) | 20) & 0xFu; }
#define XB_SPIN(cond, bar) do { unsigned _sp = 0; while (cond) { __builtin_amdgcn_s_sleep(1); \
    if ((++_sp & 255u) == 0u) { if (xb_ld(&(bar)[XB_TMO])) break; if (_sp > XB_SPIN_CAP) { atomicAdd(&(bar)[XB_TMO], 1u); break; } } } } while (0)
struct XcdBarrier { unsigned* bar; unsigned x; volatile LAS unsigned* st; };
DI XcdBarrier xcd_barrier_post(unsigned* bar, volatile LAS unsigned* st) {
    XcdBarrier b; b.bar = bar; b.x = (unsigned)__builtin_amdgcn_readfirstlane((int)xb_xcc_id()); b.st = st;
    if (threadIdx.x == 0) (void)xb_add(&bar[XB_XCNT(b.x)], 1u);
    return b;
}
DI void xcd_barrier_complete(unsigned* bar, unsigned x, unsigned& nloc, unsigned& nx) {
    const unsigned Gd = gridDim.x * gridDim.y * gridDim.z;
    unsigned sum, cnt, mine, sp = 0u;
    for (;;) {
        sum = 0u; cnt = 0u; mine = 0u;
#pragma unroll
        for (unsigned j = 0; j < 16; ++j) { const unsigned cc = xb_ld(&bar[XB_XCNT(j)]); sum += cc; cnt += (cc > 0u) ? 1u : 0u; mine = (j == x) ? cc : mine; }
        if (sum == Gd) break;
        __builtin_amdgcn_s_sleep(1);
        if ((++sp & 255u) == 0u) { if (xb_ld(&bar[XB_TMO])) break; if (sp > XB_SPIN_CAP) { atomicAdd(&bar[XB_TMO], 1u); break; } }
    }
    nloc = mine > 0u ? mine : 1u; nx = cnt > 0u ? cnt : 1u;
}
DI void xcd_barrier(const XcdBarrier& b) {
    asm volatile("s_waitcnt vmcnt(0)" ::: "memory");
    __syncthreads();
    if (threadIdx.x == 0) {
        unsigned* bar = b.bar; unsigned bx = b.x; asm volatile("" : "+s"(bar), "+s"(bx));
        __builtin_amdgcn_s_waitcnt(0);
        unsigned nloc = b.st[0], nx = b.st[1];
        if (nloc == 0u) { xcd_barrier_complete(bar, bx, nloc, nx); b.st[0] = nloc; b.st[1] = nx; }
        const unsigned old = xb_add(&bar[XB_XSUB(bx)], 1u);
        const unsigned gen = old / nloc;
        if (old + 1u == (gen + 1u) * nloc) {
            __builtin_amdgcn_fence(__ATOMIC_RELEASE, "agent");
            asm volatile("s_waitcnt vmcnt(0)" ::: "memory");
            const unsigned og = xb_add(&bar[XB_TOP], 1u);
            const unsigned tg = og / nx;
            if (og + 1u == (tg + 1u) * nx) xb_add(&bar[XB_TOPGEN], 1u);
            else XB_SPIN(xb_ld(&bar[XB_TOPGEN]) == tg, bar);
            __builtin_amdgcn_fence(__ATOMIC_ACQUIRE, "agent");
            xb_add(&bar[XB_XGEN(bx)], 1u);
            asm volatile("s_waitcnt vmcnt(0)" ::: "memory");
        } else {
            XB_SPIN(xb_ld(&bar[XB_XGEN(bx)]) == gen, bar);
            __builtin_amdgcn_fence(__ATOMIC_ACQUIRE, "agent");
            asm volatile("s_waitcnt vmcnt(0)" ::: "memory");
        }
    }
    __syncthreads();
}
constexpr int LDS_BYTES = 163840, MISC_OFF = 155648 + 320, CW_BAR = 4096;
__global__ void __launch_bounds__(512) mk_fwd(Ctx c_byval) {
    CtxP c = (CtxP)__builtin_amdgcn_kernarg_segment_ptr();
    extern __shared__ __attribute__((aligned(16))) unsigned char ldsraw[];
    float* lds = (float*)ldsraw;
    const int tid = threadIdx.x, bid = blockIdx.x, nblk = gridDim.x;
    volatile LAS unsigned* MISC = (volatile LAS unsigned*)((LAS unsigned char*)ldsraw + MISC_OFF);
    if (tid < 32) MISC[tid] = 0u;
    if ((tid & 63) == 0) ((volatile LAS int*)(unsigned long)WVTAB_OFF)[hw_slot()] = tid >> 6;
    __syncthreads();
    XcdBarrier bar = xcd_barrier_post((unsigned*)(c->ws + OFF_CTL) + CW_BAR, MISC + 8);
    s_p0(c, 0, 0, lds, bid, nblk);
    s_prenorm(c, 0, 0, lds, bid, nblk);
    xcd_barrier(bar);
    for (int slab_ = 0; slab_ < 2; ++slab_)
        for (int l_ = 0; l_ < NL; ++l_) {
            int l = l_, slab = slab_; asm volatile("" : "+s"(l), "+s"(slab));
            { const bf16_t* halo = (const bf16_t*)(c->ws + OFF_CARRY + l * CARRY_L + HALO_OFF); bf16_t* pp = (bf16_t*)(c->ws + OFF_P);
              for (int i = bid * 512 + otid(); i < NB * 3 * PP; i += nblk * 512) { const int b = i / (3 * PP), r = (i / PP) % 3, col = i % PP; pp[prow_off(b, r - 3) + col] = slab == 0 ? (bf16_t)0 : halo[i]; } }
            { pg8::Gemm g{(const bf16_t*)(c->ws + OFF_H), (const bf16_t*)(c->ws + OFF_WIN + l * WIN_L), MS, PP, D, D}; pg8::StaticOrder S; S.init(MS, PP, nblk, bid);
              pg8::EpiBf16<0> E{(bf16_t*)(c->ws + OFF_P) + 3 * PP, PP, nullptr, 0, 0, 1.f, 3};
              pg8::gemm_phase<pg8::EpiBf16<0>, pg8::StaticOrder, true, true, D, D, 0>((LAS unsigned char*)ldsraw, g, S, E); }
            xcd_barrier(bar);
            s_phase2(c, l, slab, lds, bid, nblk);
            xcd_barrier(bar);
            s_phaseSB(c, l, slab, lds, bid, nblk);
            xcd_barrier(bar);
            if (nblk == 256) s_phase3(c, l, slab, lds, bid);
            xcd_barrier(bar);
            s_bpost(c, l, slab, lds, bid, nblk);
            xcd_barrier(bar);
            { pg8::Gemm g{(const bf16_t*)(c->ws + OFF_P) + 3 * PP + ZA, (const bf16_t*)(c->ws + OFF_WOUT + l * WOUT_L), MS, 2 * D, DMIX / 2, PP}; pg8::StaticOrder S; S.init(MS, 2 * D, nblk, bid);
              pg8::EpiSplitK E{(float*)(c->ws + OFF_Y), (bf16_t*)(c->ws + OFF_Y2), D};
              pg8::gemm_phase<pg8::EpiSplitK, pg8::StaticOrder, true, true, DMIX / 2, PP, 3, DMIX / 2>((LAS unsigned char*)ldsraw, g, S, E); }
            xcd_barrier(bar);
            s_post(c, l, slab, lds, bid, nblk);
            if (l == 1 && slab == 0) s_prenorm(c, 0, 1, lds, bid, nblk);
            xcd_barrier(bar);
        }
}

extern "C" void kernel_launch(void* const* d_in, const int* in_sizes, int n_in, void* d_out, int out_size, void* d_ws, size_t ws_size, hipStream_t stream) {
    static int grid = 0;
    if (grid == 0) {
        int dev = 0, cus = 0, per_cu = 0;
        (void)hipGetDevice(&dev);
        (void)hipDeviceGetAttribute(&cus, hipDeviceAttributeMultiprocessorCount, dev);
        (void)hipFuncSetAttribute((const void*)mk_fwd, hipFuncAttributeMaxDynamicSharedMemorySize, LDS_BYTES);
        (void)hipOccupancyMaxActiveBlocksPerMultiprocessor(&per_cu, (const void*)mk_fwd, 512, LDS_BYTES);
        if (per_cu < 1) { fprintf(stderr, "kernel_launch: occupancy query says %d blocks/CU\n", per_cu); per_cu = 1; }
        grid = cus;
        if (grid != 256) fprintf(stderr, "kernel_launch: %d CUs (built for 256)\n", grid);
    }
    Ctx c{};
    const float** f = (const float**)&c;
    for (int i = 0; i < 28; ++i) f[i] = (const float*)d_in[i];
    c.out = (float*)d_out; c.ws = (unsigned char*)d_ws;
    (void)hipMemsetAsync(d_ws, 0, 1 * MiB, stream);
    void* args[] = {&c};
    hipError_t e = hipLaunchCooperativeKernel((const void*)mk_fwd, dim3(grid), dim3(512), args, LDS_BYTES, stream);
    if (e != hipSuccess) fprintf(stderr, "cooperative launch failed: %s (grid %d)\n", hipGetErrorString(e), grid);
}
```

```cpp
#include <hip/hip_runtime.h>
#include <cstdint>
#include <cstdio>

typedef unsigned short bf16_t;
#define DI __device__ __forceinline__
#define LAS __attribute__((address_space(3)))

constexpr int NB = 4, T = 4096, D = 1024, NL = 2, G = 512, NH = 8;
constexpr int TS = 2048, MS = NB * TS, NCS = TS / 64, TSP = TS + 3;
constexpr int DIN = 7824, PP = 7936, DMIX = 2048;
constexpr int A_Q = 0, A_K = 512, A_V = 1024, A_O = 1536, B_R = 2048, B_K = 2560, B_V = 3072, B_WLO = 3584, B_ALO = 3648, C_X = 3712,
              D_Q = 4224, D_K = 4736, D_V = 5248, ZA = 5760, ZB = 6272, ZC = 6784, ZD = 7296, A_I = 7808, A_F = 7816;
constexpr size_t MiB = 1u << 20;
constexpr size_t OFF_CTL = 0, OFF_ZROW = 512 * 1024, OFF_WIN = 1 * MiB, OFF_WOUT = 32 * MiB, OFF_ROPE = 40 * MiB, OFF_CARRY = 41 * MiB,
                 OFF_LS = 45 * MiB, OFF_BON = 45 * MiB + 512 * 1024, OFF_P = 45 * MiB + 768 * 1024, OFF_SA = 170 * MiB, OFF_H = 170 * MiB,
                 OFF_SD = 170 * MiB + 17301504, OFF_CK = 203 * MiB, OFF_Y = 203 * MiB, OFF_Y2 = 235 * MiB,
                 OFF_WRT = 251 * MiB, OFF_WIT = OFF_WRT + 262144, OFF_WUT = OFF_WIT + 262144, OFF_AUT = OFF_WUT + 262144;
constexpr size_t WIN_L = (size_t)PP * D * 2, WOUT_L = (size_t)D * DMIX * 2;
constexpr size_t CARRY_L = 2 * MiB, CA_OFF = 0, CD_OFF = 540672, CB_OFF = CD_OFF + 524288, CC_OFF = CB_OFF + 524288, HALO_OFF = CC_OFF + 8192;
constexpr int SAU = 4224;

struct Ctx {
    const float *x, *norm_pre, *norm_post, *w_in, *w_out, *mconv_w, *mconv_b, *mi_bias, *mf_bias, *mnorm_w, *rmu, *rw_up, *rw0, *ra_up, *ra0,
        *rk_k, *rk_a, *rr_k, *rgn_w, *rgn_b, *lconv_w, *lconv_b, *lw_r, *lb_r, *lw_i, *lb_i, *llam, *retnorm_w;
    float* out; unsigned char* ws;
};
typedef const __attribute__((address_space(4))) Ctx* CtxP;


constexpr int WVTAB_OFF = 155648 + 512;
DI int hw_slot() { return __builtin_amdgcn_s_getreg((5 << 11) | 4) & 63; }
DI int otid() { int lane; asm volatile("v_mbcnt_lo_u32_b32 %0, -1, 0\n\tv_mbcnt_hi_u32_b32 %0, -1, %0" : "=v"(lane));
    const int wv = __builtin_amdgcn_readfirstlane(((volatile LAS int*)(unsigned long)WVTAB_OFF)[hw_slot()]);
    int t = (wv << 6) | lane; asm volatile("" : "+v"(t)); return t; }
DI size_t prow_off(int b, int tl) { return (size_t)(b * TSP + 3 + tl) * PP; }
DI float bf2f(bf16_t v) { return __uint_as_float(((unsigned)v) << 16); }
DI bf16_t f2bf(float f) { unsigned u = __float_as_uint(f); u += 0x7fffu + ((u >> 16) & 1u); return (bf16_t)(u >> 16); }
DI float sigm(float x) { return __builtin_amdgcn_rcpf(1.f + __expf(-x)); }
DI float siluf(float x) { return x * __builtin_amdgcn_rcpf(1.f + __expf(-x)); }
DI float tanh_fast(float x) { return 1.f - 2.f * __builtin_amdgcn_rcpf(1.f + __expf(2.f * x)); }
DI float softplusf(float x) { return fmaxf(x, 0.f) + log1pf(expf(-fabsf(x))); }
DI float wave_sum(float v) {
#pragma unroll
    for (int o = 1; o < 64; o <<= 1) v += __shfl_xor(v, o);
    return v;
}
DI int srccol(int n) {
    if (n < 2048) return n;
    if (n < 3712) return n + 528;
    if (n < 4224) return n + 1040;
    if (n < 5760) return n + 1552;
    if (n < 6272) return n - 3712;
    if (n < 6784) return n - 2032;
    if (n < 7296) return n - 1520;
    if (n < 7808) return n + 16;
    if (n < 7824) return n - 5248;
    return -1;
}
DI void wt_item(const float* W, int K, int N, bf16_t* WT, bool permute, float* scr, int item, int lane, bool ksplit = false) {
    const int nblk = (permute ? PP : N) / 32, kb = item / nblk, nb = item % nblk, k0 = 64 * kb, n0 = 32 * nb;
    const int nn = n0 + (lane & 31); const int sc = permute ? srccol(nn) : nn;
    for (int i = 0; i < 32; ++i) { const int kk = 2 * i + (lane >> 5); scr[kk * 33 + (lane & 31)] = sc >= 0 ? W[(size_t)(k0 + kk) * N + sc] : 0.f; }
    __builtin_amdgcn_s_waitcnt(0); __builtin_amdgcn_wave_barrier();
    const int c = lane & 7;
    for (int j = 0; j < 4; ++j) { const int n = (lane >> 3) + 8 * j; const float* s = scr + (8 * c) * 33 + n;
        uint4 o; o.x = f2bf(s[0]) | ((unsigned)f2bf(s[33]) << 16); o.y = f2bf(s[66]) | ((unsigned)f2bf(s[99]) << 16);
        o.z = f2bf(s[132]) | ((unsigned)f2bf(s[165]) << 16); o.w = f2bf(s[198]) | ((unsigned)f2bf(s[231]) << 16);
        if (ksplit) *(uint4*)(WT + (size_t)((k0 >> 10) * N + n0 + n) * (K / 2) + (k0 & 1023) + 8 * c) = o;
        else *(uint4*)(WT + (size_t)(n0 + n) * K + k0 + 8 * c) = o; }
    __builtin_amdgcn_s_waitcnt(0); __builtin_amdgcn_wave_barrier();
}
DI void s_p0(CtxP c, int l, int slab, float* lds, int bid, int nblk) {
    const int tid = otid(), lane = tid & 63, wave = tid >> 6;
    float* scr = lds + wave * (64 * 33);
    const int gw = bid * 8 + wave, NGW = nblk * 8;
    constexpr int I_IN = (D / 64) * (PP / 32), I_OUT = (DMIX / 64) * (D / 32);
    for (int it = gw; it < NL * (I_IN + I_OUT); it += NGW) {
        const int l = it / (I_IN + I_OUT); int r = it % (I_IN + I_OUT);
        if (r < I_IN) wt_item(c->w_in + (size_t)l * D * DIN, D, DIN, (bf16_t*)(c->ws + OFF_WIN + l * WIN_L), true, scr, r, lane);
        else wt_item(c->w_out + (size_t)l * DMIX * D, DMIX, D, (bf16_t*)(c->ws + OFF_WOUT + l * WOUT_L), false, scr, r - I_IN, lane, true);
    }
    { bf16_t* wrt = (bf16_t*)(c->ws + OFF_WRT); bf16_t* wit = (bf16_t*)(c->ws + OFF_WIT); bf16_t* wut = (bf16_t*)(c->ws + OFF_WUT); bf16_t* aut = (bf16_t*)(c->ws + OFF_AUT);
      for (int i = bid * 512 + tid; i < NL * NH * 4096; i += nblk * 512) { const int lh = i >> 12, j = (i >> 6) & 63, ii = i & 63;
          wrt[i] = f2bf(c->lw_r[(size_t)lh * 4096 + ii * 64 + j]); wit[i] = f2bf(c->lw_i[(size_t)lh * 4096 + ii * 64 + j]); }
      for (int i = bid * 512 + tid; i < NL * G * 64; i += nblk * 512) { const int l2 = i / (G * 64), j = (i >> 6) % G, ii = i & 63;
          wut[i] = f2bf(c->rw_up[(size_t)l2 * 64 * G + ii * G + j]); aut[i] = f2bf(c->ra_up[(size_t)l2 * 64 * G + ii * G + j]); } }
    float* rope = (float*)(c->ws + OFF_ROPE);
    for (int i = bid * 512 + tid; i < T * 32; i += nblk * 512) {
        const int t = i >> 5, j = i & 31; const float inv = powf(10000.f, -(float)j / 32.f); const float ang = (float)t * inv;
        rope[2 * i] = cosf(ang); rope[2 * i + 1] = sinf(ang);
    }
}
DI void norm_row(const float* xrow, const float* g, bf16_t* hrow, int lane) {
    float4 v[4]; float ss = 0.f;
#pragma unroll
    for (int j = 0; j < 4; ++j) { v[j] = *(const float4*)(xrow + j * 256 + lane * 4); ss += v[j].x * v[j].x + v[j].y * v[j].y + v[j].z * v[j].z + v[j].w * v[j].w; }
    ss = wave_sum(ss); const float rs = rsqrtf(ss * (1.f / D) + 1e-6f);
#pragma unroll
    for (int j = 0; j < 4; ++j) { const float4 gg = *(const float4*)(g + j * 256 + lane * 4);
        uint2 o; o.x = f2bf(v[j].x * rs * gg.x) | ((unsigned)f2bf(v[j].y * rs * gg.y) << 16); o.y = f2bf(v[j].z * rs * gg.z) | ((unsigned)f2bf(v[j].w * rs * gg.w) << 16);
        *(uint2*)(hrow + j * 256 + lane * 4) = o; }
}
DI void s_prenorm(CtxP c, int l, int slab, float* lds, int bid, int nblk) {
    const int lane = otid() & 63, gw = bid * 8 + (otid() >> 6), NGW = nblk * 8;
    for (int r = gw; r < MS; r += NGW) { const int b = r / TS, tl = r % TS; const size_t grow = (size_t)b * T + slab * TS + tl;
        norm_row(c->x + grow * D, c->norm_pre, (bf16_t*)(c->ws + OFF_H) + (size_t)r * D, lane); }
}
DI float ret_logg(int h) { return log1pf(-exp2f(-5.f - (float)h)); }
DI void s_stepB(CtxP c, int l, int slab, float* lds, int bid, int nblk) {
    const int tid = otid();
    for (int item = bid; item < 288 + 256 + 4; item += nblk) {
        if (item < 288) {
            const int bh = item / 9, part = item % 9, el = part * 512 + tid; const bool on = el < 4160;
            float* CA = (float*)(c->ws + OFF_CARRY + l * CARRY_L + CA_OFF) + (size_t)bh * SAU; float* S0 = (float*)(c->ws + OFF_SA) + (size_t)(bh * NCS) * SAU;
            float m = slab == 0 ? 0.f : CA[4160 + slab - 1]; float val = (slab == 0 || !on) ? 0.f : CA[el];
            float loc[NCS], ml[NCS], tt[NCS];
#pragma unroll
            for (int cl = 0; cl < NCS; ++cl) { const float* S = S0 + (size_t)cl * SAU; ml[cl] = S[4160]; tt[cl] = S[4161]; loc[cl] = on ? S[el] : 0.f; }
#pragma unroll
            for (int cl = 0; cl < NCS; ++cl) { float* S = S0 + (size_t)cl * SAU;
                if (on) S[el] = val;
                if (el == 0) S[4162] = m;
                const float mn = fmaxf(tt[cl] + m, ml[cl]); val = expf(tt[cl] + m - mn) * val + expf(ml[cl] - mn) * loc[cl]; m = mn; }
            if (on) CA[el] = val;
            if (el == 0) CA[4160 + slab] = m;
        } else if (item < 288 + 256) {
            const int it = item - 288, bh = it / 8, el = (it % 8) * 512 + tid; const float gch = expf(ret_logg(bh % NH) * 64.f);
            float* CD = (float*)(c->ws + OFF_CARRY + l * CARRY_L + CD_OFF) + (size_t)bh * 4096; float* S0 = (float*)(c->ws + OFF_SD) + (size_t)(bh * NCS) * 4096;
            float val = slab == 0 ? 0.f : CD[el]; float loc[NCS];
#pragma unroll
            for (int cl = 0; cl < NCS; ++cl) loc[cl] = S0[(size_t)cl * 4096 + el];
#pragma unroll
            for (int cl = 0; cl < NCS; ++cl) { S0[(size_t)cl * 4096 + el] = val; val = gch * val + loc[cl]; }
            CD[el] = val;
        } else {
            const int i = (item - 544) * 512 + tid, b = i / G, ch = i % G; float* CC = (float*)(c->ws + OFF_CARRY + l * CARRY_L + CC_OFF);
            float hc = slab == 0 ? 0.f : CC[i]; float2 v[NCS];
#pragma unroll
            for (int cl = 0; cl < NCS; ++cl) v[cl] = *(const float2*)((const float*)(c->ws + OFF_LS) + ((size_t)(b * NCS + cl) * G + ch) * 2);
#pragma unroll
            for (int cl = 0; cl < NCS; ++cl) { ((float*)(c->ws + OFF_LS))[((size_t)(b * NCS + cl) * G + ch) * 2] = hc; hc = v[cl].x * hc + v[cl].y; }
            CC[i] = hc;
        }
    }
}
typedef short bf16x8 __attribute__((ext_vector_type(8)));
typedef float f32x16 __attribute__((ext_vector_type(16)));
typedef float f32x2_t __attribute__((ext_vector_type(2)));
typedef __bf16 bf16x2_t __attribute__((ext_vector_type(2)));
DI unsigned pk2(float lo, float hi) { f32x2_t v = {lo, hi}; bf16x2_t b = __builtin_convertvector(v, bf16x2_t); return __builtin_bit_cast(unsigned, b); }
DI bf16x8 pack8(const float* v) { uint4 u; u.x = pk2(v[0], v[1]); u.y = pk2(v[2], v[3]); u.z = pk2(v[4], v[5]); u.w = pk2(v[6], v[7]); return __builtin_bit_cast(bf16x8, u); }
DI void unpack8(uint4 u, float* v) { v[0] = __uint_as_float(u.x << 16); v[1] = __uint_as_float(u.x & 0xffff0000u); v[2] = __uint_as_float(u.y << 16); v[3] = __uint_as_float(u.y & 0xffff0000u);
    v[4] = __uint_as_float(u.z << 16); v[5] = __uint_as_float(u.z & 0xffff0000u); v[6] = __uint_as_float(u.w << 16); v[7] = __uint_as_float(u.w & 0xffff0000u); }
#define MFMA32(a, b, c) __builtin_amdgcn_mfma_f32_32x32x16_bf16((a), (b), (c), 0, 0, 0)
#define WSYNC() do { __builtin_amdgcn_fence(__ATOMIC_RELEASE, "wavefront"); __builtin_amdgcn_wave_barrier(); __builtin_amdgcn_fence(__ATOMIC_ACQUIRE, "wavefront"); } while (0)
DI float wave_psum(float v, int lane) {
#pragma unroll
    for (int o = 1; o < 64; o <<= 1) { const float t = __shfl_up(v, o); if (lane >= o) v += t; }
    return v;
}
DI float wave_pmax(float v, int lane) {
#pragma unroll
    for (int o = 1; o < 64; o <<= 1) { const float t = __shfl_up(v, o); if (lane >= o) v = fmaxf(v, t); }
    return v;
}
DI float wave_max(float v) {
#pragma unroll
    for (int o = 1; o < 64; o <<= 1) v = fmaxf(v, __shfl_xor(v, o));
    return v;
}
constexpr int TP = 144;
constexpr int WLDS = 19456;
#define TILE_K(NR) (((NR) * 8 + 63) / 64)
typedef unsigned u32x4 __attribute__((ext_vector_type(4)));
template <int NR> DI void tile_load(u32x4 (&tv)[TILE_K(NR)], const bf16_t* rb  , int tl_first, int col, int lane) {
#pragma unroll
    for (int k = 0; k < (NR * 8 + 63) / 64; ++k) { const int i = lane + 64 * k; int r = i >> 3; r = r < NR ? r : NR - 1; const int ch = i & 7;
        tv[k] = *(const u32x4*)(rb + (tl_first + r) * PP + col + ch * 8); }
}
template <int NR> DI void tile_store(const u32x4 (&tv)[TILE_K(NR)], unsigned char* tile, int lane) {
#pragma unroll
    for (int k = 0; k < (NR * 8 + 63) / 64; ++k) { const int i = lane + 64 * k; const int r = i >> 3, ch = i & 7;
        if (i < NR * 8) *(u32x4*)(tile + r * TP + ch * 16) = tv[k]; }
    WSYNC();
}
DI void proc_conv_tile(unsigned char* tile, const float* cw, int cws, const float* cb, float scale, int lane) {
    const int ch = lane & 7; float w[4][8], bb[8];
#pragma unroll
    for (int t = 0; t < 4; ++t) { const float4 a = *(const float4*)(cw + t * cws + ch * 8), d = *(const float4*)(cw + t * cws + ch * 8 + 4);
        w[t][0] = a.x; w[t][1] = a.y; w[t][2] = a.z; w[t][3] = a.w; w[t][4] = d.x; w[t][5] = d.y; w[t][6] = d.z; w[t][7] = d.w; }
    { const float4 a = *(const float4*)(cb + ch * 8), d = *(const float4*)(cb + ch * 8 + 4); bb[0] = a.x; bb[1] = a.y; bb[2] = a.z; bb[3] = a.w; bb[4] = d.x; bb[5] = d.y; bb[6] = d.z; bb[7] = d.w; }
#pragma unroll
    for (int k = 0; k < 8; ++k) { const int row = (lane >> 3) + 8 * k; float acc[8];
#pragma unroll
        for (int i = 0; i < 8; ++i) acc[i] = bb[i];
#pragma unroll
        for (int t = 0; t < 4; ++t) { float x[8]; unpack8(*(const uint4*)(tile + (row + t) * TP + ch * 16), x);
#pragma unroll
            for (int i = 0; i < 8; ++i) acc[i] += x[i] * w[t][i]; }
#pragma unroll
        for (int i = 0; i < 8; ++i) acc[i] = siluf(acc[i]) * scale;
        const bf16x8 res = pack8(acc); WSYNC();
        *(bf16x8*)(tile + row * TP + ch * 16) = res; }
    WSYNC();
}
DI void proc_rope_tile(unsigned char* tile, const float* ropet, int pos0, float scale, int lane) {
    const int p = lane & 3;
#pragma unroll
    for (int k = 0; k < 4; ++k) { const int row = (lane >> 2) + 16 * k; float x1[8], x2[8], o1[8], o2[8];
        unpack8(*(const uint4*)(tile + row * TP + p * 16), x1); unpack8(*(const uint4*)(tile + row * TP + (p + 4) * 16), x2);
        const float* cs = ropet + ((size_t)(pos0 + row) * 32 + p * 8) * 2;
#pragma unroll
        for (int q = 0; q < 4; ++q) { const float4 v = *(const float4*)(cs + 4 * q);
            o1[2 * q] = (x1[2 * q] * v.x - x2[2 * q] * v.y) * scale; o2[2 * q] = (x2[2 * q] * v.x + x1[2 * q] * v.y) * scale;
            o1[2 * q + 1] = (x1[2 * q + 1] * v.z - x2[2 * q + 1] * v.w) * scale; o2[2 * q + 1] = (x2[2 * q + 1] * v.z + x1[2 * q + 1] * v.w) * scale; }
        *(bf16x8*)(tile + row * TP + p * 16) = pack8(o1); *(bf16x8*)(tile + row * TP + (p + 4) * 16) = pack8(o2); asm volatile("" ::: "memory"); }
    WSYNC();
}
DI bf16x8 frag_nat(const unsigned char* tile, int row, int ch) { return *(const bf16x8*)(tile + row * TP + ch * 16); }
DI float tile_at(const unsigned char* tile, int row, int col) { return bf2f(*(const bf16_t*)(tile + row * TP + col * 2)); }

template <bool RET> DI void w_chunkA(CtxP c, int l, int slab, int u, unsigned char* wl, int lane) {
    const int bh = u / NCS, cl = u % NCS, b = bh >> 3, h = bh & 7, tl0 = cl * 64, hs = lane >> 5, li = lane & 31;
    unsigned char* tile = wl; float* tab = (float*)(wl + 9728); const bf16_t* rb = (const bf16_t*)(c->ws + OFF_P) + prow_off(b, 0);
    float* S = RET ? (float*)(c->ws + OFF_SD) + (size_t)u * 4096 : (float*)(c->ws + OFF_SA) + (size_t)u * SAU;
    float mloc = 0.f, tot = 0.f;
    u32x4 rk64[TILE_K(64)], rv64[TILE_K(64)], rk67[TILE_K(67)];
    if (RET) tile_load<64>(rk64, rb, tl0, D_K + h * 64, lane); else tile_load<67>(rk67, rb, tl0 - 3, A_K + h * 64, lane);
    tile_load<64>(rv64, rb, tl0, (RET ? D_V : A_V) + h * 64, lane);
    if (RET) { tab[lane] = expf(ret_logg(h) * (float)(63 - lane)); }
    else { const bf16_t* gr = (const bf16_t*)(c->ws + OFF_P) + prow_off(b, tl0 + lane);
        const float ig = bf2f(gr[A_I + h]) + c->mi_bias[l * NH + h]; const float lf = -softplusf(-(bf2f(gr[A_F + h]) + c->mf_bias[l * NH + h]));
        const float cum = wave_psum(lf, lane); tot = __int_as_float(__builtin_amdgcn_readlane(__float_as_int(cum), 63)); const float lw = tot - cum + ig; mloc = wave_max(lw); tab[lane] = expf(lw - mloc); }
    if (RET) { tile_store<64>(rk64, tile, lane); proc_rope_tile(tile, (const float*)(c->ws + OFF_ROPE), slab * TS + tl0, 0.125f, lane); }
    else { tile_store<67>(rk67, tile, lane); proc_conv_tile(tile, c->mconv_w + l * 4096 + 512 + h * 64, 1024, c->mconv_b + l * 1024 + 512 + h * 64, 0.125f, lane); }
    bf16x8 kf[2][4]; float nl[2] = {0.f, 0.f};
#pragma unroll
    for (int db = 0; db < 2; ++db)
#pragma unroll
        for (int ks = 0; ks < 4; ++ks) { float v[8];
#pragma unroll
            for (int j = 0; j < 8; ++j) { const int t = 16 * ks + 8 * hs + j; v[j] = tile_at(tile, t, 32 * db + li); nl[db] += tab[t] * v[j]; }
            kf[db][ks] = pack8(v); }
    WSYNC();
    tile_store<64>(rv64, tile, lane);
    f32x16 acc[2][2];
#pragma unroll
    for (int eb = 0; eb < 2; ++eb)
#pragma unroll
        for (int db = 0; db < 2; ++db)
#pragma unroll
            for (int r = 0; r < 16; ++r) acc[eb][db][r] = 0.f;
#pragma unroll
    for (int eb = 0; eb < 2; ++eb)
#pragma unroll
        for (int ks = 0; ks < 4; ++ks) { float v[8];
#pragma unroll
            for (int j = 0; j < 8; ++j) { const int t = 16 * ks + 8 * hs + j; v[j] = tile_at(tile, t, 32 * eb + li) * tab[t]; }
            const bf16x8 vf = pack8(v);
#pragma unroll
            for (int db = 0; db < 2; ++db) acc[eb][db] = MFMA32(vf, kf[db][ks], acc[eb][db]); }
#pragma unroll
    for (int eb = 0; eb < 2; ++eb)
#pragma unroll
        for (int db = 0; db < 2; ++db)
#pragma unroll
            for (int r = 0; r < 16; ++r) S[(32 * eb + (r & 3) + 8 * (r >> 2) + 4 * hs) * 64 + 32 * db + li] = acc[eb][db][r];
    if (!RET) {
#pragma unroll
        for (int db = 0; db < 2; ++db) { nl[db] += __shfl_xor(nl[db], 32); if (hs == 0) S[4096 + 32 * db + li] = nl[db]; }
        if (lane == 0) { S[4160] = mloc; S[4161] = tot; } }
    WSYNC();
}
template <bool RET> DI void w_chunkC(CtxP c, int l, int slab, int u, unsigned char* wl, int lane) {
    const int bh = u / NCS, cl = u % NCS, b = bh >> 3, h = bh & 7, tl0 = cl * 64, hs = lane >> 5, li = lane & 31;
    unsigned char* tile = wl; float* tab = (float*)(wl + 9728); const bf16_t* rb = (const bf16_t*)(c->ws + OFF_P) + prow_off(b, 0);
    const float* S = RET ? (const float*)(c->ws + OFF_SD) + (size_t)u * 4096 : (const float*)(c->ws + OFF_SA) + (size_t)u * SAU;
    const float lg = RET ? ret_logg(h) : 0.f;
    float mx_t[2] = {0.f, 0.f}, sc_t[2], dnf_t[2] = {0.f, 0.f};
    if (RET) { sc_t[0] = expf(lg * (float)(li + 1)); sc_t[1] = expf(lg * (float)(li + 33)); }
    else { const bf16_t* gr = (const bf16_t*)(c->ws + OFF_P) + prow_off(b, tl0 + lane);
        const float ig = bf2f(gr[A_I + h]) + c->mi_bias[l * NH + h]; const float lf = -softplusf(-(bf2f(gr[A_F + h]) + c->mf_bias[l * NH + h]));
        const float cum = wave_psum(lf, lane); const float a = ig - cum; const float g = wave_pmax(a, lane);
        const float mst = S[4162]; const float mx = fmaxf(mst, g); const float sint = expf(mst - mx); const float dnf = expf(-(cum + mx));
        tab[lane] = a;
        mx_t[0] = __shfl(mx, li); mx_t[1] = __shfl(mx, 32 + li); sc_t[0] = __shfl(sint, li); sc_t[1] = __shfl(sint, 32 + li); dnf_t[0] = __shfl(dnf, li); dnf_t[1] = __shfl(dnf, 32 + li); }
    u32x4 rk64[TILE_K(64)], rq64[TILE_K(64)], rv64[TILE_K(64)], rk67[TILE_K(67)], rq67[TILE_K(67)];
    if (RET) { tile_load<64>(rk64, rb, tl0, D_K + h * 64, lane); tile_load<64>(rq64, rb, tl0, D_Q + h * 64, lane); }
    else { tile_load<67>(rk67, rb, tl0 - 3, A_K + h * 64, lane); tile_load<67>(rq67, rb, tl0 - 3, A_Q + h * 64, lane); }
    bf16x8 kf[2][4], qf[2][4], cf[2][4];
#pragma unroll
    for (int eb = 0; eb < 2; ++eb)
#pragma unroll
        for (int ks = 0; ks < 4; ++ks) { const float* cp = S + (32 * eb + li) * 64 + 16 * ks + 8 * hs; const float4 c0 = *(const float4*)cp, c1 = *(const float4*)(cp + 4);
            const float cv[8] = {c0.x, c0.y, c0.z, c0.w, c1.x, c1.y, c1.z, c1.w}; cf[eb][ks] = pack8(cv); }
    do { asm volatile("" ::: "memory"); __builtin_amdgcn_sched_barrier(0); } while (0);
    if (RET) { tile_store<64>(rk64, tile, lane); proc_rope_tile(tile, (const float*)(c->ws + OFF_ROPE), slab * TS + tl0, 0.125f, lane); }
    else { tile_store<67>(rk67, tile, lane); proc_conv_tile(tile, c->mconv_w + l * 4096 + 512 + h * 64, 1024, c->mconv_b + l * 1024 + 512 + h * 64, 0.125f, lane); }
#pragma unroll
    for (int mb = 0; mb < 2; ++mb)
#pragma unroll
        for (int ks = 0; ks < 4; ++ks) kf[mb][ks] = frag_nat(tile, 32 * mb + li, 2 * ks + hs);
    WSYNC(); __builtin_amdgcn_sched_barrier(0);
    tile_load<64>(rv64, rb, tl0, (RET ? D_V : A_V) + h * 64, lane);
    if (RET) { tile_store<64>(rq64, tile, lane); proc_rope_tile(tile, (const float*)(c->ws + OFF_ROPE), slab * TS + tl0, 1.f, lane); }
    else { tile_store<67>(rq67, tile, lane); proc_conv_tile(tile, c->mconv_w + l * 4096 + h * 64, 1024, c->mconv_b + l * 1024 + h * 64, 1.f, lane); }
#pragma unroll
    for (int nb = 0; nb < 2; ++nb)
#pragma unroll
        for (int ks = 0; ks < 4; ++ks) qf[nb][ks] = frag_nat(tile, 32 * nb + li, 2 * ks + hs);
    WSYNC(); __builtin_amdgcn_sched_barrier(0);
    tile_store<64>(rv64, tile, lane);
    const int zc = (RET ? ZD : ZA) + h * 64; const float* nw = (RET ? c->retnorm_w : c->mnorm_w) + l * G + h * 64;
#pragma unroll
    for (int nb = 0; nb < 2; ++nb) {
        bf16_t* prw = (bf16_t*)(c->ws + OFF_P) + prow_off(b, tl0 + 32 * nb + li);
        uint2 ogr[2][4], zvr[2][4];
#pragma unroll
        for (int eb = 0; eb < 2; ++eb)
#pragma unroll
            for (int rg = 0; rg < 4; ++rg) { const int e0 = 32 * eb + 8 * rg + 4 * hs; zvr[eb][rg] = *(const uint2*)(prw + zc + e0); ogr[eb][rg] = RET ? make_uint2(0u, 0u) : *(const uint2*)(prw + A_O + h * 64 + e0); }
        bf16x8 xf[2][2]; float csum = 0.f;
#pragma unroll
        for (int mb = 0; mb < 2; ++mb) {
            if (!RET && mb == 1 && nb == 0) continue;
            f32x16 sa;
#pragma unroll
            for (int r = 0; r < 16; ++r) sa[r] = 0.f;
#pragma unroll
            for (int ks = 0; ks < 4; ++ks) sa = MFMA32(kf[mb][ks], qf[nb][ks], sa);
            float xv[16];
#pragma unroll
            for (int rg = 0; rg < 4; ++rg) { float av[4] = {0.f, 0.f, 0.f, 0.f};
                if (!RET) { const float4 t4 = *(const float4*)(tab + 32 * mb + 8 * rg + 4 * hs); av[0] = t4.x; av[1] = t4.y; av[2] = t4.z; av[3] = t4.w; }
#pragma unroll
                for (int i = 0; i < 4; ++i) { const int r = 4 * rg + i, s = 32 * mb + 8 * rg + 4 * hs + i, t = 32 * nb + li;
                    float w;
                    if (RET) w = __expf(lg * fabsf((float)(t - s))); else w = s <= t ? __expf(av[i] - mx_t[nb]) : 0.f;
                    xv[r] = sa[r] * w; csum += xv[r]; } }
            xf[mb][0] = pack8(xv); xf[mb][1] = pack8(xv + 8); __builtin_amdgcn_sched_barrier(0); }
        f32x16 o[2];
#pragma unroll
        for (int eb = 0; eb < 2; ++eb) {
#pragma unroll
            for (int r = 0; r < 16; ++r) o[eb][r] = 0.f;
#pragma unroll
            for (int ks = 0; ks < 4; ++ks) o[eb] = MFMA32(cf[eb][ks], qf[nb][ks], o[eb]);
#pragma unroll
            for (int r = 0; r < 16; ++r) o[eb][r] *= sc_t[nb]; }
        __builtin_amdgcn_sched_barrier(0);
        float dn = 1.f;
        if (!RET) { float qn = 0.f;
#pragma unroll
            for (int ks = 0; ks < 4; ++ks) { const float4 n0 = *(const float4*)(S + 4096 + 16 * ks + 8 * hs), n1 = *(const float4*)(S + 4096 + 16 * ks + 8 * hs + 4);
                const float nv[8] = {n0.x, n0.y, n0.z, n0.w, n1.x, n1.y, n1.z, n1.w}; float qv[8]; unpack8(__builtin_bit_cast(uint4, qf[nb][ks]), qv);
#pragma unroll
                for (int j = 0; j < 8; ++j) qn += qv[j] * nv[j]; }
            qn += __shfl_xor(qn, 32); csum += __shfl_xor(csum, 32); dn = fmaxf(fabsf(csum + sc_t[nb] * qn), dnf_t[nb]); }
#pragma unroll
        for (int eb = 0; eb < 2; ++eb)
#pragma unroll
            for (int sb = 0; sb < 2; ++sb) {
                if (!RET && sb == 1 && nb == 0) continue;
#pragma unroll
                for (int st = 0; st < 2; ++st) { bf16x8 vf;
#pragma unroll
                    for (int j = 0; j < 8; ++j) vf[j] = (short)*(const bf16_t*)(tile + (32 * sb + 16 * st + 8 * (j >> 2) + 4 * hs + (j & 3)) * TP + (32 * eb + li) * 2);
                    o[eb] = MFMA32(vf, xf[sb][st], o[eb]); }
                do { asm volatile("" ::: "memory"); __builtin_amdgcn_sched_barrier(0); } while (0); }
        do { asm volatile("" ::: "memory"); __builtin_amdgcn_sched_barrier(0); } while (0);
        const float inv = 1.f / dn; float sum = 0.f;
#pragma unroll
        for (int eb = 0; eb < 2; ++eb)
#pragma unroll
            for (int rg = 0; rg < 4; ++rg) { const int e0 = 32 * eb + 8 * rg + 4 * hs; float og[4] = {1.f, 1.f, 1.f, 1.f};
                if (!RET) { const uint2 ov = ogr[eb][rg]; og[0] = sigm(__uint_as_float(ov.x << 16)); og[1] = sigm(__uint_as_float(ov.x & 0xffff0000u)); og[2] = sigm(__uint_as_float(ov.y << 16)); og[3] = sigm(__uint_as_float(ov.y & 0xffff0000u)); }
#pragma unroll
                for (int i = 0; i < 4; ++i) { const float v = o[eb][4 * rg + i] * inv * og[i]; o[eb][4 * rg + i] = v; sum += v; } }
        sum += __shfl_xor(sum, 32); const float mu = sum * (1.f / 64.f); float vs = 0.f;
#pragma unroll
        for (int eb = 0; eb < 2; ++eb)
#pragma unroll
            for (int r = 0; r < 16; ++r) { const float d = o[eb][r] - mu; vs += d * d; }
        vs += __shfl_xor(vs, 32); const float rstd = rsqrtf(vs * (1.f / 64.f) + 1e-5f);
#pragma unroll
        for (int eb = 0; eb < 2; ++eb)
#pragma unroll
            for (int rg = 0; rg < 4; ++rg) { const int e0 = 32 * eb + 8 * rg + 4 * hs; const uint2 zv = zvr[eb][rg]; const float4 w4 = *(const float4*)(nw + e0);
                const float z[4] = {__uint_as_float(zv.x << 16), __uint_as_float(zv.x & 0xffff0000u), __uint_as_float(zv.y << 16), __uint_as_float(zv.y & 0xffff0000u)}; const float wv[4] = {w4.x, w4.y, w4.z, w4.w}; float y[4];
#pragma unroll
                for (int i = 0; i < 4; ++i) y[i] = (o[eb][4 * rg + i] - mu) * rstd * wv[i] * siluf(z[i]);
                uint2 ov; ov.x = pk2(y[0], y[1]); ov.y = pk2(y[2], y[3]); *(uint2*)(prw + zc + e0) = ov; }
        do { asm volatile("" ::: "memory"); __builtin_amdgcn_sched_barrier(0); } while (0);
    }
    WSYNC(); __builtin_amdgcn_sched_barrier(0);
}
DI void proc_conv_tile_lin(unsigned char* tile, const float* cw, int cws, const float* cb, int lane) {
    const int ch = lane & 7; float w[4][8], bb[8];
#pragma unroll
    for (int t = 0; t < 4; ++t) { const float4 a = *(const float4*)(cw + t * cws + ch * 8), d = *(const float4*)(cw + t * cws + ch * 8 + 4);
        w[t][0] = a.x; w[t][1] = a.y; w[t][2] = a.z; w[t][3] = a.w; w[t][4] = d.x; w[t][5] = d.y; w[t][6] = d.z; w[t][7] = d.w; }
    { const float4 a = *(const float4*)(cb + ch * 8), d = *(const float4*)(cb + ch * 8 + 4); bb[0] = a.x; bb[1] = a.y; bb[2] = a.z; bb[3] = a.w; bb[4] = d.x; bb[5] = d.y; bb[6] = d.z; bb[7] = d.w; }
#pragma unroll
    for (int k = 0; k < 8; ++k) { const int row = (lane >> 3) + 8 * k; float acc[8];
#pragma unroll
        for (int i = 0; i < 8; ++i) acc[i] = bb[i];
#pragma unroll
        for (int t = 0; t < 4; ++t) { float x[8]; unpack8(*(const uint4*)(tile + (row + t) * TP + ch * 16), x);
#pragma unroll
            for (int i = 0; i < 8; ++i) acc[i] += x[i] * w[t][i]; }
        const bf16x8 res = pack8(acc); WSYNC();
        *(bf16x8*)(tile + row * TP + ch * 16) = res; }
    WSYNC();
}
DI void lru_gates(CtxP c, int l, int h, int jb, const unsigned char* tile, const bf16x8 (&xf)[2][4], float (&a)[2][16], float (&u)[2][16], int li, int hs) {
    const int j = 32 * jb + li, ch = h * 64 + j;
    const bf16_t* wr = (const bf16_t*)(c->ws + OFF_WRT) + ((size_t)(l * NH + h) * 64 + j) * 64; const bf16_t* wi = (const bf16_t*)(c->ws + OFF_WIT) + ((size_t)(l * NH + h) * 64 + j) * 64;
    bf16x8 wrf[4], wif[4];
#pragma unroll
    for (int ks = 0; ks < 4; ++ks) { wrf[ks] = *(const bf16x8*)(wr + 16 * ks + 8 * hs); wif[ks] = *(const bf16x8*)(wi + 16 * ks + 8 * hs); }
    const float br = c->lb_r[l * G + ch], bi = c->lb_i[l * G + ch], sp8 = -8.f * softplusf(-c->llam[l * G + ch]);
#pragma unroll
    for (int tb = 0; tb < 2; ++tb) { f32x16 ar, ai;
#pragma unroll
        for (int r = 0; r < 16; ++r) { ar[r] = 0.f; ai[r] = 0.f; }
#pragma unroll
        for (int ks = 0; ks < 4; ++ks) { ar = MFMA32(xf[tb][ks], wrf[ks], ar); ai = MFMA32(xf[tb][ks], wif[ks], ai); }
#pragma unroll
        for (int r = 0; r < 16; ++r) { const int t = 32 * tb + (r & 3) + 8 * (r >> 2) + 4 * hs; const float x = tile_at(tile, t, j);
            const float la = sp8 * sigm(ar[r] + br); a[tb][r] = __expf(la); u[tb][r] = sqrtf(-expm1f(2.f * la)) * (sigm(ai[r] + bi) * x); } }
}
template <bool STEP_C> DI void w_lru(CtxP c, int l, int slab, int u_, unsigned char* wl, int lane, int jb_lo, int jb_hi) {
    const int bh = u_ / NCS, cl = u_ % NCS, b = bh >> 3, h = bh & 7, tl0 = cl * 64, hs = lane >> 5, li = lane & 31;
    unsigned char* tile = wl; const bf16_t* rb = (const bf16_t*)(c->ws + OFF_P) + prow_off(b, 0);
    { u32x4 rx[TILE_K(67)]; tile_load<67>(rx, rb, tl0 - 3, C_X + h * 64, lane); tile_store<67>(rx, tile, lane); }
    proc_conv_tile_lin(tile, c->lconv_w + l * 2048 + h * 64, 512, c->lconv_b + l * 512 + h * 64, lane);
    bf16x8 xf[2][4];
#pragma unroll
    for (int tb = 0; tb < 2; ++tb)
#pragma unroll
        for (int ks = 0; ks < 4; ++ks) xf[tb][ks] = frag_nat(tile, 32 * tb + li, 2 * ks + hs);
#pragma unroll 1
    for (int jb = jb_lo; jb < jb_hi; ++jb) {
        float a[2][16], u[2][16];
        lru_gates(c, l, h, jb, tile, xf, a, u, li, hs);
        const int ch = h * 64 + 32 * jb + li; float* LS = (float*)(c->ws + OFF_LS) + ((size_t)(b * NCS + cl) * G + ch) * 2;
        float cst = STEP_C ? LS[0] : 0.f, pr = 1.f;
#pragma unroll
        for (int tb = 0; tb < 2; ++tb)
#pragma unroll
            for (int q = 0; q < 4; ++q) {
                float ga = 1.f, gu = 0.f;
#pragma unroll
                for (int i = 0; i < 4; ++i) { gu = a[tb][4 * q + i] * gu + u[tb][4 * q + i]; ga *= a[tb][4 * q + i]; }
                const float pa = __shfl_xor(ga, 32), pu = __shfl_xor(gu, 32);
                const float a0 = hs ? pa : ga, u0 = hs ? pu : gu, a1 = hs ? ga : pa, u1 = hs ? gu : pu;
                if (STEP_C) { float hv = hs ? a0 * cst + u0 : cst;
#pragma unroll
                    for (int i = 0; i < 4; ++i) { hv = a[tb][4 * q + i] * hv + u[tb][4 * q + i]; u[tb][4 * q + i] = hv; } }
                cst = a1 * (a0 * cst + u0) + u1; pr *= a0 * a1; }
        if (!STEP_C) { if (hs == 0) { LS[0] = pr; LS[1] = cst; } }
        else {
#pragma unroll
            for (int tb = 0; tb < 2; ++tb)
#pragma unroll
                for (int r = 0; r < 16; ++r) { const int t = 32 * tb + (r & 3) + 8 * (r >> 2) + 4 * hs; bf16_t* pz = (bf16_t*)(c->ws + OFF_P) + prow_off(b, tl0 + t) + ZC + ch;
                    *pz = f2bf(u[tb][r] * siluf(bf2f(*pz))); } }
        asm volatile("" ::: "memory"); __builtin_amdgcn_sched_barrier(0);
    }
    WSYNC();
}
#define DPP_ADD(v, ctrl) v += __builtin_bit_cast(float, __builtin_amdgcn_update_dpp(0, __builtin_bit_cast(int, v), ctrl, 0xF, 0xF, true))
DI float allred16(float v) { DPP_ADD(v, 0xB1); DPP_ADD(v, 0x4E); DPP_ADD(v, 0x141); DPP_ADD(v, 0x140); return v; }
DI float shx(int lane, float v, int m) { return __builtin_bit_cast(float, __builtin_amdgcn_ds_bpermute((lane ^ m) << 2, __builtin_bit_cast(int, v))); }
DI float allred32(float v, int lane) { v = allred16(v); v += shx(lane, v, 16); return v; }
template <bool TANH> DI void proc_shift_tile(unsigned char* tile, const float* mu, int lane) {
    const int ch = lane & 7; float m[8];
    { const float4 a = *(const float4*)(mu + ch * 8), d = *(const float4*)(mu + ch * 8 + 4); m[0] = a.x; m[1] = a.y; m[2] = a.z; m[3] = a.w; m[4] = d.x; m[5] = d.y; m[6] = d.z; m[7] = d.w; }
#pragma unroll
    for (int k = 0; k < 8; ++k) { const int row = (lane >> 3) + 8 * k; float xp[8], x[8];
        unpack8(*(const uint4*)(tile + row * TP + ch * 16), xp); unpack8(*(const uint4*)(tile + (row + 1) * TP + ch * 16), x);
#pragma unroll
        for (int i = 0; i < 8; ++i) { const float v = x[i] + m[i] * (xp[i] - x[i]); x[i] = TANH ? tanh_fast(v) : v; }
        const bf16x8 res = pack8(x); WSYNC();
        *(bf16x8*)(tile + row * TP + ch * 16) = res; }
    WSYNC();
}
constexpr int RU_PT = 0, RU_QT = 8192, RU_YS = 12288, RU_YV = 16384, RU_VT = 18432, RU_BYTES = 22528, NC32 = TS / 32;
DI int sw64(int row, int e) { return row * 64 + ((((e >> 3) ^ (row >> 1)) & 7) << 3) + (e & 7); }
DI int sw32(int row, int e) { return row * 32 + ((((e >> 3) ^ (row >> 2)) & 3) << 3) + (e & 7); }
DI int kperm(int k) { return (k & ~12) | ((k & 4) << 1) | ((k & 8) >> 1); }
template <bool TANH> DI void proc_shift_tile32(unsigned char* tile, const float* mu, int lane) {
    const int ch = lane & 7; float m[8];
    { const float4 a = *(const float4*)(mu + ch * 8), d = *(const float4*)(mu + ch * 8 + 4); m[0] = a.x; m[1] = a.y; m[2] = a.z; m[3] = a.w; m[4] = d.x; m[5] = d.y; m[6] = d.z; m[7] = d.w; }
#pragma unroll
    for (int k = 0; k < 4; ++k) { const int row = (lane >> 3) + 8 * k; float xp[8], x[8];
        unpack8(*(const uint4*)(tile + row * TP + ch * 16), xp); unpack8(*(const uint4*)(tile + (row + 1) * TP + ch * 16), x);
#pragma unroll
        for (int i = 0; i < 8; ++i) { const float v = x[i] + m[i] * (xp[i] - x[i]); x[i] = TANH ? tanh_fast(v) : v; }
        const bf16x8 res = pack8(x); WSYNC();
        *(bf16x8*)(tile + row * TP + ch * 16) = res; }
    WSYNC();
}
#define V32(x, i) x[(i) >> 4][(i) & 15]
template <int T> struct FSub { static DI void run(f32x16 (&a0)[2], f32x16 (&a1)[2], f32x16 (&m)[2], const f32x16& N) {
    FSub<T - 1>::run(a0, a1, m, N);
#pragma unroll
    for (int j = 0; j < T; ++j) { const float nv = N[(j & 3) + 4 * (j >> 3)]; const float s = __int_as_float(__builtin_amdgcn_readlane(__float_as_int(nv), T + 32 * ((j >> 2) & 1)));
        V32(a0, T) -= V32(a0, j) * s; V32(a1, T) -= V32(a1, j) * s; V32(m, T) -= V32(m, j) * s; }
    if ((T & 3) == 3) __builtin_amdgcn_sched_barrier(0); } };
template <> struct FSub<0> { static DI void run(f32x16 (&)[2], f32x16 (&)[2], f32x16 (&)[2], const f32x16&) {} };
DI void w_rprep(CtxP c, int l, int slab, int u_, unsigned char* wl, int lane) {
    const int bh = u_ / NC32, c32 = u_ % NC32, b = bh >> 3, h = bh & 7, tl0 = c32 * 32, hs = lane >> 5, li = lane & 31;
    unsigned char *RA = wl, *RB = wl + 4752, *TA = wl + 9504, *TB = wl + 14112, *TK = wl, *TR = wl + 4608; float* TAB = (float*)(wl + 18720);
    unsigned char* UR = c->ws + OFF_CK + (size_t)u_ * RU_BYTES;
    const float* mu = c->rmu + l * 1664; const bf16_t* rb = (const bf16_t*)(c->ws + OFF_P) + prow_off(b, 0);
    bf16x8 wlf[4], alf[4];
    { u32x4 rw[TILE_K(33)], ra[TILE_K(33)], rr_[TILE_K(33)], rk_[TILE_K(33)];
      tile_load<33>(rw, rb, tl0 - 1, B_WLO, lane); tile_load<33>(ra, rb, tl0 - 1, B_ALO, lane);
      tile_store<33>(rw, RA, lane);
      tile_load<33>(rr_, rb, tl0 - 1, B_R + h * 64, lane); tile_load<33>(rk_, rb, tl0 - 1, B_K + h * 64, lane);
      proc_shift_tile32<true>(RA, mu + 1536, lane);
#pragma unroll
      for (int ks = 0; ks < 4; ++ks) wlf[ks] = frag_nat(RA, li, 2 * ks + hs);
      WSYNC();
      tile_store<33>(ra, RA, lane); proc_shift_tile32<false>(RA, mu + 1600, lane);
#pragma unroll
      for (int ks = 0; ks < 4; ++ks) alf[ks] = frag_nat(RA, li, 2 * ks + hs);
      WSYNC();
      tile_store<33>(rr_, RA, lane); tile_store<33>(rk_, RB, lane); }
    __builtin_amdgcn_sched_barrier(0);
    float rs[16], bonp[16];
    { float kk[2], mk[2];
#pragma unroll
      for (int jb = 0; jb < 2; ++jb) { kk[jb] = c->rk_k[l * G + h * 64 + 32 * jb + li]; mk[jb] = mu[512 + h * 64 + 32 * jb + li]; }
#pragma unroll
      for (int r = 0; r < 16; ++r) { const int t = (r & 3) + 8 * (r >> 2) + 4 * hs; float ss = 0.f;
#pragma unroll
          for (int jb = 0; jb < 2; ++jb) { const float x = tile_at(RB, t + 1, 32 * jb + li), xp = tile_at(RB, t, 32 * jb + li); const float kap = (x + mk[jb] * (xp - x)) * kk[jb]; ss += kap * kap; }
          rs[r] = rsqrtf(allred32(ss, lane) + 1e-12f); bonp[r] = 0.f; } }
    __builtin_amdgcn_sched_barrier(0);
    float kq[2][16], rq[2][16];
#pragma unroll
    for (int jb = 0; jb < 2; ++jb) {
        const int j = 32 * jb + li, ch = h * 64 + j;
        const bf16_t* wu = (const bf16_t*)(c->ws + OFF_WUT) + ((size_t)l * G + ch) * 64; const bf16_t* au = (const bf16_t*)(c->ws + OFF_AUT) + ((size_t)l * G + ch) * 64;
        bf16x8 wuf[4], auf[4];
#pragma unroll
        for (int ks = 0; ks < 4; ++ks) { wuf[ks] = *(const bf16x8*)(wu + 16 * ks + 8 * hs); auf[ks] = *(const bf16x8*)(au + 16 * ks + 8 * hs); }
        const float w0 = c->rw0[l * G + ch], a0 = c->ra0[l * G + ch], kkj = c->rk_k[l * G + ch], kaj = c->rk_a[l * G + ch], rkj = c->rr_k[l * G + ch], mr = mu[ch], mk = mu[512 + ch];
        f32x16 dl, da;
#pragma unroll
        for (int r = 0; r < 16; ++r) { dl[r] = 0.f; da[r] = 0.f; }
#pragma unroll
        for (int ks = 0; ks < 4; ++ks) { dl = MFMA32(wlf[ks], wuf[ks], dl); da = MFMA32(alf[ks], auf[ks], da); }
        __builtin_amdgcn_sched_barrier(0);
        float wq[16];
#pragma unroll
        for (int r = 0; r < 16; ++r) wq[r] = __expf(-0.606531f * sigm(w0 + dl[r]));
        float Gc[16], Gm[16];
        { float gp[4], pp[4];
#pragma unroll
          for (int q = 0; q < 4; ++q) { gp[q] = (wq[4 * q] * wq[4 * q + 1]) * (wq[4 * q + 2] * wq[4 * q + 3]); pp[q] = shx(lane, gp[q], 32); }
          float run = 1.f;
#pragma unroll
          for (int q = 0; q < 4; ++q) { const float g0 = hs ? pp[q] : gp[q], g1 = hs ? gp[q] : pp[q]; float cur = hs ? run * g0 : run;
#pragma unroll
              for (int i = 0; i < 4; ++i) { Gm[4 * q + i] = cur; cur *= wq[4 * q + i]; Gc[4 * q + i] = cur; }
              run = run * g0 * g1; } }
        if (hs) TAB[j] = Gc[15];
#pragma unroll
        for (int r = 0; r < 16; ++r) { const int t = (r & 3) + 8 * (r >> 2) + 4 * hs;
            const float a = sigm(a0 + da[r]);
            float x = tile_at(RA, t + 1, j), xp = tile_at(RA, t, j); const float rm = x + mr * (xp - x);
            x = tile_at(RB, t + 1, j); xp = tile_at(RB, t, j); const float km = x + mk * (xp - x);
            const float kh = km * kkj * rs[r], kt = km * (1.f + (a - 1.f) * kaj);
            bonp[r] += rm * rkj * kt;
            const float gi = __builtin_amdgcn_rcpf(Gc[r]);
            *(bf16_t*)(TA + t * TP + j * 2) = f2bf(Gm[r] * kh);
            *(bf16_t*)(TB + t * TP + j * 2) = f2bf(a * kh * gi);
            kq[jb][r] = kt * gi; rq[jb][r] = Gc[r] * rm;
            if ((r & 3) == 3) { asm volatile("" ::: "memory"); __builtin_amdgcn_sched_barrier(0); } }
    }
#pragma unroll
    for (int r = 0; r < 16; ++r) { const float bsum = allred32(bonp[r], lane); const int t = (r & 3) + 8 * (r >> 2) + 4 * hs;
        if (li == 0) ((float*)(c->ws + OFF_BON))[(size_t)(b * TS + tl0 + t) * NH + h] = bsum; }
    WSYNC();
#pragma unroll
    for (int jb = 0; jb < 2; ++jb)
#pragma unroll
        for (int r = 0; r < 16; ++r) { const int t = (r & 3) + 8 * (r >> 2) + 4 * hs, j = 32 * jb + li;
            *(bf16_t*)(TK + t * TP + j * 2) = f2bf(kq[jb][r]); *(bf16_t*)(TR + t * TP + j * 2) = f2bf(rq[jb][r]); }
    { const int vch = h * 64 + lane; const float muv = mu[1024 + vch]; const bf16_t* pv = rb + B_V + vch;
      float xs[33];
#pragma unroll
      for (int t = 0; t < 33; ++t) xs[t] = bf2f(pv[(size_t)(tl0 - 1 + t) * PP]);
      unsigned pk[16];
#pragma unroll
      for (int t = 0; t < 16; ++t) pk[t] = pk2(xs[2 * t + 1] + muv * (xs[2 * t] - xs[2 * t + 1]), xs[2 * t + 2] + muv * (xs[2 * t + 1] - xs[2 * t + 2]));
#pragma unroll
      for (int q = 0; q < 4; ++q) *(uint4*)(UR + RU_VT + sw32(lane, 8 * q) * 2) = make_uint4(pk[4 * q], pk[4 * q + 1], pk[4 * q + 2], pk[4 * q + 3]); }
    WSYNC(); __builtin_amdgcn_sched_barrier(0);
    f32x16 Nacc, G1acc, MTacc, G2Tacc;
#pragma unroll
    for (int r = 0; r < 16; ++r) { Nacc[r] = 0.f; G1acc[r] = 0.f; MTacc[r] = 0.f; G2Tacc[r] = 0.f; }
#pragma unroll
    for (int ks = 0; ks < 4; ++ks) { const bf16x8 fA = frag_nat(TA, li, 2 * ks + hs), fB = frag_nat(TB, li, 2 * ks + hs), fK = frag_nat(TK, li, 2 * ks + hs), fR = frag_nat(TR, li, 2 * ks + hs);
        Nacc = MFMA32(fB, fA, Nacc); G1acc = MFMA32(fB, fR, G1acc); MTacc = MFMA32(fA, fK, MTacc); G2Tacc = MFMA32(fR, fK, G2Tacc); }
#pragma unroll
    for (int r = 0; r < 16; ++r) { const int rr = (r & 3) + 8 * (r >> 2) + 4 * hs;
        Nacc[r] = rr < li ? Nacc[r] : 0.f; G1acc[r] = rr <= li ? G1acc[r] : 0.f; MTacc[r] = li < rr ? MTacc[r] : 0.f; G2Tacc[r] = li <= rr ? G2Tacc[r] : 0.f; }
    __builtin_amdgcn_sched_barrier(0);
    f32x16 at0[2], at1[2], mt[2];
#pragma unroll
    for (int t = 0; t < 32; ++t) { V32(at0, t) = tile_at(TA, t, li); V32(at1, t) = tile_at(TA, t, 32 + li); }
#pragma unroll
    for (int r = 0; r < 16; ++r) { const float own = MTacc[r], oth = shx(lane, own, 32); const int t0 = (r & 3) + 8 * (r >> 2), t1 = t0 + 4;
        V32(mt, t0) = hs ? oth : own; V32(mt, t1) = hs ? own : oth; }
    FSub<31>::run(at0, at1, mt, Nacc);
    bf16x8 atn[2][2], mtn[2], atp[2][2], mtp[2];
#pragma unroll
    for (int s = 0; s < 2; ++s) { float v0[8], v1[8], vm[8], p0[8], p1[8], pm[8];
#pragma unroll
        for (int i = 0; i < 8; ++i) { const int jn = 16 * s + i, jp = 16 * s + 8 * (i >> 2) + (i & 3);
            v0[i] = hs ? V32(at0, jn + 8) : V32(at0, jn); v1[i] = hs ? V32(at1, jn + 8) : V32(at1, jn); vm[i] = hs ? V32(mt, jn + 8) : V32(mt, jn);
            p0[i] = hs ? V32(at0, jp + 4) : V32(at0, jp); p1[i] = hs ? V32(at1, jp + 4) : V32(at1, jp); pm[i] = hs ? V32(mt, jp + 4) : V32(mt, jp); }
        atn[0][s] = pack8(v0); atn[1][s] = pack8(v1); mtn[s] = pack8(vm); atp[0][s] = pack8(p0); atp[1][s] = pack8(p1); mtp[s] = pack8(pm); }
    __builtin_amdgcn_sched_barrier(0);
    { bf16x8 g1f[2]; { float g[16];
#pragma unroll
        for (int r = 0; r < 16; ++r) g[r] = G1acc[r];
        g1f[0] = pack8(g); g1f[1] = pack8(g + 8); }
#pragma unroll
      for (int ct = 0; ct < 2; ++ct) { f32x16 acc;
#pragma unroll
          for (int r = 0; r < 16; ++r) acc[r] = 0.f;
          acc = MFMA32(g1f[0], atp[ct][0], acc); acc = MFMA32(g1f[1], atp[ct][1], acc);
#pragma unroll
          for (int r = 0; r < 16; ++r) { const int t = (r & 3) + 8 * (r >> 2) + 4 * hs, k = 32 * ct + li;
              *(bf16_t*)(UR + RU_YS + sw64(t, kperm(k)) * 2) = f2bf(tile_at(TR, t, k) - acc[r]); } }
      { f32x16 acc;
#pragma unroll
        for (int r = 0; r < 16; ++r) acc[r] = 0.f;
        acc = MFMA32(g1f[0], mtp[0], acc); acc = MFMA32(g1f[1], mtp[1], acc);
#pragma unroll
        for (int r = 0; r < 16; ++r) { const int t = (r & 3) + 8 * (r >> 2) + 4 * hs; *(bf16_t*)(UR + RU_YV + sw32(t, li) * 2) = f2bf(G2Tacc[r] - acc[r]); } } }
    __builtin_amdgcn_sched_barrier(0);
#pragma unroll
    for (int rt = 0; rt < 2; ++rt) { bf16x8 bmf[2];
#pragma unroll
        for (int ks = 0; ks < 2; ++ks)
#pragma unroll
            for (int i = 0; i < 8; ++i) bmf[ks][i] = (short)*(const bf16_t*)(TB + (16 * ks + 8 * hs + i) * TP + (32 * rt + li) * 2);
        float g31[16];
#pragma unroll
        for (int q = 0; q < 4; ++q) { const float4 g4 = *(const float4*)(TAB + 32 * rt + 8 * q + 4 * hs); g31[4 * q] = g4.x; g31[4 * q + 1] = g4.y; g31[4 * q + 2] = g4.z; g31[4 * q + 3] = g4.w; }
#pragma unroll
        for (int ct = 0; ct < 2; ++ct) { f32x16 acc;
#pragma unroll
            for (int r = 0; r < 16; ++r) acc[r] = 0.f;
            acc = MFMA32(bmf[0], atn[ct][0], acc); acc = MFMA32(bmf[1], atn[ct][1], acc);
#pragma unroll
            for (int r = 0; r < 16; ++r) { const int kp = 32 * rt + (r & 3) + 8 * (r >> 2) + 4 * hs, k = 32 * ct + li;
                *(bf16_t*)(UR + RU_PT + sw64(kp, kperm(k)) * 2) = f2bf(g31[r] * ((kp == k ? 1.f : 0.f) - acc[r])); } }
        { f32x16 acc;
#pragma unroll
          for (int r = 0; r < 16; ++r) acc[r] = 0.f;
          acc = MFMA32(bmf[0], mtn[0], acc); acc = MFMA32(bmf[1], mtn[1], acc);
#pragma unroll
          for (int r = 0; r < 16; ++r) { const int kp = 32 * rt + (r & 3) + 8 * (r >> 2) + 4 * hs;
              *(bf16_t*)(UR + RU_QT + sw32(kp, li) * 2) = f2bf(g31[r] * (tile_at(TK, li, kp) - acc[r])); } }
        __builtin_amdgcn_sched_barrier(0); }
    WSYNC();
}
DI int lds_ld(volatile LAS int* p) { return *p; }
constexpr int RS_YST = 4 * RU_BYTES, RS_FLAGS = RS_YST + 8192;
static_assert(RS_FLAGS + 64 <= 8 * WLDS, "scan ring fits the wave regions");
#define RS_SB __builtin_amdgcn_sched_barrier(0)
DI void s_rscan_roles(CtxP c, int l, int slab, float* lds, int bh, int wave, int lane) {
    unsigned char* ring = (unsigned char*)lds; const int b = bh >> 3, h = bh & 7;
    volatile LAS int* F = (volatile LAS int*)((LAS unsigned char*)(unsigned long)RS_FLAGS);
    const unsigned char* ur0 = c->ws + OFF_CK + (size_t)(bh * NC32) * RU_BYTES;
    if (wave >= 4) {
        const int pw = wave - 4, p = pw * 64 + lane; u32x4 pt[4][11];
#define RS_PLOAD(s_, ch_) { const u32x4* src = (const u32x4*)(ur0 + (size_t)(ch_) * RU_BYTES); _Pragma("unroll") for (int k = 0; k < 11; ++k) pt[s_][k] = src[p + 128 * k]; }
        RS_PLOAD(0, 0) RS_PLOAD(1, 1) RS_PLOAD(2, 2) RS_PLOAD(3, 3)
#pragma unroll
        for (int ch0 = 0; ch0 < NC32; ch0 += 4) {
#pragma unroll
            for (int s = 0; s < 4; ++s) { const int ch = ch0 + s;
                while (min(lds_ld(F + 2), lds_ld(F + 3)) < ch - 3) __builtin_amdgcn_s_sleep(1);
                u32x4* dst = (u32x4*)(ring + s * RU_BYTES);
#pragma unroll
                for (int k = 0; k < 11; ++k) dst[p + 128 * k] = pt[s][k];
                asm volatile("s_waitcnt lgkmcnt(0)" ::: "memory");
                if (lane == 0) F[pw] = ch + 1;
                RS_PLOAD(s, min(ch + 4, NC32 - 1)) }
        }
#undef RS_PLOAD
    } else {
        const int hs = lane >> 5, li = lane & 31, v = 32 * wave + li;
        float* CB = (float*)(c->ws + OFF_CARRY + l * CARRY_L + CB_OFF) + ((size_t)bh * 64 + v) * 64;
        f32x16 xa0, xa1;
#pragma unroll
        for (int r = 0; r < 16; ++r) { xa0[r] = slab == 0 ? 0.f : CB[(r & 3) + 8 * (r >> 2) + 4 * hs]; xa1[r] = slab == 0 ? 0.f : CB[32 + (r & 3) + 8 * (r >> 2) + 4 * hs]; }
        unsigned char* ystage = ring + RS_YST + wave * 4096;
        unsigned char* ybase4 = (unsigned char*)((float*)((bf16_t*)(c->ws + OFF_P) + prow_off(b, 0) + B_R) + h * 64 + 32 * wave) + (size_t)(lane >> 3) * (PP * 2) + (lane & 7) * 16;
        unsigned char* ydummy = c->ws + OFF_Y2 + 14 * MiB + wave * 4096 + lane * 16;
        const int oPT0 = RU_PT + sw64(li, 8 * hs) * 2, oPT1 = RU_PT + sw64(32 + li, 8 * hs) * 2, oYS = RU_YS + sw64(li, 8 * hs) * 2;
        bf16x8 op[12];
#define RS_LDPT0(base_, kk) *(const bf16x8*)((base_) + RU_PT + sw64(li, 16 * (kk) + 8 * hs) * 2)
#define RS_LDPT1(base_, kk) *(const bf16x8*)((base_) + RU_PT + sw64(32 + li, 16 * (kk) + 8 * hs) * 2)
#define RS_LDYS(base_, kk) *(const bf16x8*)((base_) + RU_YS + sw64(li, 16 * (kk) + 8 * hs) * 2)
        (void)oPT0; (void)oPT1; (void)oYS;
        while (min(lds_ld(F + 0), lds_ld(F + 1)) < 1) __builtin_amdgcn_s_sleep(1);
        asm volatile("" ::: "memory");
#pragma unroll
        for (int kk = 0; kk < 4; ++kk) { op[kk] = RS_LDPT0(ring, kk); op[4 + kk] = RS_LDPT1(ring, kk); op[8 + kk] = RS_LDYS(ring, kk); }
#pragma unroll 1
        for (int ch = 0; ch < NC32; ++ch) {
            { const int need = min(ch + 2, NC32); while (min(lds_ld(F + 0), lds_ld(F + 1)) < need) __builtin_amdgcn_s_sleep(1); }
            asm volatile("" ::: "memory");
            const unsigned char* base = ring + (ch & 3) * RU_BYTES; const unsigned char* nb = ring + ((ch + 1) & 3) * RU_BYTES;
            unsigned char* yst = ch > 0 ? ybase4 + (size_t)((ch - 1) * 32) * (PP * 2) : ydummy;
            bf16x8 xb0, xb1, xb2, xb3, vt0, vt1, ayv0, ayv1, aq00, aq01, aq10, aq11; u32x4 yq0, yq1, yq2, yq3; f32x16 ya, xn0, xn1, zz;
#pragma unroll
            for (int r = 0; r < 16; ++r) zz[r] = 0.f;
            RS_SB;
            { float g[8];
#pragma unroll
              for (int r = 0; r < 8; ++r) g[r] = xa0[r];
              xb0 = pack8(g); }
            RS_SB; ya = MFMA32(op[8], xb0, zz); RS_SB;
            { float g[8];
#pragma unroll
              for (int r = 0; r < 8; ++r) g[r] = xa0[8 + r];
              xb1 = pack8(g); }
            RS_SB; xn0 = MFMA32(op[0], xb0, zz); RS_SB;
            vt0 = *(const bf16x8*)(base + RU_VT + sw32(v, 8 * hs) * 2); vt1 = *(const bf16x8*)(base + RU_VT + sw32(v, 16 + 8 * hs) * 2);
            ayv0 = *(const bf16x8*)(base + RU_YV + sw32(li, 8 * hs) * 2); ayv1 = *(const bf16x8*)(base + RU_YV + sw32(li, 16 + 8 * hs) * 2);
            RS_SB; xn1 = MFMA32(op[4], xb0, zz); RS_SB;
            aq00 = *(const bf16x8*)(base + RU_QT + sw32(li, 8 * hs) * 2); aq01 = *(const bf16x8*)(base + RU_QT + sw32(li, 16 + 8 * hs) * 2);
            aq10 = *(const bf16x8*)(base + RU_QT + sw32(32 + li, 8 * hs) * 2); aq11 = *(const bf16x8*)(base + RU_QT + sw32(32 + li, 16 + 8 * hs) * 2);
            RS_SB; ya = MFMA32(op[9], xb1, ya); RS_SB;
            { float g[8];
#pragma unroll
              for (int r = 0; r < 8; ++r) g[r] = xa1[r];
              xb2 = pack8(g); }
            RS_SB; xn0 = MFMA32(op[1], xb1, xn0); RS_SB;
            op[8] = RS_LDYS(nb, 0); op[0] = RS_LDPT0(nb, 0);
            RS_SB; xn1 = MFMA32(op[5], xb1, xn1); RS_SB;
            op[4] = RS_LDPT1(nb, 0);
            RS_SB; ya = MFMA32(op[10], xb2, ya); RS_SB;
            { float g[8];
#pragma unroll
              for (int r = 0; r < 8; ++r) g[r] = xa1[8 + r];
              xb3 = pack8(g); }
            RS_SB; xn0 = MFMA32(op[2], xb2, xn0); RS_SB;
            op[9] = RS_LDYS(nb, 1); op[1] = RS_LDPT0(nb, 1);
            RS_SB; xn1 = MFMA32(op[6], xb2, xn1); RS_SB;
            op[5] = RS_LDPT1(nb, 1);
            RS_SB; ya = MFMA32(op[11], xb3, ya); RS_SB;
            op[10] = RS_LDYS(nb, 2); yq0 = *(const u32x4*)(ystage + lane * 16); yq1 = *(const u32x4*)(ystage + 1024 + lane * 16);
            RS_SB; xn0 = MFMA32(op[3], xb3, xn0); RS_SB;
            op[2] = RS_LDPT0(nb, 2); yq2 = *(const u32x4*)(ystage + 2048 + lane * 16); yq3 = *(const u32x4*)(ystage + 3072 + lane * 16);
            RS_SB; xn1 = MFMA32(op[7], xb3, xn1); RS_SB;
            op[6] = RS_LDPT1(nb, 2); op[11] = RS_LDYS(nb, 3);
            RS_SB; ya = MFMA32(ayv0, vt0, ya); RS_SB;
            op[3] = RS_LDPT0(nb, 3); op[7] = RS_LDPT1(nb, 3);
            RS_SB; xn0 = MFMA32(aq00, vt0, xn0); RS_SB;
            *(u32x4*)(yst) = yq0; *(u32x4*)(yst + (size_t)8 * (PP * 2)) = yq1;
            RS_SB; xn1 = MFMA32(aq10, vt0, xn1); RS_SB;
            *(u32x4*)(yst + (size_t)16 * (PP * 2)) = yq2; *(u32x4*)(yst + (size_t)24 * (PP * 2)) = yq3;
            RS_SB; ya = MFMA32(ayv1, vt1, ya); RS_SB;
            xn0 = MFMA32(aq01, vt1, xn0); RS_SB;
            xn1 = MFMA32(aq11, vt1, xn1); RS_SB;
            if (lane == 0) F[2 + wave] = ch + 1;
            RS_SB;
#pragma unroll
            for (int r = 0; r < 16; ++r) *(float*)(ystage + ((r & 3) + 8 * (r >> 2) + 4 * hs) * 128 + li * 4) = ya[r];
            xa0 = xn0; xa1 = xn1;
            RS_SB;
        }
        { u32x4 yq[4];
#pragma unroll
          for (int q = 0; q < 4; ++q) yq[q] = *(const u32x4*)(ystage + q * 1024 + lane * 16);
#pragma unroll
          for (int q = 0; q < 4; ++q) *(u32x4*)(ybase4 + (size_t)((NC32 - 1) * 32 + 8 * q) * (PP * 2)) = yq[q]; }
#undef RS_LDPT0
#undef RS_LDPT1
#undef RS_LDYS
#pragma unroll
        for (int r = 0; r < 16; ++r) { CB[(r & 3) + 8 * (r >> 2) + 4 * hs] = xa0[r]; CB[32 + (r & 3) + 8 * (r >> 2) + 4 * hs] = xa1[r]; }
    }
}
DI void s_phase2(CtxP c, int l, int slab, float* lds, int bid, int nblk) {
    const int tid = otid(), lane = tid & 63, wave = tid >> 6; unsigned char* wl = (unsigned char*)lds + wave * WLDS;
    const int gw = __builtin_amdgcn_readfirstlane(bid * 8 + wave);
    { int ln = lane; w_rprep(c, l, slab, gw, wl, ln); }
    { const int u = __builtin_amdgcn_readfirstlane(bid * 4 + (wave & 3)); int ln = lane;
        asm volatile("" : "+v"(ln) :: "memory"); __builtin_amdgcn_sched_barrier(0);
        if (wave < 4) w_lru<false>(c, l, slab, u, wl, ln, 0, 2); else w_chunkA<false>(c, l, slab, u, wl, ln);
        asm volatile("" : "+v"(ln) :: "memory"); __builtin_amdgcn_sched_barrier(0);
        if (wave >= 4) w_chunkA<true>(c, l, slab, u, wl, ln); }
    if (slab == 0) { bf16_t* halo = (bf16_t*)(c->ws + OFF_CARRY + l * CARRY_L + HALO_OFF);
        for (int i = bid * 512 + tid; i < NB * 3 * PP; i += nblk * 512) { const int b = i / (3 * PP), r = (i / PP) % 3, col = i % PP;
            halo[i] = ((const bf16_t*)(c->ws + OFF_P))[prow_off(b, TS - 3 + r) + col]; } }
}
DI void s_phaseSB(CtxP c, int l, int slab, float* lds, int bid, int nblk) {
    const int tid = otid(), lane = tid & 63, wave = tid >> 6;
    if (tid < 8) ((volatile LAS int*)((LAS unsigned char*)(unsigned long)RS_FLAGS))[tid] = 0;
    __syncthreads();
    if (bid < 32) { if ((wave & 2) == 0) s_rscan_roles(c, l, slab, lds, bid, wave, lane); }
    else s_stepB(c, l, slab, lds, bid - 32, nblk - 32);
}
DI void s_phase3(CtxP c, int l, int slab, float* lds, int bid) {
    const int tid = otid(), lane = tid & 63, wave = tid >> 6; unsigned char* wl = (unsigned char*)lds + wave * WLDS;
    { const int u = __builtin_amdgcn_readfirstlane(bid * 4 + (wave & 3)); int ln = lane;
        asm volatile("" : "+v"(ln) :: "memory"); __builtin_amdgcn_sched_barrier(0);
        if (wave < 4) w_lru<true>(c, l, slab, u, wl, ln, 0, 2); else w_chunkC<false>(c, l, slab, u, wl, ln);
        asm volatile("" : "+v"(ln) :: "memory"); __builtin_amdgcn_sched_barrier(0);
        if (wave >= 4) w_chunkC<true>(c, l, slab, u, wl, ln); }
}
DI float red8(float v) { DPP_ADD(v, 0xB1); DPP_ADD(v, 0x4E); DPP_ADD(v, 0x141); return v; }
DI void s_bpost(CtxP c, int l, int slab, float* lds, int bid, int nblk) {
    const int lane = otid() & 63, gw = bid * 8 + (otid() >> 6), NGW = nblk * 8; const int ch0 = lane * 8, h = lane >> 3;
    float gw8[8], gb8[8], mu8[8];
    { const float4 a0 = *(const float4*)(c->rgn_w + l * G + ch0), a1 = *(const float4*)(c->rgn_w + l * G + ch0 + 4), b0 = *(const float4*)(c->rgn_b + l * G + ch0), b1 = *(const float4*)(c->rgn_b + l * G + ch0 + 4),
          m0 = *(const float4*)(c->rmu + l * 1664 + 1024 + ch0), m1 = *(const float4*)(c->rmu + l * 1664 + 1024 + ch0 + 4);
      gw8[0] = a0.x; gw8[1] = a0.y; gw8[2] = a0.z; gw8[3] = a0.w; gw8[4] = a1.x; gw8[5] = a1.y; gw8[6] = a1.z; gw8[7] = a1.w;
      gb8[0] = b0.x; gb8[1] = b0.y; gb8[2] = b0.z; gb8[3] = b0.w; gb8[4] = b1.x; gb8[5] = b1.y; gb8[6] = b1.z; gb8[7] = b1.w;
      mu8[0] = m0.x; mu8[1] = m0.y; mu8[2] = m0.z; mu8[3] = m0.w; mu8[4] = m1.x; mu8[5] = m1.y; mu8[6] = m1.z; mu8[7] = m1.w; }
    for (int r0 = gw; r0 < MS; r0 += 2 * NGW) {
        float4 wa[2], wb[2]; uint4 xc[2], xq[2], zz[2]; float bon[2]; bf16_t* prw[2];
#pragma unroll
        for (int q = 0; q < 2; ++q) { int r = r0 + q * NGW; r = r < MS ? r : r0; const int b = r / TS, tl = r % TS; prw[q] = (bf16_t*)(c->ws + OFF_P) + prow_off(b, tl);
            wa[q] = *(const float4*)((const float*)(prw[q] + B_R) + ch0); wb[q] = *(const float4*)((const float*)(prw[q] + B_R) + ch0 + 4);
            xc[q] = *(const uint4*)(prw[q] + B_V + ch0); xq[q] = *(const uint4*)(prw[q] - PP + B_V + ch0); zz[q] = *(const uint4*)(prw[q] + ZB + ch0);
            bon[q] = ((const float*)(c->ws + OFF_BON))[(size_t)r * NH + h]; }
#pragma unroll
        for (int q = 0; q < 2; ++q) { if (r0 + q * NGW >= MS) break;
            float w[8] = {wa[q].x, wa[q].y, wa[q].z, wa[q].w, wb[q].x, wb[q].y, wb[q].z, wb[q].w}, x[8], xp[8], z[8], y[8];
            unpack8(xc[q], x); unpack8(xq[q], xp); unpack8(zz[q], z);
            float sm = 0.f;
#pragma unroll
            for (int i = 0; i < 8; ++i) sm += w[i];
            const float mean = red8(sm) * (1.f / 64.f); float vs = 0.f;
#pragma unroll
            for (int i = 0; i < 8; ++i) { w[i] -= mean; vs += w[i] * w[i]; }
            const float rstd = rsqrtf(red8(vs) * (1.f / 64.f) + 1e-5f);
#pragma unroll
            for (int i = 0; i < 8; ++i) { const float vm = x[i] + mu8[i] * (xp[i] - x[i]); y[i] = (w[i] * rstd * gw8[i] + gb8[i] + bon[q] * vm) * siluf(z[i]); }
            *(bf16x8*)(prw[q] + ZB + ch0) = pack8(y); }
    }
}
DI void s_post(CtxP c, int l, int slab, float* lds, int bid, int nblk) {
    const int lane = otid() & 63, gw = bid * 8 + (otid() >> 6), NGW = nblk * 8;
    for (int r0 = gw; r0 < MS; r0 += 2 * NGW) {
        float4 v[2][4], xx[2][4]; float* orow[2];
#pragma unroll
        for (int q = 0; q < 2; ++q) { int r = r0 + q * NGW; r = r < MS ? r : r0; const int b = r / TS, tl = r % TS; const size_t grow = (size_t)b * T + slab * TS + tl;
            const float* yrow = (const float*)(c->ws + OFF_Y) + (size_t)r * D; const bf16_t* y2row = (const bf16_t*)(c->ws + OFF_Y2) + (size_t)r * D;
            const float* xr = (l == 0 ? c->x : c->out) + grow * D; orow[q] = c->out + grow * D;
#pragma unroll
            for (int j = 0; j < 4; ++j) { v[q][j] = *(const float4*)(yrow + j * 256 + lane * 4); xx[q][j] = *(const float4*)(xr + j * 256 + lane * 4);
                const uint2 h2 = *(const uint2*)(y2row + j * 256 + lane * 4);
                v[q][j].x += __uint_as_float(h2.x << 16); v[q][j].y += __uint_as_float(h2.x & 0xffff0000u); v[q][j].z += __uint_as_float(h2.y << 16); v[q][j].w += __uint_as_float(h2.y & 0xffff0000u); } }
#pragma unroll
        for (int q = 0; q < 2; ++q) { const int r = r0 + q * NGW; if (r >= MS) break;
            float ss = 0.f;
#pragma unroll
            for (int j = 0; j < 4; ++j) ss += v[q][j].x * v[q][j].x + v[q][j].y * v[q][j].y + v[q][j].z * v[q][j].z + v[q][j].w * v[q][j].w;
            ss = wave_sum(ss); const float rs = rsqrtf(ss * (1.f / D) + 1e-6f); float s2 = 0.f;
#pragma unroll
            for (int j = 0; j < 4; ++j) { const float4 gg = *(const float4*)(c->norm_post + l * D + j * 256 + lane * 4); float4& o = v[q][j]; const float4 x4 = xx[q][j];
                o.x = x4.x + o.x * rs * gg.x; o.y = x4.y + o.y * rs * gg.y; o.z = x4.z + o.z * rs * gg.z; o.w = x4.w + o.w * rs * gg.w;
                *(float4*)(orow[q] + j * 256 + lane * 4) = o; s2 += o.x * o.x + o.y * o.y + o.z * o.z + o.w * o.w; }
            if (l == 0) { s2 = wave_sum(s2); const float r2 = rsqrtf(s2 * (1.f / D) + 1e-6f); bf16_t* hrow = (bf16_t*)(c->ws + OFF_H) + (size_t)r * D;
#pragma unroll
                for (int j = 0; j < 4; ++j) { const float4 gg = *(const float4*)(c->norm_pre + D + j * 256 + lane * 4); const float4 o = v[q][j];
                    uint2 w; w.x = pk2(o.x * r2 * gg.x, o.y * r2 * gg.y); w.y = pk2(o.z * r2 * gg.z, o.w * r2 * gg.w);
                    *(uint2*)(hrow + j * 256 + lane * 4) = w; } } }
    }
}
namespace pg8 {
#define PG8_LAS __attribute__((address_space(3)))
typedef unsigned short bf16_t;
typedef short bf16x8 __attribute__((ext_vector_type(8)));
typedef float f32x4 __attribute__((ext_vector_type(4)));
typedef unsigned u32x4 __attribute__((ext_vector_type(4)));
constexpr int BM = 256, BK = 64, HALF = 128, HTB = HALF * BK * 2  , STAGE_BYTES = 8 * HTB, NXCD = 8, WGM = 8;

__host__ __device__ __forceinline__ int lds_byte(int r, int c) { const int st = (r >> 4) * 2 + (c >> 5), rr = r & 15, cc = c & 31, ob = rr * 64 + cc * 2; return st * 1024 + (ob ^ (((ob >> 9) & 1) << 5)); }
__host__ __device__ __forceinline__ void stage_rc(int b, int& R, int& C) { const int st = b / 1024, sb = b % 1024, swz = sb ^ (((sb >> 9) & 1) << 5); R = (st >> 1) * 16 + swz / 64; C = (st & 1) * 32 + (swz % 64) / 2; }
__host__ __device__ __forceinline__ int perm32(int rho) { const int n = rho >> 4, i = rho & 15; return 8 * (i >> 2) + 4 * n + (i & 3); }

struct Unit { int pm, pn; };
struct Gemm { const bf16_t* A; const bf16_t* Bt; int M, N, K, lda; };

struct StaticOrder {
    int nM, nN, nwg, G, c;
    __host__ __device__ void init(int M, int N, int G_, int c_) { nM = M / BM; nN = N / BM; nwg = nM * nN; G = G_; c = c_; }
    __host__ __device__ bool next(int i, Unit& u) const {
        const long L = (long)i * G + c; if (L >= nwg) return false;
        int wgid = (int)L; { const int q = nwg / NXCD, r = nwg % NXCD, xcd = wgid % NXCD, off = wgid / NXCD; wgid = (xcd < r ? xcd * (q + 1) : r * (q + 1) + (xcd - r) * q) + off; }
        const int nig = WGM * nN, gid = wgid / nig, fm = gid * WGM, gsz = (nM - fm) < WGM ? (nM - fm) : WGM;
        u.pm = fm + ((wgid % nig) % gsz); u.pn = (wgid % nig) / gsz; return true;
    }
    __device__ __forceinline__ void a_ready(const Unit&) const {}
    __device__ __forceinline__ void done(const Unit&) const {}
};

__device__ __forceinline__ unsigned cvt_pk_bf16(float lo, float hi) { unsigned r; asm volatile("v_cvt_pk_bf16_f32 %0, %1, %2" : "=v"(r) : "v"(lo), "v"(hi)); return r; }
typedef float f32x2 __attribute__((ext_vector_type(2)));
__device__ __forceinline__ f32x2 gelu_pk(f32x2 v) {
    const f32x2 av = __builtin_elementwise_abs(v), d = av * 0.2316418882f + 1.0f;
    f32x2 t; t.x = __builtin_amdgcn_rcpf(d.x); t.y = __builtin_amdgcn_rcpf(d.y);
    f32x2 q = t * 0.5307027145f + (-0.7265760135f); q = q * t + 0.7107068705f; q = q * t + (-0.142248368f); q = q * t + 0.127414796f; q = q * t;
    const f32x2 s = (v * v) * (-0.72134752044f);
    f32x2 e; e.x = __builtin_amdgcn_exp2f(s.x); e.y = __builtin_amdgcn_exp2f(s.y);
    const f32x2 m = v * (q * e), r = v - m;
    f32x2 o; o.x = v.x < 0.f ? m.x : r.x; o.y = v.y < 0.f ? m.y : r.y; return o;
}

template <int ACT  > struct EpiBf16 {
    static constexpr bool PERM = true, AFTER_DRAIN = false; static_assert(ACT == 0 || ACT == 1, "EpiBf16: ACT is 0 (none) or 1 (gelu_pk)");
    bf16_t* O; int ldc; const float* bias; int split_cols; size_t split_stride; float scale0; int rskip;
    __device__ __forceinline__ void operator()(const f32x4 (&acc)[2][2][4][2], const Unit& u, int wr, int wc, int fr, int fq) const {
        const int row0 = u.pm * BM + wr * 64 + fr + (u.pm >> 3) * rskip; int colt = u.pn * BM; bf16_t* base = O;
        float sc = 1.f; if (split_cols) { const int t = colt / split_cols; base += (size_t)t * split_stride; colt -= t * split_cols; if (t == 0) sc = scale0; }
        const int col0 = colt + wc * 32 + 8 * fq, bcol0 = u.pn * BM + wc * 32 + 8 * fq;
        f32x4 bv[2][2];
#pragma unroll
        for (int bj = 0; bj < 2; ++bj)
#pragma unroll
            for (int n = 0; n < 2; ++n) bv[bj][n] = bias ? *(const f32x4*)(bias + bcol0 + bj * HALF + 4 * n) : (f32x4){0.f, 0.f, 0.f, 0.f};
#pragma unroll
        for (int ai = 0; ai < 2; ++ai)
#pragma unroll
            for (int m = 0; m < 4; ++m) { bf16_t* rowp = base + (size_t)(row0 + ai * HALF + m * 16) * ldc + col0;
#pragma unroll
                for (int bj = 0; bj < 2; ++bj) { f32x4 v0 = acc[ai][bj][m][0] + bv[bj][0], v1 = acc[ai][bj][m][1] + bv[bj][1];
                    if (ACT == 1) { f32x2 a = gelu_pk((f32x2){v0[0], v0[1]}), b = gelu_pk((f32x2){v0[2], v0[3]}), c = gelu_pk((f32x2){v1[0], v1[1]}), d = gelu_pk((f32x2){v1[2], v1[3]});
                        v0 = (f32x4){a.x, a.y, b.x, b.y}; v1 = (f32x4){c.x, c.y, d.x, d.y}; }
                    v0 = v0 * sc; v1 = v1 * sc; u32x4 w; w.x = cvt_pk_bf16(v0[0], v0[1]); w.y = cvt_pk_bf16(v0[2], v0[3]); w.z = cvt_pk_bf16(v1[0], v1[1]); w.w = cvt_pk_bf16(v1[2], v1[3]);
                    *(u32x4*)(rowp + bj * HALF) = w; } }
    }
};


struct EpiF32 {
    static constexpr bool PERM = false, AFTER_DRAIN = false;
    float* O; int ldc;
    __device__ __forceinline__ void operator()(const f32x4 (&acc)[2][2][4][2], const Unit& u, int wr, int wc, int fr, int fq) const {
        const int row0 = u.pm * BM + wr * 64 + fr, col0 = u.pn * BM + wc * 32 + 4 * fq;
#pragma unroll
        for (int ai = 0; ai < 2; ++ai)
#pragma unroll
            for (int m = 0; m < 4; ++m) { float* rowp = O + (size_t)(row0 + ai * HALF + m * 16) * ldc + col0;
#pragma unroll
                for (int bj = 0; bj < 2; ++bj)
#pragma unroll
                    for (int n = 0; n < 2; ++n) *(f32x4*)(rowp + bj * HALF + n * 16) = acc[ai][bj][m][n]; }
    }
};
struct EpiSplitK {
    static constexpr bool PERM = false, AFTER_DRAIN = false;
    float* O; bf16_t* O2; int ldc;
    __device__ __forceinline__ void operator()(const f32x4 (&acc)[2][2][4][2], const Unit& u, int wr, int wc, int fr, int fq) const {
        const int row0 = u.pm * BM + wr * 64 + fr, col0 = (u.pn & 3) * BM + wc * 32 + 4 * fq; const bool hi = u.pn >= 4;
#pragma unroll
        for (int ai = 0; ai < 2; ++ai)
#pragma unroll
            for (int m = 0; m < 4; ++m) { const size_t ro = (size_t)(row0 + ai * HALF + m * 16) * ldc + col0;
#pragma unroll
                for (int bj = 0; bj < 2; ++bj)
#pragma unroll
                    for (int n = 0; n < 2; ++n) { const f32x4 v = acc[ai][bj][m][n];
                        if (hi) { unsigned lo = cvt_pk_bf16(v[0], v[1]), hi2 = cvt_pk_bf16(v[2], v[3]); *(uint2*)(O2 + ro + bj * HALF + n * 16) = make_uint2(lo, hi2); }
                        else *(f32x4*)(O + ro + bj * HALF + n * 16) = v; } }
    }
};
template <class Epi, class Sched, bool ALIGN_EPI, bool SP2, int KK, int LDA, int ASKIP, int KSPLIT = 0>
__device__ __forceinline__ void gemm_phase(PG8_LAS unsigned char* lds, const Gemm g, const Sched& S, const Epi& E) {
    const int tid = otid(), wid = __builtin_amdgcn_readfirstlane(tid >> 6), lane = tid & 63, wr = wid >> 2, wc = wid & 3, fr = lane & 15, fq = lane >> 4;
    constexpr int K = KK, nt = K / BK;
    unsigned voffA[2], voffB[2];
#pragma unroll
    for (int i = 0; i < 2; ++i) { int R, C; stage_rc(tid * 16 + i * 8192, R, C); const int Rb = Epi::PERM ? ((R & ~31) + perm32(R & 31)) : R;
        voffA[i] = (unsigned)(R * LDA + C) * 2u; voffB[i] = (unsigned)(Rb * K + C) * 2u; }
    constexpr size_t kstep = (size_t)(BK * 2);
    constexpr size_t hstepA = (size_t)HALF * LDA * 2, hstepB = (size_t)HALF * K * 2;
    constexpr size_t tstepA = 2 * hstepA, tstepB = 2 * hstepB;
    const unsigned ldsw = (unsigned)wid * 1024u;
    const int aoff = lds_byte(wr * 64 + fr, fq * 8), boff = lds_byte(wc * 32 + fr, fq * 8);
#define PG8_SA(b, h) (((b) * 2 + (h)) * HTB)
#define PG8_SB(b, h) ((4 + (b) * 2 + (h)) * HTB)
#define PG8_STAGE(bufoff, gbase, voff) do { _Pragma("unroll") for (int _i = 0; _i < 2; ++_i) \
        __builtin_amdgcn_global_load_lds((const unsigned*)((const char*)(gbase) + (voff)[_i]), (PG8_LAS unsigned*)(lds + (bufoff) + ldsw + _i * 8192), 16, 0, 0); } while (0)
#define PG8_LDA(dst, b, h) do { _Pragma("unroll") for (int m = 0; m < 4; ++m) _Pragma("unroll") for (int k = 0; k < 2; ++k) dst[m][k] = *(const PG8_LAS bf16x8*)(lds + PG8_SA(b, h) + aoff + m * 2048 + k * 1024); } while (0)
#define PG8_LDB(dst, b, h) do { _Pragma("unroll") for (int n = 0; n < 2; ++n) _Pragma("unroll") for (int k = 0; k < 2; ++k) dst[n][k] = *(const PG8_LAS bf16x8*)(lds + PG8_SB(b, h) + boff + n * 2048 + k * 1024); } while (0)
#define PG8_MMA(ai, bj, At, Bt) do { __builtin_amdgcn_s_setprio(1); _Pragma("unroll") for (int m = 0; m < 4; ++m) _Pragma("unroll") for (int n = 0; n < 2; ++n) _Pragma("unroll") for (int k = 0; k < 2; ++k) \
        acc[ai][bj][m][n] = __builtin_amdgcn_mfma_f32_16x16x32_bf16(Bt[n][k], At[m][k], acc[ai][bj][m][n], 0, 0, 0); __builtin_amdgcn_s_setprio(0); } while (0)
#define PG8_WAIT_V(n) asm volatile("s_waitcnt vmcnt(" #n ")" ::: "memory")
#define PG8_WAIT_L(n) asm volatile("s_waitcnt lgkmcnt(" #n ")" ::: "memory")
#define PG8_BAR __builtin_amdgcn_s_barrier()
#define PG8_SCHED __builtin_amdgcn_sched_barrier(0)
    Unit cur, nxt; int ui = 0;
    if (!S.next(0, cur)) return;
    f32x4 acc[2][2][4][2];
#pragma unroll
    for (int a = 0; a < 2; ++a)
#pragma unroll
        for (int b = 0; b < 2; ++b)
#pragma unroll
            for (int m = 0; m < 4; ++m)
#pragma unroll
                for (int n = 0; n < 2; ++n) acc[a][b][m][n] = (f32x4){0.f, 0.f, 0.f, 0.f};
    bf16x8 At[4][2], B0[2][2], B1[2][2];
    const char* cA = (const char*)g.A + (size_t)cur.pm * tstepA + (size_t)(cur.pm >> 3) * (ASKIP * LDA * 2) + (size_t)(KSPLIT ? (cur.pn >> 2) : 0) * (KSPLIT * 2); const char* cB = (const char*)g.Bt + (size_t)cur.pn * tstepB;
    S.a_ready(cur);
    if constexpr (SP2) {
        PG8_STAGE(PG8_SB(0, 0), cB, voffB); PG8_STAGE(PG8_SB(0, 1), cB + hstepB, voffB); PG8_STAGE(PG8_SA(0, 0), cA, voffA); PG8_STAGE(PG8_SA(0, 1), cA + hstepA, voffA);
        if (wr == 1) PG8_BAR;
        PG8_WAIT_V(2); PG8_BAR;
        PG8_STAGE(PG8_SB(1, 0), cB + kstep, voffB); PG8_STAGE(PG8_SA(1, 0), cA + kstep, voffA); PG8_STAGE(PG8_SB(1, 1), cB + hstepB + kstep, voffB);
        PG8_WAIT_V(6); PG8_BAR;
    } else {
        PG8_STAGE(PG8_SB(0, 0), cB, voffB); PG8_STAGE(PG8_SA(0, 0), cA, voffA); PG8_STAGE(PG8_SB(0, 1), cB + hstepB, voffB); PG8_STAGE(PG8_SA(0, 1), cA + hstepA, voffA);
        if (wr == 1) PG8_BAR;
        PG8_WAIT_V(4); PG8_BAR;
        PG8_STAGE(PG8_SB(1, 0), cB + kstep, voffB); PG8_STAGE(PG8_SA(1, 0), cA + kstep, voffA); PG8_STAGE(PG8_SB(1, 1), cB + hstepB + kstep, voffB);
        PG8_WAIT_V(6); PG8_BAR;
    }
    for (;;) {
        const bool has_next = S.next(ui + 1, nxt);
        const char* nA = has_next ? (const char*)g.A + (size_t)nxt.pm * tstepA + (size_t)(nxt.pm >> 3) * (ASKIP * LDA * 2) + (size_t)(KSPLIT ? (nxt.pn >> 2) : 0) * (KSPLIT * 2) : cA; const char* nB = has_next ? (const char*)g.Bt + (size_t)nxt.pn * tstepB : cB;
        for (int t = 0; t < nt; t += 2) {
            const bool last = (t == nt - 2);
            const char* a1 = cA + (size_t)(t + 1) * kstep;
            const char* a2 = last ? nA : cA + (size_t)(t + 2) * kstep; const char* b2 = last ? nB : cB + (size_t)(t + 2) * kstep;
            const char* a3 = a2 + kstep; const char* b3 = b2 + kstep;
            if (last && has_next) S.a_ready(nxt);
            if constexpr (SP2) {
            PG8_LDB(B0, 0, 0); PG8_LDB(B1, 0, 1); PG8_SCHED; PG8_LDA(At, 0, 0); PG8_STAGE(PG8_SA(1, 1), a1 + hstepA, voffA);
            PG8_WAIT_V(8); PG8_WAIT_L(0); PG8_BAR; PG8_MMA(0, 0, At, B0); PG8_MMA(0, 1, At, B1); PG8_BAR; PG8_SCHED;
            PG8_LDA(At, 0, 1); PG8_STAGE(PG8_SB(0, 0), b2, voffB); PG8_STAGE(PG8_SB(0, 1), b2 + hstepB, voffB); PG8_STAGE(PG8_SA(0, 0), a2, voffA);
            PG8_WAIT_V(8); PG8_WAIT_L(0); PG8_BAR; PG8_MMA(1, 0, At, B0); PG8_MMA(1, 1, At, B1); PG8_BAR; PG8_SCHED;
            PG8_LDB(B0, 1, 0); PG8_LDB(B1, 1, 1); PG8_SCHED; PG8_LDA(At, 1, 0); PG8_STAGE(PG8_SA(0, 1), a2 + hstepA, voffA);
            PG8_WAIT_V(8); PG8_WAIT_L(0); PG8_BAR; PG8_MMA(0, 0, At, B0); PG8_MMA(0, 1, At, B1); PG8_BAR; PG8_SCHED;
            PG8_LDA(At, 1, 1); PG8_STAGE(PG8_SB(1, 0), b3, voffB); PG8_STAGE(PG8_SB(1, 1), b3 + hstepB, voffB); PG8_STAGE(PG8_SA(1, 0), a3, voffA);
            PG8_WAIT_V(8); PG8_WAIT_L(0); PG8_BAR; PG8_MMA(1, 0, At, B0); PG8_MMA(1, 1, At, B1); PG8_BAR; PG8_SCHED;
            } else {
            PG8_LDB(B0, 0, 0); PG8_SCHED; PG8_LDA(At, 0, 0); PG8_STAGE(PG8_SA(1, 1), a1 + hstepA, voffA);
            PG8_WAIT_L(8); PG8_BAR; PG8_WAIT_L(0); PG8_MMA(0, 0, At, B0); PG8_BAR; PG8_SCHED;
            PG8_LDB(B1, 0, 1); PG8_STAGE(PG8_SB(0, 0), b2, voffB);
            PG8_BAR; PG8_WAIT_L(0); PG8_MMA(0, 1, At, B1); PG8_BAR;
            PG8_LDA(At, 0, 1); PG8_STAGE(PG8_SA(0, 0), a2, voffA);
            PG8_BAR; PG8_WAIT_L(0); PG8_MMA(1, 0, At, B0); PG8_BAR; PG8_SCHED;
            PG8_STAGE(PG8_SB(0, 1), b2 + hstepB, voffB);
            PG8_WAIT_V(6); PG8_BAR; PG8_MMA(1, 1, At, B1); PG8_BAR;
            PG8_LDB(B0, 1, 0); PG8_SCHED; PG8_LDA(At, 1, 0); PG8_STAGE(PG8_SA(0, 1), a2 + hstepA, voffA);
            PG8_WAIT_L(8); PG8_BAR; PG8_WAIT_L(0); PG8_MMA(0, 0, At, B0); PG8_BAR; PG8_SCHED;
            PG8_LDB(B1, 1, 1); PG8_STAGE(PG8_SB(1, 0), b3, voffB);
            PG8_BAR; PG8_WAIT_L(0); PG8_MMA(0, 1, At, B1); PG8_BAR;
            PG8_LDA(At, 1, 1); PG8_STAGE(PG8_SA(1, 0), a3, voffA);
            PG8_BAR; PG8_WAIT_L(0); PG8_MMA(1, 0, At, B0); PG8_BAR; PG8_SCHED;
            PG8_STAGE(PG8_SB(1, 1), b3 + hstepB, voffB);
            PG8_WAIT_V(6); PG8_BAR; PG8_MMA(1, 1, At, B1); PG8_BAR;
            }
        }
        if constexpr (ALIGN_EPI) { if (wr == 0) PG8_BAR; }
        if constexpr (!Epi::AFTER_DRAIN) { E(acc, cur, wr, wc, fr, fq); S.done(cur); }
        if (!has_next) break;
#pragma unroll
        for (int a = 0; a < 2; ++a)
#pragma unroll
            for (int b = 0; b < 2; ++b)
#pragma unroll
                for (int m = 0; m < 4; ++m)
#pragma unroll
                    for (int n = 0; n < 2; ++n) acc[a][b][m][n] = (f32x4){0.f, 0.f, 0.f, 0.f};
        cur = nxt; cA = nA; cB = nB; ++ui;
        if constexpr (ALIGN_EPI) { if (wr == 1) PG8_BAR; }
    }
    PG8_WAIT_V(0);
    if constexpr (!ALIGN_EPI) { if (wr == 0) PG8_BAR; }
    PG8_BAR;
    if constexpr (Epi::AFTER_DRAIN) { E.fused(acc, cur, wr, wc, fr, fq, lds, wid, lane); S.done(cur); }
#undef PG8_SA
#undef PG8_SB
#undef PG8_STAGE
#undef PG8_LDA
#undef PG8_LDB
#undef PG8_MMA
#undef PG8_WAIT_V
#undef PG8_WAIT_L
#undef PG8_BAR
#undef PG8_SCHED
}
}

#define XB_TMO      128
#define XB_XCNT(j)  (256  + 64 * (j))
#define XB_XSUB(j)  (1280 + 64 * (j))
#define XB_XGEN(j)  (2304 + 64 * (j))
#define XB_TOP      3328
#define XB_TOPGEN   3392
#define XCD_BAR_WORDS 3456
#define XB_SPIN_CAP (1u << 18)
DI unsigned xb_ld(unsigned* p)              { return __hip_atomic_load(p, __ATOMIC_RELAXED, __HIP_MEMORY_SCOPE_AGENT); }
DI unsigned xb_add(unsigned* p, unsigned v) { return __hip_atomic_fetch_add(p, v, __ATOMIC_RELAXED, __HIP_MEMORY_SCOPE_AGENT); }
DI unsigned xb_xcc_id() { return (unsigned)__builtin_amdgcn_s_getreg((3 << 11) | 20) & 0xFu; }
#define XB_SPIN(cond, bar) do { unsigned _sp = 0; while (cond) { __builtin_amdgcn_s_sleep(1); \
    if ((++_sp & 255u) == 0u) { if (xb_ld(&(bar)[XB_TMO])) break; if (_sp > XB_SPIN_CAP) { atomicAdd(&(bar)[XB_TMO], 1u); break; } } } } while (0)
struct XcdBarrier { unsigned* bar; unsigned x; volatile LAS unsigned* st; };
DI XcdBarrier xcd_barrier_post(unsigned* bar, volatile LAS unsigned* st) {
    XcdBarrier b; b.bar = bar; b.x = (unsigned)__builtin_amdgcn_readfirstlane((int)xb_xcc_id()); b.st = st;
    if (threadIdx.x == 0) (void)xb_add(&bar[XB_XCNT(b.x)], 1u);
    return b;
}
DI void xcd_barrier_complete(unsigned* bar, unsigned x, unsigned& nloc, unsigned& nx) {
    const unsigned Gd = gridDim.x * gridDim.y * gridDim.z;
    unsigned sum, cnt, mine, sp = 0u;
    for (;;) {
        sum = 0u; cnt = 0u; mine = 0u;
#pragma unroll
        for (unsigned j = 0; j < 16; ++j) { const unsigned cc = xb_ld(&bar[XB_XCNT(j)]); sum += cc; cnt += (cc > 0u) ? 1u : 0u; mine = (j == x) ? cc : mine; }
        if (sum == Gd) break;
        __builtin_amdgcn_s_sleep(1);
        if ((++sp & 255u) == 0u) { if (xb_ld(&bar[XB_TMO])) break; if (sp > XB_SPIN_CAP) { atomicAdd(&bar[XB_TMO], 1u); break; } }
    }
    nloc = mine > 0u ? mine : 1u; nx = cnt > 0u ? cnt : 1u;
}
DI void xcd_barrier(const XcdBarrier& b) {
    asm volatile("s_waitcnt vmcnt(0)" ::: "memory");
    __syncthreads();
    if (threadIdx.x == 0) {
        unsigned* bar = b.bar; unsigned bx = b.x; asm volatile("" : "+s"(bar), "+s"(bx));
        __builtin_amdgcn_s_waitcnt(0);
        unsigned nloc = b.st[0], nx = b.st[1];
        if (nloc == 0u) { xcd_barrier_complete(bar, bx, nloc, nx); b.st[0] = nloc; b.st[1] = nx; }
        const unsigned old = xb_add(&bar[XB_XSUB(bx)], 1u);
        const unsigned gen = old / nloc;
        if (old + 1u == (gen + 1u) * nloc) {
            __builtin_amdgcn_fence(__ATOMIC_RELEASE, "agent");
            asm volatile("s_waitcnt vmcnt(0)" ::: "memory");
            const unsigned og = xb_add(&bar[XB_TOP], 1u);
            const unsigned tg = og / nx;
            if (og + 1u == (tg + 1u) * nx) xb_add(&bar[XB_TOPGEN], 1u);
            else XB_SPIN(xb_ld(&bar[XB_TOPGEN]) == tg, bar);
            __builtin_amdgcn_fence(__ATOMIC_ACQUIRE, "agent");
            xb_add(&bar[XB_XGEN(bx)], 1u);
            asm volatile("s_waitcnt vmcnt(0)" ::: "memory");
        } else {
            XB_SPIN(xb_ld(&bar[XB_XGEN(bx)]) == gen, bar);
            __builtin_amdgcn_fence(__ATOMIC_ACQUIRE, "agent");
            asm volatile("s_waitcnt vmcnt(0)" ::: "memory");
        }
    }
    __syncthreads();
}
constexpr int LDS_BYTES = 163840, MISC_OFF = 155648 + 320, CW_BAR = 4096;
__global__ void __launch_bounds__(512) mk_fwd(Ctx c_byval) {
    CtxP c = (CtxP)__builtin_amdgcn_kernarg_segment_ptr();
    extern __shared__ __attribute__((aligned(16))) unsigned char ldsraw[];
    float* lds = (float*)ldsraw;
    const int tid = threadIdx.x, bid = blockIdx.x, nblk = gridDim.x;
    volatile LAS unsigned* MISC = (volatile LAS unsigned*)((LAS unsigned char*)ldsraw + MISC_OFF);
    if (tid < 32) MISC[tid] = 0u;
    if ((tid & 63) == 0) ((volatile LAS int*)(unsigned long)WVTAB_OFF)[hw_slot()] = tid >> 6;
    __syncthreads();
    XcdBarrier bar = xcd_barrier_post((unsigned*)(c->ws + OFF_CTL) + CW_BAR, MISC + 8);
    s_p0(c, 0, 0, lds, bid, nblk);
    s_prenorm(c, 0, 0, lds, bid, nblk);
    xcd_barrier(bar);
    for (int slab_ = 0; slab_ < 2; ++slab_)
        for (int l_ = 0; l_ < NL; ++l_) {
            int l = l_, slab = slab_; asm volatile("" : "+s"(l), "+s"(slab));
            { const bf16_t* halo = (const bf16_t*)(c->ws + OFF_CARRY + l * CARRY_L + HALO_OFF); bf16_t* pp = (bf16_t*)(c->ws + OFF_P);
              for (int i = bid * 512 + otid(); i < NB * 3 * PP; i += nblk * 512) { const int b = i / (3 * PP), r = (i / PP) % 3, col = i % PP; pp[prow_off(b, r - 3) + col] = slab == 0 ? (bf16_t)0 : halo[i]; } }
            { pg8::Gemm g{(const bf16_t*)(c->ws + OFF_H), (const bf16_t*)(c->ws + OFF_WIN + l * WIN_L), MS, PP, D, D}; pg8::StaticOrder S; S.init(MS, PP, nblk, bid);
              pg8::EpiBf16<0> E{(bf16_t*)(c->ws + OFF_P) + 3 * PP, PP, nullptr, 0, 0, 1.f, 3};
              pg8::gemm_phase<pg8::EpiBf16<0>, pg8::StaticOrder, true, true, D, D, 0>((LAS unsigned char*)ldsraw, g, S, E); }
            xcd_barrier(bar);
            s_phase2(c, l, slab, lds, bid, nblk);
            xcd_barrier(bar);
            s_phaseSB(c, l, slab, lds, bid, nblk);
            xcd_barrier(bar);
            if (nblk == 256) s_phase3(c, l, slab, lds, bid);
            xcd_barrier(bar);
            s_bpost(c, l, slab, lds, bid, nblk);
            xcd_barrier(bar);
            { pg8::Gemm g{(const bf16_t*)(c->ws + OFF_P) + 3 * PP + ZA, (const bf16_t*)(c->ws + OFF_WOUT + l * WOUT_L), MS, 2 * D, DMIX / 2, PP}; pg8::StaticOrder S; S.init(MS, 2 * D, nblk, bid);
              pg8::EpiSplitK E{(float*)(c->ws + OFF_Y), (bf16_t*)(c->ws + OFF_Y2), D};
              pg8::gemm_phase<pg8::EpiSplitK, pg8::StaticOrder, true, true, DMIX / 2, PP, 3, DMIX / 2>((LAS unsigned char*)ldsraw, g, S, E); }
            xcd_barrier(bar);
            s_post(c, l, slab, lds, bid, nblk);
            if (l == 1 && slab == 0) s_prenorm(c, 0, 1, lds, bid, nblk);
            xcd_barrier(bar);
        }
}

extern "C" void kernel_launch(void* const* d_in, const int* in_sizes, int n_in, void* d_out, int out_size, void* d_ws, size_t ws_size, hipStream_t stream) {
    static int grid = 0;
    if (grid == 0) {
        int dev = 0, cus = 0, per_cu = 0;
        (void)hipGetDevice(&dev);
        (void)hipDeviceGetAttribute(&cus, hipDeviceAttributeMultiprocessorCount, dev);
        (void)hipFuncSetAttribute((const void*)mk_fwd, hipFuncAttributeMaxDynamicSharedMemorySize, LDS_BYTES);
        (void)hipOccupancyMaxActiveBlocksPerMultiprocessor(&per_cu, (const void*)mk_fwd, 512, LDS_BYTES);
        if (per_cu < 1) { fprintf(stderr, "kernel_launch: occupancy query says %d blocks/CU\n", per_cu); per_cu = 1; }
        grid = cus;
        if (grid != 256) fprintf(stderr, "kernel_launch: %d CUs (built for 256)\n", grid);
    }
    Ctx c{};
    const float** f = (const float**)&c;
    for (int i = 0; i < 28; ++i) f[i] = (const float*)d_in[i];
    c.out = (float*)d_out; c.ws = (unsigned char*)d_ws;
    (void)hipMemsetAsync(d_ws, 0, 1 * MiB, stream);
    void* args[] = {&c};
    hipError_t e = hipLaunchCooperativeKernel((const void*)mk_fwd, dim3(grid), dim3(512), args, LDS_BYTES, stream);
    if (e != hipSuccess) fprintf(stderr, "cooperative launch failed: %s (grid %d)\n", hipGetErrorString(e), grid);
}
```

```cpp
#include <hip/hip_runtime.h>
#include <cstdint>
#include <cstdio>

typedef unsigned short bf16_t;
#define DI __device__ __forceinline__
#define LAS __attribute__((address_space(3)))

constexpr int NB = 4, T = 4096, D = 1024, NL = 2, G = 512, NH = 8;
constexpr int TS = 2048, MS = NB * TS, NCS = TS / 64, TSP = TS + 3;
constexpr int DIN = 7824, PP = 7936, DMIX = 2048;
constexpr int A_Q = 0, A_K = 512, A_V = 1024, A_O = 1536, B_R = 2048, B_K = 2560, B_V = 3072, B_WLO = 3584, B_ALO = 3648, C_X = 3712,
              D_Q = 4224, D_K = 4736, D_V = 5248, ZA = 5760, ZB = 6272, ZC = 6784, ZD = 7296, A_I = 7808, A_F = 7816;
constexpr size_t MiB = 1u << 20;
constexpr size_t OFF_CTL = 0, OFF_ZROW = 512 * 1024, OFF_WIN = 1 * MiB, OFF_WOUT = 32 * MiB, OFF_ROPE = 40 * MiB, OFF_CARRY = 41 * MiB,
                 OFF_LS = 45 * MiB, OFF_BON = 45 * MiB + 512 * 1024, OFF_P = 45 * MiB + 768 * 1024, OFF_SA = 170 * MiB, OFF_H = 170 * MiB,
                 OFF_SD = 170 * MiB + 17301504, OFF_CK = 203 * MiB, OFF_Y = 203 * MiB, OFF_Y2 = 235 * MiB,
                 OFF_WRT = 251 * MiB, OFF_WIT = OFF_WRT + 262144, OFF_WUT = OFF_WIT + 262144, OFF_AUT = OFF_WUT + 262144;
constexpr size_t WIN_L = (size_t)PP * D * 2, WOUT_L = (size_t)D * DMIX * 2;
constexpr size_t CARRY_L = 2 * MiB, CA_OFF = 0, CD_OFF = 540672, CB_OFF = CD_OFF + 524288, CC_OFF = CB_OFF + 524288, HALO_OFF = CC_OFF + 8192;
constexpr int SAU = 4224;

struct Ctx {
    const float *x, *norm_pre, *norm_post, *w_in, *w_out, *mconv_w, *mconv_b, *mi_bias, *mf_bias, *mnorm_w, *rmu, *rw_up, *rw0, *ra_up, *ra0,
        *rk_k, *rk_a, *rr_k, *rgn_w, *rgn_b, *lconv_w, *lconv_b, *lw_r, *lb_r, *lw_i, *lb_i, *llam, *retnorm_w;
    float* out; unsigned char* ws;
};
typedef const __attribute__((address_space(4))) Ctx* CtxP;


constexpr int WVTAB_OFF = 155648 + 512;
DI int hw_slot() { return __builtin_amdgcn_s_getreg((5 << 11) | 4) & 63; }
DI int otid() { int lane; asm volatile("v_mbcnt_lo_u32_b32 %0, -1, 0\n\tv_mbcnt_hi_u32_b32 %0, -1, %0" : "=v"(lane));
    const int wv = __builtin_amdgcn_readfirstlane(((volatile LAS int*)(unsigned long)WVTAB_OFF)[hw_slot()]);
    int t = (wv << 6) | lane; asm volatile("" : "+v"(t)); return t; }
DI size_t prow_off(int b, int tl) { return (size_t)(b * TSP + 3 + tl) * PP; }
DI float bf2f(bf16_t v) { return __uint_as_float(((unsigned)v) << 16); }
typedef float f32x2c_t __attribute__((ext_vector_type(2))); typedef __bf16 bf16x2c_t __attribute__((ext_vector_type(2)));
DI bf16_t f2bf(float f) { f32x2c_t v = {f, f}; bf16x2c_t b = __builtin_convertvector(v, bf16x2c_t); return (bf16_t)__builtin_bit_cast(unsigned, b); }
DI float sigm(float x) { return __builtin_amdgcn_rcpf(1.f + __expf(-x)); }
DI float siluf(float x) { return x * __builtin_amdgcn_rcpf(1.f + __expf(-x)); }
DI float tanh_fast(float x) { return 1.f - 2.f * __builtin_amdgcn_rcpf(1.f + __expf(2.f * x)); }
DI float softplusf(float x) { return fmaxf(x, 0.f) + log1pf(expf(-fabsf(x))); }
DI float wave_sum(float v) {
#pragma unroll
    for (int o = 1; o < 64; o <<= 1) v += __shfl_xor(v, o);
    return v;
}
DI int srccol(int n) {
    if (n < 2048) return n;
    if (n < 3712) return n + 528;
    if (n < 4224) return n + 1040;
    if (n < 5760) return n + 1552;
    if (n < 6272) return n - 3712;
    if (n < 6784) return n - 2032;
    if (n < 7296) return n - 1520;
    if (n < 7808) return n + 16;
    if (n < 7824) return n - 5248;
    return -1;
}
DI void wt_item(const float* W, int K, int N, bf16_t* WT, bool permute, float* scr, int item, int lane, bool ksplit = false) {
    const int nblk = (permute ? PP : N) / 32, kb = item / nblk, nb = item % nblk, k0 = 64 * kb, n0 = 32 * nb;
    const int nn = n0 + (lane & 31); const int sc = permute ? srccol(nn) : nn;
    for (int i = 0; i < 32; ++i) { const int kk = 2 * i + (lane >> 5); scr[kk * 33 + (lane & 31)] = sc >= 0 ? W[(size_t)(k0 + kk) * N + sc] : 0.f; }
    __builtin_amdgcn_s_waitcnt(0); __builtin_amdgcn_wave_barrier();
    const int c = lane & 7;
    for (int j = 0; j < 4; ++j) { const int n = (lane >> 3) + 8 * j; const float* s = scr + (8 * c) * 33 + n;
        uint4 o; o.x = f2bf(s[0]) | ((unsigned)f2bf(s[33]) << 16); o.y = f2bf(s[66]) | ((unsigned)f2bf(s[99]) << 16);
        o.z = f2bf(s[132]) | ((unsigned)f2bf(s[165]) << 16); o.w = f2bf(s[198]) | ((unsigned)f2bf(s[231]) << 16);
        if (ksplit) *(uint4*)(WT + (size_t)((k0 >> 10) * N + n0 + n) * (K / 2) + (k0 & 1023) + 8 * c) = o;
        else *(uint4*)(WT + (size_t)(n0 + n) * K + k0 + 8 * c) = o; }
    __builtin_amdgcn_s_waitcnt(0); __builtin_amdgcn_wave_barrier();
}
DI void s_p0(CtxP c, int l, int slab, float* lds, int bid, int nblk) {
    const int tid = otid(), lane = tid & 63, wave = tid >> 6;
    float* scr = lds + wave * (64 * 33);
    const int gw = bid * 8 + wave, NGW = nblk * 8;
    constexpr int I_IN = (D / 64) * (PP / 32), I_OUT = (DMIX / 64) * (D / 32);
    for (int it = gw; it < NL * (I_IN + I_OUT); it += NGW) {
        const int l = it / (I_IN + I_OUT); int r = it % (I_IN + I_OUT);
        if (r < I_IN) wt_item(c->w_in + (size_t)l * D * DIN, D, DIN, (bf16_t*)(c->ws + OFF_WIN + l * WIN_L), true, scr, r, lane);
        else wt_item(c->w_out + (size_t)l * DMIX * D, DMIX, D, (bf16_t*)(c->ws + OFF_WOUT + l * WOUT_L), false, scr, r - I_IN, lane, true);
    }
    { bf16_t* wrt = (bf16_t*)(c->ws + OFF_WRT); bf16_t* wit = (bf16_t*)(c->ws + OFF_WIT); bf16_t* wut = (bf16_t*)(c->ws + OFF_WUT); bf16_t* aut = (bf16_t*)(c->ws + OFF_AUT);
      for (int i = bid * 512 + tid; i < NL * NH * 4096; i += nblk * 512) { const int lh = i >> 12, j = (i >> 6) & 63, ii = i & 63;
          wrt[i] = f2bf(c->lw_r[(size_t)lh * 4096 + ii * 64 + j]); wit[i] = f2bf(c->lw_i[(size_t)lh * 4096 + ii * 64 + j]); }
      for (int i = bid * 512 + tid; i < NL * G * 64; i += nblk * 512) { const int l2 = i / (G * 64), j = (i >> 6) % G, ii = i & 63;
          wut[i] = f2bf(c->rw_up[(size_t)l2 * 64 * G + ii * G + j]); aut[i] = f2bf(c->ra_up[(size_t)l2 * 64 * G + ii * G + j]); } }
    float* rope = (float*)(c->ws + OFF_ROPE);
    for (int i = bid * 512 + tid; i < T * 32; i += nblk * 512) {
        const int t = i >> 5, j = i & 31; const float inv = powf(10000.f, -(float)j / 32.f); const float ang = (float)t * inv;
        rope[2 * i] = cosf(ang); rope[2 * i + 1] = sinf(ang);
    }
}
DI void norm_row(const float* xrow, const float* g, bf16_t* hrow, int lane) {
    float4 v[4]; float ss = 0.f;
#pragma unroll
    for (int j = 0; j < 4; ++j) { v[j] = *(const float4*)(xrow + j * 256 + lane * 4); ss += v[j].x * v[j].x + v[j].y * v[j].y + v[j].z * v[j].z + v[j].w * v[j].w; }
    ss = wave_sum(ss); const float rs = rsqrtf(ss * (1.f / D) + 1e-6f);
#pragma unroll
    for (int j = 0; j < 4; ++j) { const float4 gg = *(const float4*)(g + j * 256 + lane * 4);
        uint2 o; o.x = f2bf(v[j].x * rs * gg.x) | ((unsigned)f2bf(v[j].y * rs * gg.y) << 16); o.y = f2bf(v[j].z * rs * gg.z) | ((unsigned)f2bf(v[j].w * rs * gg.w) << 16);
        *(uint2*)(hrow + j * 256 + lane * 4) = o; }
}
DI void s_prenorm(CtxP c, int l, int slab, float* lds, int bid, int nblk) {
    const int lane = otid() & 63, gw = bid * 8 + (otid() >> 6), NGW = nblk * 8;
    for (int r = gw; r < MS; r += NGW) { const int b = r / TS, tl = r % TS; const size_t grow = (size_t)b * T + slab * TS + tl;
        norm_row(c->x + grow * D, c->norm_pre, (bf16_t*)(c->ws + OFF_H) + (size_t)r * D, lane); }
}
DI float ret_logg(int h) { return log1pf(-exp2f(-5.f - (float)h)); }
DI void s_stepB(CtxP c, int l, int slab, float* lds, int bid, int nblk) {
    const int tid = otid();
    for (int item = bid; item < 288 + 256; item += nblk) {
        if (item < 288) {
            const int bh = item / 9, part = item % 9, el = part * 512 + tid; const bool on = el < 4160;
            float* CA = (float*)(c->ws + OFF_CARRY + l * CARRY_L + CA_OFF) + (size_t)bh * SAU; float* S0 = (float*)(c->ws + OFF_SA) + (size_t)(bh * NCS) * SAU;
            float m = slab == 0 ? 0.f : CA[4160 + slab - 1]; float val = (slab == 0 || !on) ? 0.f : CA[el];
            float loc[NCS], ml[NCS], tt[NCS];
#pragma unroll
            for (int cl = 0; cl < NCS; ++cl) { const float* S = S0 + (size_t)cl * SAU; ml[cl] = S[4160]; tt[cl] = S[4161]; loc[cl] = on ? S[el] : 0.f; }
#pragma unroll
            for (int cl = 0; cl < NCS; ++cl) { float* S = S0 + (size_t)cl * SAU;
                if (on) S[el] = val;
                if (el == 0) S[4162] = m;
                const float mn = fmaxf(tt[cl] + m, ml[cl]); val = expf(tt[cl] + m - mn) * val + expf(ml[cl] - mn) * loc[cl]; m = mn; }
            if (on) CA[el] = val;
            if (el == 0) CA[4160 + slab] = m;
        } else if (item < 288 + 256) {
            const int it = item - 288, bh = it / 8, el = (it % 8) * 512 + tid; const float gch = expf(ret_logg(bh % NH) * 64.f);
            float* CD = (float*)(c->ws + OFF_CARRY + l * CARRY_L + CD_OFF) + (size_t)bh * 4096; float* S0 = (float*)(c->ws + OFF_SD) + (size_t)(bh * NCS) * 4096;
            float val = slab == 0 ? 0.f : CD[el]; float loc[NCS];
#pragma unroll
            for (int cl = 0; cl < NCS; ++cl) loc[cl] = S0[(size_t)cl * 4096 + el];
#pragma unroll
            for (int cl = 0; cl < NCS; ++cl) { S0[(size_t)cl * 4096 + el] = val; val = gch * val + loc[cl]; }
            CD[el] = val;
        } else {
            const int i = (item - 544) * 512 + tid, b = i / G, ch = i % G; float* CC = (float*)(c->ws + OFF_CARRY + l * CARRY_L + CC_OFF);
            float hc = slab == 0 ? 0.f : CC[i]; float2 v[NCS];
#pragma unroll
            for (int cl = 0; cl < NCS; ++cl) v[cl] = *(const float2*)((const float*)(c->ws + OFF_LS) + ((size_t)(b * NCS + cl) * G + ch) * 2);
#pragma unroll
            for (int cl = 0; cl < NCS; ++cl) { ((float*)(c->ws + OFF_LS))[((size_t)(b * NCS + cl) * G + ch) * 2] = hc; hc = v[cl].x * hc + v[cl].y; }
            CC[i] = hc;
        }
    }
}
typedef short bf16x8 __attribute__((ext_vector_type(8)));
typedef float f32x16 __attribute__((ext_vector_type(16)));
typedef float f32x2_t __attribute__((ext_vector_type(2)));
typedef __bf16 bf16x2_t __attribute__((ext_vector_type(2)));
DI unsigned pk2(float lo, float hi) { f32x2_t v = {lo, hi}; bf16x2_t b = __builtin_convertvector(v, bf16x2_t); return __builtin_bit_cast(unsigned, b); }
DI bf16x8 pack8(const float* v) { uint4 u; u.x = pk2(v[0], v[1]); u.y = pk2(v[2], v[3]); u.z = pk2(v[4], v[5]); u.w = pk2(v[6], v[7]); return __builtin_bit_cast(bf16x8, u); }
DI void unpack8(uint4 u, float* v) { v[0] = __uint_as_float(u.x << 16); v[1] = __uint_as_float(u.x & 0xffff0000u); v[2] = __uint_as_float(u.y << 16); v[3] = __uint_as_float(u.y & 0xffff0000u);
    v[4] = __uint_as_float(u.z << 16); v[5] = __uint_as_float(u.z & 0xffff0000u); v[6] = __uint_as_float(u.w << 16); v[7] = __uint_as_float(u.w & 0xffff0000u); }
#define MFMA32(a, b, c) __builtin_amdgcn_mfma_f32_32x32x16_bf16((a), (b), (c), 0, 0, 0)
#define WSYNC() do { __builtin_amdgcn_fence(__ATOMIC_RELEASE, "wavefront"); __builtin_amdgcn_wave_barrier(); __builtin_amdgcn_fence(__ATOMIC_ACQUIRE, "wavefront"); } while (0)
DI float wave_psum(float v, int lane) {
#pragma unroll
    for (int o = 1; o < 64; o <<= 1) { const float t = __shfl_up(v, o); if (lane >= o) v += t; }
    return v;
}
DI float wave_pmax(float v, int lane) {
#pragma unroll
    for (int o = 1; o < 64; o <<= 1) { const float t = __shfl_up(v, o); if (lane >= o) v = fmaxf(v, t); }
    return v;
}
DI float wave_max(float v) {
#pragma unroll
    for (int o = 1; o < 64; o <<= 1) v = fmaxf(v, __shfl_xor(v, o));
    return v;
}
constexpr int TP = 144;
constexpr int WLDS = 19456;
#define TILE_K(NR) (((NR) * 8 + 63) / 64)
typedef unsigned u32x4 __attribute__((ext_vector_type(4)));
template <int NR> DI void tile_load(u32x4 (&tv)[TILE_K(NR)], const bf16_t* rb  , int tl_first, int col, int lane) {
#pragma unroll
    for (int k = 0; k < (NR * 8 + 63) / 64; ++k) { const int i = lane + 64 * k; int r = i >> 3; r = r < NR ? r : NR - 1; const int ch = i & 7;
        tv[k] = *(const u32x4*)(rb + (tl_first + r) * PP + col + ch * 8); }
}
template <int NR> DI void tile_store(const u32x4 (&tv)[TILE_K(NR)], unsigned char* tile, int lane) {
#pragma unroll
    for (int k = 0; k < (NR * 8 + 63) / 64; ++k) { const int i = lane + 64 * k; const int r = i >> 3, ch = i & 7;
        if (i < NR * 8) *(u32x4*)(tile + r * TP + ch * 16) = tv[k]; }
    WSYNC();
}
DI void proc_conv_tile(unsigned char* tile, const float* cw, int cws, const float* cb, float scale, int lane) {
    const int ch = lane & 7; float w[4][8], bb[8];
#pragma unroll
    for (int t = 0; t < 4; ++t) { const float4 a = *(const float4*)(cw + t * cws + ch * 8), d = *(const float4*)(cw + t * cws + ch * 8 + 4);
        w[t][0] = a.x; w[t][1] = a.y; w[t][2] = a.z; w[t][3] = a.w; w[t][4] = d.x; w[t][5] = d.y; w[t][6] = d.z; w[t][7] = d.w; }
    { const float4 a = *(const float4*)(cb + ch * 8), d = *(const float4*)(cb + ch * 8 + 4); bb[0] = a.x; bb[1] = a.y; bb[2] = a.z; bb[3] = a.w; bb[4] = d.x; bb[5] = d.y; bb[6] = d.z; bb[7] = d.w; }
#pragma unroll
    for (int k = 0; k < 8; ++k) { const int row = (lane >> 3) + 8 * k; float acc[8];
#pragma unroll
        for (int i = 0; i < 8; ++i) acc[i] = bb[i];
#pragma unroll
        for (int t = 0; t < 4; ++t) { float x[8]; unpack8(*(const uint4*)(tile + (row + t) * TP + ch * 16), x);
#pragma unroll
            for (int i = 0; i < 8; ++i) acc[i] += x[i] * w[t][i]; }
#pragma unroll
        for (int i = 0; i < 8; ++i) acc[i] = siluf(acc[i]) * scale;
        const bf16x8 res = pack8(acc); WSYNC();
        *(bf16x8*)(tile + row * TP + ch * 16) = res; }
    WSYNC();
}
DI void proc_rope_tile(unsigned char* tile, const float* ropet, int pos0, float scale, int lane) {
    const int p = lane & 3;
#pragma unroll
    for (int k = 0; k < 4; ++k) { const int row = (lane >> 2) + 16 * k; float x1[8], x2[8], o1[8], o2[8];
        unpack8(*(const uint4*)(tile + row * TP + p * 16), x1); unpack8(*(const uint4*)(tile + row * TP + (p + 4) * 16), x2);
        const float* cs = ropet + ((size_t)(pos0 + row) * 32 + p * 8) * 2;
#pragma unroll
        for (int q = 0; q < 4; ++q) { const float4 v = *(const float4*)(cs + 4 * q);
            o1[2 * q] = (x1[2 * q] * v.x - x2[2 * q] * v.y) * scale; o2[2 * q] = (x2[2 * q] * v.x + x1[2 * q] * v.y) * scale;
            o1[2 * q + 1] = (x1[2 * q + 1] * v.z - x2[2 * q + 1] * v.w) * scale; o2[2 * q + 1] = (x2[2 * q + 1] * v.z + x1[2 * q + 1] * v.w) * scale; }
        *(bf16x8*)(tile + row * TP + p * 16) = pack8(o1); *(bf16x8*)(tile + row * TP + (p + 4) * 16) = pack8(o2); asm volatile("" ::: "memory"); }
    WSYNC();
}
DI bf16x8 frag_nat(const unsigned char* tile, int row, int ch) { return *(const bf16x8*)(tile + row * TP + ch * 16); }
DI float tile_at(const unsigned char* tile, int row, int col) { return bf2f(*(const bf16_t*)(tile + row * TP + col * 2)); }
typedef short s16x4 __attribute__((ext_vector_type(4)));
DI unsigned tr_lane_off(int lane) { return (unsigned)(((lane & 15) >> 2) * TP + (16 * ((lane >> 4) & 1) + 4 * (lane & 3)) * 2); }
DI s16x4 tr_rd(const unsigned char* tile, unsigned lane_off, int row0, int col0) {
    return __builtin_amdgcn_ds_read_tr16_b64_v4i16((LAS s16x4*)(unsigned long)((unsigned)(unsigned long)tile + lane_off + (unsigned)(row0 * TP + col0 * 2))); }
DI bf16x8 tr_frag(const unsigned char* tile, unsigned lane_off, int row0, int row1, int col0) { const s16x4 a = tr_rd(tile, lane_off, row0, col0), b = tr_rd(tile, lane_off, row1, col0);
    return __builtin_shufflevector(a, b, 0, 1, 2, 3, 4, 5, 6, 7); }

template <bool RET> DI void w_chunkA(CtxP c, int l, int slab, int u, unsigned char* wl, int lane) {
    const int bh = u / NCS, cl = u % NCS, b = bh >> 3, h = bh & 7, tl0 = cl * 64, hs = lane >> 5, li = lane & 31;
    unsigned char* tile = wl; float* tab = (float*)(wl + 9728); const bf16_t* rb = (const bf16_t*)(c->ws + OFF_P) + prow_off(b, 0);
    float* S = RET ? (float*)(c->ws + OFF_SD) + (size_t)u * 4096 : (float*)(c->ws + OFF_SA) + (size_t)u * SAU;
    float mloc = 0.f, tot = 0.f;
    u32x4 rk64[TILE_K(64)], rv64[TILE_K(64)], rk67[TILE_K(67)];
    if (RET) tile_load<64>(rk64, rb, tl0, D_K + h * 64, lane); else tile_load<67>(rk67, rb, tl0 - 3, A_K + h * 64, lane);
    tile_load<64>(rv64, rb, tl0, (RET ? D_V : A_V) + h * 64, lane);
    if (RET) { tab[lane] = expf(ret_logg(h) * (float)(63 - lane)); }
    else { const bf16_t* gr = (const bf16_t*)(c->ws + OFF_P) + prow_off(b, tl0 + lane);
        const float ig = bf2f(gr[A_I + h]) + c->mi_bias[l * NH + h]; const float lf = -softplusf(-(bf2f(gr[A_F + h]) + c->mf_bias[l * NH + h]));
        const float cum = wave_psum(lf, lane); tot = __int_as_float(__builtin_amdgcn_readlane(__float_as_int(cum), 63)); const float lw = tot - cum + ig; mloc = wave_max(lw); tab[lane] = expf(lw - mloc); }
    if (RET) { tile_store<64>(rk64, tile, lane); proc_rope_tile(tile, (const float*)(c->ws + OFF_ROPE), slab * TS + tl0, 0.125f, lane); }
    else { tile_store<67>(rk67, tile, lane); proc_conv_tile(tile, c->mconv_w + l * 4096 + 512 + h * 64, 1024, c->mconv_b + l * 1024 + 512 + h * 64, 0.125f, lane); }
    bf16x8 kf[2][4]; float nl[2] = {0.f, 0.f};
#pragma unroll
    for (int db = 0; db < 2; ++db)
#pragma unroll
        for (int ks = 0; ks < 4; ++ks) { kf[db][ks] = tr_frag(tile, tr_lane_off(lane), 16 * ks + 8 * hs, 16 * ks + 8 * hs + 4, 32 * db);
#pragma unroll
            for (int j = 0; j < 8; ++j) nl[db] += tab[16 * ks + 8 * hs + j] * bf2f((bf16_t)kf[db][ks][j]); }
    WSYNC();
    tile_store<64>(rv64, tile, lane);
    f32x16 acc[2][2];
#pragma unroll
    for (int eb = 0; eb < 2; ++eb)
#pragma unroll
        for (int db = 0; db < 2; ++db)
#pragma unroll
            for (int r = 0; r < 16; ++r) acc[eb][db][r] = 0.f;
#pragma unroll
    for (int eb = 0; eb < 2; ++eb)
#pragma unroll
        for (int ks = 0; ks < 4; ++ks) { float v[8]; const bf16x8 vr = tr_frag(tile, tr_lane_off(lane), 16 * ks + 8 * hs, 16 * ks + 8 * hs + 4, 32 * eb);
#pragma unroll
            for (int j = 0; j < 8; ++j) v[j] = bf2f((bf16_t)vr[j]) * tab[16 * ks + 8 * hs + j];
            const bf16x8 vf = pack8(v);
#pragma unroll
            for (int db = 0; db < 2; ++db) acc[eb][db] = MFMA32(vf, kf[db][ks], acc[eb][db]); }
#pragma unroll
    for (int eb = 0; eb < 2; ++eb)
#pragma unroll
        for (int db = 0; db < 2; ++db)
#pragma unroll
            for (int r = 0; r < 16; ++r) S[(32 * eb + (r & 3) + 8 * (r >> 2) + 4 * hs) * 64 + 32 * db + li] = acc[eb][db][r];
    if (!RET) {
#pragma unroll
        for (int db = 0; db < 2; ++db) { nl[db] += __shfl_xor(nl[db], 32); if (hs == 0) S[4096 + 32 * db + li] = nl[db]; }
        if (lane == 0) { S[4160] = mloc; S[4161] = tot; } }
    WSYNC();
}
template <bool RET> DI void w_chunkC(CtxP c, int l, int slab, int u, unsigned char* wl, int lane) {
    const int bh = u / NCS, cl = u % NCS, b = bh >> 3, h = bh & 7, tl0 = cl * 64, hs = lane >> 5, li = lane & 31;
    unsigned char* tile = wl; float* tab = (float*)(wl + 9728); const bf16_t* rb = (const bf16_t*)(c->ws + OFF_P) + prow_off(b, 0);
    const float* S = RET ? (const float*)(c->ws + OFF_SD) + (size_t)u * 4096 : (const float*)(c->ws + OFF_SA) + (size_t)u * SAU;
    const float lg = RET ? ret_logg(h) : 0.f;
    float mx_t[2] = {0.f, 0.f}, sc_t[2], dnf_t[2] = {0.f, 0.f};
    if (RET) { sc_t[0] = expf(lg * (float)(li + 1)); sc_t[1] = expf(lg * (float)(li + 33)); }
    else { const bf16_t* gr = (const bf16_t*)(c->ws + OFF_P) + prow_off(b, tl0 + lane);
        const float ig = bf2f(gr[A_I + h]) + c->mi_bias[l * NH + h]; const float lf = -softplusf(-(bf2f(gr[A_F + h]) + c->mf_bias[l * NH + h]));
        const float cum = wave_psum(lf, lane); const float a = ig - cum; const float g = wave_pmax(a, lane);
        const float mst = S[4162]; const float mx = fmaxf(mst, g); const float sint = expf(mst - mx); const float dnf = expf(-(cum + mx));
        tab[lane] = a;
        mx_t[0] = __shfl(mx, li); mx_t[1] = __shfl(mx, 32 + li); sc_t[0] = __shfl(sint, li); sc_t[1] = __shfl(sint, 32 + li); dnf_t[0] = __shfl(dnf, li); dnf_t[1] = __shfl(dnf, 32 + li); }
    u32x4 rk64[TILE_K(64)], rq64[TILE_K(64)], rv64[TILE_K(64)], rk67[TILE_K(67)], rq67[TILE_K(67)];
    if (RET) { tile_load<64>(rk64, rb, tl0, D_K + h * 64, lane); tile_load<64>(rq64, rb, tl0, D_Q + h * 64, lane); }
    else { tile_load<67>(rk67, rb, tl0 - 3, A_K + h * 64, lane); tile_load<67>(rq67, rb, tl0 - 3, A_Q + h * 64, lane); }
    bf16x8 kf[2][4], qf[2][4], cf[2][4];
#pragma unroll
    for (int eb = 0; eb < 2; ++eb)
#pragma unroll
        for (int ks = 0; ks < 4; ++ks) { const float* cp = S + (32 * eb + li) * 64 + 16 * ks + 8 * hs; const float4 c0 = *(const float4*)cp, c1 = *(const float4*)(cp + 4);
            const float cv[8] = {c0.x, c0.y, c0.z, c0.w, c1.x, c1.y, c1.z, c1.w}; cf[eb][ks] = pack8(cv); }
    do { asm volatile("" ::: "memory"); __builtin_amdgcn_sched_barrier(0); } while (0);
    if (RET) { tile_store<64>(rk64, tile, lane); proc_rope_tile(tile, (const float*)(c->ws + OFF_ROPE), slab * TS + tl0, 0.125f, lane); }
    else { tile_store<67>(rk67, tile, lane); proc_conv_tile(tile, c->mconv_w + l * 4096 + 512 + h * 64, 1024, c->mconv_b + l * 1024 + 512 + h * 64, 0.125f, lane); }
#pragma unroll
    for (int mb = 0; mb < 2; ++mb)
#pragma unroll
        for (int ks = 0; ks < 4; ++ks) kf[mb][ks] = frag_nat(tile, 32 * mb + li, 2 * ks + hs);
    WSYNC(); __builtin_amdgcn_sched_barrier(0);
    tile_load<64>(rv64, rb, tl0, (RET ? D_V : A_V) + h * 64, lane);
    if (RET) { tile_store<64>(rq64, tile, lane); proc_rope_tile(tile, (const float*)(c->ws + OFF_ROPE), slab * TS + tl0, 1.f, lane); }
    else { tile_store<67>(rq67, tile, lane); proc_conv_tile(tile, c->mconv_w + l * 4096 + h * 64, 1024, c->mconv_b + l * 1024 + h * 64, 1.f, lane); }
#pragma unroll
    for (int nb = 0; nb < 2; ++nb)
#pragma unroll
        for (int ks = 0; ks < 4; ++ks) qf[nb][ks] = frag_nat(tile, 32 * nb + li, 2 * ks + hs);
    WSYNC(); __builtin_amdgcn_sched_barrier(0);
    tile_store<64>(rv64, tile, lane);
    const int zc = (RET ? ZD : ZA) + h * 64; const float* nw = (RET ? c->retnorm_w : c->mnorm_w) + l * G + h * 64;
#pragma unroll
    for (int nb = 0; nb < 2; ++nb) {
        bf16_t* prw = (bf16_t*)(c->ws + OFF_P) + prow_off(b, tl0 + 32 * nb + li);
        uint2 ogr[2][4], zvr[2][4];
#pragma unroll
        for (int eb = 0; eb < 2; ++eb)
#pragma unroll
            for (int rg = 0; rg < 4; ++rg) { const int e0 = 32 * eb + 8 * rg + 4 * hs; zvr[eb][rg] = *(const uint2*)(prw + zc + e0); ogr[eb][rg] = RET ? make_uint2(0u, 0u) : *(const uint2*)(prw + A_O + h * 64 + e0); }
        bf16x8 xf[2][2]; float csum = 0.f;
#pragma unroll
        for (int mb = 0; mb < 2; ++mb) {
            if (!RET && mb == 1 && nb == 0) continue;
            f32x16 sa;
#pragma unroll
            for (int r = 0; r < 16; ++r) sa[r] = 0.f;
#pragma unroll
            for (int ks = 0; ks < 4; ++ks) sa = MFMA32(kf[mb][ks], qf[nb][ks], sa);
            float xv[16];
#pragma unroll
            for (int rg = 0; rg < 4; ++rg) { float av[4] = {0.f, 0.f, 0.f, 0.f};
                if (!RET) { const float4 t4 = *(const float4*)(tab + 32 * mb + 8 * rg + 4 * hs); av[0] = t4.x; av[1] = t4.y; av[2] = t4.z; av[3] = t4.w; }
#pragma unroll
                for (int i = 0; i < 4; ++i) { const int r = 4 * rg + i, s = 32 * mb + 8 * rg + 4 * hs + i, t = 32 * nb + li;
                    float w;
                    if (RET) w = __expf(lg * fabsf((float)(t - s))); else w = s <= t ? __expf(av[i] - mx_t[nb]) : 0.f;
                    xv[r] = sa[r] * w; csum += xv[r]; } }
            xf[mb][0] = pack8(xv); xf[mb][1] = pack8(xv + 8); __builtin_amdgcn_sched_barrier(0); }
        f32x16 o[2];
#pragma unroll
        for (int eb = 0; eb < 2; ++eb) {
#pragma unroll
            for (int r = 0; r < 16; ++r) o[eb][r] = 0.f;
#pragma unroll
            for (int ks = 0; ks < 4; ++ks) o[eb] = MFMA32(cf[eb][ks], qf[nb][ks], o[eb]);
#pragma unroll
            for (int r = 0; r < 16; ++r) o[eb][r] *= sc_t[nb]; }
        __builtin_amdgcn_sched_barrier(0);
        float dn = 1.f;
        if (!RET) { float qn = 0.f;
#pragma unroll
            for (int ks = 0; ks < 4; ++ks) { const float4 n0 = *(const float4*)(S + 4096 + 16 * ks + 8 * hs), n1 = *(const float4*)(S + 4096 + 16 * ks + 8 * hs + 4);
                const float nv[8] = {n0.x, n0.y, n0.z, n0.w, n1.x, n1.y, n1.z, n1.w}; float qv[8]; unpack8(__builtin_bit_cast(uint4, qf[nb][ks]), qv);
#pragma unroll
                for (int j = 0; j < 8; ++j) qn += qv[j] * nv[j]; }
            qn += __shfl_xor(qn, 32); csum += __shfl_xor(csum, 32); dn = fmaxf(fabsf(csum + sc_t[nb] * qn), dnf_t[nb]); }
#pragma unroll
        for (int eb = 0; eb < 2; ++eb)
#pragma unroll
            for (int sb = 0; sb < 2; ++sb) {
                if (!RET && sb == 1 && nb == 0) continue;
#pragma unroll
                for (int st = 0; st < 2; ++st) { const bf16x8 vf = tr_frag(tile, tr_lane_off(lane), 32 * sb + 16 * st + 4 * hs, 32 * sb + 16 * st + 8 + 4 * hs, 32 * eb);
                    o[eb] = MFMA32(vf, xf[sb][st], o[eb]); }
                do { asm volatile("" ::: "memory"); __builtin_amdgcn_sched_barrier(0); } while (0); }
        do { asm volatile("" ::: "memory"); __builtin_amdgcn_sched_barrier(0); } while (0);
        const float inv = 1.f / dn; float sum = 0.f;
#pragma unroll
        for (int eb = 0; eb < 2; ++eb)
#pragma unroll
            for (int rg = 0; rg < 4; ++rg) { const int e0 = 32 * eb + 8 * rg + 4 * hs; float og[4] = {1.f, 1.f, 1.f, 1.f};
                if (!RET) { const uint2 ov = ogr[eb][rg]; og[0] = sigm(__uint_as_float(ov.x << 16)); og[1] = sigm(__uint_as_float(ov.x & 0xffff0000u)); og[2] = sigm(__uint_as_float(ov.y << 16)); og[3] = sigm(__uint_as_float(ov.y & 0xffff0000u)); }
#pragma unroll
                for (int i = 0; i < 4; ++i) { const float v = o[eb][4 * rg + i] * inv * og[i]; o[eb][4 * rg + i] = v; sum += v; } }
        sum += __shfl_xor(sum, 32); const float mu = sum * (1.f / 64.f); float vs = 0.f;
#pragma unroll
        for (int eb = 0; eb < 2; ++eb)
#pragma unroll
            for (int r = 0; r < 16; ++r) { const float d = o[eb][r] - mu; vs += d * d; }
        vs += __shfl_xor(vs, 32); const float rstd = rsqrtf(vs * (1.f / 64.f) + 1e-5f);
#pragma unroll
        for (int eb = 0; eb < 2; ++eb)
#pragma unroll
            for (int rg = 0; rg < 4; ++rg) { const int e0 = 32 * eb + 8 * rg + 4 * hs; const uint2 zv = zvr[eb][rg]; const float4 w4 = *(const float4*)(nw + e0);
                const float z[4] = {__uint_as_float(zv.x << 16), __uint_as_float(zv.x & 0xffff0000u), __uint_as_float(zv.y << 16), __uint_as_float(zv.y & 0xffff0000u)}; const float wv[4] = {w4.x, w4.y, w4.z, w4.w}; float y[4];
#pragma unroll
                for (int i = 0; i < 4; ++i) y[i] = (o[eb][4 * rg + i] - mu) * rstd * wv[i] * siluf(z[i]);
                uint2 ov; ov.x = pk2(y[0], y[1]); ov.y = pk2(y[2], y[3]); *(uint2*)(prw + zc + e0) = ov; }
        do { asm volatile("" ::: "memory"); __builtin_amdgcn_sched_barrier(0); } while (0);
    }
    WSYNC(); __builtin_amdgcn_sched_barrier(0);
}
DI void proc_conv_tile_lin(unsigned char* tile, const float* cw, int cws, const float* cb, int lane) {
    const int ch = lane & 7; float w[4][8], bb[8];
#pragma unroll
    for (int t = 0; t < 4; ++t) { const float4 a = *(const float4*)(cw + t * cws + ch * 8), d = *(const float4*)(cw + t * cws + ch * 8 + 4);
        w[t][0] = a.x; w[t][1] = a.y; w[t][2] = a.z; w[t][3] = a.w; w[t][4] = d.x; w[t][5] = d.y; w[t][6] = d.z; w[t][7] = d.w; }
    { const float4 a = *(const float4*)(cb + ch * 8), d = *(const float4*)(cb + ch * 8 + 4); bb[0] = a.x; bb[1] = a.y; bb[2] = a.z; bb[3] = a.w; bb[4] = d.x; bb[5] = d.y; bb[6] = d.z; bb[7] = d.w; }
#pragma unroll
    for (int k = 0; k < 8; ++k) { const int row = (lane >> 3) + 8 * k; float acc[8];
#pragma unroll
        for (int i = 0; i < 8; ++i) acc[i] = bb[i];
#pragma unroll
        for (int t = 0; t < 4; ++t) { float x[8]; unpack8(*(const uint4*)(tile + (row + t) * TP + ch * 16), x);
#pragma unroll
            for (int i = 0; i < 8; ++i) acc[i] += x[i] * w[t][i]; }
        const bf16x8 res = pack8(acc); WSYNC();
        *(bf16x8*)(tile + row * TP + ch * 16) = res; }
    WSYNC();
}
DI void lru_gates(CtxP c, int l, int h, int jb, const unsigned char* tile, const bf16x8 (&xf)[2][4], float (&a)[2][16], float (&u)[2][16], int li, int hs) {
    const int j = 32 * jb + li, ch = h * 64 + j;
    const bf16_t* wr = (const bf16_t*)(c->ws + OFF_WRT) + ((size_t)(l * NH + h) * 64 + j) * 64; const bf16_t* wi = (const bf16_t*)(c->ws + OFF_WIT) + ((size_t)(l * NH + h) * 64 + j) * 64;
    bf16x8 wrf[4], wif[4];
#pragma unroll
    for (int ks = 0; ks < 4; ++ks) { wrf[ks] = *(const bf16x8*)(wr + 16 * ks + 8 * hs); wif[ks] = *(const bf16x8*)(wi + 16 * ks + 8 * hs); }
    const float br = c->lb_r[l * G + ch], bi = c->lb_i[l * G + ch], sp8 = -8.f * softplusf(-c->llam[l * G + ch]);
#pragma unroll
    for (int tb = 0; tb < 2; ++tb) { f32x16 ar, ai;
#pragma unroll
        for (int r = 0; r < 16; ++r) { ar[r] = 0.f; ai[r] = 0.f; }
#pragma unroll
        for (int ks = 0; ks < 4; ++ks) { ar = MFMA32(xf[tb][ks], wrf[ks], ar); ai = MFMA32(xf[tb][ks], wif[ks], ai); }
#pragma unroll
        for (int r = 0; r < 16; ++r) { const int t = 32 * tb + (r & 3) + 8 * (r >> 2) + 4 * hs; const float x = tile_at(tile, t, j);
            const float la = sp8 * sigm(ar[r] + br); const float av = __expf(la); a[tb][r] = av; u[tb][r] = __builtin_amdgcn_sqrtf(fmaxf(1.f - av * av, 0.f)) * (sigm(ai[r] + bi) * x); } }
}
template <bool STEP_C, bool LOOKBACK = false> DI void w_lru(CtxP c, int l, int slab, int u_, unsigned char* wl, int lane, int jb_lo, int jb_hi) {
    const int bh = u_ / NCS, cl = u_ % NCS, b = bh >> 3, h = bh & 7, tl0 = cl * 64, hs = lane >> 5, li = lane & 31;
    unsigned char* tile = wl; const bf16_t* rb = (const bf16_t*)(c->ws + OFF_P) + prow_off(b, 0);
    { u32x4 rx[TILE_K(67)]; tile_load<67>(rx, rb, tl0 - 3, C_X + h * 64, lane); tile_store<67>(rx, tile, lane); }
    proc_conv_tile_lin(tile, c->lconv_w + l * 2048 + h * 64, 512, c->lconv_b + l * 512 + h * 64, lane);
    bf16x8 xf[2][4];
#pragma unroll
    for (int tb = 0; tb < 2; ++tb)
#pragma unroll
        for (int ks = 0; ks < 4; ++ks) xf[tb][ks] = frag_nat(tile, 32 * tb + li, 2 * ks + hs);
#pragma unroll 1
    for (int jb = jb_lo; jb < jb_hi; ++jb) {
        float a[2][16], u[2][16];
        lru_gates(c, l, h, jb, tile, xf, a, u, li, hs);
        const int ch = h * 64 + 32 * jb + li; float* LS = (float*)(c->ws + OFF_LS) + ((size_t)(b * NCS + cl) * G + ch) * 2;
        float cst = 0.f, pr = 1.f;
        if (LOOKBACK) {
            float lp = 1.f, lc = 0.f;
#pragma unroll
            for (int tb = 0; tb < 2; ++tb)
#pragma unroll
                for (int q = 0; q < 4; ++q) { float ga = 1.f, gu = 0.f;
#pragma unroll
                    for (int i = 0; i < 4; ++i) { gu = a[tb][4 * q + i] * gu + u[tb][4 * q + i]; ga *= a[tb][4 * q + i]; }
                    const float pa = __shfl_xor(ga, 32), pu = __shfl_xor(gu, 32);
                    const float a0 = hs ? pa : ga, u0 = hs ? pu : gu, a1 = hs ? ga : pa, u1 = hs ? gu : pu;
                    lc = a1 * (a0 * lc + u0) + u1; lp *= a0 * a1; }
            const unsigned tag = (unsigned)(slab * 2 + l + 1) & 3u;
            if (hs == 0) { const unsigned long long pk = (unsigned long long)((__float_as_uint(lp) & ~3u) | tag) | ((unsigned long long)__float_as_uint(lc) << 32);
                __hip_atomic_store((unsigned long long*)LS, pk, __ATOMIC_RELAXED, __HIP_MEMORY_SCOPE_AGENT); }
            { const unsigned long long* L0q = (const unsigned long long*)((const float*)(c->ws + OFF_LS) + ((size_t)(b * NCS) * G + ch) * 2);
              float hc = slab == 0 ? 0.f : ((const float*)(c->ws + OFF_CARRY + l * CARRY_L + CC_OFF))[b * G + ch];
#pragma unroll 1
              for (int c0 = 0; c0 < cl; c0 += 8) { unsigned long long pv[8];
                  for (;;) { bool ok = true;
#pragma unroll
                      for (int i = 0; i < 8; ++i) { pv[i] = __hip_atomic_load(L0q + (size_t)min(c0 + i, cl - 1) * G, __ATOMIC_RELAXED, __HIP_MEMORY_SCOPE_AGENT); ok = ok && (((unsigned)pv[i] & 3u) == tag); }
                      if (__builtin_amdgcn_ballot_w64(!ok) == 0ull) break;
                      __builtin_amdgcn_s_sleep(2); }
#pragma unroll
                  for (int i = 0; i < 8; ++i) hc = c0 + i < cl ? __uint_as_float((unsigned)pv[i]) * hc + __uint_as_float((unsigned)(pv[i] >> 32)) : hc; }
              cst = hc; } }
        if (STEP_C && !LOOKBACK) {
            float* CC = (float*)(c->ws + OFF_CARRY + l * CARRY_L + CC_OFF) + b * G + ch; const f32x2_t* L0p = (const f32x2_t*)((const float*)(c->ws + OFF_LS) + ((size_t)(b * NCS) * G + ch) * 2);
            float hc = slab == 0 ? 0.f : *CC;
#pragma unroll 1
            for (int c0 = 0; c0 < cl; c0 += 8) { f32x2_t pv[8];
#pragma unroll
                for (int i = 0; i < 8; ++i) pv[i] = L0p[(size_t)min(c0 + i, NCS - 1) * G];
#pragma unroll
                for (int i = 0; i < 8; ++i) hc = c0 + i < cl ? pv[i][0] * hc + pv[i][1] : hc; }
            cst = hc; }
#pragma unroll
        for (int tb = 0; tb < 2; ++tb)
#pragma unroll
            for (int q = 0; q < 4; ++q) {
                float ga = 1.f, gu = 0.f;
#pragma unroll
                for (int i = 0; i < 4; ++i) { gu = a[tb][4 * q + i] * gu + u[tb][4 * q + i]; ga *= a[tb][4 * q + i]; }
                const float pa = __shfl_xor(ga, 32), pu = __shfl_xor(gu, 32);
                const float a0 = hs ? pa : ga, u0 = hs ? pu : gu, a1 = hs ? ga : pa, u1 = hs ? gu : pu;
                if (STEP_C) { float hv = hs ? a0 * cst + u0 : cst;
#pragma unroll
                    for (int i = 0; i < 4; ++i) { hv = a[tb][4 * q + i] * hv + u[tb][4 * q + i]; u[tb][4 * q + i] = hv; } }
                cst = a1 * (a0 * cst + u0) + u1; pr *= a0 * a1; }
        if (!STEP_C) { if (hs == 0) { LS[0] = pr; LS[1] = cst; } }
        else {
            if (cl == NCS - 1 && slab == 0 && hs == 0) ((float*)(c->ws + OFF_CARRY + l * CARRY_L + CC_OFF))[b * G + ch] = cst;
#pragma unroll
            for (int tb = 0; tb < 2; ++tb)
#pragma unroll
                for (int r = 0; r < 16; ++r) { const int t = 32 * tb + (r & 3) + 8 * (r >> 2) + 4 * hs; bf16_t* pz = (bf16_t*)(c->ws + OFF_P) + prow_off(b, tl0 + t) + ZC + ch;
                    *pz = f2bf(u[tb][r] * siluf(bf2f(*pz))); } }
        asm volatile("" ::: "memory"); __builtin_amdgcn_sched_barrier(0);
    }
    WSYNC();
}
#define DPP_ADD(v, ctrl) v += __builtin_bit_cast(float, __builtin_amdgcn_update_dpp(0, __builtin_bit_cast(int, v), ctrl, 0xF, 0xF, true))
DI float allred16(float v) { DPP_ADD(v, 0xB1); DPP_ADD(v, 0x4E); DPP_ADD(v, 0x141); DPP_ADD(v, 0x140); return v; }
DI float shx(int lane, float v, int m) { return __builtin_bit_cast(float, __builtin_amdgcn_ds_bpermute((lane ^ m) << 2, __builtin_bit_cast(int, v))); }
DI float allred32(float v, int lane) { v = allred16(v); v += shx(lane, v, 16); return v; }
template <bool TANH> DI void proc_shift_tile(unsigned char* tile, const float* mu, int lane) {
    const int ch = lane & 7; float m[8];
    { const float4 a = *(const float4*)(mu + ch * 8), d = *(const float4*)(mu + ch * 8 + 4); m[0] = a.x; m[1] = a.y; m[2] = a.z; m[3] = a.w; m[4] = d.x; m[5] = d.y; m[6] = d.z; m[7] = d.w; }
#pragma unroll
    for (int k = 0; k < 8; ++k) { const int row = (lane >> 3) + 8 * k; float xp[8], x[8];
        unpack8(*(const uint4*)(tile + row * TP + ch * 16), xp); unpack8(*(const uint4*)(tile + (row + 1) * TP + ch * 16), x);
#pragma unroll
        for (int i = 0; i < 8; ++i) { const float v = x[i] + m[i] * (xp[i] - x[i]); x[i] = TANH ? tanh_fast(v) : v; }
        const bf16x8 res = pack8(x); WSYNC();
        *(bf16x8*)(tile + row * TP + ch * 16) = res; }
    WSYNC();
}
constexpr int RU_PT = 0, RU_QT = 8192, RU_YS = 12288, RU_YV = 16384, RU_VT = 18432, RU_BYTES = 22528, NC32 = TS / 32;
DI int sw64(int row, int e) { return row * 64 + ((((e >> 3) ^ (row >> 1)) & 7) << 3) + (e & 7); }
DI int sw32(int row, int e) { return row * 32 + ((((e >> 3) ^ (row >> 2)) & 3) << 3) + (e & 7); }
DI int kperm(int k) { return (k & ~12) | ((k & 4) << 1) | ((k & 8) >> 1); }
template <bool TANH> DI void proc_shift_tile32(unsigned char* tile, const float* mu, int lane) {
    const int ch = lane & 7; float m[8];
    { const float4 a = *(const float4*)(mu + ch * 8), d = *(const float4*)(mu + ch * 8 + 4); m[0] = a.x; m[1] = a.y; m[2] = a.z; m[3] = a.w; m[4] = d.x; m[5] = d.y; m[6] = d.z; m[7] = d.w; }
#pragma unroll
    for (int k = 0; k < 4; ++k) { const int row = (lane >> 3) + 8 * k; float xp[8], x[8];
        unpack8(*(const uint4*)(tile + row * TP + ch * 16), xp); unpack8(*(const uint4*)(tile + (row + 1) * TP + ch * 16), x);
#pragma unroll
        for (int i = 0; i < 8; ++i) { const float v = x[i] + m[i] * (xp[i] - x[i]); x[i] = TANH ? tanh_fast(v) : v; }
        const bf16x8 res = pack8(x); WSYNC();
        *(bf16x8*)(tile + row * TP + ch * 16) = res; }
    WSYNC();
}
#define V32(x, i) x[(i) >> 4][(i) & 15]
template <int T> struct FSub { static DI void run(f32x16 (&a0)[2], f32x16 (&m)[2], const f32x16& N) {
    FSub<T - 1>::run(a0, m, N);
#pragma unroll
    for (int j = 0; j < T; ++j) { const float nv = N[(j & 3) + 4 * (j >> 3)]; const float s = __int_as_float(__builtin_amdgcn_readlane(__float_as_int(nv), T + 32 * ((j >> 2) & 1)));
        V32(a0, T) -= V32(a0, j) * s; V32(m, T) -= V32(m, j) * s; }
    if ((T & 3) == 3) __builtin_amdgcn_sched_barrier(0); } };
template <> struct FSub<0> { static DI void run(f32x16 (&)[2], f32x16 (&)[2], const f32x16&) {} };
DI void w_rprep(CtxP c, int l, int slab, int u_, unsigned char* wl, int lane) {
    const int bh = u_ / NC32, c32 = u_ % NC32, b = bh >> 3, h = bh & 7, tl0 = c32 * 32, hs = lane >> 5, li = lane & 31;
    unsigned char *RA = wl, *RB = wl + 4752, *TA = wl + 9504, *TB = wl + 14112, *TK = wl, *TR = wl + 4608; float* TAB = (float*)(wl + 18720);
    unsigned char* UR = c->ws + OFF_CK + (size_t)u_ * RU_BYTES;
    const float* mu = c->rmu + l * 1664; const bf16_t* rb = (const bf16_t*)(c->ws + OFF_P) + prow_off(b, 0);
    bf16x8 wlf[4], alf[4];
    { u32x4 rw[TILE_K(33)], ra[TILE_K(33)], rr_[TILE_K(33)], rk_[TILE_K(33)];
      tile_load<33>(rw, rb, tl0 - 1, B_WLO, lane); tile_load<33>(ra, rb, tl0 - 1, B_ALO, lane);
      tile_store<33>(rw, RA, lane);
      tile_load<33>(rr_, rb, tl0 - 1, B_R + h * 64, lane); tile_load<33>(rk_, rb, tl0 - 1, B_K + h * 64, lane);
      proc_shift_tile32<true>(RA, mu + 1536, lane);
#pragma unroll
      for (int ks = 0; ks < 4; ++ks) wlf[ks] = frag_nat(RA, li, 2 * ks + hs);
      WSYNC();
      tile_store<33>(ra, RA, lane); proc_shift_tile32<false>(RA, mu + 1600, lane);
#pragma unroll
      for (int ks = 0; ks < 4; ++ks) alf[ks] = frag_nat(RA, li, 2 * ks + hs);
      WSYNC();
      tile_store<33>(rr_, RA, lane); tile_store<33>(rk_, RB, lane); }
    __builtin_amdgcn_sched_barrier(0);
    f32x2_t rs2[8], bonp2[8];
    { float kk[2], mk[2];
#pragma unroll
      for (int jb = 0; jb < 2; ++jb) { kk[jb] = c->rk_k[l * G + h * 64 + 32 * jb + li]; mk[jb] = mu[512 + h * 64 + 32 * jb + li]; }
#pragma unroll
      for (int r = 0; r < 16; ++r) { const int t = (r & 3) + 8 * (r >> 2) + 4 * hs; float ss = 0.f;
#pragma unroll
          for (int jb = 0; jb < 2; ++jb) { const float x = tile_at(RB, t + 1, 32 * jb + li), xp = tile_at(RB, t, 32 * jb + li); const float kap = (x + mk[jb] * (xp - x)) * kk[jb]; ss += kap * kap; }
          rs2[r >> 1][r & 1] = rsqrtf(allred32(ss, lane) + 1e-12f); bonp2[r >> 1][r & 1] = 0.f; } }
    __builtin_amdgcn_sched_barrier(0);
    f32x2_t kq2[2][8], rq2[2][8];
#pragma unroll
    for (int jb = 0; jb < 2; ++jb) {
        const int j = 32 * jb + li, ch = h * 64 + j;
        const bf16_t* wu = (const bf16_t*)(c->ws + OFF_WUT) + ((size_t)l * G + ch) * 64; const bf16_t* au = (const bf16_t*)(c->ws + OFF_AUT) + ((size_t)l * G + ch) * 64;
        bf16x8 wuf[4], auf[4];
#pragma unroll
        for (int ks = 0; ks < 4; ++ks) { wuf[ks] = *(const bf16x8*)(wu + 16 * ks + 8 * hs); auf[ks] = *(const bf16x8*)(au + 16 * ks + 8 * hs); }
        const float w0 = c->rw0[l * G + ch], a0 = c->ra0[l * G + ch], kkj = c->rk_k[l * G + ch], kaj = c->rk_a[l * G + ch], rkj = c->rr_k[l * G + ch], mr = mu[ch], mk = mu[512 + ch];
        f32x16 dl, da;
#pragma unroll
        for (int r = 0; r < 16; ++r) { dl[r] = 0.f; da[r] = 0.f; }
#pragma unroll
        for (int ks = 0; ks < 4; ++ks) { dl = MFMA32(wlf[ks], wuf[ks], dl); da = MFMA32(alf[ks], auf[ks], da); }
        __builtin_amdgcn_sched_barrier(0);
        f32x2_t wq2[8];
#pragma unroll
        for (int p = 0; p < 8; ++p) { f32x2_t z = {dl[2 * p], dl[2 * p + 1]}; z = (z + w0) * -1.44269504f; f32x2_t e = {__builtin_amdgcn_exp2f(z[0]), __builtin_amdgcn_exp2f(z[1])}; e = e + 1.f;
            f32x2_t q = {__builtin_amdgcn_rcpf(e[0]), __builtin_amdgcn_rcpf(e[1])}; q = q * (-0.606531f * 1.44269504f); wq2[p] = (f32x2_t){__builtin_amdgcn_exp2f(q[0]), __builtin_amdgcn_exp2f(q[1])}; }
        f32x2_t Gc2[8], Gm2[8];
        { float gp[4], pp[4];
#pragma unroll
          for (int q = 0; q < 4; ++q) { gp[q] = (wq2[2 * q][0] * wq2[2 * q][1]) * (wq2[2 * q + 1][0] * wq2[2 * q + 1][1]); pp[q] = shx(lane, gp[q], 32); }
          float run = 1.f;
#pragma unroll
          for (int q = 0; q < 4; ++q) { const float g0 = hs ? pp[q] : gp[q], g1 = hs ? gp[q] : pp[q]; float cur = hs ? run * g0 : run;
#pragma unroll
              for (int i = 0; i < 4; ++i) { const int r = 4 * q + i; Gm2[r >> 1][r & 1] = cur; cur *= wq2[r >> 1][r & 1]; Gc2[r >> 1][r & 1] = cur; }
              run = run * g0 * g1; } }
        if (hs) TAB[j] = Gc2[7][1];
#pragma unroll
        for (int p = 0; p < 8; ++p) { const int r = 2 * p, t = (r & 3) + 8 * (r >> 2) + 4 * hs;
            f32x2_t za = {da[r], da[r + 1]}; za = (za + a0) * -1.44269504f; f32x2_t ea = {__builtin_amdgcn_exp2f(za[0]), __builtin_amdgcn_exp2f(za[1])}; ea = ea + 1.f;
            const f32x2_t a = {__builtin_amdgcn_rcpf(ea[0]), __builtin_amdgcn_rcpf(ea[1])};
            const float ra0_ = tile_at(RA, t, j), ra1_ = tile_at(RA, t + 1, j), ra2_ = tile_at(RA, t + 2, j), rb0_ = tile_at(RB, t, j), rb1_ = tile_at(RB, t + 1, j), rb2_ = tile_at(RB, t + 2, j);
            f32x2_t x = {ra1_, ra2_}, xp = {ra0_, ra1_}; const f32x2_t rm = x + (xp - x) * mr;
            x = (f32x2_t){rb1_, rb2_}; xp = (f32x2_t){rb0_, rb1_}; const f32x2_t km = x + (xp - x) * mk;
            const f32x2_t kh = km * (rs2[p] * kkj), kt = km * ((a - 1.f) * kaj + 1.f);
            bonp2[p] = bonp2[p] + rm * kt * rkj;
            const f32x2_t gi = {__builtin_amdgcn_rcpf(Gc2[p][0]), __builtin_amdgcn_rcpf(Gc2[p][1])};
            const f32x2_t al = Gm2[p] * kh, be = a * kh * gi;
            const unsigned pa = pk2(al[0], al[1]), pb = pk2(be[0], be[1]);
            *(bf16_t*)(TA + t * TP + j * 2) = (bf16_t)pa; *(bf16_t*)(TA + (t + 1) * TP + j * 2) = (bf16_t)(pa >> 16);
            *(bf16_t*)(TB + t * TP + j * 2) = (bf16_t)pb; *(bf16_t*)(TB + (t + 1) * TP + j * 2) = (bf16_t)(pb >> 16);
            kq2[jb][p] = kt * gi; rq2[jb][p] = Gc2[p] * rm;
            if ((p & 1) == 1) { asm volatile("" ::: "memory"); __builtin_amdgcn_sched_barrier(0); } }
    }
#pragma unroll
    for (int r = 0; r < 16; ++r) { const float bsum = allred32(bonp2[r >> 1][r & 1], lane); const int t = (r & 3) + 8 * (r >> 2) + 4 * hs;
        if (li == 0) ((float*)(c->ws + OFF_BON))[(size_t)(b * TS + tl0 + t) * NH + h] = bsum; }
    WSYNC();
#pragma unroll
    for (int jb = 0; jb < 2; ++jb)
#pragma unroll
        for (int r = 0; r < 16; ++r) { const int t = (r & 3) + 8 * (r >> 2) + 4 * hs, j = 32 * jb + li;
            *(bf16_t*)(TK + t * TP + j * 2) = f2bf(kq2[jb][r >> 1][r & 1]); *(bf16_t*)(TR + t * TP + j * 2) = f2bf(rq2[jb][r >> 1][r & 1]); }
    { const int vch = h * 64 + lane; const float muv = mu[1024 + vch]; const bf16_t* pv = rb + B_V + vch;
      float xs[33];
#pragma unroll
      for (int t = 0; t < 33; ++t) xs[t] = bf2f(pv[(size_t)(tl0 - 1 + t) * PP]);
      unsigned pk[16];
#pragma unroll
      for (int t = 0; t < 16; ++t) pk[t] = pk2(xs[2 * t + 1] + muv * (xs[2 * t] - xs[2 * t + 1]), xs[2 * t + 2] + muv * (xs[2 * t + 1] - xs[2 * t + 2]));
#pragma unroll
      for (int q = 0; q < 4; ++q) *(uint4*)(UR + RU_VT + sw32(lane, 8 * q) * 2) = make_uint4(pk[4 * q], pk[4 * q + 1], pk[4 * q + 2], pk[4 * q + 3]); }
    WSYNC(); __builtin_amdgcn_sched_barrier(0);
    f32x16 Nacc, G1acc, MTacc, G2Tacc;
#pragma unroll
    for (int r = 0; r < 16; ++r) { Nacc[r] = 0.f; G1acc[r] = 0.f; MTacc[r] = 0.f; G2Tacc[r] = 0.f; }
#pragma unroll
    for (int ks = 0; ks < 4; ++ks) { const bf16x8 fA = frag_nat(TA, li, 2 * ks + hs), fB = frag_nat(TB, li, 2 * ks + hs), fK = frag_nat(TK, li, 2 * ks + hs), fR = frag_nat(TR, li, 2 * ks + hs);
        Nacc = MFMA32(fB, fA, Nacc); G1acc = MFMA32(fB, fR, G1acc); MTacc = MFMA32(fA, fK, MTacc); G2Tacc = MFMA32(fR, fK, G2Tacc); }
#pragma unroll
    for (int r = 0; r < 16; ++r) { const int rr = (r & 3) + 8 * (r >> 2) + 4 * hs;
        Nacc[r] = rr < li ? Nacc[r] : 0.f; G1acc[r] = rr <= li ? G1acc[r] : 0.f; MTacc[r] = li < rr ? MTacc[r] : 0.f; G2Tacc[r] = li <= rr ? G2Tacc[r] : 0.f; }
    __builtin_amdgcn_sched_barrier(0);
    f32x16 ca[2], mt[2];
#pragma unroll
    for (int t = 0; t < 32; ++t) V32(ca, t) = tile_at(TA, t, 32 * hs + li);
#pragma unroll
    for (int r = 0; r < 16; ++r) { const float own = MTacc[r], oth = shx(lane, own, 32); const int t0 = (r & 3) + 8 * (r >> 2), t1 = t0 + 4;
        V32(mt, t0) = hs ? oth : own; V32(mt, t1) = hs ? own : oth; }
    FSub<31>::run(ca, mt, Nacc);
    bf16x8 atn[2][2], mtn[2], atp[2][2], mtp[2];
#pragma unroll
    for (int s = 0; s < 2; ++s) { float un[8], wn[8], up[8], wp[8], vm[8], pm[8];
#pragma unroll
        for (int i = 0; i < 8; ++i) { const int jn = 16 * s + i, jp = 16 * s + 8 * (i >> 2) + (i & 3);
            un[i] = V32(ca, jn); wn[i] = V32(ca, jn + 8); up[i] = V32(ca, jp); wp[i] = V32(ca, jp + 4);
            vm[i] = hs ? V32(mt, jn + 8) : V32(mt, jn); pm[i] = hs ? V32(mt, jp + 4) : V32(mt, jp); }
        u32x4 Un = __builtin_bit_cast(u32x4, pack8(un)), Wn = __builtin_bit_cast(u32x4, pack8(wn)), Up = __builtin_bit_cast(u32x4, pack8(up)), Wp = __builtin_bit_cast(u32x4, pack8(wp));
#pragma unroll
        for (int d = 0; d < 4; ++d) { auto rn = __builtin_amdgcn_permlane32_swap(Un[d], Wn[d], false, false); Un[d] = rn[0]; Wn[d] = rn[1];
            auto rp = __builtin_amdgcn_permlane32_swap(Up[d], Wp[d], false, false); Up[d] = rp[0]; Wp[d] = rp[1]; }
        atn[0][s] = __builtin_bit_cast(bf16x8, Un); atn[1][s] = __builtin_bit_cast(bf16x8, Wn); atp[0][s] = __builtin_bit_cast(bf16x8, Up); atp[1][s] = __builtin_bit_cast(bf16x8, Wp);
        mtn[s] = pack8(vm); mtp[s] = pack8(pm); }
    __builtin_amdgcn_sched_barrier(0);
    const unsigned E2l = (2u * (unsigned)kperm(li)) ^ ((unsigned)hs << 5);
    const unsigned Lsw[2] = {(unsigned)hs * 512u + E2l, (unsigned)hs * 512u + (E2l ^ 16u)};
    const unsigned Ysw0 = (unsigned)hs * 256u + ((2u * (unsigned)li) ^ ((unsigned)hs << 4)); const unsigned Ysw[2] = {Ysw0, Ysw0 ^ 32u};
    unsigned char* const URys = UR + RU_YS; unsigned char* const URyv = UR + RU_YV; unsigned char* const URqt = UR + RU_QT;
#define RS_OFF64(r_, ct_) (128 * (((r_) & 3) + 8 * ((r_) >> 2)) + 64 * ((ct_) ^ (((r_) >> 2) & 1)))
#define RS_L64(r_) Lsw[((r_) & 3) >> 1]
#define RS_OFF32(r_) (64 * (((r_) & 3) + 8 * ((r_) >> 2)))
#define RS_Y32(r_) Ysw[((r_) >> 2) & 1]
    { bf16x8 g1f[2]; { float g[16];
#pragma unroll
        for (int r = 0; r < 16; ++r) g[r] = G1acc[r];
        g1f[0] = pack8(g); g1f[1] = pack8(g + 8); }
#pragma unroll
      for (int ct = 0; ct < 2; ++ct) { f32x16 acc;
#pragma unroll
          for (int r = 0; r < 16; ++r) acc[r] = 0.f;
          acc = MFMA32(g1f[0], atp[ct][0], acc); acc = MFMA32(g1f[1], atp[ct][1], acc);
#pragma unroll
          for (int r = 0; r < 16; ++r) { const int t = (r & 3) + 8 * (r >> 2) + 4 * hs, k = 32 * ct + li;
              *(bf16_t*)(URys + RS_OFF64(r, ct) + RS_L64(r)) = f2bf(tile_at(TR, t, k) - acc[r]); } }
      { f32x16 acc;
#pragma unroll
        for (int r = 0; r < 16; ++r) acc[r] = 0.f;
        acc = MFMA32(g1f[0], mtp[0], acc); acc = MFMA32(g1f[1], mtp[1], acc);
#pragma unroll
        for (int r = 0; r < 16; ++r) { const int t = (r & 3) + 8 * (r >> 2) + 4 * hs; *(bf16_t*)(URyv + RS_OFF32(r) + RS_Y32(r)) = f2bf(G2Tacc[r] - acc[r]); (void)t; } } }
    __builtin_amdgcn_sched_barrier(0);
#pragma unroll
    for (int rt = 0; rt < 2; ++rt) { bf16x8 bmf[2];
#pragma unroll
        for (int ks = 0; ks < 2; ++ks)
            bmf[ks] = tr_frag(TB, tr_lane_off(lane), 16 * ks + 8 * hs, 16 * ks + 8 * hs + 4, 32 * rt);
        float g31[16];
#pragma unroll
        for (int q = 0; q < 4; ++q) { const float4 g4 = *(const float4*)(TAB + 32 * rt + 8 * q + 4 * hs); g31[4 * q] = g4.x; g31[4 * q + 1] = g4.y; g31[4 * q + 2] = g4.z; g31[4 * q + 3] = g4.w; }
#pragma unroll
        for (int ct = 0; ct < 2; ++ct) { f32x16 acc;
#pragma unroll
            for (int r = 0; r < 16; ++r) acc[r] = 0.f;
            acc = MFMA32(bmf[0], atn[ct][0], acc); acc = MFMA32(bmf[1], atn[ct][1], acc);
#pragma unroll
            for (int r = 0; r < 16; ++r) { const int kp = 32 * rt + (r & 3) + 8 * (r >> 2) + 4 * hs, k = 32 * ct + li;
                *(bf16_t*)(UR + 4096 * rt + RS_OFF64(r, ct) + RS_L64(r)) = f2bf(g31[r] * ((kp == k ? 1.f : 0.f) - acc[r])); } }
        { f32x16 acc;
#pragma unroll
          for (int r = 0; r < 16; ++r) acc[r] = 0.f;
          acc = MFMA32(bmf[0], mtn[0], acc); acc = MFMA32(bmf[1], mtn[1], acc);
#pragma unroll
          for (int r = 0; r < 16; ++r) { const int kp = 32 * rt + (r & 3) + 8 * (r >> 2) + 4 * hs;
              *(bf16_t*)(URqt + 2048 * rt + RS_OFF32(r) + RS_Y32(r)) = f2bf(g31[r] * (tile_at(TK, li, kp) - acc[r])); } }
        __builtin_amdgcn_sched_barrier(0); }
#undef RS_OFF64
#undef RS_L64
#undef RS_OFF32
#undef RS_Y32
    WSYNC();
}
DI int lds_ld(volatile LAS int* p) { return *p; }
constexpr int RS_YST = 4 * RU_BYTES, RS_FLAGS = RS_YST + 16384;
static_assert(RS_FLAGS + 64 <= 8 * WLDS, "scan ring fits the wave regions");
#define RS_SB __builtin_amdgcn_sched_barrier(0)
DI void s_rscan_roles(CtxP c, int l, int slab, float* lds, int bh, int wave, int lane) {
    unsigned char* ring = (unsigned char*)lds; const int b = bh >> 3, h = bh & 7;
    volatile LAS int* F = (volatile LAS int*)((LAS unsigned char*)(unsigned long)RS_FLAGS);
    const unsigned char* ur0 = c->ws + OFF_CK + (size_t)(bh * NC32) * RU_BYTES;
    if (wave >= 4) {
        const int pw = wave - 4, p = pw * 64 + lane; u32x4 pt[4][11];
#define RS_PLOAD(s_, ch_) { const u32x4* src = (const u32x4*)(ur0 + (size_t)(ch_) * RU_BYTES); _Pragma("unroll") for (int k = 0; k < 11; ++k) pt[s_][k] = src[p + 128 * k]; }
        RS_PLOAD(0, 0) RS_PLOAD(1, 1) RS_PLOAD(2, 2) RS_PLOAD(3, 3)
#pragma unroll 1
        for (int ch0 = 0; ch0 < NC32; ch0 += 4) {
#pragma unroll
            for (int s = 0; s < 4; ++s) { const int ch = ch0 + s;
                while (min(lds_ld(F + 2), lds_ld(F + 3)) < ch - 3) __builtin_amdgcn_s_sleep(1);
                u32x4* dst = (u32x4*)(ring + s * RU_BYTES);
#pragma unroll
                for (int k = 0; k < 11; ++k) dst[p + 128 * k] = pt[s][k];
                asm volatile("s_waitcnt lgkmcnt(0)" ::: "memory");
                if (lane == 0) F[pw] = ch + 1;
                RS_PLOAD(s, min(ch + 4, NC32 - 1)) }
        }
#undef RS_PLOAD
    } else {
        const int hs = lane >> 5, li = lane & 31, v = 32 * wave + li;
        float* CB = (float*)(c->ws + OFF_CARRY + l * CARRY_L + CB_OFF) + ((size_t)bh * 64 + v) * 64;
        f32x16 xa0, xa1;
#pragma unroll
        for (int r = 0; r < 16; ++r) { xa0[r] = slab == 0 ? 0.f : CB[(r & 3) + 8 * (r >> 2) + 4 * hs]; xa1[r] = slab == 0 ? 0.f : CB[32 + (r & 3) + 8 * (r >> 2) + 4 * hs]; }
        unsigned char* ystage = ring + RS_YST + wave * 8192;
        const int oPT0 = RU_PT + sw64(li, 8 * hs) * 2, oPT1 = RU_PT + sw64(32 + li, 8 * hs) * 2, oYS = RU_YS + sw64(li, 8 * hs) * 2;
        bf16x8 op[12];
#define RS_LDPT0(base_, kk) *(const bf16x8*)((base_) + RU_PT + sw64(li, 16 * (kk) + 8 * hs) * 2)
#define RS_LDPT1(base_, kk) *(const bf16x8*)((base_) + RU_PT + sw64(32 + li, 16 * (kk) + 8 * hs) * 2)
#define RS_LDYS(base_, kk) *(const bf16x8*)((base_) + RU_YS + sw64(li, 16 * (kk) + 8 * hs) * 2)
        (void)oPT0; (void)oPT1; (void)oYS;
        while (min(lds_ld(F + 0), lds_ld(F + 1)) < 1) __builtin_amdgcn_s_sleep(1);
        asm volatile("" ::: "memory");
#pragma unroll
        for (int kk = 0; kk < 4; ++kk) { op[kk] = RS_LDPT0(ring, kk); op[4 + kk] = RS_LDPT1(ring, kk); op[8 + kk] = RS_LDYS(ring, kk); }
#pragma unroll 1
        for (int ch = 0; ch < NC32; ++ch) {
            { const int need = min(ch + 2, NC32); while (min(lds_ld(F + 0), lds_ld(F + 1)) < need || min(min(lds_ld(F + 6), lds_ld(F + 7)), min(lds_ld(F + 8), lds_ld(F + 9))) < ch - 1) __builtin_amdgcn_s_sleep(1); }
            asm volatile("" ::: "memory");
            const unsigned char* base = ring + (ch & 3) * RU_BYTES; const unsigned char* nb = ring + ((ch + 1) & 3) * RU_BYTES;
            unsigned char* ytile = ystage + (ch & 1) * 4096;
            bf16x8 xb0, xb1, xb2, xb3, vt0, vt1, ayv0, ayv1, aq00, aq01, aq10, aq11; f32x16 ya, xn0, xn1, zz;
#pragma unroll
            for (int r = 0; r < 16; ++r) zz[r] = 0.f;
            RS_SB;
            { float g[8];
#pragma unroll
              for (int r = 0; r < 8; ++r) g[r] = xa0[r];
              xb0 = pack8(g); }
            RS_SB; ya = MFMA32(op[8], xb0, zz); RS_SB;
            { float g[8];
#pragma unroll
              for (int r = 0; r < 8; ++r) g[r] = xa0[8 + r];
              xb1 = pack8(g); }
            RS_SB; xn0 = MFMA32(op[0], xb0, zz); RS_SB;
            vt0 = *(const bf16x8*)(base + RU_VT + sw32(v, 8 * hs) * 2); vt1 = *(const bf16x8*)(base + RU_VT + sw32(v, 16 + 8 * hs) * 2);
            ayv0 = *(const bf16x8*)(base + RU_YV + sw32(li, 8 * hs) * 2); ayv1 = *(const bf16x8*)(base + RU_YV + sw32(li, 16 + 8 * hs) * 2);
            RS_SB; xn1 = MFMA32(op[4], xb0, zz); RS_SB;
            aq00 = *(const bf16x8*)(base + RU_QT + sw32(li, 8 * hs) * 2); aq01 = *(const bf16x8*)(base + RU_QT + sw32(li, 16 + 8 * hs) * 2);
            aq10 = *(const bf16x8*)(base + RU_QT + sw32(32 + li, 8 * hs) * 2); aq11 = *(const bf16x8*)(base + RU_QT + sw32(32 + li, 16 + 8 * hs) * 2);
            RS_SB; ya = MFMA32(op[9], xb1, ya); RS_SB;
            { float g[8];
#pragma unroll
              for (int r = 0; r < 8; ++r) g[r] = xa1[r];
              xb2 = pack8(g); }
            RS_SB; xn0 = MFMA32(op[1], xb1, xn0); RS_SB;
            op[8] = RS_LDYS(nb, 0); op[0] = RS_LDPT0(nb, 0);
            RS_SB; xn1 = MFMA32(op[5], xb1, xn1); RS_SB;
            op[4] = RS_LDPT1(nb, 0);
            RS_SB; ya = MFMA32(op[10], xb2, ya); RS_SB;
            { float g[8];
#pragma unroll
              for (int r = 0; r < 8; ++r) g[r] = xa1[8 + r];
              xb3 = pack8(g); }
            RS_SB; xn0 = MFMA32(op[2], xb2, xn0); RS_SB;
            op[9] = RS_LDYS(nb, 1); op[1] = RS_LDPT0(nb, 1);
            RS_SB; xn1 = MFMA32(op[6], xb2, xn1); RS_SB;
            op[5] = RS_LDPT1(nb, 1);
            RS_SB; ya = MFMA32(op[11], xb3, ya); RS_SB;
            op[10] = RS_LDYS(nb, 2);
            RS_SB; xn0 = MFMA32(op[3], xb3, xn0); RS_SB;
            op[2] = RS_LDPT0(nb, 2);
            RS_SB; xn1 = MFMA32(op[7], xb3, xn1); RS_SB;
            op[6] = RS_LDPT1(nb, 2); op[11] = RS_LDYS(nb, 3);
            RS_SB; ya = MFMA32(ayv0, vt0, ya); RS_SB;
            op[3] = RS_LDPT0(nb, 3); op[7] = RS_LDPT1(nb, 3);
            RS_SB; xn0 = MFMA32(aq00, vt0, xn0); RS_SB;
            RS_SB; xn1 = MFMA32(aq10, vt0, xn1); RS_SB;
            RS_SB; ya = MFMA32(ayv1, vt1, ya); RS_SB;
            xn0 = MFMA32(aq01, vt1, xn0); RS_SB;
            xn1 = MFMA32(aq11, vt1, xn1); RS_SB;
            if (lane == 0) F[2 + wave] = ch + 1;
            RS_SB;
#pragma unroll
            for (int r = 0; r < 16; ++r) *(float*)(ytile + ((r & 3) + 8 * (r >> 2) + 4 * hs) * 128 + li * 4) = ya[r];
            if (lane == 0) F[4 + wave] = ch + 1;
            xa0 = xn0; xa1 = xn1;
            RS_SB;
        }
#undef RS_LDPT0
#undef RS_LDPT1
#undef RS_LDYS
#pragma unroll
        for (int r = 0; r < 16; ++r) { CB[(r & 3) + 8 * (r >> 2) + 4 * hs] = xa0[r]; CB[32 + (r & 3) + 8 * (r >> 2) + 4 * hs] = xa1[r]; }
    }
}
DI float red8(float v) { DPP_ADD(v, 0xB1); DPP_ADD(v, 0x4E); DPP_ADD(v, 0x141); return v; }
DI void s_rscan_out(CtxP c, int l, int slab, float* lds, int bh, int bw, int lane) {
    unsigned char* ring = (unsigned char*)lds; const int b = bh >> 3, h = bh & 7, g = lane & 7, ts = lane >> 3, ch0 = h * 64 + 8 * g;
    volatile LAS int* F = (volatile LAS int*)((LAS unsigned char*)(unsigned long)RS_FLAGS);
    float gw8[8], gb8[8], mu8[8];
    { const float4 a0 = *(const float4*)(c->rgn_w + l * G + ch0), a1 = *(const float4*)(c->rgn_w + l * G + ch0 + 4), b0 = *(const float4*)(c->rgn_b + l * G + ch0), b1 = *(const float4*)(c->rgn_b + l * G + ch0 + 4),
          m0 = *(const float4*)(c->rmu + l * 1664 + 1024 + ch0), m1 = *(const float4*)(c->rmu + l * 1664 + 1024 + ch0 + 4);
      gw8[0] = a0.x; gw8[1] = a0.y; gw8[2] = a0.z; gw8[3] = a0.w; gw8[4] = a1.x; gw8[5] = a1.y; gw8[6] = a1.z; gw8[7] = a1.w;
      gb8[0] = b0.x; gb8[1] = b0.y; gb8[2] = b0.z; gb8[3] = b0.w; gb8[4] = b1.x; gb8[5] = b1.y; gb8[6] = b1.z; gb8[7] = b1.w;
      mu8[0] = m0.x; mu8[1] = m0.y; mu8[2] = m0.z; mu8[3] = m0.w; mu8[4] = m1.x; mu8[5] = m1.y; mu8[6] = m1.z; mu8[7] = m1.w; }
    const unsigned char* ytile0 = ring + RS_YST + (g >> 2) * 8192 + (g & 3) * 32;
    bf16_t* prow0 = (bf16_t*)(c->ws + OFF_P) + prow_off(b, 8 * bw + ts); const float* bon0 = (const float*)(c->ws + OFF_BON) + (size_t)(b * TS + 8 * bw + ts) * NH + h;
    u32x4 xc[4][1], xq[4][1], zz[4][1]; float bon[4][1];
#define RO_LOAD(s_, ch_) { const int cc_ = min((ch_), NC32 - 1); _Pragma("unroll") for (int q = 0; q < 1; ++q) { const bf16_t* pr_ = prow0 + (size_t)(cc_ * 32 + 8 * q) * PP; \
        xc[s_][q] = *(const u32x4*)(pr_ + B_V + ch0); xq[s_][q] = *(const u32x4*)(pr_ - PP + B_V + ch0); zz[s_][q] = *(const u32x4*)(pr_ + ZB + ch0); bon[s_][q] = bon0[(size_t)(cc_ * 32 + 8 * q) * NH]; } }
    RO_LOAD(0, 0) RO_LOAD(1, 1) RO_LOAD(2, 2) RO_LOAD(3, 3)
#pragma unroll 1
    for (int ch0_ = 0; ch0_ < NC32; ch0_ += 4) {
#pragma unroll
        for (int s = 0; s < 4; ++s) { const int ch = ch0_ + s;
            while (min(lds_ld(F + 4), lds_ld(F + 5)) < ch + 1) __builtin_amdgcn_s_sleep(1);
            asm volatile("" ::: "memory");
            u32x4 wq[1][2];
#pragma unroll
            for (int q = 0; q < 1; ++q) { const unsigned char* yt = ytile0 + (s & 1) * 4096 + (8 * bw + 8 * q + ts) * 128; wq[q][0] = *(const u32x4*)yt; wq[q][1] = *(const u32x4*)(yt + 16); }
            asm volatile("s_waitcnt lgkmcnt(0)" ::: "memory");
            if (lane == 0) F[6 + bw] = ch + 1;
#pragma unroll
            for (int q = 0; q < 1; ++q) {
                float w[8], x[8], xp[8], z[8], y[8];
#pragma unroll
                for (int i = 0; i < 4; ++i) { w[i] = __uint_as_float(wq[q][0][i]); w[4 + i] = __uint_as_float(wq[q][1][i]); }
                unpack8(__builtin_bit_cast(uint4, xc[s][q]), x); unpack8(__builtin_bit_cast(uint4, xq[s][q]), xp); unpack8(__builtin_bit_cast(uint4, zz[s][q]), z);
                float sm = 0.f;
#pragma unroll
                for (int i = 0; i < 8; ++i) sm += w[i];
                const float mean = red8(sm) * (1.f / 64.f); float vs = 0.f;
#pragma unroll
                for (int i = 0; i < 8; ++i) { w[i] -= mean; vs += w[i] * w[i]; }
                const float rstd = rsqrtf(red8(vs) * (1.f / 64.f) + 1e-5f);
#pragma unroll
                for (int i = 0; i < 8; ++i) { const float vm = x[i] + mu8[i] * (xp[i] - x[i]); y[i] = (w[i] * rstd * gw8[i] + gb8[i] + bon[s][q] * vm) * siluf(z[i]); }
                *(bf16x8*)(prow0 + (size_t)(ch * 32 + 8 * q) * PP + ZB + ch0) = pack8(y); }
            RO_LOAD(s, ch + 4) }
    }
#undef RO_LOAD
}
DI void s_phase2(CtxP c, int l, int slab, float* lds, int bid, int nblk) {
    const int tid = otid(), lane = tid & 63, wave = tid >> 6; unsigned char* wl = (unsigned char*)lds + wave * WLDS;
    const int gw = __builtin_amdgcn_readfirstlane(bid * 8 + wave);
    { int ln = lane; w_rprep(c, l, slab, gw, wl, ln); }
    { const int u = __builtin_amdgcn_readfirstlane(bid * 4 + (wave & 3)); int ln = lane;
        asm volatile("" : "+v"(ln) :: "memory"); __builtin_amdgcn_sched_barrier(0);
        if (wave < 4) w_chunkA<false>(c, l, slab, u, wl, ln); else w_chunkA<true>(c, l, slab, u, wl, ln); }
    if (slab == 0) { bf16_t* halo = (bf16_t*)(c->ws + OFF_CARRY + l * CARRY_L + HALO_OFF);
        for (int i = bid * 512 + tid; i < NB * 3 * PP; i += nblk * 512) { const int b = i / (3 * PP), r = (i / PP) % 3, col = i % PP;
            halo[i] = ((const bf16_t*)(c->ws + OFF_P))[prow_off(b, TS - 3 + r) + col]; } }
}
DI void s_phaseSB(CtxP c, int l, int slab, float* lds, int bid, int nblk) {
    const int tid = otid(), lane = tid & 63, wave = tid >> 6;
    if (tid < 16) ((volatile LAS int*)((LAS unsigned char*)(unsigned long)RS_FLAGS))[tid] = 0;
    __syncthreads();
    if (bid < 32) { if ((wave & 2) == 0) s_rscan_roles(c, l, slab, lds, bid, wave, lane); else s_rscan_out(c, l, slab, lds, bid, (wave & 1) + (wave >> 2) * 2, lane); }
    else if (bid < 160) {
        const int u = __builtin_amdgcn_readfirstlane((bid - 32) * 8 + wave); int ln = lane; unsigned char* wl = (unsigned char*)lds + wave * WLDS;
        asm volatile("" : "+v"(ln) :: "memory"); __builtin_amdgcn_sched_barrier(0);
        w_lru<true, true>(c, l, slab, u, wl, ln, 0, 2); }
    else { int sb = bid; asm volatile("" : "+v"(sb)); sb = __builtin_amdgcn_readfirstlane(sb) - 160; s_stepB(c, l, slab, lds, sb, 96); }
}
DI void s_phase3(CtxP c, int l, int slab, float* lds, int bid) {
    const int tid = otid(), lane = tid & 63, wave = tid >> 6; unsigned char* wl = (unsigned char*)lds + wave * WLDS;
    { const int u = __builtin_amdgcn_readfirstlane(bid * 4 + (wave & 3)); int ln = lane;
        asm volatile("" : "+v"(ln) :: "memory"); __builtin_amdgcn_sched_barrier(0);
        if (wave < 4) w_chunkC<false>(c, l, slab, u, wl, ln); else w_chunkC<true>(c, l, slab, u, wl, ln); }
}
DI void s_bpost(CtxP c, int l, int slab, float* lds, int bid, int nblk) {
    const int lane = otid() & 63, gw = bid * 8 + (otid() >> 6), NGW = nblk * 8; const int ch0 = lane * 8, h = lane >> 3;
    float gw8[8], gb8[8], mu8[8];
    { const float4 a0 = *(const float4*)(c->rgn_w + l * G + ch0), a1 = *(const float4*)(c->rgn_w + l * G + ch0 + 4), b0 = *(const float4*)(c->rgn_b + l * G + ch0), b1 = *(const float4*)(c->rgn_b + l * G + ch0 + 4),
          m0 = *(const float4*)(c->rmu + l * 1664 + 1024 + ch0), m1 = *(const float4*)(c->rmu + l * 1664 + 1024 + ch0 + 4);
      gw8[0] = a0.x; gw8[1] = a0.y; gw8[2] = a0.z; gw8[3] = a0.w; gw8[4] = a1.x; gw8[5] = a1.y; gw8[6] = a1.z; gw8[7] = a1.w;
      gb8[0] = b0.x; gb8[1] = b0.y; gb8[2] = b0.z; gb8[3] = b0.w; gb8[4] = b1.x; gb8[5] = b1.y; gb8[6] = b1.z; gb8[7] = b1.w;
      mu8[0] = m0.x; mu8[1] = m0.y; mu8[2] = m0.z; mu8[3] = m0.w; mu8[4] = m1.x; mu8[5] = m1.y; mu8[6] = m1.z; mu8[7] = m1.w; }
    for (int r0 = gw; r0 < MS; r0 += 2 * NGW) {
        float4 wa[2], wb[2]; uint4 xc[2], xq[2], zz[2]; float bon[2]; bf16_t* prw[2];
#pragma unroll
        for (int q = 0; q < 2; ++q) { int r = r0 + q * NGW; r = r < MS ? r : r0; const int b = r / TS, tl = r % TS; prw[q] = (bf16_t*)(c->ws + OFF_P) + prow_off(b, tl);
            wa[q] = *(const float4*)((const float*)(prw[q] + B_R) + ch0); wb[q] = *(const float4*)((const float*)(prw[q] + B_R) + ch0 + 4);
            xc[q] = *(const uint4*)(prw[q] + B_V + ch0); xq[q] = *(const uint4*)(prw[q] - PP + B_V + ch0); zz[q] = *(const uint4*)(prw[q] + ZB + ch0);
            bon[q] = ((const float*)(c->ws + OFF_BON))[(size_t)r * NH + h]; }
#pragma unroll
        for (int q = 0; q < 2; ++q) { if (r0 + q * NGW >= MS) break;
            float w[8] = {wa[q].x, wa[q].y, wa[q].z, wa[q].w, wb[q].x, wb[q].y, wb[q].z, wb[q].w}, x[8], xp[8], z[8], y[8];
            unpack8(xc[q], x); unpack8(xq[q], xp); unpack8(zz[q], z);
            float sm = 0.f;
#pragma unroll
            for (int i = 0; i < 8; ++i) sm += w[i];
            const float mean = red8(sm) * (1.f / 64.f); float vs = 0.f;
#pragma unroll
            for (int i = 0; i < 8; ++i) { w[i] -= mean; vs += w[i] * w[i]; }
            const float rstd = rsqrtf(red8(vs) * (1.f / 64.f) + 1e-5f);
#pragma unroll
            for (int i = 0; i < 8; ++i) { const float vm = x[i] + mu8[i] * (xp[i] - x[i]); y[i] = (w[i] * rstd * gw8[i] + gb8[i] + bon[q] * vm) * siluf(z[i]); }
            *(bf16x8*)(prw[q] + ZB + ch0) = pack8(y); }
    }
}
DI void s_post(CtxP c, int l, int slab, float* lds, int bid, int nblk) {
    const int lane = otid() & 63, gw = bid * 8 + (otid() >> 6), NGW = nblk * 8;
    for (int r0 = gw; r0 < MS; r0 += 4 * NGW) {
        float4 v[4][4], xx[4][4]; float* orow[4];
#pragma unroll
        for (int q = 0; q < 4; ++q) { int r = r0 + q * NGW; r = r < MS ? r : r0; const int b = r / TS, tl = r % TS; const size_t grow = (size_t)b * T + slab * TS + tl;
            const bf16_t* yrow = (const bf16_t*)(c->ws + OFF_Y) + (size_t)r * D; const bf16_t* y2row = (const bf16_t*)(c->ws + OFF_Y2) + (size_t)r * D;
            const float* xr = (l == 0 ? c->x : c->out) + grow * D; orow[q] = c->out + grow * D;
#pragma unroll
            for (int j2 = 0; j2 < 2; ++j2) { const int cb = j2 * 512 + lane * 8; const u32x4 h1 = *(const u32x4*)(yrow + cb), h2 = *(const u32x4*)(y2row + cb);
                xx[q][2 * j2] = *(const float4*)(xr + cb); xx[q][2 * j2 + 1] = *(const float4*)(xr + cb + 4);
                v[q][2 * j2] = make_float4(__uint_as_float(h1[0] << 16) + __uint_as_float(h2[0] << 16), __uint_as_float(h1[0] & 0xffff0000u) + __uint_as_float(h2[0] & 0xffff0000u),
                                           __uint_as_float(h1[1] << 16) + __uint_as_float(h2[1] << 16), __uint_as_float(h1[1] & 0xffff0000u) + __uint_as_float(h2[1] & 0xffff0000u));
                v[q][2 * j2 + 1] = make_float4(__uint_as_float(h1[2] << 16) + __uint_as_float(h2[2] << 16), __uint_as_float(h1[2] & 0xffff0000u) + __uint_as_float(h2[2] & 0xffff0000u),
                                               __uint_as_float(h1[3] << 16) + __uint_as_float(h2[3] << 16), __uint_as_float(h1[3] & 0xffff0000u) + __uint_as_float(h2[3] & 0xffff0000u)); } }
#pragma unroll
        for (int q = 0; q < 4; ++q) { const int r = r0 + q * NGW; if (r >= MS) break;
            float ss = 0.f;
#pragma unroll
            for (int j = 0; j < 4; ++j) ss += v[q][j].x * v[q][j].x + v[q][j].y * v[q][j].y + v[q][j].z * v[q][j].z + v[q][j].w * v[q][j].w;
            ss = wave_sum(ss); const float rs = rsqrtf(ss * (1.f / D) + 1e-6f); float s2 = 0.f;
#pragma unroll
            for (int j = 0; j < 4; ++j) { const int cj = (j >> 1) * 512 + lane * 8 + (j & 1) * 4; const float4 gg = *(const float4*)(c->norm_post + l * D + cj); float4& o = v[q][j]; const float4 x4 = xx[q][j];
                o.x = x4.x + o.x * rs * gg.x; o.y = x4.y + o.y * rs * gg.y; o.z = x4.z + o.z * rs * gg.z; o.w = x4.w + o.w * rs * gg.w;
                *(float4*)(orow[q] + cj) = o; s2 += o.x * o.x + o.y * o.y + o.z * o.z + o.w * o.w; }
            if (l == 0) { s2 = wave_sum(s2); const float r2 = rsqrtf(s2 * (1.f / D) + 1e-6f); bf16_t* hrow = (bf16_t*)(c->ws + OFF_H) + (size_t)r * D;
#pragma unroll
                for (int j2 = 0; j2 < 2; ++j2) { const int cb = j2 * 512 + lane * 8; const float4 g0 = *(const float4*)(c->norm_pre + D + cb), g1 = *(const float4*)(c->norm_pre + D + cb + 4); const float4 o0 = v[q][2 * j2], o1 = v[q][2 * j2 + 1];
                    u32x4 w; w[0] = pk2(o0.x * r2 * g0.x, o0.y * r2 * g0.y); w[1] = pk2(o0.z * r2 * g0.z, o0.w * r2 * g0.w); w[2] = pk2(o1.x * r2 * g1.x, o1.y * r2 * g1.y); w[3] = pk2(o1.z * r2 * g1.z, o1.w * r2 * g1.w);
                    *(u32x4*)(hrow + cb) = w; } } }
    }
}
namespace pg8 {
#define PG8_LAS __attribute__((address_space(3)))
typedef unsigned short bf16_t;
typedef short bf16x8 __attribute__((ext_vector_type(8)));
typedef float f32x4 __attribute__((ext_vector_type(4)));
typedef unsigned u32x4 __attribute__((ext_vector_type(4)));
constexpr int BM = 256, BK = 64, HALF = 128, HTB = HALF * BK * 2  , STAGE_BYTES = 8 * HTB, NXCD = 8, WGM = 8;

__host__ __device__ __forceinline__ int lds_byte(int r, int c) { const int st = (r >> 4) * 2 + (c >> 5), rr = r & 15, cc = c & 31, ob = rr * 64 + cc * 2; return st * 1024 + (ob ^ (((ob >> 9) & 1) << 5)); }
__host__ __device__ __forceinline__ void stage_rc(int b, int& R, int& C) { const int st = b / 1024, sb = b % 1024, swz = sb ^ (((sb >> 9) & 1) << 5); R = (st >> 1) * 16 + swz / 64; C = (st & 1) * 32 + (swz % 64) / 2; }
__host__ __device__ __forceinline__ int perm32(int rho) { const int n = rho >> 4, i = rho & 15; return 8 * (i >> 2) + 4 * n + (i & 3); }

struct Unit { int pm, pn; };
struct Gemm { const bf16_t* A; const bf16_t* Bt; int M, N, K, lda; };

struct StaticOrder {
    int nM, nN, nwg, G, c;
    __host__ __device__ void init(int M, int N, int G_, int c_) { nM = M / BM; nN = N / BM; nwg = nM * nN; G = G_; c = c_; }
    __host__ __device__ bool next(int i, Unit& u) const {
        const long L = (long)i * G + c; if (L >= nwg) return false;
        int wgid = (int)L; { const int q = nwg / NXCD, r = nwg % NXCD, xcd = wgid % NXCD, off = wgid / NXCD; wgid = (xcd < r ? xcd * (q + 1) : r * (q + 1) + (xcd - r) * q) + off; }
        const int nig = WGM * nN, gid = wgid / nig, fm = gid * WGM, gsz = (nM - fm) < WGM ? (nM - fm) : WGM;
        u.pm = fm + ((wgid % nig) % gsz); u.pn = (wgid % nig) / gsz; return true;
    }
    __device__ __forceinline__ void a_ready(const Unit&) const {}
    __device__ __forceinline__ void done(const Unit&) const {}
};

__device__ __forceinline__ unsigned cvt_pk_bf16(float lo, float hi) { unsigned r; asm volatile("v_cvt_pk_bf16_f32 %0, %1, %2" : "=v"(r) : "v"(lo), "v"(hi)); return r; }
typedef float f32x2 __attribute__((ext_vector_type(2)));
__device__ __forceinline__ f32x2 gelu_pk(f32x2 v) {
    const f32x2 av = __builtin_elementwise_abs(v), d = av * 0.2316418882f + 1.0f;
    f32x2 t; t.x = __builtin_amdgcn_rcpf(d.x); t.y = __builtin_amdgcn_rcpf(d.y);
    f32x2 q = t * 0.5307027145f + (-0.7265760135f); q = q * t + 0.7107068705f; q = q * t + (-0.142248368f); q = q * t + 0.127414796f; q = q * t;
    const f32x2 s = (v * v) * (-0.72134752044f);
    f32x2 e; e.x = __builtin_amdgcn_exp2f(s.x); e.y = __builtin_amdgcn_exp2f(s.y);
    const f32x2 m = v * (q * e), r = v - m;
    f32x2 o; o.x = v.x < 0.f ? m.x : r.x; o.y = v.y < 0.f ? m.y : r.y; return o;
}

template <int ACT  > struct EpiBf16 {
    static constexpr bool PERM = true, AFTER_DRAIN = false; static_assert(ACT == 0 || ACT == 1, "EpiBf16: ACT is 0 (none) or 1 (gelu_pk)");
    bf16_t* O; int ldc; const float* bias; int split_cols; size_t split_stride; float scale0; int rskip;
    __device__ __forceinline__ void operator()(const f32x4 (&acc)[2][2][4][2], const Unit& u, int wr, int wc, int fr, int fq) const {
        const int row0 = u.pm * BM + wr * 64 + fr + (u.pm >> 3) * rskip; int colt = u.pn * BM; bf16_t* base = O;
        float sc = 1.f; if (split_cols) { const int t = colt / split_cols; base += (size_t)t * split_stride; colt -= t * split_cols; if (t == 0) sc = scale0; }
        const int col0 = colt + wc * 32 + 8 * fq, bcol0 = u.pn * BM + wc * 32 + 8 * fq;
        f32x4 bv[2][2];
#pragma unroll
        for (int bj = 0; bj < 2; ++bj)
#pragma unroll
            for (int n = 0; n < 2; ++n) bv[bj][n] = bias ? *(const f32x4*)(bias + bcol0 + bj * HALF + 4 * n) : (f32x4){0.f, 0.f, 0.f, 0.f};
#pragma unroll
        for (int ai = 0; ai < 2; ++ai)
#pragma unroll
            for (int m = 0; m < 4; ++m) { bf16_t* rowp = base + (size_t)(row0 + ai * HALF + m * 16) * ldc + col0;
#pragma unroll
                for (int bj = 0; bj < 2; ++bj) { f32x4 v0 = acc[ai][bj][m][0] + bv[bj][0], v1 = acc[ai][bj][m][1] + bv[bj][1];
                    if (ACT == 1) { f32x2 a = gelu_pk((f32x2){v0[0], v0[1]}), b = gelu_pk((f32x2){v0[2], v0[3]}), c = gelu_pk((f32x2){v1[0], v1[1]}), d = gelu_pk((f32x2){v1[2], v1[3]});
                        v0 = (f32x4){a.x, a.y, b.x, b.y}; v1 = (f32x4){c.x, c.y, d.x, d.y}; }
                    v0 = v0 * sc; v1 = v1 * sc; u32x4 w; w.x = cvt_pk_bf16(v0[0], v0[1]); w.y = cvt_pk_bf16(v0[2], v0[3]); w.z = cvt_pk_bf16(v1[0], v1[1]); w.w = cvt_pk_bf16(v1[2], v1[3]);
                    *(u32x4*)(rowp + bj * HALF) = w; } }
    }
};


struct EpiF32 {
    static constexpr bool PERM = false, AFTER_DRAIN = false;
    float* O; int ldc;
    __device__ __forceinline__ void operator()(const f32x4 (&acc)[2][2][4][2], const Unit& u, int wr, int wc, int fr, int fq) const {
        const int row0 = u.pm * BM + wr * 64 + fr, col0 = u.pn * BM + wc * 32 + 4 * fq;
#pragma unroll
        for (int ai = 0; ai < 2; ++ai)
#pragma unroll
            for (int m = 0; m < 4; ++m) { float* rowp = O + (size_t)(row0 + ai * HALF + m * 16) * ldc + col0;
#pragma unroll
                for (int bj = 0; bj < 2; ++bj)
#pragma unroll
                    for (int n = 0; n < 2; ++n) *(f32x4*)(rowp + bj * HALF + n * 16) = acc[ai][bj][m][n]; }
    }
};
struct EpiSplitK {
    static constexpr bool PERM = true, AFTER_DRAIN = false;
    bf16_t* O; bf16_t* O2; int ldc;
    __device__ __forceinline__ void operator()(const f32x4 (&acc)[2][2][4][2], const Unit& u, int wr, int wc, int fr, int fq) const {
        const int row0 = u.pm * BM + wr * 64 + fr, col0 = (u.pn & 3) * BM + wc * 32 + 8 * fq; bf16_t* base = u.pn >= 4 ? O2 : O;
#pragma unroll
        for (int ai = 0; ai < 2; ++ai)
#pragma unroll
            for (int m = 0; m < 4; ++m) { bf16_t* rowp = base + (size_t)(row0 + ai * HALF + m * 16) * ldc + col0;
#pragma unroll
                for (int bj = 0; bj < 2; ++bj) { const f32x4 v0 = acc[ai][bj][m][0], v1 = acc[ai][bj][m][1];
                    u32x4 w; w.x = cvt_pk_bf16(v0[0], v0[1]); w.y = cvt_pk_bf16(v0[2], v0[3]); w.z = cvt_pk_bf16(v1[0], v1[1]); w.w = cvt_pk_bf16(v1[2], v1[3]);
                    *(u32x4*)(rowp + bj * HALF) = w; } }
    }
};
template <class Epi, class Sched, bool ALIGN_EPI, bool SP2, int KK, int LDA, int ASKIP, int KSPLIT = 0>
__device__ __forceinline__ void gemm_phase(PG8_LAS unsigned char* lds, const Gemm g, const Sched& S, const Epi& E) {
    const int tid = otid(), wid = __builtin_amdgcn_readfirstlane(tid >> 6), lane = tid & 63, wr = wid >> 2, wc = wid & 3, fr = lane & 15, fq = lane >> 4;
    constexpr int K = KK, nt = K / BK;
    unsigned voffA[2], voffB[2];
#pragma unroll
    for (int i = 0; i < 2; ++i) { int R, C; stage_rc(tid * 16 + i * 8192, R, C); const int Rb = Epi::PERM ? ((R & ~31) + perm32(R & 31)) : R;
        voffA[i] = (unsigned)(R * LDA + C) * 2u; voffB[i] = (unsigned)(Rb * K + C) * 2u; }
    constexpr size_t kstep = (size_t)(BK * 2);
    constexpr size_t hstepA = (size_t)HALF * LDA * 2, hstepB = (size_t)HALF * K * 2;
    constexpr size_t tstepA = 2 * hstepA, tstepB = 2 * hstepB;
    const unsigned ldsw = (unsigned)wid * 1024u;
    const int aoff = lds_byte(wr * 64 + fr, fq * 8), boff = lds_byte(wc * 32 + fr, fq * 8);
#define PG8_SA(b, h) (((b) * 2 + (h)) * HTB)
#define PG8_SB(b, h) ((4 + (b) * 2 + (h)) * HTB)
#define PG8_STAGE(bufoff, gbase, voff) do { _Pragma("unroll") for (int _i = 0; _i < 2; ++_i) \
        __builtin_amdgcn_global_load_lds((const unsigned*)((const char*)(gbase) + (voff)[_i]), (PG8_LAS unsigned*)(lds + (bufoff) + ldsw + _i * 8192), 16, 0, 0); } while (0)
#define PG8_LDA(dst, b, h) do { _Pragma("unroll") for (int m = 0; m < 4; ++m) _Pragma("unroll") for (int k = 0; k < 2; ++k) dst[m][k] = *(const PG8_LAS bf16x8*)(lds + PG8_SA(b, h) + aoff + m * 2048 + k * 1024); } while (0)
#define PG8_LDB(dst, b, h) do { _Pragma("unroll") for (int n = 0; n < 2; ++n) _Pragma("unroll") for (int k = 0; k < 2; ++k) dst[n][k] = *(const PG8_LAS bf16x8*)(lds + PG8_SB(b, h) + boff + n * 2048 + k * 1024); } while (0)
#define PG8_MMA(ai, bj, At, Bt) do { __builtin_amdgcn_s_setprio(1); _Pragma("unroll") for (int m = 0; m < 4; ++m) _Pragma("unroll") for (int n = 0; n < 2; ++n) _Pragma("unroll") for (int k = 0; k < 2; ++k) \
        acc[ai][bj][m][n] = __builtin_amdgcn_mfma_f32_16x16x32_bf16(Bt[n][k], At[m][k], acc[ai][bj][m][n], 0, 0, 0); __builtin_amdgcn_s_setprio(0); } while (0)
#define PG8_WAIT_V(n) asm volatile("s_waitcnt vmcnt(" #n ")" ::: "memory")
#define PG8_WAIT_L(n) asm volatile("s_waitcnt lgkmcnt(" #n ")" ::: "memory")
#define PG8_BAR __builtin_amdgcn_s_barrier()
#define PG8_SCHED __builtin_amdgcn_sched_barrier(0)
    Unit cur, nxt; int ui = 0;
    if (!S.next(0, cur)) return;
    f32x4 acc[2][2][4][2];
#pragma unroll
    for (int a = 0; a < 2; ++a)
#pragma unroll
        for (int b = 0; b < 2; ++b)
#pragma unroll
            for (int m = 0; m < 4; ++m)
#pragma unroll
                for (int n = 0; n < 2; ++n) acc[a][b][m][n] = (f32x4){0.f, 0.f, 0.f, 0.f};
    bf16x8 At[4][2], B0[2][2], B1[2][2];
    const char* cA = (const char*)g.A + (size_t)cur.pm * tstepA + (size_t)(cur.pm >> 3) * (ASKIP * LDA * 2) + (size_t)(KSPLIT ? (cur.pn >> 2) : 0) * (KSPLIT * 2); const char* cB = (const char*)g.Bt + (size_t)cur.pn * tstepB;
    S.a_ready(cur);
    if constexpr (SP2) {
        PG8_STAGE(PG8_SB(0, 0), cB, voffB); PG8_STAGE(PG8_SB(0, 1), cB + hstepB, voffB); PG8_STAGE(PG8_SA(0, 0), cA, voffA); PG8_STAGE(PG8_SA(0, 1), cA + hstepA, voffA);
        if (wr == 1) PG8_BAR;
        PG8_WAIT_V(2); PG8_BAR;
        PG8_STAGE(PG8_SB(1, 0), cB + kstep, voffB); PG8_STAGE(PG8_SA(1, 0), cA + kstep, voffA); PG8_STAGE(PG8_SB(1, 1), cB + hstepB + kstep, voffB);
        PG8_WAIT_V(6); PG8_BAR;
    } else {
        PG8_STAGE(PG8_SB(0, 0), cB, voffB); PG8_STAGE(PG8_SA(0, 0), cA, voffA); PG8_STAGE(PG8_SB(0, 1), cB + hstepB, voffB); PG8_STAGE(PG8_SA(0, 1), cA + hstepA, voffA);
        if (wr == 1) PG8_BAR;
        PG8_WAIT_V(4); PG8_BAR;
        PG8_STAGE(PG8_SB(1, 0), cB + kstep, voffB); PG8_STAGE(PG8_SA(1, 0), cA + kstep, voffA); PG8_STAGE(PG8_SB(1, 1), cB + hstepB + kstep, voffB);
        PG8_WAIT_V(6); PG8_BAR;
    }
    for (;;) {
        const bool has_next = S.next(ui + 1, nxt);
        const char* nA = has_next ? (const char*)g.A + (size_t)nxt.pm * tstepA + (size_t)(nxt.pm >> 3) * (ASKIP * LDA * 2) + (size_t)(KSPLIT ? (nxt.pn >> 2) : 0) * (KSPLIT * 2) : cA; const char* nB = has_next ? (const char*)g.Bt + (size_t)nxt.pn * tstepB : cB;
        for (int t = 0; t < nt; t += 2) {
            const bool last = (t == nt - 2);
            const char* a1 = cA + (size_t)(t + 1) * kstep;
            const char* a2 = last ? nA : cA + (size_t)(t + 2) * kstep; const char* b2 = last ? nB : cB + (size_t)(t + 2) * kstep;
            const char* a3 = a2 + kstep; const char* b3 = b2 + kstep;
            if (last && has_next) S.a_ready(nxt);
            if constexpr (SP2) {
            PG8_LDB(B0, 0, 0); PG8_LDB(B1, 0, 1); PG8_SCHED; PG8_LDA(At, 0, 0); PG8_STAGE(PG8_SA(1, 1), a1 + hstepA, voffA);
            PG8_WAIT_V(8); PG8_WAIT_L(0); PG8_BAR; PG8_MMA(0, 0, At, B0); PG8_MMA(0, 1, At, B1); PG8_BAR; PG8_SCHED;
            PG8_LDA(At, 0, 1); PG8_STAGE(PG8_SB(0, 0), b2, voffB); PG8_STAGE(PG8_SB(0, 1), b2 + hstepB, voffB); PG8_STAGE(PG8_SA(0, 0), a2, voffA);
            PG8_WAIT_V(8); PG8_WAIT_L(0); PG8_BAR; PG8_MMA(1, 0, At, B0); PG8_MMA(1, 1, At, B1); PG8_BAR; PG8_SCHED;
            PG8_LDB(B0, 1, 0); PG8_LDB(B1, 1, 1); PG8_SCHED; PG8_LDA(At, 1, 0); PG8_STAGE(PG8_SA(0, 1), a2 + hstepA, voffA);
            PG8_WAIT_V(8); PG8_WAIT_L(0); PG8_BAR; PG8_MMA(0, 0, At, B0); PG8_MMA(0, 1, At, B1); PG8_BAR; PG8_SCHED;
            PG8_LDA(At, 1, 1); PG8_STAGE(PG8_SB(1, 0), b3, voffB); PG8_STAGE(PG8_SB(1, 1), b3 + hstepB, voffB); PG8_STAGE(PG8_SA(1, 0), a3, voffA);
            PG8_WAIT_V(8); PG8_WAIT_L(0); PG8_BAR; PG8_MMA(1, 0, At, B0); PG8_MMA(1, 1, At, B1); PG8_BAR; PG8_SCHED;
            } else {
            PG8_LDB(B0, 0, 0); PG8_SCHED; PG8_LDA(At, 0, 0); PG8_STAGE(PG8_SA(1, 1), a1 + hstepA, voffA);
            PG8_WAIT_L(8); PG8_BAR; PG8_WAIT_L(0); PG8_MMA(0, 0, At, B0); PG8_BAR; PG8_SCHED;
            PG8_LDB(B1, 0, 1); PG8_STAGE(PG8_SB(0, 0), b2, voffB);
            PG8_BAR; PG8_WAIT_L(0); PG8_MMA(0, 1, At, B1); PG8_BAR;
            PG8_LDA(At, 0, 1); PG8_STAGE(PG8_SA(0, 0), a2, voffA);
            PG8_BAR; PG8_WAIT_L(0); PG8_MMA(1, 0, At, B0); PG8_BAR; PG8_SCHED;
            PG8_STAGE(PG8_SB(0, 1), b2 + hstepB, voffB);
            PG8_WAIT_V(6); PG8_BAR; PG8_MMA(1, 1, At, B1); PG8_BAR;
            PG8_LDB(B0, 1, 0); PG8_SCHED; PG8_LDA(At, 1, 0); PG8_STAGE(PG8_SA(0, 1), a2 + hstepA, voffA);
            PG8_WAIT_L(8); PG8_BAR; PG8_WAIT_L(0); PG8_MMA(0, 0, At, B0); PG8_BAR; PG8_SCHED;
            PG8_LDB(B1, 1, 1); PG8_STAGE(PG8_SB(1, 0), b3, voffB);
            PG8_BAR; PG8_WAIT_L(0); PG8_MMA(0, 1, At, B1); PG8_BAR;
            PG8_LDA(At, 1, 1); PG8_STAGE(PG8_SA(1, 0), a3, voffA);
            PG8_BAR; PG8_WAIT_L(0); PG8_MMA(1, 0, At, B0); PG8_BAR; PG8_SCHED;
            PG8_STAGE(PG8_SB(1, 1), b3 + hstepB, voffB);
            PG8_WAIT_V(6); PG8_BAR; PG8_MMA(1, 1, At, B1); PG8_BAR;
            }
        }
        if constexpr (ALIGN_EPI) { if (wr == 0) PG8_BAR; }
        if constexpr (!Epi::AFTER_DRAIN) { E(acc, cur, wr, wc, fr, fq); S.done(cur); }
        if (!has_next) break;
#pragma unroll
        for (int a = 0; a < 2; ++a)
#pragma unroll
            for (int b = 0; b < 2; ++b)
#pragma unroll
                for (int m = 0; m < 4; ++m)
#pragma unroll
                    for (int n = 0; n < 2; ++n) acc[a][b][m][n] = (f32x4){0.f, 0.f, 0.f, 0.f};
        cur = nxt; cA = nA; cB = nB; ++ui;
        if constexpr (ALIGN_EPI) { if (wr == 1) PG8_BAR; }
    }
    PG8_WAIT_V(0);
    if constexpr (!ALIGN_EPI) { if (wr == 0) PG8_BAR; }
    PG8_BAR;
    if constexpr (Epi::AFTER_DRAIN) { E.fused(acc, cur, wr, wc, fr, fq, lds, wid, lane); S.done(cur); }
#undef PG8_SA
#undef PG8_SB
#undef PG8_STAGE
#undef PG8_LDA
#undef PG8_LDB
#undef PG8_MMA
#undef PG8_WAIT_V
#undef PG8_WAIT_L
#undef PG8_BAR
#undef PG8_SCHED
}
}

#define XB_TMO      128
#define XB_XCNT(j)  (256  + 64 * (j))
#define XB_XSUB(j)  (1280 + 64 * (j))
#define XB_XGEN(j)  (2304 + 64 * (j))
#define XB_TOP      3328
#define XB_TOPGEN   3392
#define XCD_BAR_WORDS 3456
#define XB_SPIN_CAP (1u << 18)
DI unsigned xb_ld(unsigned* p)              { return __hip_atomic_load(p, __ATOMIC_RELAXED, __HIP_MEMORY_SCOPE_AGENT); }
DI unsigned xb_add(unsigned* p, unsigned v) { return __hip_atomic_fetch_add(p, v, __ATOMIC_RELAXED, __HIP_MEMORY_SCOPE_AGENT); }
DI unsigned xb_xcc_id() { return (unsigned)__builtin_amdgcn_s_getreg((3 << 11) | 20) & 0xFu; }
#define XB_SPIN(cond, bar) do { unsigned _sp = 0; while (cond) { __builtin_amdgcn_s_sleep(1); \
    if ((++_sp & 255u) == 0u) { if (xb_ld(&(bar)[XB_TMO])) break; if (_sp > XB_SPIN_CAP) { atomicAdd(&(bar)[XB_TMO], 1u); break; } } } } while (0)
struct XcdBarrier { unsigned* bar; unsigned x; volatile LAS unsigned* st; };
DI XcdBarrier xcd_barrier_post(unsigned* bar, volatile LAS unsigned* st) {
    XcdBarrier b; b.bar = bar; b.x = (unsigned)__builtin_amdgcn_readfirstlane((int)xb_xcc_id()); b.st = st;
    if (threadIdx.x == 0) (void)xb_add(&bar[XB_XCNT(b.x)], 1u);
    return b;
}
DI void xcd_barrier_complete(unsigned* bar, unsigned x, unsigned& nloc, unsigned& nx) {
    const unsigned Gd = gridDim.x * gridDim.y * gridDim.z;
    unsigned sum, cnt, mine, sp = 0u;
    for (;;) {
        sum = 0u; cnt = 0u; mine = 0u;
#pragma unroll
        for (unsigned j = 0; j < 16; ++j) { const unsigned cc = xb_ld(&bar[XB_XCNT(j)]); sum += cc; cnt += (cc > 0u) ? 1u : 0u; mine = (j == x) ? cc : mine; }
        if (sum == Gd) break;
        __builtin_amdgcn_s_sleep(1);
        if ((++sp & 255u) == 0u) { if (xb_ld(&bar[XB_TMO])) break; if (sp > XB_SPIN_CAP) { atomicAdd(&bar[XB_TMO], 1u); break; } }
    }
    nloc = mine > 0u ? mine : 1u; nx = cnt > 0u ? cnt : 1u;
}
DI void xcd_barrier(const XcdBarrier& b) {
    asm volatile("s_waitcnt vmcnt(0)" ::: "memory");
    __syncthreads();
    if (threadIdx.x == 0) {
        unsigned* bar = b.bar; unsigned bx = b.x; asm volatile("" : "+s"(bar), "+s"(bx));
        __builtin_amdgcn_s_waitcnt(0);
        unsigned nloc = b.st[0], nx = b.st[1];
        if (nloc == 0u) { xcd_barrier_complete(bar, bx, nloc, nx); b.st[0] = nloc; b.st[1] = nx; }
        const unsigned old = xb_add(&bar[XB_XSUB(bx)], 1u);
        const unsigned gen = old / nloc;
        if (old + 1u == (gen + 1u) * nloc) {
            __builtin_amdgcn_fence(__ATOMIC_RELEASE, "agent");
            asm volatile("s_waitcnt vmcnt(0)" ::: "memory");
            const unsigned og = xb_add(&bar[XB_TOP], 1u);
            const unsigned tg = og / nx;
            if (og + 1u == (tg + 1u) * nx) xb_add(&bar[XB_TOPGEN], 1u);
            else XB_SPIN(xb_ld(&bar[XB_TOPGEN]) == tg, bar);
            __builtin_amdgcn_fence(__ATOMIC_ACQUIRE, "agent");
            xb_add(&bar[XB_XGEN(bx)], 1u);
            asm volatile("s_waitcnt vmcnt(0)" ::: "memory");
        } else {
            XB_SPIN(xb_ld(&bar[XB_XGEN(bx)]) == gen, bar);
            __builtin_amdgcn_fence(__ATOMIC_ACQUIRE, "agent");
            asm volatile("s_waitcnt vmcnt(0)" ::: "memory");
        }
    }
    __syncthreads();
}
constexpr int LDS_BYTES = 163840, MISC_OFF = 155648 + 320, CW_BAR = 4096;
__global__ void __launch_bounds__(512) mk_fwd(Ctx c_byval) {
    CtxP c = (CtxP)__builtin_amdgcn_kernarg_segment_ptr();
    extern __shared__ __attribute__((aligned(16))) unsigned char ldsraw[];
    float* lds = (float*)ldsraw;
    const int tid = threadIdx.x, bid = blockIdx.x, nblk = gridDim.x;
    volatile LAS unsigned* MISC = (volatile LAS unsigned*)((LAS unsigned char*)ldsraw + MISC_OFF);
    if (tid < 32) MISC[tid] = 0u;
    if ((tid & 63) == 0) ((volatile LAS int*)(unsigned long)WVTAB_OFF)[hw_slot()] = tid >> 6;
    __syncthreads();
    XcdBarrier bar = xcd_barrier_post((unsigned*)(c->ws + OFF_CTL) + CW_BAR, MISC + 8);
    s_p0(c, 0, 0, lds, bid, nblk);
    s_prenorm(c, 0, 0, lds, bid, nblk);
    xcd_barrier(bar);
    for (int slab_ = 0; slab_ < 2; ++slab_)
        for (int l_ = 0; l_ < NL; ++l_) {
            int l = l_, slab = slab_; asm volatile("" : "+s"(l), "+s"(slab));
            { const bf16_t* halo = (const bf16_t*)(c->ws + OFF_CARRY + l * CARRY_L + HALO_OFF); bf16_t* pp = (bf16_t*)(c->ws + OFF_P);
              for (int i = bid * 512 + otid(); i < NB * 3 * PP; i += nblk * 512) { const int b = i / (3 * PP), r = (i / PP) % 3, col = i % PP; pp[prow_off(b, r - 3) + col] = slab == 0 ? (bf16_t)0 : halo[i]; } }
            { pg8::Gemm g{(const bf16_t*)(c->ws + OFF_H), (const bf16_t*)(c->ws + OFF_WIN + l * WIN_L), MS, PP, D, D}; pg8::StaticOrder S; S.init(MS, PP, nblk, bid);
              pg8::EpiBf16<0> E{(bf16_t*)(c->ws + OFF_P) + 3 * PP, PP, nullptr, 0, 0, 1.f, 3};
              pg8::gemm_phase<pg8::EpiBf16<0>, pg8::StaticOrder, true, true, D, D, 0>((LAS unsigned char*)ldsraw, g, S, E); }
            xcd_barrier(bar);
            s_phase2(c, l, slab, lds, bid, nblk);
            xcd_barrier(bar);
            s_phaseSB(c, l, slab, lds, bid, nblk);
            xcd_barrier(bar);
            if (nblk == 256) s_phase3(c, l, slab, lds, bid);
            xcd_barrier(bar);
            { pg8::Gemm g{(const bf16_t*)(c->ws + OFF_P) + 3 * PP + ZA, (const bf16_t*)(c->ws + OFF_WOUT + l * WOUT_L), MS, 2 * D, DMIX / 2, PP}; pg8::StaticOrder S; S.init(MS, 2 * D, nblk, bid);
              pg8::EpiSplitK E{(bf16_t*)(c->ws + OFF_Y), (bf16_t*)(c->ws + OFF_Y2), D};
              pg8::gemm_phase<pg8::EpiSplitK, pg8::StaticOrder, true, true, DMIX / 2, PP, 3, DMIX / 2>((LAS unsigned char*)ldsraw, g, S, E); }
            xcd_barrier(bar);
            s_post(c, l, slab, lds, bid, nblk);
            if (l == 1 && slab == 0) s_prenorm(c, 0, 1, lds, bid, nblk);
            xcd_barrier(bar);
        }
}

extern "C" void kernel_launch(void* const* d_in, const int* in_sizes, int n_in, void* d_out, int out_size, void* d_ws, size_t ws_size, hipStream_t stream) {
    static int grid = 0;
    if (grid == 0) {
        int dev = 0, cus = 0, per_cu = 0;
        (void)hipGetDevice(&dev);
        (void)hipDeviceGetAttribute(&cus, hipDeviceAttributeMultiprocessorCount, dev);
        (void)hipFuncSetAttribute((const void*)mk_fwd, hipFuncAttributeMaxDynamicSharedMemorySize, LDS_BYTES);
        (void)hipOccupancyMaxActiveBlocksPerMultiprocessor(&per_cu, (const void*)mk_fwd, 512, LDS_BYTES);
        if (per_cu < 1) { fprintf(stderr, "kernel_launch: occupancy query says %d blocks/CU\n", per_cu); per_cu = 1; }
        grid = cus;
        if (grid != 256) fprintf(stderr, "kernel_launch: %d CUs (built for 256)\n", grid);
    }
    Ctx c{};
    const float** f = (const float**)&c;
    for (int i = 0; i < 28; ++i) f[i] = (const float*)d_in[i];
    c.out = (float*)d_out; c.ws = (unsigned char*)d_ws;
    (void)hipMemsetAsync(d_ws, 0, 1 * MiB, stream);
    void* args[] = {&c};
    hipError_t e = hipLaunchCooperativeKernel((const void*)mk_fwd, dim3(grid), dim3(512), args, LDS_BYTES, stream);
    if (e != hipSuccess) fprintf(stderr, "cooperative launch failed: %s (grid %d)\n", hipGetErrorString(e), grid);
}
```
